# Optimizing an MI355X kernel written in HIP

```python
import jax
import jax.numpy as jnp
from jax import lax
import numpy as np

D_MODEL = 1024
BATCH = 1
SEQ = 16384
DEPTH = 4

HEAD_DIM = 64
N_RET_HEADS = D_MODEL // (2 * HEAD_DIM)
N_DIL_HEADS = D_MODEL // (2 * HEAD_DIM)
N_NA_HEADS = D_MODEL // HEAD_DIM
RET_W = N_RET_HEADS * HEAD_DIM
DIL_W = N_DIL_HEADS * HEAD_DIM
NA_W = N_NA_HEADS * HEAD_DIM
EVEN_IN = 5 * RET_W + 3 * DIL_W
ODD_IN = 3 * NA_W
RET_CHUNK = 128
RET_DECAY_EXP0 = 5.0
ROPE_THETA = 10000.0
DIL_CONFIGS = ((128, 1), (512, 4), (2048, 16))
GRID_W = 64
NA_KH_MAX = 8
NA_KW = 16
N_EXPERTS = 32
TOP_K = 4
D_FF = D_MODEL
SWIGLU_LIMIT = 7.0
SWIGLU_ALPHA = 1.702
MOE_BLOCK = 128
LN_EPS = 1e-5
GN_EPS = 1e-6
NEG_INF = -1e30
DEEPNORM_ALPHA = (2.0 * DEPTH) ** 0.25
DEEPNORM_BETA = (8.0 * DEPTH) ** -0.25
N_EVEN = (DEPTH + 1) // 2
N_ODD = DEPTH // 2

kernel_name = "hybrid_retnet_longnet_natten_moe_encoder"


def layer_norm(x, g, b):
    xf = x.astype(jnp.float32)
    mu = xf.mean(-1, keepdims=True)
    var = jnp.square(xf - mu).mean(-1, keepdims=True)
    return ((xf - mu) * lax.rsqrt(var + LN_EPS) * g + b).astype(x.dtype)


def head_norm(x):
    xf = x.astype(jnp.float32)
    mu = xf.mean(-1, keepdims=True)
    var = jnp.square(xf - mu).mean(-1, keepdims=True)
    return (xf - mu) * lax.rsqrt(var + GN_EPS)


def rope_tables(T):
    pos = jnp.arange(T, dtype=jnp.float32)
    inv = ROPE_THETA ** (-jnp.arange(0, HEAD_DIM, 2, dtype=jnp.float32) / HEAD_DIM)
    ang = pos[:, None] * inv[None, :]
    return jnp.cos(ang), jnp.sin(ang)


def apply_rope(x, cos, sin):
    x1, x2 = jnp.split(x, 2, axis=-1)
    c = cos[None, :, None, :].astype(x.dtype)
    s = sin[None, :, None, :].astype(x.dtype)
    return jnp.concatenate([x1 * c - x2 * s, x2 * c + x1 * s], axis=-1)


def retention_one_direction(q, k, v, log_gamma, strict):
    b_, h_, t_, d_ = q.shape
    C = RET_CHUNK
    nc = t_ // C
    qc = q.reshape(b_, h_, nc, C, d_)
    kc = k.reshape(b_, h_, nc, C, d_)
    vc = v.reshape(b_, h_, nc, C, d_)
    idx = jnp.arange(C, dtype=jnp.float32)
    diff = idx[:, None] - idx[None, :]
    keep = (diff > 0) if strict else (diff >= 0)
    decay = jnp.where(keep, jnp.exp(log_gamma[:, None, None] * jnp.maximum(diff, 0.0)), 0.0)
    scores = jnp.einsum('bhncd,bhnmd->bhncm', qc, kc) * decay[None, :, None]
    intra = jnp.einsum('bhncm,bhnme->bhnce', scores, vc)
    zeta = jnp.exp(log_gamma[:, None] * (C - 1.0 - idx)[None, :])
    chunk_state = jnp.einsum('bhnmd,hm,bhnme->nbhde', kc, zeta, vc)
    chunk_decay = jnp.exp(log_gamma * C)[None, :, None, None]

    def step(R, S):
        return chunk_decay * R + S, R

    _, r_prev = lax.scan(step, jnp.zeros_like(chunk_state[0]), chunk_state)
    xi = jnp.exp(log_gamma[:, None] * (idx + 1.0)[None, :])
    cross = jnp.einsum('bhncd,nbhde->bhnce', qc, r_prev) * xi[None, :, None, :, None]
    return (intra + cross).reshape(b_, h_, t_, d_)


def retention_mixer(q, k, v, g_f, g_b, decay_logits, cos, sin):
    b_, t_, h_, d_ = q.shape
    q = apply_rope(q, cos, sin)
    k = apply_rope(k, cos, sin) * (HEAD_DIM ** -0.5)
    qf, kf, vf = [a.astype(jnp.float32).transpose(0, 2, 1, 3) for a in (q, k, v)]
    log_gamma = jax.nn.log_sigmoid(decay_logits.astype(jnp.float32))
    o_f = retention_one_direction(qf, kf, vf, log_gamma[0], strict=False)
    o_b = jnp.flip(retention_one_direction(jnp.flip(qf, 2), jnp.flip(kf, 2), jnp.flip(vf, 2),
                                           log_gamma[1], strict=True), 2)
    o_f = head_norm(o_f.transpose(0, 2, 1, 3))
    o_b = head_norm(o_b.transpose(0, 2, 1, 3))
    y = jax.nn.silu(g_f.astype(jnp.float32)) * o_f + jax.nn.silu(g_b.astype(jnp.float32)) * o_b
    return y.reshape(b_, t_, h_ * d_).astype(q.dtype)


def dilated_branch(q, k, v, dil, half):
    b_, h_, t_, d_ = q.shape
    L = t_ // dil
    nb = -(-L // half)
    Lp = nb * half

    def classes(a):
        return a.reshape(b_, h_, L, dil, d_).transpose(0, 1, 3, 2, 4)

    qr, kr, vr = classes(q), classes(k), classes(v)
    qb = jnp.pad(qr, ((0, 0), (0, 0), (0, 0), (0, Lp - L), (0, 0))).reshape(b_, h_, dil, nb, half, d_)

    def windows(a):
        ap = jnp.pad(a, ((0, 0), (0, 0), (0, 0), (half, Lp - L + half), (0, 0)))
        ap = ap.reshape(b_, h_, dil, nb + 2, half, d_)
        return jnp.concatenate([ap[:, :, :, :-2], ap[:, :, :, 1:-1], ap[:, :, :, 2:]], axis=4)

    kw, vw = windows(kr), windows(vr)
    qi = jnp.arange(nb)[:, None, None] * half + jnp.arange(half)[None, :, None]
    ki = jnp.arange(nb)[:, None, None] * half - half + jnp.arange(3 * half)[None, None, :]
    valid = (jnp.abs(ki - qi) <= half) & (ki >= 0) & (ki < L)
    s = jnp.einsum('bhrnqd,bhrnkd->bhrnqk', qb, kw).astype(jnp.float32)
    s = jnp.where(valid, s, NEG_INF)
    m = s.max(-1, keepdims=True)
    p = jnp.exp(s - m)
    den = p.sum(-1, keepdims=True)
    o = jnp.einsum('bhrnqk,bhrnkd->bhrnqd', (p / den).astype(v.dtype), vw)
    lse = (m + jnp.log(den))[..., 0]
    o = o.reshape(b_, h_, dil, Lp, d_)[:, :, :, :L].transpose(0, 1, 3, 2, 4).reshape(b_, h_, t_, d_)
    lse = lse.reshape(b_, h_, dil, Lp)[..., :L].transpose(0, 1, 3, 2).reshape(b_, h_, t_)
    return o, lse


def dilated_mixer(q, k, v, cos, sin):
    b_, t_, h_, d_ = q.shape
    q = (apply_rope(q, cos, sin) * (HEAD_DIM ** -0.5)).transpose(0, 2, 1, 3)
    k = apply_rope(k, cos, sin).transpose(0, 2, 1, 3)
    v = v.transpose(0, 2, 1, 3)
    outs, lses = [], []
    for window, dil in DIL_CONFIGS:
        o, lse = dilated_branch(q, k, v, dil, window // (2 * dil))
        outs.append(o)
        lses.append(lse)
    wts = jax.nn.softmax(jnp.stack(lses, 0), axis=0).astype(v.dtype)
    o = jnp.einsum('gbht,gbhtd->bthd', wts, jnp.stack(outs, 0))
    return o.reshape(b_, t_, h_ * d_)


def neighbourhood_attention(q, k, v, rpb):
    b_, t_, h_, d_ = q.shape
    rows = t_ // GRID_W
    kh = min(NA_KH_MAX, rows)
    qg = q.reshape(b_, rows, GRID_W, h_, d_) * (HEAD_DIM ** -0.5)
    kg = k.reshape(b_, rows, GRID_W, h_, d_)
    vg = v.reshape(b_, rows, GRID_W, h_, d_)
    cols = jnp.arange(GRID_W)
    col_start = jnp.clip(cols - NA_KW // 2, 0, GRID_W - NA_KW)
    col_idx = col_start[:, None] + jnp.arange(NA_KW)[None, :]
    col_off = col_idx - cols[:, None] + (NA_KW - 1)
    rpb_cols = rpb[:, :, col_off]

    def one_row(r):
        r0 = jnp.clip(r - kh // 2, 0, rows - kh)
        kb = lax.dynamic_slice_in_dim(kg, r0, kh, axis=1)[:, :, col_idx]
        vb = lax.dynamic_slice_in_dim(vg, r0, kh, axis=1)[:, :, col_idx]
        row_off = r0 + jnp.arange(kh) - r + (NA_KH_MAX - 1)
        bias = rpb_cols[:, row_off].transpose(0, 2, 1, 3)
        q_r = lax.dynamic_index_in_dim(qg, r, axis=1, keepdims=False)
        s = jnp.einsum('bqhd,biqjhd->bhqij', q_r, kb).astype(jnp.float32) + bias[None]
        p = jax.nn.softmax(s.reshape(b_, h_, GRID_W, kh * NA_KW), axis=-1)
        p = p.reshape(s.shape).astype(v.dtype)
        return jnp.einsum('bhqij,biqjhd->bqhd', p, vb)

    out = lax.map(one_row, jnp.arange(rows))
    return out.transpose(1, 0, 2, 3, 4).reshape(b_, t_, h_ * d_)


def even_mixer(x, w_in, w_out, decay_logits, cos, sin):
    b_, t_, _ = x.shape
    h = jnp.einsum('btd,de->bte', x, w_in)
    cuts = [RET_W, 2 * RET_W, 3 * RET_W, 4 * RET_W, 5 * RET_W, 5 * RET_W + DIL_W, 5 * RET_W + 2 * DIL_W]
    rq, rk, rv, rgf, rgb, dq, dk, dv = jnp.split(h, cuts, axis=-1)
    ret_heads = lambda a: a.reshape(b_, t_, N_RET_HEADS, HEAD_DIM)
    dil_heads = lambda a: a.reshape(b_, t_, N_DIL_HEADS, HEAD_DIM)
    y_ret = retention_mixer(ret_heads(rq), ret_heads(rk), ret_heads(rv), ret_heads(rgf), ret_heads(rgb),
                            decay_logits, cos, sin)
    y_dil = dilated_mixer(dil_heads(dq), dil_heads(dk), dil_heads(dv), cos, sin)
    return jnp.einsum('bte,ed->btd', jnp.concatenate([y_ret, y_dil], axis=-1), w_out)


def odd_mixer(x, w_in, w_out, rpb):
    b_, t_, _ = x.shape
    h = jnp.einsum('btd,de->bte', x, w_in)
    q, k, v = [a.reshape(b_, t_, N_NA_HEADS, HEAD_DIM) for a in jnp.split(h, 3, axis=-1)]
    return jnp.einsum('bte,ed->btd', neighbourhood_attention(q, k, v, rpb), w_out)


def moe(x2d, router_w, router_b, w_up, b_up, w_down, b_down):
    n_tok, d_ = x2d.shape
    logits = (x2d @ router_w + router_b).astype(jnp.float32)
    top_v, top_i = lax.top_k(logits, TOP_K)
    gates = jax.nn.softmax(top_v, axis=-1).astype(x2d.dtype)
    n_slot = n_tok * TOP_K
    flat_e = top_i.reshape(-1).astype(jnp.int32)
    flat_g = gates.reshape(-1)
    flat_tok = jnp.arange(n_slot, dtype=jnp.int32) // TOP_K
    order = jnp.argsort(flat_e)
    se = flat_e[order]
    counts = jnp.bincount(flat_e, length=N_EXPERTS).astype(jnp.int32)
    start = jnp.cumsum(counts) - counts
    pcounts = (counts + MOE_BLOCK - 1) // MOE_BLOCK * MOE_BLOCK
    pend = jnp.cumsum(pcounts)
    pstart = pend - pcounts
    dest = pstart[se] + (jnp.arange(n_slot, dtype=jnp.int32) - start[se])
    n_pad = n_slot + N_EXPERTS * MOE_BLOCK
    n_blk = n_pad // MOE_BLOCK
    slot_tok = jnp.full((n_pad,), n_tok, dtype=jnp.int32).at[dest].set(flat_tok[order])
    slot_gate = jnp.zeros((n_pad,), x2d.dtype).at[dest].set(flat_g[order])
    blk_e = jnp.minimum(jnp.searchsorted(pend, jnp.arange(n_blk, dtype=jnp.int32) * MOE_BLOCK, side='right'),
                        N_EXPERTS - 1)
    x_pad = jnp.concatenate([x2d, jnp.zeros((1, d_), x2d.dtype)], axis=0)

    def block(args):
        tok, g, e = args
        h = x_pad[tok] @ w_up[e] + b_up[e]
        x_glu = jnp.minimum(h[:, 0::2], SWIGLU_LIMIT)
        x_lin = jnp.clip(h[:, 1::2], -SWIGLU_LIMIT, SWIGLU_LIMIT)
        act = x_glu * jax.nn.sigmoid(SWIGLU_ALPHA * x_glu) * (x_lin + 1.0)
        return (act @ w_down[e] + b_down[e]) * g[:, None]

    out = lax.map(block, (slot_tok.reshape(n_blk, MOE_BLOCK), slot_gate.reshape(n_blk, MOE_BLOCK), blk_e))
    y = jnp.zeros((n_tok + 1, d_), x2d.dtype).at[slot_tok].add(out.reshape(n_pad, d_))
    return y[:n_tok]


def setup_inputs(seed: int = 0) -> dict:
    key = jax.random.key(seed)
    ks = jax.random.split(key, 16)
    nrm = lambda k, shape, scale: jax.random.normal(k, shape, jnp.float32) * scale
    base_logit = jnp.log(2.0 ** (RET_DECAY_EXP0 + jnp.arange(N_RET_HEADS, dtype=jnp.float32)) - 1.0)
    return {
        'x': nrm(ks[0], (BATCH, SEQ, D_MODEL), 1.0),
        'ab_w_in': nrm(ks[1], (N_EVEN, D_MODEL, EVEN_IN), D_MODEL ** -0.5),
        'ab_w_out': nrm(ks[2], (N_EVEN, RET_W + DIL_W, D_MODEL), DEEPNORM_BETA * (RET_W + DIL_W) ** -0.5),
        'ret_decay': base_logit[None, None, :] + nrm(ks[3], (N_EVEN, 2, N_RET_HEADS), 0.1),
        'c_w_in': nrm(ks[4], (N_ODD, D_MODEL, ODD_IN), D_MODEL ** -0.5),
        'c_w_out': nrm(ks[5], (N_ODD, NA_W, D_MODEL), DEEPNORM_BETA * NA_W ** -0.5),
        'c_rpb': nrm(ks[6], (N_ODD, N_NA_HEADS, 2 * NA_KH_MAX - 1, 2 * NA_KW - 1), 0.02),
        'ln_g': 1.0 + nrm(ks[7], (DEPTH, 2, D_MODEL), 0.02),
        'ln_b': nrm(ks[8], (DEPTH, 2, D_MODEL), 0.02),
        'router_w': nrm(ks[9], (DEPTH, D_MODEL, N_EXPERTS), D_MODEL ** -0.5),
        'router_b': nrm(ks[10], (DEPTH, N_EXPERTS), 0.01),
        'exp_w_up': nrm(ks[11], (DEPTH, N_EXPERTS, D_MODEL, 2 * D_FF), D_MODEL ** -0.5),
        'exp_b_up': nrm(ks[12], (DEPTH, N_EXPERTS, 2 * D_FF), 0.01),
        'exp_w_down': nrm(ks[13], (DEPTH, N_EXPERTS, D_FF, D_MODEL), DEEPNORM_BETA * D_FF ** -0.5),
        'exp_b_down': nrm(ks[14], (DEPTH, N_EXPERTS, D_MODEL), 0.01),
    }


def reference(x, ab_w_in, ab_w_out, ret_decay, c_w_in, c_w_out, c_rpb, ln_g, ln_b,
              router_w, router_b, exp_w_up, exp_b_up, exp_w_down, exp_b_down):
    b_, t_, d_ = x.shape
    cos, sin = rope_tables(t_)
    for layer in range(DEPTH):
        j = layer // 2
        if layer % 2 == 0:
            mix = even_mixer(x, ab_w_in[j], ab_w_out[j], ret_decay[j], cos, sin)
        else:
            mix = odd_mixer(x, c_w_in[j], c_w_out[j], c_rpb[j])
        x = layer_norm(DEEPNORM_ALPHA * x + mix, ln_g[layer, 0], ln_b[layer, 0])
        ffn = moe(x.reshape(b_ * t_, d_), router_w[layer], router_b[layer], exp_w_up[layer],
                  exp_b_up[layer], exp_w_down[layer], exp_b_down[layer]).reshape(b_, t_, d_)
        x = layer_norm(DEEPNORM_ALPHA * x + ffn, ln_g[layer, 1], ln_b[layer, 1])
    return x
```

```cpp
#include <hip/hip_runtime.h>
#include <cstdio>
#include <cstdint>

#ifndef N_LAUNCH_MODE
#define N_LAUNCH_MODE 0
#endif

#define GAS __attribute__((address_space(1)))
#define LAS __attribute__((address_space(3)))
typedef unsigned short bf16;
typedef short bf16x8 __attribute__((ext_vector_type(8)));
typedef float f32x4 __attribute__((ext_vector_type(4)));
typedef float f32x2 __attribute__((ext_vector_type(2)));
typedef unsigned u32x4 __attribute__((ext_vector_type(4)));
typedef unsigned u32x2 __attribute__((ext_vector_type(2)));

constexpr int T = 16384, D = 1024, DEPTH = 4, HD = 64, NEXP = 32, TOPK = 4;
constexpr int EVEN_IN = 4096, ODD_IN = 3072;
constexpr int NPAD = T * TOPK + NEXP * 256;
constexpr int MAXTILES = NPAD / 256;
constexpr float LN_EPS = 1e-5f, GN_EPS = 1e-6f;
constexpr float ALPHA = 1.681792830507429f;
constexpr int NWAVES = 8, NTHR = 512, GRID = 256;

constexpr size_t MiB = 1u << 20;
constexpr size_t WS_CTL = 0, CTL_ZERO_BYTES = 1 * MiB;
constexpr size_t WS_COS = 1 * MiB, WS_SIN = 3 * MiB;
constexpr size_t WS_CNT = 5 * MiB;
constexpr size_t WS_TOPE = 6 * MiB, WS_GATE = 7 * MiB, WS_LRANK = 8 * MiB, WS_SLOT = 9 * MiB;
constexpr size_t WS_TILES = 10 * MiB;
constexpr size_t WS_WIN_E = 16 * MiB, WS_WOUT_E = 32 * MiB, WS_WIN_O = 36 * MiB, WS_WOUT_O = 48 * MiB;
constexpr size_t WS_WUP = 64 * MiB, WS_WDN = 576 * MiB;
constexpr size_t WS_X = 832 * MiB, WS_XB = 896 * MiB, WS_H = 928 * MiB, WS_Y = 1056 * MiB, WS_U = 1088 * MiB;
constexpr size_t WS_X1 = 1152 * MiB, WS_X1B = 1216 * MiB, WS_XPERM = 1248 * MiB, WS_ACT = 1392 * MiB, WS_OSLOT = 1536 * MiB;
constexpr size_t WS_RS = 1680 * MiB, WS_RR = 1712 * MiB, WS_END = 1744 * MiB;
static_assert((size_t)NPAD * 1024 * 2 <= 144 * MiB, "slot buffers");
constexpr int CW_BAR = 4096;

constexpr int RING_BYTES = 131072, MISC_OFF = 131072, LDS_BYTES = 147456;

__device__ __forceinline__ unsigned f2bf(float f) { unsigned u = __builtin_bit_cast(unsigned, f); return (u + 0x7fffu + ((u >> 16) & 1u)) >> 16; }
__device__ __forceinline__ unsigned pk2(float lo, float hi) { return f2bf(lo) | (f2bf(hi) << 16); }
__device__ __forceinline__ float bflo(unsigned w) { return __builtin_bit_cast(float, w << 16); }
__device__ __forceinline__ float bfhi(unsigned w) { return __builtin_bit_cast(float, w & 0xffff0000u); }
__device__ __forceinline__ unsigned cvt_pk_bf16(float lo, float hi) { unsigned r; asm volatile("v_cvt_pk_bf16_f32 %0, %1, %2" : "=v"(r) : "v"(lo), "v"(hi)); return r; }
__device__ __forceinline__ float wave_sum(float v) {
#pragma unroll
    for (int o = 1; o < 64; o <<= 1) v += __shfl_xor(v, o);
    return v;
}
__device__ __forceinline__ void unpack8(const u32x4 w, float* f) {
    f[0] = bflo(w.x); f[1] = bfhi(w.x); f[2] = bflo(w.y); f[3] = bfhi(w.y); f[4] = bflo(w.z); f[5] = bfhi(w.z); f[6] = bflo(w.w); f[7] = bfhi(w.w);
}
__device__ __forceinline__ float log2_gamma(float logit) { return -log1pf(expf(-logit)) * 1.4426950408889634f; }
__device__ __forceinline__ float sigmoidf_(float z) { return 1.0f / (1.0f + __expf(-z)); }

#define XB_TMO      128
#define XB_XCNT(j)  (256  + 64 * (j))
#define XB_XSUB(j)  (1280 + 64 * (j))
#define XB_XGEN(j)  (2304 + 64 * (j))
#define XB_TOP      3328
#define XB_TOPGEN   3392
#define XCD_BAR_WORDS 3456
#define XB_SPIN_CAP (1u << 18)

__device__ __forceinline__ unsigned xb_ld(unsigned* p)              { return __hip_atomic_load(p, __ATOMIC_RELAXED, __HIP_MEMORY_SCOPE_AGENT); }
__device__ __forceinline__ unsigned xb_add(unsigned* p, unsigned v) { return __hip_atomic_fetch_add(p, v, __ATOMIC_RELAXED, __HIP_MEMORY_SCOPE_AGENT); }
__device__ __forceinline__ unsigned xb_xcc_id() { return (unsigned)__builtin_amdgcn_s_getreg((3 << 11) | 20) & 0xFu; }
#define XB_SPIN(cond, bar) do { unsigned _sp = 0; while (cond) { __builtin_amdgcn_s_sleep(1); \
    if ((++_sp & 255u) == 0u) { if (xb_ld(&(bar)[XB_TMO])) break; if (_sp > XB_SPIN_CAP) { atomicAdd(&(bar)[XB_TMO], 1u); break; } } } } while (0)

struct XcdBarrier { unsigned* bar; unsigned x; volatile LAS unsigned* st; };

__device__ __forceinline__ XcdBarrier xcd_barrier_post(unsigned* bar, volatile LAS unsigned* st) {
    XcdBarrier b; b.bar = bar; b.x = xb_xcc_id(); b.st = st;
    if (threadIdx.x == 0) (void)xb_add(&bar[XB_XCNT(b.x)], 1u);
    return b;
}
__device__ __forceinline__ void xcd_barrier_complete(unsigned* bar, unsigned x, unsigned& nloc, unsigned& nx) {
    const unsigned G = gridDim.x * gridDim.y * gridDim.z;
    unsigned sum, cnt, mine, sp = 0u;
    for (;;) {
        sum = 0u; cnt = 0u; mine = 0u;
#pragma unroll
        for (unsigned j = 0; j < 16; ++j) { const unsigned c = xb_ld(&bar[XB_XCNT(j)]); sum += c; cnt += (c > 0u) ? 1u : 0u; mine = (j == x) ? c : mine; }
        if (sum == G) break;
        __builtin_amdgcn_s_sleep(1);
        if ((++sp & 255u) == 0u) { if (xb_ld(&bar[XB_TMO])) break; if (sp > XB_SPIN_CAP) { atomicAdd(&bar[XB_TMO], 1u); break; } }
    }
    nloc = mine > 0u ? mine : 1u; nx = cnt > 0u ? cnt : 1u;
}
__device__ __forceinline__ void xcd_barrier(const XcdBarrier& b0) {
    XcdBarrier b = b0; asm volatile("" : "+s"(b.bar)); asm volatile("" : "+s"(b.x));
    asm volatile("s_waitcnt vmcnt(0)" ::: "memory");
    __syncthreads();
    if (threadIdx.x == 0) {
        unsigned* bar = b.bar;
        __builtin_amdgcn_s_waitcnt(0);
        unsigned nloc = b.st[0], nx = b.st[1];
        if (nloc == 0u) { xcd_barrier_complete(bar, b.x, nloc, nx); b.st[0] = nloc; b.st[1] = nx; }
        const unsigned old = xb_add(&bar[XB_XSUB(b.x)], 1u);
        const unsigned gen = old / nloc;
        if (old + 1u == (gen + 1u) * nloc) {
            __builtin_amdgcn_fence(__ATOMIC_RELEASE, "agent");
            asm volatile("s_waitcnt vmcnt(0)" ::: "memory");
            const unsigned og = xb_add(&bar[XB_TOP], 1u);
            const unsigned tg = og / nx;
            if (og + 1u == (tg + 1u) * nx) xb_add(&bar[XB_TOPGEN], 1u);
            else XB_SPIN(xb_ld(&bar[XB_TOPGEN]) == tg, bar);
            __builtin_amdgcn_fence(__ATOMIC_ACQUIRE, "agent");
            xb_add(&bar[XB_XGEN(b.x)], 1u);
            asm volatile("s_waitcnt vmcnt(0)" ::: "memory");
        } else {
            XB_SPIN(xb_ld(&bar[XB_XGEN(b.x)]) == gen, bar);
            __builtin_amdgcn_fence(__ATOMIC_ACQUIRE, "agent");
            asm volatile("s_waitcnt vmcnt(0)" ::: "memory");
        }
    }
    __syncthreads();
}

namespace pg8 {
constexpr int BM = 256, BK = 64, HALF = 128, HTB = HALF * BK * 2, STAGE_BYTES = 8 * HTB, NXCD = 8, WGM = 8, KD = 1024;
constexpr size_t TILE_BYTES = (size_t)BM * KD * 2;

__host__ __device__ __forceinline__ int lds_byte(int r, int c) { const int st = (r >> 4) * 2 + (c >> 5), rr = r & 15, cc = c & 31, ob = rr * 64 + cc * 2; return st * 1024 + (ob ^ (((ob >> 9) & 1) << 5)); }
__host__ __device__ __forceinline__ void stage_rc(int b, int& R, int& C) { const int st = b / 1024, sb = b % 1024, swz = sb ^ (((sb >> 9) & 1) << 5); R = (st >> 1) * 16 + swz / 64; C = (st & 1) * 32 + (swz % 64) / 2; }
__host__ __device__ __forceinline__ int perm32(int rho) { const int n = rho >> 4, i = rho & 15; return 8 * (i >> 2) + 4 * n + (i & 3); }

struct Unit { int pm, pn, e; };

__device__ __forceinline__ bool order_next(int i, int G, int c, int nM, int nN, int& pm, int& pn) {
    const int nwg = nM * nN; const long L = (long)i * G + c; if (L >= nwg) return false;
    int wgid = (int)L; { const int q = nwg / NXCD, r = nwg % NXCD, xcd = wgid % NXCD, off = wgid / NXCD; wgid = (xcd < r ? xcd * (q + 1) : r * (q + 1) + (xcd - r) * q) + off; }
    const int nig = WGM * nN, gid = wgid / nig, fm = gid * WGM, gsz = (nM - fm) < WGM ? (nM - fm) : WGM;
    pm = fm + ((wgid % nig) % gsz); pn = (wgid % nig) / gsz; return true;
}
struct DenseOrder {
    int nM, nN, G, c; const char* A; const char* B;
    __device__ __forceinline__ bool next(int i, Unit& u) const { u.e = 0; return order_next(i, G, c, nM, nN, u.pm, u.pn); }
    __device__ __forceinline__ const char* a_base(const Unit& u) const { return A + (size_t)u.pm * TILE_BYTES; }
    __device__ __forceinline__ const char* b_base(const Unit& u) const { return B + (size_t)u.pn * TILE_BYTES; }
};
struct GroupOrder {
    int nM, nN, G, c; const char* A; const char* B; size_t bstride; const LAS int* tile_e;
    __device__ __forceinline__ bool next(int i, Unit& u) const { if (!order_next(i, G, c, nM, nN, u.pm, u.pn)) return false; u.e = tile_e[u.pm]; return true; }
    __device__ __forceinline__ const char* a_base(const Unit& u) const { return A + (size_t)u.pm * TILE_BYTES; }
    __device__ __forceinline__ const char* b_base(const Unit& u) const { return B + (size_t)u.e * bstride + (size_t)u.pn * TILE_BYTES; }
};

__device__ __forceinline__ void store8(bf16* p, const f32x4 v0, const f32x4 v1) {
    u32x4 w; w.x = cvt_pk_bf16(v0[0], v0[1]); w.y = cvt_pk_bf16(v0[2], v0[3]); w.z = cvt_pk_bf16(v1[0], v1[1]); w.w = cvt_pk_bf16(v1[2], v1[3]); *(u32x4*)p = w;
}
struct EpiInEven {
    static constexpr bool PERM = true, AFTER_DRAIN = false;
    bf16* H; const float* cs; const float* sn;
    __device__ __forceinline__ void operator()(const f32x4 (&acc)[2][2][4][2], const Unit& u, int wr, int wc, int fr, int fq) const {
        const int pn = u.pn; const bool rope = (pn < 4) || (pn >= 10 && pn < 14);
        const float sc = ((pn >= 2 && pn < 4) || (pn >= 10 && pn < 12)) ? 0.125f : 1.0f;
        const int row0 = u.pm * BM + wr * 64 + fr;
        if (rope) {
#pragma unroll
            for (int ai = 0; ai < 2; ++ai)
#pragma unroll
                for (int m = 0; m < 4; ++m) {
                    const int row = row0 + ai * HALF + m * 16;
                    const float* cr = cs + (size_t)row * 32 + 8 * fq; const float* sr = sn + (size_t)row * 32 + 8 * fq;
                    const f32x4 c0 = *(const f32x4*)cr, c1 = *(const f32x4*)(cr + 4), s0 = *(const f32x4*)sr, s1 = *(const f32x4*)(sr + 4);
                    const f32x4 x1a = acc[ai][0][m][0], x1b = acc[ai][0][m][1], x2a = acc[ai][1][m][0], x2b = acc[ai][1][m][1];
                    const f32x4 o1a = (x1a * c0 - x2a * s0) * sc, o1b = (x1b * c1 - x2b * s1) * sc, o2a = (x2a * c0 + x1a * s0) * sc, o2b = (x2b * c1 + x1b * s1) * sc;
                    bf16* rowp = H + (size_t)row * EVEN_IN + pn * BM + wc * 64 + 8 * fq;
                    store8(rowp, o1a, o1b); store8(rowp + 32, o2a, o2b);
                }
        } else {
#pragma unroll
            for (int ai = 0; ai < 2; ++ai)
#pragma unroll
                for (int m = 0; m < 4; ++m) {
                    bf16* rowp = H + (size_t)(row0 + ai * HALF + m * 16) * EVEN_IN + pn * BM + wc * 32 + 8 * fq;
#pragma unroll
                    for (int bj = 0; bj < 2; ++bj) store8(rowp + bj * HALF, acc[ai][bj][m][0], acc[ai][bj][m][1]);
                }
        }
    }
};
struct EpiInOdd {
    static constexpr bool PERM = true, AFTER_DRAIN = false;
    bf16* H;
    __device__ __forceinline__ void operator()(const f32x4 (&acc)[2][2][4][2], const Unit& u, int wr, int wc, int fr, int fq) const {
        const float sc = (u.pn < 4) ? 0.125f : 1.0f;
        const int row0 = u.pm * BM + wr * 64 + fr;
#pragma unroll
        for (int ai = 0; ai < 2; ++ai)
#pragma unroll
            for (int m = 0; m < 4; ++m) {
                bf16* rowp = H + (size_t)(row0 + ai * HALF + m * 16) * ODD_IN + u.pn * BM + wc * 32 + 8 * fq;
#pragma unroll
                for (int bj = 0; bj < 2; ++bj) store8(rowp + bj * HALF, acc[ai][bj][m][0] * sc, acc[ai][bj][m][1] * sc);
            }
    }
};
struct EpiOut {
    static constexpr bool PERM = false, AFTER_DRAIN = false;
    const float* Xres; float* U;
    __device__ __forceinline__ void operator()(const f32x4 (&acc)[2][2][4][2], const Unit& u, int wr, int wc, int fr, int fq) const {
        const int row0 = u.pm * BM + wr * 64 + fr, col0 = u.pn * BM + wc * 32 + 4 * fq;
#pragma unroll
        for (int ai = 0; ai < 2; ++ai)
#pragma unroll
            for (int m = 0; m < 4; ++m) {
                const size_t off = (size_t)(row0 + ai * HALF + m * 16) * D + col0;
#pragma unroll
                for (int bj = 0; bj < 2; ++bj)
#pragma unroll
                    for (int n = 0; n < 2; ++n) { const f32x4 xr = *(const f32x4*)(Xres + off + bj * HALF + n * 16); *(f32x4*)(U + off + bj * HALF + n * 16) = xr * ALPHA + acc[ai][bj][m][n]; }
            }
    }
};
struct EpiUp {
    static constexpr bool PERM = true, AFTER_DRAIN = false;
    bf16* Act; const float* bup;
    __device__ __forceinline__ void operator()(const f32x4 (&acc)[2][2][4][2], const Unit& u, int wr, int wc, int fr, int fq) const {
        const int row0 = u.pm * BM + wr * 64 + fr, f0 = u.pn * HALF + wc * 32 + 8 * fq;
        const float* bp = bup + (size_t)u.e * 2048 + 2 * f0;
        f32x4 bb[4];
#pragma unroll
        for (int i = 0; i < 4; ++i) bb[i] = *(const f32x4*)(bp + 4 * i);
#pragma unroll
        for (int ai = 0; ai < 2; ++ai)
#pragma unroll
            for (int m = 0; m < 4; ++m) {
                f32x4 o[2];
#pragma unroll
                for (int n = 0; n < 2; ++n) {
                    const f32x4 g = acc[ai][0][m][n], l = acc[ai][1][m][n];
#pragma unroll
                    for (int j = 0; j < 4; ++j) {
                        const float bg = bb[2 * n + (j >> 1)][(j & 1) * 2], bl = bb[2 * n + (j >> 1)][(j & 1) * 2 + 1];
                        const float xg = fminf(g[j] + bg, 7.0f), xl = fminf(fmaxf(l[j] + bl, -7.0f), 7.0f);
                        o[n][j] = xg * sigmoidf_(1.702f * xg) * (xl + 1.0f);
                    }
                }
                store8(Act + (size_t)(row0 + ai * HALF + m * 16) * 1024 + f0, o[0], o[1]);
            }
    }
};
struct EpiDown {
    static constexpr bool PERM = true, AFTER_DRAIN = false;
    bf16* O; const float* bdn;
    __device__ __forceinline__ void operator()(const f32x4 (&acc)[2][2][4][2], const Unit& u, int wr, int wc, int fr, int fq) const {
        const int row0 = u.pm * BM + wr * 64 + fr, col0 = u.pn * BM + wc * 32 + 8 * fq;
        const float* bp = bdn + (size_t)u.e * 1024 + col0;
        f32x4 bv[2][2];
#pragma unroll
        for (int bj = 0; bj < 2; ++bj)
#pragma unroll
            for (int n = 0; n < 2; ++n) bv[bj][n] = *(const f32x4*)(bp + bj * HALF + 4 * n);
#pragma unroll
        for (int ai = 0; ai < 2; ++ai)
#pragma unroll
            for (int m = 0; m < 4; ++m) {
                bf16* rowp = O + (size_t)(row0 + ai * HALF + m * 16) * 1024 + col0;
#pragma unroll
                for (int bj = 0; bj < 2; ++bj) store8(rowp + bj * HALF, acc[ai][bj][m][0] + bv[bj][0], acc[ai][bj][m][1] + bv[bj][1]);
            }
    }
};

template <class Epi, class Sched, bool ALIGN_EPI = true, bool SP2 = true>
__device__ __forceinline__ void gemm_phase(LAS unsigned char* lds, const Sched& S, const Epi& E, const int tid) {
    const int wid = __builtin_amdgcn_readfirstlane(tid >> 6), lane = tid & 63, wr = wid >> 2, wc = wid & 3, fr = lane & 15, fq = lane >> 4;
    constexpr int K = KD, nt = K / BK;
    unsigned voffA[2], voffB[2];
#pragma unroll
    for (int i = 0; i < 2; ++i) { int R, C; stage_rc(tid * 16 + i * 8192, R, C); const int Rb = Epi::PERM ? ((R & ~31) + perm32(R & 31)) : R;
        voffA[i] = (unsigned)(R * K + C) * 2u; voffB[i] = (unsigned)(Rb * K + C) * 2u; }
    const size_t kstep = (size_t)(BK * 2);
    const size_t hstep = (size_t)HALF * K * 2;
    const unsigned ldsw = (unsigned)wid * 1024u;
    const int aoff = lds_byte(wr * 64 + fr, fq * 8), boff = lds_byte(wc * 32 + fr, fq * 8);
#define PG8_SA(b, h) (((b) * 2 + (h)) * HTB)
#define PG8_SB(b, h) ((4 + (b) * 2 + (h)) * HTB)
#define PG8_STAGE(bufoff, gbase, voff) do { _Pragma("unroll") for (int _i = 0; _i < 2; ++_i) \
        __builtin_amdgcn_global_load_lds((const unsigned*)((const char*)(gbase) + (voff)[_i]), (LAS unsigned*)(lds + (bufoff) + ldsw + _i * 8192), 16, 0, 0); } while (0)
#define PG8_LDA(dst, b, h) do { _Pragma("unroll") for (int m = 0; m < 4; ++m) _Pragma("unroll") for (int k = 0; k < 2; ++k) dst[m][k] = *(const LAS bf16x8*)(lds + PG8_SA(b, h) + aoff + m * 2048 + k * 1024); } while (0)
#define PG8_LDB(dst, b, h) do { _Pragma("unroll") for (int n = 0; n < 2; ++n) _Pragma("unroll") for (int k = 0; k < 2; ++k) dst[n][k] = *(const LAS bf16x8*)(lds + PG8_SB(b, h) + boff + n * 2048 + k * 1024); } while (0)
#define PG8_MMA(ai, bj, At, Bt) do { __builtin_amdgcn_s_setprio(1); _Pragma("unroll") for (int m = 0; m < 4; ++m) _Pragma("unroll") for (int n = 0; n < 2; ++n) _Pragma("unroll") for (int k = 0; k < 2; ++k) \
        acc[ai][bj][m][n] = __builtin_amdgcn_mfma_f32_16x16x32_bf16(Bt[n][k], At[m][k], acc[ai][bj][m][n], 0, 0, 0); __builtin_amdgcn_s_setprio(0); } while (0)
#define PG8_WAIT_V(n) asm volatile("s_waitcnt vmcnt(" #n ")" ::: "memory")
#define PG8_WAIT_L(n) asm volatile("s_waitcnt lgkmcnt(" #n ")" ::: "memory")
#define PG8_BAR __builtin_amdgcn_s_barrier()
#define PG8_SCHED __builtin_amdgcn_sched_barrier(0)
    Unit cur, nxt; int ui = 0;
    if (!S.next(0, cur)) return;
    f32x4 acc[2][2][4][2];
#pragma unroll
    for (int a = 0; a < 2; ++a)
#pragma unroll
        for (int b = 0; b < 2; ++b)
#pragma unroll
            for (int m = 0; m < 4; ++m)
#pragma unroll
                for (int n = 0; n < 2; ++n) acc[a][b][m][n] = (f32x4){0.f, 0.f, 0.f, 0.f};
    bf16x8 At[4][2], B0[2][2], B1[2][2];
    const char* cA = S.a_base(cur); const char* cB = S.b_base(cur);
    if constexpr (SP2) {
        PG8_STAGE(PG8_SB(0, 0), cB, voffB); PG8_STAGE(PG8_SB(0, 1), cB + hstep, voffB); PG8_STAGE(PG8_SA(0, 0), cA, voffA); PG8_STAGE(PG8_SA(0, 1), cA + hstep, voffA);
        if (wr == 1) PG8_BAR;
        PG8_WAIT_V(2); PG8_BAR;
        PG8_STAGE(PG8_SB(1, 0), cB + kstep, voffB); PG8_STAGE(PG8_SA(1, 0), cA + kstep, voffA); PG8_STAGE(PG8_SB(1, 1), cB + hstep + kstep, voffB);
        PG8_WAIT_V(6); PG8_BAR;
    } else {
        PG8_STAGE(PG8_SB(0, 0), cB, voffB); PG8_STAGE(PG8_SA(0, 0), cA, voffA); PG8_STAGE(PG8_SB(0, 1), cB + hstep, voffB); PG8_STAGE(PG8_SA(0, 1), cA + hstep, voffA);
        if (wr == 1) PG8_BAR;
        PG8_WAIT_V(4); PG8_BAR;
        PG8_STAGE(PG8_SB(1, 0), cB + kstep, voffB); PG8_STAGE(PG8_SA(1, 0), cA + kstep, voffA); PG8_STAGE(PG8_SB(1, 1), cB + hstep + kstep, voffB);
        PG8_WAIT_V(6); PG8_BAR;
    }
    for (;;) {
        const bool has_next = S.next(ui + 1, nxt);
        const char* nA = has_next ? S.a_base(nxt) : cA; const char* nB = has_next ? S.b_base(nxt) : cB;
        for (int t = 0; t < nt; t += 2) {
            const bool last = (t == nt - 2);
            const char* a1 = cA + (size_t)(t + 1) * kstep;
            const char* a2 = last ? nA : cA + (size_t)(t + 2) * kstep; const char* b2 = last ? nB : cB + (size_t)(t + 2) * kstep;
            const char* a3 = a2 + kstep; const char* b3 = b2 + kstep;
            if constexpr (SP2) {
            PG8_LDB(B0, 0, 0); PG8_LDB(B1, 0, 1); PG8_SCHED; PG8_LDA(At, 0, 0); PG8_STAGE(PG8_SA(1, 1), a1 + hstep, voffA);
            PG8_WAIT_V(8); PG8_WAIT_L(0); PG8_BAR; PG8_MMA(0, 0, At, B0); PG8_MMA(0, 1, At, B1); PG8_BAR; PG8_SCHED;
            PG8_LDA(At, 0, 1); PG8_STAGE(PG8_SB(0, 0), b2, voffB); PG8_STAGE(PG8_SB(0, 1), b2 + hstep, voffB); PG8_STAGE(PG8_SA(0, 0), a2, voffA);
            PG8_WAIT_V(8); PG8_WAIT_L(0); PG8_BAR; PG8_MMA(1, 0, At, B0); PG8_MMA(1, 1, At, B1); PG8_BAR; PG8_SCHED;
            PG8_LDB(B0, 1, 0); PG8_LDB(B1, 1, 1); PG8_SCHED; PG8_LDA(At, 1, 0); PG8_STAGE(PG8_SA(0, 1), a2 + hstep, voffA);
            PG8_WAIT_V(8); PG8_WAIT_L(0); PG8_BAR; PG8_MMA(0, 0, At, B0); PG8_MMA(0, 1, At, B1); PG8_BAR; PG8_SCHED;
            PG8_LDA(At, 1, 1); PG8_STAGE(PG8_SB(1, 0), b3, voffB); PG8_STAGE(PG8_SB(1, 1), b3 + hstep, voffB); PG8_STAGE(PG8_SA(1, 0), a3, voffA);
            PG8_WAIT_V(8); PG8_WAIT_L(0); PG8_BAR; PG8_MMA(1, 0, At, B0); PG8_MMA(1, 1, At, B1); PG8_BAR; PG8_SCHED;
            } else {
            PG8_LDB(B0, 0, 0); PG8_SCHED; PG8_LDA(At, 0, 0); PG8_STAGE(PG8_SA(1, 1), a1 + hstep, voffA);
            PG8_WAIT_L(8); PG8_BAR; PG8_WAIT_L(0); PG8_MMA(0, 0, At, B0); PG8_BAR; PG8_SCHED;
            PG8_LDB(B1, 0, 1); PG8_STAGE(PG8_SB(0, 0), b2, voffB);
            PG8_BAR; PG8_WAIT_L(0); PG8_MMA(0, 1, At, B1); PG8_BAR;
            PG8_LDA(At, 0, 1); PG8_STAGE(PG8_SA(0, 0), a2, voffA);
            PG8_BAR; PG8_WAIT_L(0); PG8_MMA(1, 0, At, B0); PG8_BAR; PG8_SCHED;
            PG8_STAGE(PG8_SB(0, 1), b2 + hstep, voffB);
            PG8_WAIT_V(6); PG8_BAR; PG8_MMA(1, 1, At, B1); PG8_BAR;
            PG8_LDB(B0, 1, 0); PG8_SCHED; PG8_LDA(At, 1, 0); PG8_STAGE(PG8_SA(0, 1), a2 + hstep, voffA);
            PG8_WAIT_L(8); PG8_BAR; PG8_WAIT_L(0); PG8_MMA(0, 0, At, B0); PG8_BAR; PG8_SCHED;
            PG8_LDB(B1, 1, 1); PG8_STAGE(PG8_SB(1, 0), b3, voffB);
            PG8_BAR; PG8_WAIT_L(0); PG8_MMA(0, 1, At, B1); PG8_BAR;
            PG8_LDA(At, 1, 1); PG8_STAGE(PG8_SA(1, 0), a3, voffA);
            PG8_BAR; PG8_WAIT_L(0); PG8_MMA(1, 0, At, B0); PG8_BAR; PG8_SCHED;
            PG8_STAGE(PG8_SB(1, 1), b3 + hstep, voffB);
            PG8_WAIT_V(6); PG8_BAR; PG8_MMA(1, 1, At, B1); PG8_BAR;
            }
        }
        if constexpr (ALIGN_EPI) { if (wr == 0) PG8_BAR; }
        E(acc, cur, wr, wc, fr, fq);
        if (!has_next) break;
#pragma unroll
        for (int a = 0; a < 2; ++a)
#pragma unroll
            for (int b = 0; b < 2; ++b)
#pragma unroll
                for (int m = 0; m < 4; ++m)
#pragma unroll
                    for (int n = 0; n < 2; ++n) acc[a][b][m][n] = (f32x4){0.f, 0.f, 0.f, 0.f};
        cur = nxt; cA = nA; cB = nB; ++ui;
        if constexpr (ALIGN_EPI) { if (wr == 1) PG8_BAR; }
    }
    PG8_WAIT_V(0);
    if constexpr (!ALIGN_EPI) { if (wr == 0) PG8_BAR; }
    PG8_BAR;
#undef PG8_SA
#undef PG8_SB
#undef PG8_STAGE
#undef PG8_LDA
#undef PG8_LDB
#undef PG8_MMA
#undef PG8_WAIT_V
#undef PG8_WAIT_L
#undef PG8_BAR
#undef PG8_SCHED
}
}

__device__ __forceinline__ int rowmap(int mode, int c) {
    if (mode == 1) { const int pn = c >> 8; const bool rope = (pn < 4) || (pn >= 10 && pn < 14);
        return rope ? ((c & ~255) | (((c >> 5) & 1) << 7) | (((c >> 6) & 3) << 5) | (c & 31)) : c; }
    if (mode == 2) { const int f = c >> 1, bj = c & 1; return ((f >> 7) << 8) | (bj << 7) | (f & 127); }
    return c;
}
__device__ __forceinline__ void p0_transpose_item(const float* W, int N, bf16* WT, int mode, LAS float* scr, int item, int lane) {
    const int nblk = N / 32, kb = item / nblk, nb = item % nblk, k0 = 64 * kb, n0 = 32 * nb;
#pragma unroll 8
    for (int i = 0; i < 32; ++i) { const int kk = 2 * i + (lane >> 5); scr[kk * 33 + (lane & 31)] = W[(size_t)(k0 + kk) * N + n0 + (lane & 31)]; }
    asm volatile("s_waitcnt lgkmcnt(0)" ::: "memory");
    const int c = lane & 7;
#pragma unroll
    for (int j = 0; j < 4; ++j) { const int n = (lane >> 3) + 8 * j; const LAS float* s = scr + (8 * c) * 33 + n;
        u32x4 o; o.x = pk2(s[0 * 33], s[1 * 33]); o.y = pk2(s[2 * 33], s[3 * 33]); o.z = pk2(s[4 * 33], s[5 * 33]); o.w = pk2(s[6 * 33], s[7 * 33]);
        *(u32x4*)(WT + (size_t)rowmap(mode, n0 + n) * 1024 + k0 + 8 * c) = o; }
    asm volatile("s_waitcnt lgkmcnt(0)" ::: "memory");
}
__device__ const double INV_FREQ[32] = {1, 0.74989420933245587, 0.56234132519034907, 0.42169650342858223, 0.31622776601683794, 0.23713737056616552, 0.17782794100389229, 0.1333521432163324,
    0.10000000000000001, 0.074989420933245579, 0.056234132519034911, 0.042169650342858224, 0.031622776601683791, 0.023713737056616554, 0.017782794100389229, 0.013335214321633241,
    0.01, 0.0074989420933245579, 0.005623413251903491, 0.0042169650342858229, 0.0031622776601683794, 0.0023713737056616554, 0.0017782794100389228, 0.0013335214321633241,
    0.001, 0.00074989420933245586, 0.0005623413251903491, 0.00042169650342858224, 0.00031622776601683794, 0.00023713737056616554, 0.00017782794100389227, 0.0001333521432163324};

struct Ptrs {
    const float *x, *ab_w_in, *ab_w_out, *ret_decay, *c_w_in, *c_w_out, *c_rpb, *ln_g, *ln_b, *router_w, *router_b, *w_up, *b_up, *w_down, *b_down;
    float* out; unsigned char* ws;
};

__device__ __forceinline__ void phase_prologue(const Ptrs& P, LAS unsigned char* lds, int bid, int tid) {
    const int wave = tid >> 6, lane = tid & 63;
    LAS float* scr = (LAS float*)(lds + wave * 16384);
    const int gw = bid * NWAVES + wave, NGW = GRID * NWAVES;
    constexpr int I0 = 2 * 2048, I1 = 2 * 512, I2 = 2 * 1536, I3 = 2 * 512, I4 = 128 * 1024, I5 = 128 * 512;
    constexpr int NITEMS = I0 + I1 + I2 + I3 + I4 + I5;
    unsigned char* ws = P.ws;
    for (int it = gw; it < NITEMS; it += NGW) {
        int r = it;
        if (r < I0) { const int mi = r / 2048, ii = r % 2048; p0_transpose_item(P.ab_w_in + (size_t)mi * 1024 * 4096, 4096, (bf16*)(ws + WS_WIN_E) + (size_t)mi * 4096 * 1024, 1, scr, ii, lane); continue; } r -= I0;
        if (r < I1) { const int mi = r / 512, ii = r % 512; p0_transpose_item(P.ab_w_out + (size_t)mi * 1024 * 1024, 1024, (bf16*)(ws + WS_WOUT_E) + (size_t)mi * 1024 * 1024, 0, scr, ii, lane); continue; } r -= I1;
        if (r < I2) { const int mi = r / 1536, ii = r % 1536; p0_transpose_item(P.c_w_in + (size_t)mi * 1024 * 3072, 3072, (bf16*)(ws + WS_WIN_O) + (size_t)mi * 3072 * 1024, 0, scr, ii, lane); continue; } r -= I2;
        if (r < I3) { const int mi = r / 512, ii = r % 512; p0_transpose_item(P.c_w_out + (size_t)mi * 1024 * 1024, 1024, (bf16*)(ws + WS_WOUT_O) + (size_t)mi * 1024 * 1024, 0, scr, ii, lane); continue; } r -= I3;
        if (r < I4) { const int mi = r / 1024, ii = r % 1024; p0_transpose_item(P.w_up + (size_t)mi * 1024 * 2048, 2048, (bf16*)(ws + WS_WUP) + (size_t)mi * 2048 * 1024, 2, scr, ii, lane); continue; } r -= I4;
        { const int mi = r / 512, ii = r % 512; p0_transpose_item(P.w_down + (size_t)mi * 1024 * 1024, 1024, (bf16*)(ws + WS_WDN) + (size_t)mi * 1024 * 1024, 0, scr, ii, lane); }
    }
    float* cs = (float*)(ws + WS_COS); float* sn = (float*)(ws + WS_SIN);
    for (int g = bid * NTHR + tid; g < T * 32; g += GRID * NTHR) {
        const int pos = g >> 5, i = g & 31;
        const double rev = (double)pos * INV_FREQ[i] * 0.15915494309189535;
        const double fr = rev - __builtin_rint(rev);
        const float a = (float)(fr * 6.283185307179586);
        cs[g] = cosf(a); sn[g] = sinf(a);
    }
    bf16* xb = (bf16*)(ws + WS_XB);
    for (size_t g = (size_t)bid * NTHR + tid; g < (size_t)T * D / 8; g += (size_t)GRID * NTHR) {
        const f32x4 a = *(const f32x4*)(P.x + g * 8), b = *(const f32x4*)(P.x + g * 8 + 4);
        u32x4 o; o.x = pk2(a[0], a[1]); o.y = pk2(a[2], a[3]); o.z = pk2(b[0], b[1]); o.w = pk2(b[2], b[3]);
        *(u32x4*)(xb + g * 8) = o;
    }
}

__device__ __forceinline__ void load_panel_f32(LAS float* dst, const bf16* src, int ldh, int tid) {
    const int row = tid >> 2, c0 = (tid & 3) * 16;
    const bf16* p = src + (size_t)row * ldh + c0;
    const u32x4 a = *(const u32x4*)p, b = *(const u32x4*)(p + 8);
    float f[16]; unpack8(a, f); unpack8(b, f + 8);
    LAS f32x4* d = (LAS f32x4*)(dst + row * 64 + c0);
    d[0] = (f32x4){f[0], f[1], f[2], f[3]}; d[1] = (f32x4){f[4], f[5], f[6], f[7]}; d[2] = (f32x4){f[8], f[9], f[10], f[11]}; d[3] = (f32x4){f[12], f[13], f[14], f[15]};
}
__device__ __forceinline__ void phase_ret_states(LAS unsigned char* lds, const bf16* H, const float* decay, float* S, int bid, int tid) {
    LAS float* kf = (LAS float*)lds; LAS float* vf = kf + 128 * 64; LAS float* zt = (LAS float*)(lds + MISC_OFF + 4096);
    for (int unit = bid; unit < 1024; unit += GRID) {
        const int h = unit >> 7, n = unit & 127;
        const float lgf = log2_gamma(decay[h]), lgb = log2_gamma(decay[8 + h]);
        __syncthreads();
        load_panel_f32(kf, H + (size_t)(n * 128) * EVEN_IN + 512 + h * 64, EVEN_IN, tid);
        load_panel_f32(vf, H + (size_t)(n * 128) * EVEN_IN + 1024 + h * 64, EVEN_IN, tid);
        if (tid < 128) { zt[tid] = exp2f(lgf * (float)(127 - tid)); zt[128 + tid] = exp2f(lgb * (float)tid); }
        __syncthreads();
        const int d = tid >> 3, e0 = (tid & 7) * 8;
        f32x4 af0 = {0, 0, 0, 0}, af1 = af0, ab0 = af0, ab1 = af0;
        for (int m = 0; m < 128; ++m) {
            const float kd = kf[m * 64 + d]; const float a = kd * zt[m], b = kd * zt[128 + m];
            const f32x4 v0 = *(const LAS f32x4*)(vf + m * 64 + e0), v1 = *(const LAS f32x4*)(vf + m * 64 + e0 + 4);
            af0 += v0 * a; af1 += v1 * a; ab0 += v0 * b; ab1 += v1 * b;
        }
        float* sf = S + ((size_t)(h) * 128 + n) * 4096 + d * 64 + e0;
        float* sb = S + ((size_t)(8 + h) * 128 + n) * 4096 + d * 64 + e0;
        *(f32x4*)sf = af0; *(f32x4*)(sf + 4) = af1; *(f32x4*)sb = ab0; *(f32x4*)(sb + 4) = ab1;
    }
}
__device__ __forceinline__ void phase_ret_scan(const float* S, float* R, const float* decay, int bid, int tid) {
    for (int g = bid * NTHR + tid; g < 65536; g += GRID * NTHR) {
        const int dir = g >> 15, h = (g >> 12) & 7, de = g & 4095;
        const float gc = exp2f(log2_gamma(decay[dir * 8 + h]) * 128.0f);
        const float* s = S + ((size_t)(dir * 8 + h) * 128) * 4096 + de; float* r = R + ((size_t)(dir * 8 + h) * 128) * 4096 + de;
        float a = 0.f;
        if (dir == 0) { for (int n = 0; n < 128; ++n) { r[(size_t)n * 4096] = a; a = gc * a + s[(size_t)n * 4096]; } }
        else { for (int n = 127; n >= 0; --n) { r[(size_t)n * 4096] = a; a = gc * a + s[(size_t)n * 4096]; } }
    }
}
__device__ __forceinline__ void phase_ret_out(LAS unsigned char* lds, const bf16* H, const float* R, const float* decay, bf16* Y, int bid, int tid) {
    LAS float* qf = (LAS float*)lds; LAS float* kf = qf + 8192; LAS float* vf = kf + 8192; LAS float* rf = vf + 8192; LAS float* rb = rf + 4096;
    for (int unit = bid; unit < 1024; unit += GRID) {
        const int h = unit >> 7, n = unit & 127;
        const float lgf = log2_gamma(decay[h]), lgb = log2_gamma(decay[8 + h]);
        __syncthreads();
        const bf16* hp = H + (size_t)(n * 128) * EVEN_IN + h * 64;
        load_panel_f32(qf, hp, EVEN_IN, tid); load_panel_f32(kf, hp + 512, EVEN_IN, tid); load_panel_f32(vf, hp + 1024, EVEN_IN, tid);
        { const float* r0 = R + ((size_t)(h) * 128 + n) * 4096 + tid * 8; const float* r1 = R + ((size_t)(8 + h) * 128 + n) * 4096 + tid * 8;
          *(LAS f32x4*)(rf + tid * 8) = *(const f32x4*)r0; *(LAS f32x4*)(rf + tid * 8 + 4) = *(const f32x4*)(r0 + 4);
          *(LAS f32x4*)(rb + tid * 8) = *(const f32x4*)r1; *(LAS f32x4*)(rb + tid * 8 + 4) = *(const f32x4*)(r1 + 4); }
        __syncthreads();
        const int c = tid >> 2, e0 = (tid & 3) * 16;
        f32x4 q[16];
#pragma unroll
        for (int i = 0; i < 16; ++i) q[i] = *(const LAS f32x4*)(qf + c * 64 + 4 * i);
        f32x4 of[4], ob[4];
#pragma unroll
        for (int i = 0; i < 4; ++i) { of[i] = (f32x4){0, 0, 0, 0}; ob[i] = of[i]; }
        for (int m = 0; m < 128; ++m) {
            f32x4 sv = {0, 0, 0, 0};
#pragma unroll
            for (int i = 0; i < 16; ++i) sv += q[i] * *(const LAS f32x4*)(kf + m * 64 + 4 * i);
            const float s = (sv[0] + sv[1]) + (sv[2] + sv[3]);
            const float df = (float)(c - m);
            const float pf = (m <= c) ? exp2f(lgf * df) : 0.0f;
            const float pb = (m > c) ? exp2f(-lgb * df) : 0.0f;
            const float wf = s * pf, wb = s * pb;
#pragma unroll
            for (int i = 0; i < 4; ++i) { const f32x4 v = *(const LAS f32x4*)(vf + m * 64 + e0 + 4 * i); of[i] += v * wf; ob[i] += v * wb; }
        }
        f32x4 cf[4], cb[4];
#pragma unroll
        for (int i = 0; i < 4; ++i) { cf[i] = (f32x4){0, 0, 0, 0}; cb[i] = cf[i]; }
#pragma unroll
        for (int d4 = 0; d4 < 16; ++d4)
#pragma unroll
            for (int dd = 0; dd < 4; ++dd) {
                const float qd = q[d4][dd]; const int d = 4 * d4 + dd;
#pragma unroll
                for (int i = 0; i < 4; ++i) { cf[i] += *(const LAS f32x4*)(rf + d * 64 + e0 + 4 * i) * qd; cb[i] += *(const LAS f32x4*)(rb + d * 64 + e0 + 4 * i) * qd; }
            }
        const float xif = exp2f(lgf * (float)(c + 1)), xib = exp2f(lgb * (float)(128 - c));
        float sf = 0.f, sb = 0.f;
#pragma unroll
        for (int i = 0; i < 4; ++i) { of[i] += cf[i] * xif; ob[i] += cb[i] * xib; sf += (of[i][0] + of[i][1]) + (of[i][2] + of[i][3]); sb += (ob[i][0] + ob[i][1]) + (ob[i][2] + ob[i][3]); }
        sf += __shfl_xor(sf, 1); sf += __shfl_xor(sf, 2); sb += __shfl_xor(sb, 1); sb += __shfl_xor(sb, 2);
        const float muf = sf * (1.0f / 64.0f), mub = sb * (1.0f / 64.0f);
        float vfq = 0.f, vbq = 0.f;
#pragma unroll
        for (int i = 0; i < 4; ++i) { of[i] = of[i] - muf; ob[i] = ob[i] - mub;
            vfq += (of[i][0] * of[i][0] + of[i][1] * of[i][1]) + (of[i][2] * of[i][2] + of[i][3] * of[i][3]);
            vbq += (ob[i][0] * ob[i][0] + ob[i][1] * ob[i][1]) + (ob[i][2] * ob[i][2] + ob[i][3] * ob[i][3]); }
        vfq += __shfl_xor(vfq, 1); vfq += __shfl_xor(vfq, 2); vbq += __shfl_xor(vbq, 1); vbq += __shfl_xor(vbq, 2);
        const float rsf = 1.0f / sqrtf(vfq * (1.0f / 64.0f) + GN_EPS), rsb = 1.0f / sqrtf(vbq * (1.0f / 64.0f) + GN_EPS);
        const int tok = n * 128 + c;
        const bf16* gp = H + (size_t)tok * EVEN_IN + 1536 + h * 64 + e0;
        float gf[16], gb[16];
        unpack8(*(const u32x4*)gp, gf); unpack8(*(const u32x4*)(gp + 8), gf + 8); unpack8(*(const u32x4*)(gp + 512), gb); unpack8(*(const u32x4*)(gp + 520), gb + 8);
        float y[16];
#pragma unroll
        for (int i = 0; i < 16; ++i) { const float a = gf[i] * sigmoidf_(gf[i]), b = gb[i] * sigmoidf_(gb[i]); y[i] = a * (of[i >> 2][i & 3] * rsf) + b * (ob[i >> 2][i & 3] * rsb); }
        bf16* yp = Y + (size_t)tok * D + h * 64 + e0;
        u32x4 w0, w1; w0.x = pk2(y[0], y[1]); w0.y = pk2(y[2], y[3]); w0.z = pk2(y[4], y[5]); w0.w = pk2(y[6], y[7]); w1.x = pk2(y[8], y[9]); w1.y = pk2(y[10], y[11]); w1.z = pk2(y[12], y[13]); w1.w = pk2(y[14], y[15]);
        *(u32x4*)yp = w0; *(u32x4*)(yp + 8) = w1;
    }
}

struct OnlineSm { float m, l; f32x4 o[16]; };
__device__ __forceinline__ void load_q64(const bf16* p, f32x4 (&q)[16]) {
#pragma unroll
    for (int i = 0; i < 8; ++i) { float f[8]; unpack8(*(const u32x4*)(p + 8 * i), f); q[2 * i] = (f32x4){f[0], f[1], f[2], f[3]}; q[2 * i + 1] = (f32x4){f[4], f[5], f[6], f[7]}; }
}
__device__ __forceinline__ float dot64(const f32x4 (&q)[16], const bf16* kp) {
    f32x4 sv = {0, 0, 0, 0};
#pragma unroll
    for (int i = 0; i < 8; ++i) { float f[8]; unpack8(*(const u32x4*)(kp + 8 * i), f); sv += q[2 * i] * (f32x4){f[0], f[1], f[2], f[3]}; sv += q[2 * i + 1] * (f32x4){f[4], f[5], f[6], f[7]}; }
    return (sv[0] + sv[1]) + (sv[2] + sv[3]);
}
__device__ __forceinline__ void sm_update(OnlineSm& st, float s, const bf16* vp) {
    const float mn = fmaxf(st.m, s), sc = __expf(st.m - mn), p = __expf(s - mn);
    st.l = st.l * sc + p; st.m = mn;
#pragma unroll
    for (int i = 0; i < 8; ++i) { float f[8]; unpack8(*(const u32x4*)(vp + 8 * i), f);
        st.o[2 * i] = st.o[2 * i] * sc + (f32x4){f[0], f[1], f[2], f[3]} * p; st.o[2 * i + 1] = st.o[2 * i + 1] * sc + (f32x4){f[4], f[5], f[6], f[7]} * p; }
}
__device__ __forceinline__ void sm_store(const OnlineSm& st, bf16* yp) {
    const float inv = 1.0f / st.l;
#pragma unroll
    for (int i = 0; i < 8; ++i) { const f32x4 a = st.o[2 * i] * inv, b = st.o[2 * i + 1] * inv; u32x4 w; w.x = pk2(a[0], a[1]); w.y = pk2(a[2], a[3]); w.z = pk2(b[0], b[1]); w.w = pk2(b[2], b[3]); *(u32x4*)(yp + 8 * i) = w; }
}
__device__ __forceinline__ void phase_dilated(const bf16* H, bf16* Y, int bid, int tid) {
    const int g = bid * NTHR + tid, h = g >> 14, i = g & 16383;
    f32x4 q[16]; load_q64(H + (size_t)i * EVEN_IN + 2560 + h * 64, q);
    OnlineSm st; st.m = -1e30f; st.l = 0.f;
#pragma unroll
    for (int k = 0; k < 16; ++k) st.o[k] = (f32x4){0, 0, 0, 0};
    for (int b = 0; b < 3; ++b) {
        const int dil = (b == 0) ? 1 : ((b == 1) ? 4 : 16);
        for (int jj = -64; jj <= 64; ++jj) {
            const int j = i + dil * jj;
            if (j < 0 || j >= T) continue;
            const bf16* kp = H + (size_t)j * EVEN_IN + 3072 + h * 64;
            const float s = dot64(q, kp);
            sm_update(st, s, kp + 512);
        }
    }
    sm_store(st, Y + (size_t)i * D + 512 + h * 64);
}
__device__ __forceinline__ void phase_natten(const bf16* H, const float* rpb, bf16* Y, int bid, int tid) {
    for (int rep = 0; rep < 2; ++rep) {
        const int g = rep * (GRID * NTHR) + bid * NTHR + tid, h = g >> 14, i = g & 16383, r = i >> 6, c = i & 63;
        const int r0 = min(max(r - 4, 0), 248), c0 = min(max(c - 8, 0), 48);
        f32x4 q[16]; load_q64(H + (size_t)i * ODD_IN + h * 64, q);
        OnlineSm st; st.m = -1e30f; st.l = 0.f;
#pragma unroll
        for (int k = 0; k < 16; ++k) st.o[k] = (f32x4){0, 0, 0, 0};
        for (int ii = 0; ii < 8; ++ii)
            for (int jj = 0; jj < 16; ++jj) {
                const int kr = r0 + ii, kc = c0 + jj, j = kr * 64 + kc;
                const float bias = rpb[(h * 15 + (kr - r + 7)) * 31 + (kc - c + 15)];
                const bf16* kp = H + (size_t)j * ODD_IN + 1024 + h * 64;
                const float s = dot64(q, kp) + bias;
                sm_update(st, s, kp + 1024);
            }
        sm_store(st, Y + (size_t)i * D + h * 64);
    }
}

__device__ __forceinline__ void phase_ln1_router(LAS unsigned char* lds, const float* U, const float* lng, const float* lnb, const float* rw, const float* rbias,
                                                 float* X1, bf16* X1b, int* tope, float* gate, int* lrank, int* cnt, int bid, int tid) {
    const int wave = tid >> 6, lane = tid & 63;
    LAS int* lcnt = (LAS int*)(lds + MISC_OFF + 1024);
    __syncthreads();
    for (int idx = tid; idx < 1024 * 8; idx += NTHR) { const int d = idx >> 3, c = idx & 7;
        *(LAS f32x4*)(lds + d * 128 + ((c ^ ((d >> 1) & 7)) << 4)) = *(const f32x4*)(rw + d * 32 + c * 4); }
    if (tid < 32) lcnt[tid] = 0;
    __syncthreads();
    float gg[16], bb[16];
#pragma unroll
    for (int i = 0; i < 16; ++i) { gg[i] = lng[64 * i + lane]; bb[i] = lnb[64 * i + lane]; }
    const float rbe = rbias[lane >> 1];
    for (int rr = 0; rr < 8; ++rr) {
        const int row = bid * 64 + wave * 8 + rr;
        float x[16]; float s = 0.f;
#pragma unroll
        for (int i = 0; i < 16; ++i) { x[i] = U[(size_t)row * D + 64 * i + lane]; s += x[i]; }
        const float mean = wave_sum(s) * (1.0f / D); float s2 = 0.f;
#pragma unroll
        for (int i = 0; i < 16; ++i) { x[i] -= mean; s2 += x[i] * x[i]; }
        const float rstd = 1.0f / sqrtf(wave_sum(s2) * (1.0f / D) + LN_EPS);
#pragma unroll
        for (int i = 0; i < 16; ++i) { x[i] = x[i] * rstd * gg[i] + bb[i]; X1[(size_t)row * D + 64 * i + lane] = x[i]; X1b[(size_t)row * D + 64 * i + lane] = (bf16)f2bf(x[i]); }
        float acc[32];
#pragma unroll
        for (int e = 0; e < 32; ++e) acc[e] = 0.f;
#pragma unroll
        for (int i = 0; i < 16; ++i) { const int d = 64 * i + lane;
#pragma unroll
            for (int c = 0; c < 8; ++c) { const f32x4 w = *(const LAS f32x4*)(lds + d * 128 + ((c ^ ((d >> 1) & 7)) << 4));
                acc[4 * c] += x[i] * w[0]; acc[4 * c + 1] += x[i] * w[1]; acc[4 * c + 2] += x[i] * w[2]; acc[4 * c + 3] += x[i] * w[3]; } }
#pragma unroll
        for (int t = 0; t < 16; ++t) { const bool up = (lane & 32) != 0; const float snd = up ? acc[t] : acc[t + 16]; const float rcv = __shfl_xor(snd, 32); acc[t] = (up ? acc[t + 16] : acc[t]) + rcv; }
#pragma unroll
        for (int t = 0; t < 8; ++t) { const bool up = (lane & 16) != 0; const float snd = up ? acc[t] : acc[t + 8]; const float rcv = __shfl_xor(snd, 16); acc[t] = (up ? acc[t + 8] : acc[t]) + rcv; }
#pragma unroll
        for (int t = 0; t < 4; ++t) { const bool up = (lane & 8) != 0; const float snd = up ? acc[t] : acc[t + 4]; const float rcv = __shfl_xor(snd, 8); acc[t] = (up ? acc[t + 4] : acc[t]) + rcv; }
#pragma unroll
        for (int t = 0; t < 2; ++t) { const bool up = (lane & 4) != 0; const float snd = up ? acc[t] : acc[t + 2]; const float rcv = __shfl_xor(snd, 4); acc[t] = (up ? acc[t + 2] : acc[t]) + rcv; }
        { const bool up = (lane & 2) != 0; const float snd = up ? acc[0] : acc[1]; const float rcv = __shfl_xor(snd, 2); acc[0] = (up ? acc[1] : acc[0]) + rcv; }
        float lv = acc[0] + __shfl_xor(acc[0], 1) + rbe;
        const int me = lane >> 1;
        float tv[4]; int ti[4];
#pragma unroll
        for (int k = 0; k < 4; ++k) {
            float bv = lv; int bi = me;
#pragma unroll
            for (int o = 32; o >= 1; o >>= 1) { const float ov = __shfl_xor(bv, o); const int oi = __shfl_xor(bi, o); if (ov > bv || (ov == bv && oi < bi)) { bv = ov; bi = oi; } }
            tv[k] = bv; ti[k] = bi; if (me == bi) lv = -INFINITY;
        }
        const float p1 = expf(tv[1] - tv[0]), p2 = expf(tv[2] - tv[0]), p3 = expf(tv[3] - tv[0]); const float inv = 1.0f / (1.0f + p1 + p2 + p3);
        if (lane < 4) {
            const int e = (lane == 0) ? ti[0] : (lane == 1) ? ti[1] : (lane == 2) ? ti[2] : ti[3];
            const float gk = ((lane == 0) ? 1.0f : (lane == 1) ? p1 : (lane == 2) ? p2 : p3) * inv;
            const int rk = __hip_atomic_fetch_add(lcnt + e, 1, __ATOMIC_RELAXED, __HIP_MEMORY_SCOPE_WORKGROUP);
            tope[row * 4 + lane] = e; gate[row * 4 + lane] = gk; lrank[row * 4 + lane] = rk;
        }
    }
    __syncthreads();
    if (tid < 32) cnt[bid * 32 + tid] = lcnt[tid];
}

__device__ __forceinline__ void phase_dispatch(LAS unsigned char* lds, const int* cnt, const int* tope, const int* lrank, int* slot, int* tiles, const bf16* X1b, bf16* Xperm, int bid, int tid) {
    LAS int* tot = (LAS int*)(lds + MISC_OFF + 1024); LAS int* pre = tot + 32; LAS int* pst = pre + 32; LAS int* ldest = pst + 40;
    const int wave = tid >> 6, lane = tid & 63;
    __syncthreads();
    if (tid < 32) { int t = 0, p = 0; for (int b2 = 0; b2 < GRID; ++b2) { const int v = cnt[b2 * 32 + tid]; t += v; p += (b2 < bid) ? v : 0; } tot[tid] = t; pre[tid] = p; }
    __syncthreads();
    if (tid == 0) { int ps = 0;
#pragma unroll 1
        for (int e = 0; e < NEXP; ++e) { pst[e] = ps; ps += ((tot[e] + 255) >> 8) << 8; }
        pst[NEXP] = ps; }
    __syncthreads();
    if (bid == 0 && tid < 1 + MAXTILES) {
        if (tid == 0) tiles[0] = pst[NEXP] >> 8;
        else { const int i = tid - 1; int ee = 0;
#pragma unroll 1
            for (int e = 0; e < NEXP; ++e) ee = ((pst[e] >> 8) <= i) ? e : ee;
            tiles[tid] = ee; }
    }
    if (tid < 256) { const int row = bid * 64 + (tid >> 2), k = tid & 3; const int e = tope[row * 4 + k]; const int dest = pst[e] + pre[e] + lrank[row * 4 + k]; slot[row * 4 + k] = dest; ldest[tid] = dest; }
    __syncthreads();
    for (int s = wave * 32; s < wave * 32 + 32; ++s) {
        const int row = bid * 64 + (s >> 2); const int dest = ldest[s];
        const u32x4* src = (const u32x4*)(X1b + (size_t)row * D); u32x4* dst = (u32x4*)(Xperm + (size_t)dest * D);
        const u32x4 a = src[lane], b = src[64 + lane]; dst[lane] = a; dst[64 + lane] = b;
    }
}

__device__ __forceinline__ void phase_combine_ln2(const float* X1, const bf16* Oslot, const int* slot, const float* gate, const float* lng, const float* lnb, float* Xout, bf16* Xb, int bid, int tid) {
    const int wave = tid >> 6, lane = tid & 63;
    f32x4 gg[4], bb[4];
#pragma unroll
    for (int j = 0; j < 4; ++j) { gg[j] = *(const f32x4*)(lng + 256 * j + 4 * lane); bb[j] = *(const f32x4*)(lnb + 256 * j + 4 * lane); }
    for (int rr = 0; rr < 8; ++rr) {
        const int row = bid * 64 + wave * 8 + rr;
        f32x4 v[4];
#pragma unroll
        for (int j = 0; j < 4; ++j) v[j] = *(const f32x4*)(X1 + (size_t)row * D + 256 * j + 4 * lane) * ALPHA;
#pragma unroll
        for (int k = 0; k < 4; ++k) { const int s = slot[row * 4 + k]; const float g = gate[row * 4 + k];
#pragma unroll
            for (int j = 0; j < 4; ++j) { const u32x2 w = *(const u32x2*)(Oslot + (size_t)s * D + 256 * j + 4 * lane); v[j] += (f32x4){bflo(w.x), bfhi(w.x), bflo(w.y), bfhi(w.y)} * g; } }
        float s = 0.f;
#pragma unroll
        for (int j = 0; j < 4; ++j) s += (v[j][0] + v[j][1]) + (v[j][2] + v[j][3]);
        const float mean = wave_sum(s) * (1.0f / D); float s2 = 0.f;
#pragma unroll
        for (int j = 0; j < 4; ++j) { v[j] = v[j] - mean; s2 += (v[j][0] * v[j][0] + v[j][1] * v[j][1]) + (v[j][2] * v[j][2] + v[j][3] * v[j][3]); }
        const float rstd = 1.0f / sqrtf(wave_sum(s2) * (1.0f / D) + LN_EPS);
#pragma unroll
        for (int j = 0; j < 4; ++j) { const f32x4 o = v[j] * rstd * gg[j] + bb[j]; *(f32x4*)(Xout + (size_t)row * D + 256 * j + 4 * lane) = o;
            if (Xb) { u32x2 w; w.x = pk2(o[0], o[1]); w.y = pk2(o[2], o[3]); *(u32x2*)(Xb + (size_t)row * D + 256 * j + 4 * lane) = w; } }
    }
}

constexpr int NPH = 10, N_PHASES = 1 + DEPTH * NPH;
struct Args { Ptrs p; int ph_lo, ph_hi; };
static_assert(sizeof(Args) == 17 * 8 + 8, "Args has no padding");
typedef __attribute__((address_space(4))) const Args CArgs;

__global__ void __launch_bounds__(NTHR, 2) fwd_kernel(Args args) {
    extern __shared__ __attribute__((aligned(16))) unsigned char lds_raw[];
    LAS unsigned char* lds0 = (LAS unsigned char*)lds_raw;
    const int tid0 = threadIdx.x, bid0 = blockIdx.x;
    const int lo = args.ph_lo, hi = args.ph_hi;
    volatile LAS unsigned* MISC = (volatile LAS unsigned*)(lds0 + MISC_OFF);
    if (tid0 < 64) MISC[tid0] = 0u;
    __syncthreads();
    XcdBarrier bar = xcd_barrier_post((unsigned*)(((CArgs*)__builtin_amdgcn_kernarg_segment_ptr())->p.ws + WS_CTL) + CW_BAR, MISC + 8);
#define IN(k) (lo <= (k) && (k) < hi)
#define SEAM(k) do { if (IN(k) && IN((k) + 1)) xcd_barrier(bar); } while (0)
#define SITE int tid = tid0, bid = bid0, L = L0; CArgs* ap = (CArgs*)__builtin_amdgcn_kernarg_segment_ptr(); asm volatile("" : "+v"(tid)); asm volatile("" : "+s"(bid)); asm volatile("" : "+s"(L)); asm volatile("" : "+s"(ap)); LAS unsigned char* lds = lds0; asm volatile("" : "+s"(lds)); \
    unsigned char* ws = ap->p.ws; const int jl = L >> 1; const bool odd = (L & 1) != 0; (void)jl; (void)odd; (void)tid; (void)bid; (void)ws;

    { const int L0 = 0; if (IN(0)) { SITE; Ptrs P{}; P.x = ap->p.x; P.ab_w_in = ap->p.ab_w_in; P.ab_w_out = ap->p.ab_w_out; P.c_w_in = ap->p.c_w_in; P.c_w_out = ap->p.c_w_out; P.w_up = ap->p.w_up; P.w_down = ap->p.w_down; P.ws = ws; phase_prologue(P, lds, bid, tid); } }
    SEAM(0);

    for (int L0 = 0; L0 < DEPTH; ++L0) {
        const int pb = 1 + L0 * NPH; const bool odd0 = (L0 & 1) != 0;
        if (IN(pb + 0)) {
            if (!odd0) { SITE; pg8::DenseOrder S{T / 256, EVEN_IN / 256, GRID, bid, (const char*)(ws + WS_XB), (const char*)(ws + WS_WIN_E) + (size_t)jl * EVEN_IN * 1024 * 2};
                pg8::EpiInEven E{(bf16*)(ws + WS_H), (const float*)(ws + WS_COS), (const float*)(ws + WS_SIN)}; pg8::gemm_phase<pg8::EpiInEven, pg8::DenseOrder>(lds, S, E, tid); }
            else { SITE; pg8::DenseOrder S{T / 256, ODD_IN / 256, GRID, bid, (const char*)(ws + WS_XB), (const char*)(ws + WS_WIN_O) + (size_t)jl * ODD_IN * 1024 * 2};
                pg8::EpiInOdd E{(bf16*)(ws + WS_H)}; pg8::gemm_phase<pg8::EpiInOdd, pg8::DenseOrder>(lds, S, E, tid); }
        }
        SEAM(pb + 0);
        if (IN(pb + 1)) {
            if (!odd0) { { SITE; phase_ret_states(lds, (const bf16*)(ws + WS_H), ap->p.ret_decay + jl * 16, (float*)(ws + WS_RS), bid, tid); }
                         { SITE; phase_dilated((const bf16*)(ws + WS_H), (bf16*)(ws + WS_Y), bid, tid); } }
            else { SITE; phase_natten((const bf16*)(ws + WS_H), ap->p.c_rpb + (size_t)jl * 16 * 15 * 31, (bf16*)(ws + WS_Y), bid, tid); }
        }
        SEAM(pb + 1);
        if (!odd0) {
            if (IN(pb + 2)) { SITE; phase_ret_scan((const float*)(ws + WS_RS), (float*)(ws + WS_RR), ap->p.ret_decay + jl * 16, bid, tid); }
            SEAM(pb + 2);
            if (IN(pb + 3)) { SITE; phase_ret_out(lds, (const bf16*)(ws + WS_H), (const float*)(ws + WS_RR), ap->p.ret_decay + jl * 16, (bf16*)(ws + WS_Y), bid, tid); }
            SEAM(pb + 3);
        }
        if (IN(pb + 4)) { SITE;
            pg8::DenseOrder S{T / 256, D / 256, GRID, bid, (const char*)(ws + WS_Y), (const char*)(ws + (odd ? WS_WOUT_O : WS_WOUT_E)) + (size_t)jl * 1024 * 1024 * 2};
            pg8::EpiOut E{(L == 0) ? ap->p.x : (const float*)(ws + WS_X), (float*)(ws + WS_U)}; pg8::gemm_phase<pg8::EpiOut, pg8::DenseOrder>(lds, S, E, tid);
        }
        SEAM(pb + 4);
        if (IN(pb + 5)) { SITE; phase_ln1_router(lds, (const float*)(ws + WS_U), ap->p.ln_g + (size_t)(L * 2) * D, ap->p.ln_b + (size_t)(L * 2) * D, ap->p.router_w + (size_t)L * D * NEXP, ap->p.router_b + L * NEXP,
                                         (float*)(ws + WS_X1), (bf16*)(ws + WS_X1B), (int*)(ws + WS_TOPE), (float*)(ws + WS_GATE), (int*)(ws + WS_LRANK), (int*)(ws + WS_CNT), bid, tid); }
        SEAM(pb + 5);
        if (IN(pb + 6)) { SITE; phase_dispatch(lds, (const int*)(ws + WS_CNT), (const int*)(ws + WS_TOPE), (const int*)(ws + WS_LRANK), (int*)(ws + WS_SLOT), (int*)(ws + WS_TILES), (const bf16*)(ws + WS_X1B), (bf16*)(ws + WS_XPERM), bid, tid); }
        SEAM(pb + 6);
        if (IN(pb + 7)) { SITE;
            LAS int* ltile = (LAS int*)(lds + MISC_OFF + 2048); const int* tiles = (const int*)(ws + WS_TILES);
            __syncthreads();
            for (int i = tid; i < 1 + MAXTILES; i += NTHR) ltile[i] = tiles[i];
            __syncthreads();
            pg8::GroupOrder S{(int)ltile[0], 2048 / 256, GRID, bid, (const char*)(ws + WS_XPERM), (const char*)(ws + WS_WUP) + (size_t)L * 32 * 2048 * 1024 * 2, (size_t)2048 * 1024 * 2, ltile + 1};
            pg8::EpiUp E{(bf16*)(ws + WS_ACT), ap->p.b_up + (size_t)L * 32 * 2048}; pg8::gemm_phase<pg8::EpiUp, pg8::GroupOrder>(lds, S, E, tid);
        }
        SEAM(pb + 7);
        if (IN(pb + 8)) { SITE;
            LAS int* ltile = (LAS int*)(lds + MISC_OFF + 2048); const int* tiles = (const int*)(ws + WS_TILES);
            __syncthreads();
            for (int i = tid; i < 1 + MAXTILES; i += NTHR) ltile[i] = tiles[i];
            __syncthreads();
            pg8::GroupOrder S{(int)ltile[0], 1024 / 256, GRID, bid, (const char*)(ws + WS_ACT), (const char*)(ws + WS_WDN) + (size_t)L * 32 * 1024 * 1024 * 2, (size_t)1024 * 1024 * 2, ltile + 1};
            pg8::EpiDown E{(bf16*)(ws + WS_OSLOT), ap->p.b_down + (size_t)L * 32 * 1024}; pg8::gemm_phase<pg8::EpiDown, pg8::GroupOrder>(lds, S, E, tid);
        }
        SEAM(pb + 8);
        if (IN(pb + 9)) { SITE; phase_combine_ln2((const float*)(ws + WS_X1), (const bf16*)(ws + WS_OSLOT), (const int*)(ws + WS_SLOT), (const float*)(ws + WS_GATE), ap->p.ln_g + (size_t)(L * 2 + 1) * D, ap->p.ln_b + (size_t)(L * 2 + 1) * D,
                                          (L == DEPTH - 1) ? ap->p.out : (float*)(ws + WS_X), (L == DEPTH - 1) ? (bf16*)nullptr : (bf16*)(ws + WS_XB), bid, tid); }
        SEAM(pb + 9);
    }
#undef IN
#undef SEAM
#undef SITE
}

extern "C" void kernel_launch(void* const* d_in, const int* in_sizes, int n_in, void* d_out, int out_size, void* d_ws, size_t ws_size, hipStream_t stream) {
    static int ready = 0;
    if (ready == 0) {
        if (n_in != 15 || in_sizes[0] != T * D || out_size != T * D || ws_size < WS_END) {
            fprintf(stderr, "kernel_launch: unexpected problem (n_in %d, in0 %d, out %d, ws %zu); nothing launched\n", n_in, n_in > 0 ? in_sizes[0] : -1, out_size, ws_size); ready = -1; return; }
        if (hipFuncSetAttribute((const void*)fwd_kernel, hipFuncAttributeMaxDynamicSharedMemorySize, LDS_BYTES) != hipSuccess) { fprintf(stderr, "kernel_launch: hipFuncSetAttribute failed\n"); ready = -1; return; }
        int per_cu = 0;
        if (hipOccupancyMaxActiveBlocksPerMultiprocessor(&per_cu, (const void*)fwd_kernel, NTHR, LDS_BYTES) != hipSuccess || per_cu < 1) fprintf(stderr, "kernel_launch: occupancy query reports %d workgroups per CU\n", per_cu);
        (void)hipGetLastError();
        ready = 1;
    }
    if (ready < 0) return;
    (void)hipMemsetAsync((char*)d_ws + WS_CTL, 0, CTL_ZERO_BYTES, stream);
    Args a{};
    a.p.x = (const float*)d_in[0]; a.p.ab_w_in = (const float*)d_in[1]; a.p.ab_w_out = (const float*)d_in[2]; a.p.ret_decay = (const float*)d_in[3];
    a.p.c_w_in = (const float*)d_in[4]; a.p.c_w_out = (const float*)d_in[5]; a.p.c_rpb = (const float*)d_in[6]; a.p.ln_g = (const float*)d_in[7]; a.p.ln_b = (const float*)d_in[8];
    a.p.router_w = (const float*)d_in[9]; a.p.router_b = (const float*)d_in[10]; a.p.w_up = (const float*)d_in[11]; a.p.b_up = (const float*)d_in[12]; a.p.w_down = (const float*)d_in[13]; a.p.b_down = (const float*)d_in[14];
    a.p.out = (float*)d_out; a.p.ws = (unsigned char*)d_ws;
#if N_LAUNCH_MODE == 0
    a.ph_lo = 0; a.ph_hi = N_PHASES;
    hipLaunchKernelGGL(fwd_kernel, dim3(GRID), dim3(NTHR), LDS_BYTES, stream, a);
#else
    for (int ph = 0; ph < N_PHASES; ++ph) {
        if (ph >= 1) { const int L = (ph - 1) / NPH, p = (ph - 1) % NPH; if ((L & 1) && (p == 2 || p == 3)) continue; }
        a.ph_lo = ph; a.ph_hi = ph + 1;
        hipLaunchKernelGGL(fwd_kernel, dim3(GRID), dim3(NTHR), LDS_BYTES, stream, a);
    }
#endif
}
```

```cpp
#include <hip/hip_runtime.h>
#include <cstdio>
#include <cstdint>

#ifndef N_LAUNCH_MODE
#define N_LAUNCH_MODE 0
#endif

#define GAS __attribute__((address_space(1)))
#define LAS __attribute__((address_space(3)))
typedef unsigned short bf16;
typedef short bf16x8 __attribute__((ext_vector_type(8)));
typedef float f32x4 __attribute__((ext_vector_type(4)));
typedef float f32x2 __attribute__((ext_vector_type(2)));
typedef unsigned u32x4 __attribute__((ext_vector_type(4)));
typedef unsigned u32x2 __attribute__((ext_vector_type(2)));

constexpr int T = 16384, D = 1024, DEPTH = 4, HD = 64, NEXP = 32, TOPK = 4;
constexpr int EVEN_IN = 4096, ODD_IN = 3072;
constexpr int NPAD = T * TOPK + NEXP * 256;
constexpr int MAXTILES = NPAD / 256;
constexpr float LN_EPS = 1e-5f, GN_EPS = 1e-6f;
constexpr float ALPHA = 1.681792830507429f;
constexpr int NWAVES = 8, NTHR = 512, GRID = 256;

constexpr size_t MiB = 1u << 20;
constexpr size_t WS_CTL = 0, CTL_ZERO_BYTES = 1 * MiB;
constexpr size_t WS_COS = 1 * MiB, WS_SIN = 3 * MiB;
constexpr size_t WS_CNT = 5 * MiB;
constexpr size_t WS_TOPE = 6 * MiB, WS_GATE = 7 * MiB, WS_LRANK = 8 * MiB, WS_SLOT = 9 * MiB;
constexpr size_t WS_TILES = 10 * MiB;
constexpr size_t WS_WIN_E = 16 * MiB, WS_WOUT_E = 32 * MiB, WS_WIN_O = 36 * MiB, WS_WOUT_O = 48 * MiB;
constexpr size_t WS_WUP = 64 * MiB, WS_WDN = 576 * MiB;
constexpr size_t WS_X = 832 * MiB, WS_XB = 896 * MiB, WS_H = 928 * MiB, WS_Y = 1056 * MiB, WS_U = 1088 * MiB;
constexpr size_t WS_X1 = 1152 * MiB, WS_X1B = 1216 * MiB, WS_XPERM = 1248 * MiB, WS_ACT = 1392 * MiB, WS_OSLOT = 1536 * MiB;
constexpr size_t WS_RS = 1680 * MiB, WS_RR = 1712 * MiB, WS_END = 1744 * MiB;
static_assert((size_t)NPAD * 1024 * 2 <= 144 * MiB, "slot buffers");
constexpr int CW_BAR = 4096;

constexpr int RING_BYTES = 131072, MISC_OFF = 131072, LDS_BYTES = 147456;

__device__ __forceinline__ unsigned f2bf(float f) { unsigned u = __builtin_bit_cast(unsigned, f); return (u + 0x7fffu + ((u >> 16) & 1u)) >> 16; }
__device__ __forceinline__ unsigned pk2(float lo, float hi) { return f2bf(lo) | (f2bf(hi) << 16); }
__device__ __forceinline__ float bflo(unsigned w) { return __builtin_bit_cast(float, w << 16); }
__device__ __forceinline__ float bfhi(unsigned w) { return __builtin_bit_cast(float, w & 0xffff0000u); }
__device__ __forceinline__ unsigned cvt_pk_bf16(float lo, float hi) { unsigned r; asm volatile("v_cvt_pk_bf16_f32 %0, %1, %2" : "=v"(r) : "v"(lo), "v"(hi)); return r; }
__device__ __forceinline__ float wave_sum(float v) {
#pragma unroll
    for (int o = 1; o < 64; o <<= 1) v += __shfl_xor(v, o);
    return v;
}
__device__ __forceinline__ void unpack8(const u32x4 w, float* f) {
    f[0] = bflo(w.x); f[1] = bfhi(w.x); f[2] = bflo(w.y); f[3] = bfhi(w.y); f[4] = bflo(w.z); f[5] = bfhi(w.z); f[6] = bflo(w.w); f[7] = bfhi(w.w);
}
__device__ __forceinline__ float log2_gamma(float logit) { return -log1pf(expf(-logit)) * 1.4426950408889634f; }
__device__ __forceinline__ float sigmoidf_(float z) { return 1.0f / (1.0f + __expf(-z)); }

#define XB_TMO      128
#define XB_XCNT(j)  (256  + 64 * (j))
#define XB_XSUB(j)  (1280 + 64 * (j))
#define XB_XGEN(j)  (2304 + 64 * (j))
#define XB_TOP      3328
#define XB_TOPGEN   3392
#define XCD_BAR_WORDS 3456
#define XB_SPIN_CAP (1u << 18)

__device__ __forceinline__ unsigned xb_ld(unsigned* p)              { return __hip_atomic_load(p, __ATOMIC_RELAXED, __HIP_MEMORY_SCOPE_AGENT); }
__device__ __forceinline__ unsigned xb_add(unsigned* p, unsigned v) { return __hip_atomic_fetch_add(p, v, __ATOMIC_RELAXED, __HIP_MEMORY_SCOPE_AGENT); }
__device__ __forceinline__ unsigned xb_xcc_id() { return (unsigned)__builtin_amdgcn_s_getreg((3 << 11) | 20) & 0xFu; }
#define XB_SPIN(cond, bar) do { unsigned _sp = 0; while (cond) { __builtin_amdgcn_s_sleep(1); \
    if ((++_sp & 255u) == 0u) { if (xb_ld(&(bar)[XB_TMO])) break; if (_sp > XB_SPIN_CAP) { atomicAdd(&(bar)[XB_TMO], 1u); break; } } } } while (0)

struct XcdBarrier { unsigned* bar; unsigned x; volatile LAS unsigned* st; };

__device__ __forceinline__ XcdBarrier xcd_barrier_post(unsigned* bar, volatile LAS unsigned* st) {
    XcdBarrier b; b.bar = bar; b.x = xb_xcc_id(); b.st = st;
    if (threadIdx.x == 0) (void)xb_add(&bar[XB_XCNT(b.x)], 1u);
    return b;
}
__device__ __forceinline__ void xcd_barrier_complete(unsigned* bar, unsigned x, unsigned& nloc, unsigned& nx) {
    const unsigned G = gridDim.x * gridDim.y * gridDim.z;
    unsigned sum, cnt, mine, sp = 0u;
    for (;;) {
        sum = 0u; cnt = 0u; mine = 0u;
#pragma unroll
        for (unsigned j = 0; j < 16; ++j) { const unsigned c = xb_ld(&bar[XB_XCNT(j)]); sum += c; cnt += (c > 0u) ? 1u : 0u; mine = (j == x) ? c : mine; }
        if (sum == G) break;
        __builtin_amdgcn_s_sleep(1);
        if ((++sp & 255u) == 0u) { if (xb_ld(&bar[XB_TMO])) break; if (sp > XB_SPIN_CAP) { atomicAdd(&bar[XB_TMO], 1u); break; } }
    }
    nloc = mine > 0u ? mine : 1u; nx = cnt > 0u ? cnt : 1u;
}
__device__ __forceinline__ void xcd_barrier(const XcdBarrier& b0) {
    XcdBarrier b = b0; asm volatile("" : "+s"(b.bar)); asm volatile("" : "+s"(b.x));
    asm volatile("s_waitcnt vmcnt(0)" ::: "memory");
    __syncthreads();
    if (threadIdx.x == 0) {
        unsigned* bar = b.bar;
        __builtin_amdgcn_s_waitcnt(0);
        unsigned nloc = b.st[0], nx = b.st[1];
        if (nloc == 0u) { xcd_barrier_complete(bar, b.x, nloc, nx); b.st[0] = nloc; b.st[1] = nx; }
        const unsigned old = xb_add(&bar[XB_XSUB(b.x)], 1u);
        const unsigned gen = old / nloc;
        if (old + 1u == (gen + 1u) * nloc) {
            __builtin_amdgcn_fence(__ATOMIC_RELEASE, "agent");
            asm volatile("s_waitcnt vmcnt(0)" ::: "memory");
            const unsigned og = xb_add(&bar[XB_TOP], 1u);
            const unsigned tg = og / nx;
            if (og + 1u == (tg + 1u) * nx) xb_add(&bar[XB_TOPGEN], 1u);
            else XB_SPIN(xb_ld(&bar[XB_TOPGEN]) == tg, bar);
            __builtin_amdgcn_fence(__ATOMIC_ACQUIRE, "agent");
            xb_add(&bar[XB_XGEN(b.x)], 1u);
            asm volatile("s_waitcnt vmcnt(0)" ::: "memory");
        } else {
            XB_SPIN(xb_ld(&bar[XB_XGEN(b.x)]) == gen, bar);
            __builtin_amdgcn_fence(__ATOMIC_ACQUIRE, "agent");
            asm volatile("s_waitcnt vmcnt(0)" ::: "memory");
        }
    }
    __syncthreads();
}

namespace pg8 {
constexpr int BM = 256, BK = 64, HALF = 128, HTB = HALF * BK * 2, STAGE_BYTES = 8 * HTB, NXCD = 8, WGM = 8, KD = 1024;
constexpr size_t TILE_BYTES = (size_t)BM * KD * 2;

__host__ __device__ __forceinline__ int lds_byte(int r, int c) { const int st = (r >> 4) * 2 + (c >> 5), rr = r & 15, cc = c & 31, ob = rr * 64 + cc * 2; return st * 1024 + (ob ^ (((ob >> 9) & 1) << 5)); }
__host__ __device__ __forceinline__ void stage_rc(int b, int& R, int& C) { const int st = b / 1024, sb = b % 1024, swz = sb ^ (((sb >> 9) & 1) << 5); R = (st >> 1) * 16 + swz / 64; C = (st & 1) * 32 + (swz % 64) / 2; }
__host__ __device__ __forceinline__ int perm32(int rho) { const int n = rho >> 4, i = rho & 15; return 8 * (i >> 2) + 4 * n + (i & 3); }

struct Unit { int pm, pn, e; };

__device__ __forceinline__ bool order_next(int i, int G, int c, int nM, int nN, int& pm, int& pn) {
    const int nwg = nM * nN; const long L = (long)i * G + c; if (L >= nwg) return false;
    int wgid = (int)L; { const int q = nwg / NXCD, r = nwg % NXCD, xcd = wgid % NXCD, off = wgid / NXCD; wgid = (xcd < r ? xcd * (q + 1) : r * (q + 1) + (xcd - r) * q) + off; }
    const int nig = WGM * nN, gid = wgid / nig, fm = gid * WGM, gsz = (nM - fm) < WGM ? (nM - fm) : WGM;
    pm = fm + ((wgid % nig) % gsz); pn = (wgid % nig) / gsz; return true;
}
struct DenseOrder {
    int nM, nN, G, c; const char* A; const char* B;
    __device__ __forceinline__ bool next(int i, Unit& u) const { u.e = 0; return order_next(i, G, c, nM, nN, u.pm, u.pn); }
    __device__ __forceinline__ const char* a_base(const Unit& u) const { return A + (size_t)u.pm * TILE_BYTES; }
    __device__ __forceinline__ const char* b_base(const Unit& u) const { return B + (size_t)u.pn * TILE_BYTES; }
};
struct GroupOrder {
    int nM, nN, G, c; const char* A; const char* B; size_t bstride; const LAS int* tile_e;
    __device__ __forceinline__ bool next(int i, Unit& u) const { if (!order_next(i, G, c, nM, nN, u.pm, u.pn)) return false; u.e = tile_e[u.pm]; return true; }
    __device__ __forceinline__ const char* a_base(const Unit& u) const { return A + (size_t)u.pm * TILE_BYTES; }
    __device__ __forceinline__ const char* b_base(const Unit& u) const { return B + (size_t)u.e * bstride + (size_t)u.pn * TILE_BYTES; }
};

__device__ __forceinline__ void store8(bf16* p, const f32x4 v0, const f32x4 v1) {
    u32x4 w; w.x = cvt_pk_bf16(v0[0], v0[1]); w.y = cvt_pk_bf16(v0[2], v0[3]); w.z = cvt_pk_bf16(v1[0], v1[1]); w.w = cvt_pk_bf16(v1[2], v1[3]); *(u32x4*)p = w;
}
struct EpiInEven {
    static constexpr bool PERM = true, AFTER_DRAIN = false;
    bf16* H; const float* cs; const float* sn;
    __device__ __forceinline__ void operator()(const f32x4 (&acc)[2][2][4][2], const Unit& u, int wr, int wc, int fr, int fq) const {
        const int pn = u.pn; const bool rope = (pn < 4) || (pn >= 10 && pn < 14);
        const float sc = ((pn >= 2 && pn < 4) || (pn >= 10 && pn < 12)) ? 0.125f : 1.0f;
        const int row0 = u.pm * BM + wr * 64 + fr;
        if (rope) {
#pragma unroll
            for (int ai = 0; ai < 2; ++ai)
#pragma unroll
                for (int m = 0; m < 4; ++m) {
                    const int row = row0 + ai * HALF + m * 16;
                    const float* cr = cs + (size_t)row * 32 + 8 * fq; const float* sr = sn + (size_t)row * 32 + 8 * fq;
                    const f32x4 c0 = *(const f32x4*)cr, c1 = *(const f32x4*)(cr + 4), s0 = *(const f32x4*)sr, s1 = *(const f32x4*)(sr + 4);
                    const f32x4 x1a = acc[ai][0][m][0], x1b = acc[ai][0][m][1], x2a = acc[ai][1][m][0], x2b = acc[ai][1][m][1];
                    const f32x4 o1a = (x1a * c0 - x2a * s0) * sc, o1b = (x1b * c1 - x2b * s1) * sc, o2a = (x2a * c0 + x1a * s0) * sc, o2b = (x2b * c1 + x1b * s1) * sc;
                    bf16* rowp = H + (size_t)row * EVEN_IN + pn * BM + wc * 64 + 8 * fq;
                    store8(rowp, o1a, o1b); store8(rowp + 32, o2a, o2b);
                }
        } else {
#pragma unroll
            for (int ai = 0; ai < 2; ++ai)
#pragma unroll
                for (int m = 0; m < 4; ++m) {
                    bf16* rowp = H + (size_t)(row0 + ai * HALF + m * 16) * EVEN_IN + pn * BM + wc * 32 + 8 * fq;
#pragma unroll
                    for (int bj = 0; bj < 2; ++bj) store8(rowp + bj * HALF, acc[ai][bj][m][0], acc[ai][bj][m][1]);
                }
        }
    }
};
struct EpiInOdd {
    static constexpr bool PERM = true, AFTER_DRAIN = false;
    bf16* H;
    __device__ __forceinline__ void operator()(const f32x4 (&acc)[2][2][4][2], const Unit& u, int wr, int wc, int fr, int fq) const {
        const float sc = (u.pn < 4) ? 0.125f : 1.0f;
        const int row0 = u.pm * BM + wr * 64 + fr;
#pragma unroll
        for (int ai = 0; ai < 2; ++ai)
#pragma unroll
            for (int m = 0; m < 4; ++m) {
                bf16* rowp = H + (size_t)(row0 + ai * HALF + m * 16) * ODD_IN + u.pn * BM + wc * 32 + 8 * fq;
#pragma unroll
                for (int bj = 0; bj < 2; ++bj) store8(rowp + bj * HALF, acc[ai][bj][m][0] * sc, acc[ai][bj][m][1] * sc);
            }
    }
};
struct EpiOut {
    static constexpr bool PERM = false, AFTER_DRAIN = false;
    const float* Xres; float* U;
    __device__ __forceinline__ void operator()(const f32x4 (&acc)[2][2][4][2], const Unit& u, int wr, int wc, int fr, int fq) const {
        const int row0 = u.pm * BM + wr * 64 + fr, col0 = u.pn * BM + wc * 32 + 4 * fq;
#pragma unroll
        for (int ai = 0; ai < 2; ++ai)
#pragma unroll
            for (int m = 0; m < 4; ++m) {
                const size_t off = (size_t)(row0 + ai * HALF + m * 16) * D + col0;
#pragma unroll
                for (int bj = 0; bj < 2; ++bj)
#pragma unroll
                    for (int n = 0; n < 2; ++n) { const f32x4 xr = *(const f32x4*)(Xres + off + bj * HALF + n * 16); *(f32x4*)(U + off + bj * HALF + n * 16) = xr * ALPHA + acc[ai][bj][m][n]; }
            }
    }
};
struct EpiUp {
    static constexpr bool PERM = true, AFTER_DRAIN = false;
    bf16* Act; const float* bup;
    __device__ __forceinline__ void operator()(const f32x4 (&acc)[2][2][4][2], const Unit& u, int wr, int wc, int fr, int fq) const {
        const int row0 = u.pm * BM + wr * 64 + fr, f0 = u.pn * HALF + wc * 32 + 8 * fq;
        const float* bp = bup + (size_t)u.e * 2048 + 2 * f0;
        f32x4 bb[4];
#pragma unroll
        for (int i = 0; i < 4; ++i) bb[i] = *(const f32x4*)(bp + 4 * i);
#pragma unroll
        for (int ai = 0; ai < 2; ++ai)
#pragma unroll
            for (int m = 0; m < 4; ++m) {
                f32x4 o[2];
#pragma unroll
                for (int n = 0; n < 2; ++n) {
                    const f32x4 g = acc[ai][0][m][n], l = acc[ai][1][m][n];
#pragma unroll
                    for (int j = 0; j < 4; ++j) {
                        const float bg = bb[2 * n + (j >> 1)][(j & 1) * 2], bl = bb[2 * n + (j >> 1)][(j & 1) * 2 + 1];
                        const float xg = fminf(g[j] + bg, 7.0f), xl = fminf(fmaxf(l[j] + bl, -7.0f), 7.0f);
                        o[n][j] = xg * sigmoidf_(1.702f * xg) * (xl + 1.0f);
                    }
                }
                store8(Act + (size_t)(row0 + ai * HALF + m * 16) * 1024 + f0, o[0], o[1]);
            }
    }
};
struct EpiDown {
    static constexpr bool PERM = true, AFTER_DRAIN = false;
    bf16* O; const float* bdn;
    __device__ __forceinline__ void operator()(const f32x4 (&acc)[2][2][4][2], const Unit& u, int wr, int wc, int fr, int fq) const {
        const int row0 = u.pm * BM + wr * 64 + fr, col0 = u.pn * BM + wc * 32 + 8 * fq;
        const float* bp = bdn + (size_t)u.e * 1024 + col0;
        f32x4 bv[2][2];
#pragma unroll
        for (int bj = 0; bj < 2; ++bj)
#pragma unroll
            for (int n = 0; n < 2; ++n) bv[bj][n] = *(const f32x4*)(bp + bj * HALF + 4 * n);
#pragma unroll
        for (int ai = 0; ai < 2; ++ai)
#pragma unroll
            for (int m = 0; m < 4; ++m) {
                bf16* rowp = O + (size_t)(row0 + ai * HALF + m * 16) * 1024 + col0;
#pragma unroll
                for (int bj = 0; bj < 2; ++bj) store8(rowp + bj * HALF, acc[ai][bj][m][0] + bv[bj][0], acc[ai][bj][m][1] + bv[bj][1]);
            }
    }
};

template <class Epi, class Sched, bool ALIGN_EPI = true, bool SP2 = true>
__device__ __forceinline__ void gemm_phase(LAS unsigned char* lds, const Sched& S, const Epi& E, const int tid) {
    const int wid = __builtin_amdgcn_readfirstlane(tid >> 6), lane = tid & 63, wr = wid >> 2, wc = wid & 3, fr = lane & 15, fq = lane >> 4;
    constexpr int K = KD, nt = K / BK;
    unsigned voffA[2], voffB[2];
#pragma unroll
    for (int i = 0; i < 2; ++i) { int R, C; stage_rc(tid * 16 + i * 8192, R, C); const int Rb = Epi::PERM ? ((R & ~31) + perm32(R & 31)) : R;
        voffA[i] = (unsigned)(R * K + C) * 2u; voffB[i] = (unsigned)(Rb * K + C) * 2u; }
    const size_t kstep = (size_t)(BK * 2);
    const size_t hstep = (size_t)HALF * K * 2;
    const unsigned ldsw = (unsigned)wid * 1024u;
    const int aoff = lds_byte(wr * 64 + fr, fq * 8), boff = lds_byte(wc * 32 + fr, fq * 8);
#define PG8_SA(b, h) (((b) * 2 + (h)) * HTB)
#define PG8_SB(b, h) ((4 + (b) * 2 + (h)) * HTB)
#define PG8_STAGE(bufoff, gbase, voff) do { _Pragma("unroll") for (int _i = 0; _i < 2; ++_i) \
        __builtin_amdgcn_global_load_lds((const unsigned*)((const char*)(gbase) + (voff)[_i]), (LAS unsigned*)(lds + (bufoff) + ldsw + _i * 8192), 16, 0, 0); } while (0)
#define PG8_LDA(dst, b, h) do { _Pragma("unroll") for (int m = 0; m < 4; ++m) _Pragma("unroll") for (int k = 0; k < 2; ++k) dst[m][k] = *(const LAS bf16x8*)(lds + PG8_SA(b, h) + aoff + m * 2048 + k * 1024); } while (0)
#define PG8_LDB(dst, b, h) do { _Pragma("unroll") for (int n = 0; n < 2; ++n) _Pragma("unroll") for (int k = 0; k < 2; ++k) dst[n][k] = *(const LAS bf16x8*)(lds + PG8_SB(b, h) + boff + n * 2048 + k * 1024); } while (0)
#define PG8_MMA(ai, bj, At, Bt) do { __builtin_amdgcn_s_setprio(1); _Pragma("unroll") for (int m = 0; m < 4; ++m) _Pragma("unroll") for (int n = 0; n < 2; ++n) _Pragma("unroll") for (int k = 0; k < 2; ++k) \
        acc[ai][bj][m][n] = __builtin_amdgcn_mfma_f32_16x16x32_bf16(Bt[n][k], At[m][k], acc[ai][bj][m][n], 0, 0, 0); __builtin_amdgcn_s_setprio(0); } while (0)
#define PG8_WAIT_V(n) asm volatile("s_waitcnt vmcnt(" #n ")" ::: "memory")
#define PG8_WAIT_L(n) asm volatile("s_waitcnt lgkmcnt(" #n ")" ::: "memory")
#define PG8_BAR __builtin_amdgcn_s_barrier()
#define PG8_SCHED __builtin_amdgcn_sched_barrier(0)
    Unit cur, nxt; int ui = 0;
    if (!S.next(0, cur)) return;
    f32x4 acc[2][2][4][2];
#pragma unroll
    for (int a = 0; a < 2; ++a)
#pragma unroll
        for (int b = 0; b < 2; ++b)
#pragma unroll
            for (int m = 0; m < 4; ++m)
#pragma unroll
                for (int n = 0; n < 2; ++n) acc[a][b][m][n] = (f32x4){0.f, 0.f, 0.f, 0.f};
    bf16x8 At[4][2], B0[2][2], B1[2][2];
    const char* cA = S.a_base(cur); const char* cB = S.b_base(cur);
    if constexpr (SP2) {
        PG8_STAGE(PG8_SB(0, 0), cB, voffB); PG8_STAGE(PG8_SB(0, 1), cB + hstep, voffB); PG8_STAGE(PG8_SA(0, 0), cA, voffA); PG8_STAGE(PG8_SA(0, 1), cA + hstep, voffA);
        if (wr == 1) PG8_BAR;
        PG8_WAIT_V(2); PG8_BAR;
        PG8_STAGE(PG8_SB(1, 0), cB + kstep, voffB); PG8_STAGE(PG8_SA(1, 0), cA + kstep, voffA); PG8_STAGE(PG8_SB(1, 1), cB + hstep + kstep, voffB);
        PG8_WAIT_V(6); PG8_BAR;
    } else {
        PG8_STAGE(PG8_SB(0, 0), cB, voffB); PG8_STAGE(PG8_SA(0, 0), cA, voffA); PG8_STAGE(PG8_SB(0, 1), cB + hstep, voffB); PG8_STAGE(PG8_SA(0, 1), cA + hstep, voffA);
        if (wr == 1) PG8_BAR;
        PG8_WAIT_V(4); PG8_BAR;
        PG8_STAGE(PG8_SB(1, 0), cB + kstep, voffB); PG8_STAGE(PG8_SA(1, 0), cA + kstep, voffA); PG8_STAGE(PG8_SB(1, 1), cB + hstep + kstep, voffB);
        PG8_WAIT_V(6); PG8_BAR;
    }
    for (;;) {
        const bool has_next = S.next(ui + 1, nxt);
        const char* nA = has_next ? S.a_base(nxt) : cA; const char* nB = has_next ? S.b_base(nxt) : cB;
        for (int t = 0; t < nt; t += 2) {
            const bool last = (t == nt - 2);
            const char* a1 = cA + (size_t)(t + 1) * kstep;
            const char* a2 = last ? nA : cA + (size_t)(t + 2) * kstep; const char* b2 = last ? nB : cB + (size_t)(t + 2) * kstep;
            const char* a3 = a2 + kstep; const char* b3 = b2 + kstep;
            if constexpr (SP2) {
            PG8_LDB(B0, 0, 0); PG8_LDB(B1, 0, 1); PG8_SCHED; PG8_LDA(At, 0, 0); PG8_STAGE(PG8_SA(1, 1), a1 + hstep, voffA);
            PG8_WAIT_V(8); PG8_WAIT_L(0); PG8_BAR; PG8_MMA(0, 0, At, B0); PG8_MMA(0, 1, At, B1); PG8_BAR; PG8_SCHED;
            PG8_LDA(At, 0, 1); PG8_STAGE(PG8_SB(0, 0), b2, voffB); PG8_STAGE(PG8_SB(0, 1), b2 + hstep, voffB); PG8_STAGE(PG8_SA(0, 0), a2, voffA);
            PG8_WAIT_V(8); PG8_WAIT_L(0); PG8_BAR; PG8_MMA(1, 0, At, B0); PG8_MMA(1, 1, At, B1); PG8_BAR; PG8_SCHED;
            PG8_LDB(B0, 1, 0); PG8_LDB(B1, 1, 1); PG8_SCHED; PG8_LDA(At, 1, 0); PG8_STAGE(PG8_SA(0, 1), a2 + hstep, voffA);
            PG8_WAIT_V(8); PG8_WAIT_L(0); PG8_BAR; PG8_MMA(0, 0, At, B0); PG8_MMA(0, 1, At, B1); PG8_BAR; PG8_SCHED;
            PG8_LDA(At, 1, 1); PG8_STAGE(PG8_SB(1, 0), b3, voffB); PG8_STAGE(PG8_SB(1, 1), b3 + hstep, voffB); PG8_STAGE(PG8_SA(1, 0), a3, voffA);
            PG8_WAIT_V(8); PG8_WAIT_L(0); PG8_BAR; PG8_MMA(1, 0, At, B0); PG8_MMA(1, 1, At, B1); PG8_BAR; PG8_SCHED;
            } else {
            PG8_LDB(B0, 0, 0); PG8_SCHED; PG8_LDA(At, 0, 0); PG8_STAGE(PG8_SA(1, 1), a1 + hstep, voffA);
            PG8_WAIT_L(8); PG8_BAR; PG8_WAIT_L(0); PG8_MMA(0, 0, At, B0); PG8_BAR; PG8_SCHED;
            PG8_LDB(B1, 0, 1); PG8_STAGE(PG8_SB(0, 0), b2, voffB);
            PG8_BAR; PG8_WAIT_L(0); PG8_MMA(0, 1, At, B1); PG8_BAR;
            PG8_LDA(At, 0, 1); PG8_STAGE(PG8_SA(0, 0), a2, voffA);
            PG8_BAR; PG8_WAIT_L(0); PG8_MMA(1, 0, At, B0); PG8_BAR; PG8_SCHED;
            PG8_STAGE(PG8_SB(0, 1), b2 + hstep, voffB);
            PG8_WAIT_V(6); PG8_BAR; PG8_MMA(1, 1, At, B1); PG8_BAR;
            PG8_LDB(B0, 1, 0); PG8_SCHED; PG8_LDA(At, 1, 0); PG8_STAGE(PG8_SA(0, 1), a2 + hstep, voffA);
            PG8_WAIT_L(8); PG8_BAR; PG8_WAIT_L(0); PG8_MMA(0, 0, At, B0); PG8_BAR; PG8_SCHED;
            PG8_LDB(B1, 1, 1); PG8_STAGE(PG8_SB(1, 0), b3, voffB);
            PG8_BAR; PG8_WAIT_L(0); PG8_MMA(0, 1, At, B1); PG8_BAR;
            PG8_LDA(At, 1, 1); PG8_STAGE(PG8_SA(1, 0), a3, voffA);
            PG8_BAR; PG8_WAIT_L(0); PG8_MMA(1, 0, At, B0); PG8_BAR; PG8_SCHED;
            PG8_STAGE(PG8_SB(1, 1), b3 + hstep, voffB);
            PG8_WAIT_V(6); PG8_BAR; PG8_MMA(1, 1, At, B1); PG8_BAR;
            }
        }
        if constexpr (ALIGN_EPI) { if (wr == 0) PG8_BAR; }
        E(acc, cur, wr, wc, fr, fq);
        if (!has_next) break;
#pragma unroll
        for (int a = 0; a < 2; ++a)
#pragma unroll
            for (int b = 0; b < 2; ++b)
#pragma unroll
                for (int m = 0; m < 4; ++m)
#pragma unroll
                    for (int n = 0; n < 2; ++n) acc[a][b][m][n] = (f32x4){0.f, 0.f, 0.f, 0.f};
        cur = nxt; cA = nA; cB = nB; ++ui;
        if constexpr (ALIGN_EPI) { if (wr == 1) PG8_BAR; }
    }
    PG8_WAIT_V(0);
    if constexpr (!ALIGN_EPI) { if (wr == 0) PG8_BAR; }
    PG8_BAR;
#undef PG8_SA
#undef PG8_SB
#undef PG8_STAGE
#undef PG8_LDA
#undef PG8_LDB
#undef PG8_MMA
#undef PG8_WAIT_V
#undef PG8_WAIT_L
#undef PG8_BAR
#undef PG8_SCHED
}
}

__device__ __forceinline__ int rowmap(int mode, int c) {
    if (mode == 1) { const int pn = c >> 8; const bool rope = (pn < 4) || (pn >= 10 && pn < 14);
        return rope ? ((c & ~255) | (((c >> 5) & 1) << 7) | (((c >> 6) & 3) << 5) | (c & 31)) : c; }
    if (mode == 2) { const int f = c >> 1, bj = c & 1; return ((f >> 7) << 8) | (bj << 7) | (f & 127); }
    return c;
}
__device__ __forceinline__ void p0_transpose_item(const float* W, int N, bf16* WT, int mode, LAS float* scr, int item, int lane) {
    const int nblk = N / 32, kb = item / nblk, nb = item % nblk, k0 = 64 * kb, n0 = 32 * nb;
#pragma unroll 8
    for (int i = 0; i < 32; ++i) { const int kk = 2 * i + (lane >> 5); scr[kk * 33 + (lane & 31)] = W[(size_t)(k0 + kk) * N + n0 + (lane & 31)]; }
    asm volatile("s_waitcnt lgkmcnt(0)" ::: "memory");
    const int c = lane & 7;
#pragma unroll
    for (int j = 0; j < 4; ++j) { const int n = (lane >> 3) + 8 * j; const LAS float* s = scr + (8 * c) * 33 + n;
        u32x4 o; o.x = pk2(s[0 * 33], s[1 * 33]); o.y = pk2(s[2 * 33], s[3 * 33]); o.z = pk2(s[4 * 33], s[5 * 33]); o.w = pk2(s[6 * 33], s[7 * 33]);
        *(u32x4*)(WT + (size_t)rowmap(mode, n0 + n) * 1024 + k0 + 8 * c) = o; }
    asm volatile("s_waitcnt lgkmcnt(0)" ::: "memory");
}
__device__ const double INV_FREQ[32] = {1, 0.74989420933245587, 0.56234132519034907, 0.42169650342858223, 0.31622776601683794, 0.23713737056616552, 0.17782794100389229, 0.1333521432163324,
    0.10000000000000001, 0.074989420933245579, 0.056234132519034911, 0.042169650342858224, 0.031622776601683791, 0.023713737056616554, 0.017782794100389229, 0.013335214321633241,
    0.01, 0.0074989420933245579, 0.005623413251903491, 0.0042169650342858229, 0.0031622776601683794, 0.0023713737056616554, 0.0017782794100389228, 0.0013335214321633241,
    0.001, 0.00074989420933245586, 0.0005623413251903491, 0.00042169650342858224, 0.00031622776601683794, 0.00023713737056616554, 0.00017782794100389227, 0.0001333521432163324};

struct Ptrs {
    const float *x, *ab_w_in, *ab_w_out, *ret_decay, *c_w_in, *c_w_out, *c_rpb, *ln_g, *ln_b, *router_w, *router_b, *w_up, *b_up, *w_down, *b_down;
    float* out; unsigned char* ws;
};

__device__ __forceinline__ void phase_prologue(const Ptrs& P, LAS unsigned char* lds, int bid, int tid) {
    const int wave = tid >> 6, lane = tid & 63;
    LAS float* scr = (LAS float*)(lds + wave * 16384);
    const int gw = bid * NWAVES + wave, NGW = GRID * NWAVES;
    constexpr int I0 = 2 * 2048, I1 = 2 * 512, I2 = 2 * 1536, I3 = 2 * 512, I4 = 128 * 1024, I5 = 128 * 512;
    constexpr int NITEMS = I0 + I1 + I2 + I3 + I4 + I5;
    unsigned char* ws = P.ws;
    for (int it = gw; it < NITEMS; it += NGW) {
        int r = it;
        if (r < I0) { const int mi = r / 2048, ii = r % 2048; p0_transpose_item(P.ab_w_in + (size_t)mi * 1024 * 4096, 4096, (bf16*)(ws + WS_WIN_E) + (size_t)mi * 4096 * 1024, 1, scr, ii, lane); continue; } r -= I0;
        if (r < I1) { const int mi = r / 512, ii = r % 512; p0_transpose_item(P.ab_w_out + (size_t)mi * 1024 * 1024, 1024, (bf16*)(ws + WS_WOUT_E) + (size_t)mi * 1024 * 1024, 0, scr, ii, lane); continue; } r -= I1;
        if (r < I2) { const int mi = r / 1536, ii = r % 1536; p0_transpose_item(P.c_w_in + (size_t)mi * 1024 * 3072, 3072, (bf16*)(ws + WS_WIN_O) + (size_t)mi * 3072 * 1024, 0, scr, ii, lane); continue; } r -= I2;
        if (r < I3) { const int mi = r / 512, ii = r % 512; p0_transpose_item(P.c_w_out + (size_t)mi * 1024 * 1024, 1024, (bf16*)(ws + WS_WOUT_O) + (size_t)mi * 1024 * 1024, 0, scr, ii, lane); continue; } r -= I3;
        if (r < I4) { const int mi = r / 1024, ii = r % 1024; p0_transpose_item(P.w_up + (size_t)mi * 1024 * 2048, 2048, (bf16*)(ws + WS_WUP) + (size_t)mi * 2048 * 1024, 2, scr, ii, lane); continue; } r -= I4;
        { const int mi = r / 512, ii = r % 512; p0_transpose_item(P.w_down + (size_t)mi * 1024 * 1024, 1024, (bf16*)(ws + WS_WDN) + (size_t)mi * 1024 * 1024, 0, scr, ii, lane); }
    }
    float* cs = (float*)(ws + WS_COS); float* sn = (float*)(ws + WS_SIN);
    for (int g = bid * NTHR + tid; g < T * 32; g += GRID * NTHR) {
        const int pos = g >> 5, i = g & 31;
        const double rev = (double)pos * INV_FREQ[i] * 0.15915494309189535;
        const double fr = rev - __builtin_rint(rev);
        const float a = (float)(fr * 6.283185307179586);
        cs[g] = cosf(a); sn[g] = sinf(a);
    }
    bf16* xb = (bf16*)(ws + WS_XB);
    for (size_t g = (size_t)bid * NTHR + tid; g < (size_t)T * D / 8; g += (size_t)GRID * NTHR) {
        const f32x4 a = *(const f32x4*)(P.x + g * 8), b = *(const f32x4*)(P.x + g * 8 + 4);
        u32x4 o; o.x = pk2(a[0], a[1]); o.y = pk2(a[2], a[3]); o.z = pk2(b[0], b[1]); o.w = pk2(b[2], b[3]);
        *(u32x4*)(xb + g * 8) = o;
    }
}

__device__ __forceinline__ void load_panel_f32(LAS float* dst, const bf16* src, int ldh, int tid) {
    const int row = tid >> 2, c0 = (tid & 3) * 16;
    const bf16* p = src + (size_t)row * ldh + c0;
    const u32x4 a = *(const u32x4*)p, b = *(const u32x4*)(p + 8);
    float f[16]; unpack8(a, f); unpack8(b, f + 8);
    LAS f32x4* d = (LAS f32x4*)(dst + row * 64 + c0);
    d[0] = (f32x4){f[0], f[1], f[2], f[3]}; d[1] = (f32x4){f[4], f[5], f[6], f[7]}; d[2] = (f32x4){f[8], f[9], f[10], f[11]}; d[3] = (f32x4){f[12], f[13], f[14], f[15]};
}
__device__ __forceinline__ void phase_ret_states(LAS unsigned char* lds, const bf16* H, const float* decay, float* S, int bid, int tid) {
    LAS float* kf = (LAS float*)lds; LAS float* vf = kf + 128 * 64; LAS float* zt = (LAS float*)(lds + MISC_OFF + 4096);
    for (int unit = bid; unit < 1024; unit += GRID) {
        const int h = unit >> 7, n = unit & 127;
        const float lgf = log2_gamma(decay[h]), lgb = log2_gamma(decay[8 + h]);
        __syncthreads();
        load_panel_f32(kf, H + (size_t)(n * 128) * EVEN_IN + 512 + h * 64, EVEN_IN, tid);
        load_panel_f32(vf, H + (size_t)(n * 128) * EVEN_IN + 1024 + h * 64, EVEN_IN, tid);
        if (tid < 128) { zt[tid] = exp2f(lgf * (float)(127 - tid)); zt[128 + tid] = exp2f(lgb * (float)tid); }
        __syncthreads();
        const int e = tid >> 3, d0 = (tid & 7) * 8;
        f32x4 af0 = {0, 0, 0, 0}, af1 = af0, ab0 = af0, ab1 = af0;
        for (int m = 0; m < 128; ++m) {
            const float ve = vf[m * 64 + e]; const float a = ve * zt[m], b = ve * zt[128 + m];
            const f32x4 k0 = *(const LAS f32x4*)(kf + m * 64 + d0), k1 = *(const LAS f32x4*)(kf + m * 64 + d0 + 4);
            af0 += k0 * a; af1 += k1 * a; ab0 += k0 * b; ab1 += k1 * b;
        }
        float* sf = S + ((size_t)(h) * 128 + n) * 4096 + e * 64 + d0;
        float* sb = S + ((size_t)(8 + h) * 128 + n) * 4096 + e * 64 + d0;
        *(f32x4*)sf = af0; *(f32x4*)(sf + 4) = af1; *(f32x4*)sb = ab0; *(f32x4*)(sb + 4) = ab1;
    }
}
__device__ __forceinline__ void phase_ret_scan(const float* S, bf16* R, const float* decay, int bid, int tid) {
    for (int g = bid * NTHR + tid; g < 65536; g += GRID * NTHR) {
        const int dir = g >> 15, h = (g >> 12) & 7, de = g & 4095;
        const float gc = exp2f(log2_gamma(decay[dir * 8 + h]) * 128.0f);
        const float* s = S + ((size_t)(dir * 8 + h) * 128) * 4096 + de; bf16* r = R + ((size_t)(dir * 8 + h) * 128) * 4096 + de;
        float a = 0.f;
        if (dir == 0) { for (int n = 0; n < 128; ++n) { r[(size_t)n * 4096] = (bf16)f2bf(a); a = gc * a + s[(size_t)n * 4096]; } }
        else { for (int n = 127; n >= 0; --n) { r[(size_t)n * 4096] = (bf16)f2bf(a); a = gc * a + s[(size_t)n * 4096]; } }
    }
}
__device__ __forceinline__ void phase_ret_out(LAS unsigned char* lds, const bf16* H, const float* R, const float* decay, bf16* Y, int bid, int tid) {
    LAS float* qf = (LAS float*)lds; LAS float* kf = qf + 8192; LAS float* vf = kf + 8192; LAS float* rf = vf + 8192; LAS float* rb = rf + 4096;
    for (int unit = bid; unit < 1024; unit += GRID) {
        const int h = unit >> 7, n = unit & 127;
        const float lgf = log2_gamma(decay[h]), lgb = log2_gamma(decay[8 + h]);
        __syncthreads();
        const bf16* hp = H + (size_t)(n * 128) * EVEN_IN + h * 64;
        load_panel_f32(qf, hp, EVEN_IN, tid); load_panel_f32(kf, hp + 512, EVEN_IN, tid); load_panel_f32(vf, hp + 1024, EVEN_IN, tid);
        { const float* r0 = R + ((size_t)(h) * 128 + n) * 4096 + tid * 8; const float* r1 = R + ((size_t)(8 + h) * 128 + n) * 4096 + tid * 8;
          *(LAS f32x4*)(rf + tid * 8) = *(const f32x4*)r0; *(LAS f32x4*)(rf + tid * 8 + 4) = *(const f32x4*)(r0 + 4);
          *(LAS f32x4*)(rb + tid * 8) = *(const f32x4*)r1; *(LAS f32x4*)(rb + tid * 8 + 4) = *(const f32x4*)(r1 + 4); }
        __syncthreads();
        const int c = tid >> 2, e0 = (tid & 3) * 16;
        f32x4 q[16];
#pragma unroll
        for (int i = 0; i < 16; ++i) q[i] = *(const LAS f32x4*)(qf + c * 64 + 4 * i);
        f32x4 of[4], ob[4];
#pragma unroll
        for (int i = 0; i < 4; ++i) { of[i] = (f32x4){0, 0, 0, 0}; ob[i] = of[i]; }
        for (int m = 0; m < 128; ++m) {
            f32x4 sv = {0, 0, 0, 0};
#pragma unroll
            for (int i = 0; i < 16; ++i) sv += q[i] * *(const LAS f32x4*)(kf + m * 64 + 4 * i);
            const float s = (sv[0] + sv[1]) + (sv[2] + sv[3]);
            const float df = (float)(c - m);
            const float pf = (m <= c) ? exp2f(lgf * df) : 0.0f;
            const float pb = (m > c) ? exp2f(-lgb * df) : 0.0f;
            const float wf = s * pf, wb = s * pb;
#pragma unroll
            for (int i = 0; i < 4; ++i) { const f32x4 v = *(const LAS f32x4*)(vf + m * 64 + e0 + 4 * i); of[i] += v * wf; ob[i] += v * wb; }
        }
        f32x4 cf[4], cb[4];
#pragma unroll
        for (int i = 0; i < 4; ++i) { cf[i] = (f32x4){0, 0, 0, 0}; cb[i] = cf[i]; }
#pragma unroll
        for (int d4 = 0; d4 < 16; ++d4)
#pragma unroll
            for (int dd = 0; dd < 4; ++dd) {
                const float qd = q[d4][dd]; const int d = 4 * d4 + dd;
#pragma unroll
                for (int i = 0; i < 4; ++i) { cf[i] += *(const LAS f32x4*)(rf + d * 64 + e0 + 4 * i) * qd; cb[i] += *(const LAS f32x4*)(rb + d * 64 + e0 + 4 * i) * qd; }
            }
        const float xif = exp2f(lgf * (float)(c + 1)), xib = exp2f(lgb * (float)(128 - c));
        float sf = 0.f, sb = 0.f;
#pragma unroll
        for (int i = 0; i < 4; ++i) { of[i] += cf[i] * xif; ob[i] += cb[i] * xib; sf += (of[i][0] + of[i][1]) + (of[i][2] + of[i][3]); sb += (ob[i][0] + ob[i][1]) + (ob[i][2] + ob[i][3]); }
        sf += __shfl_xor(sf, 1); sf += __shfl_xor(sf, 2); sb += __shfl_xor(sb, 1); sb += __shfl_xor(sb, 2);
        const float muf = sf * (1.0f / 64.0f), mub = sb * (1.0f / 64.0f);
        float vfq = 0.f, vbq = 0.f;
#pragma unroll
        for (int i = 0; i < 4; ++i) { of[i] = of[i] - muf; ob[i] = ob[i] - mub;
            vfq += (of[i][0] * of[i][0] + of[i][1] * of[i][1]) + (of[i][2] * of[i][2] + of[i][3] * of[i][3]);
            vbq += (ob[i][0] * ob[i][0] + ob[i][1] * ob[i][1]) + (ob[i][2] * ob[i][2] + ob[i][3] * ob[i][3]); }
        vfq += __shfl_xor(vfq, 1); vfq += __shfl_xor(vfq, 2); vbq += __shfl_xor(vbq, 1); vbq += __shfl_xor(vbq, 2);
        const float rsf = 1.0f / sqrtf(vfq * (1.0f / 64.0f) + GN_EPS), rsb = 1.0f / sqrtf(vbq * (1.0f / 64.0f) + GN_EPS);
        const int tok = n * 128 + c;
        const bf16* gp = H + (size_t)tok * EVEN_IN + 1536 + h * 64 + e0;
        float gf[16], gb[16];
        unpack8(*(const u32x4*)gp, gf); unpack8(*(const u32x4*)(gp + 8), gf + 8); unpack8(*(const u32x4*)(gp + 512), gb); unpack8(*(const u32x4*)(gp + 520), gb + 8);
        float y[16];
#pragma unroll
        for (int i = 0; i < 16; ++i) { const float a = gf[i] * sigmoidf_(gf[i]), b = gb[i] * sigmoidf_(gb[i]); y[i] = a * (of[i >> 2][i & 3] * rsf) + b * (ob[i >> 2][i & 3] * rsb); }
        bf16* yp = Y + (size_t)tok * D + h * 64 + e0;
        u32x4 w0, w1; w0.x = pk2(y[0], y[1]); w0.y = pk2(y[2], y[3]); w0.z = pk2(y[4], y[5]); w0.w = pk2(y[6], y[7]); w1.x = pk2(y[8], y[9]); w1.y = pk2(y[10], y[11]); w1.z = pk2(y[12], y[13]); w1.w = pk2(y[14], y[15]);
        *(u32x4*)yp = w0; *(u32x4*)(yp + 8) = w1;
    }
}

struct OnlineSm { float m, l; f32x4 o[16]; };
__device__ __forceinline__ void load_q64(const bf16* p, f32x4 (&q)[16]) {
#pragma unroll
    for (int i = 0; i < 8; ++i) { float f[8]; unpack8(*(const u32x4*)(p + 8 * i), f); q[2 * i] = (f32x4){f[0], f[1], f[2], f[3]}; q[2 * i + 1] = (f32x4){f[4], f[5], f[6], f[7]}; }
}
__device__ __forceinline__ float dot64(const f32x4 (&q)[16], const bf16* kp) {
    f32x4 sv = {0, 0, 0, 0};
#pragma unroll
    for (int i = 0; i < 8; ++i) { float f[8]; unpack8(*(const u32x4*)(kp + 8 * i), f); sv += q[2 * i] * (f32x4){f[0], f[1], f[2], f[3]}; sv += q[2 * i + 1] * (f32x4){f[4], f[5], f[6], f[7]}; }
    return (sv[0] + sv[1]) + (sv[2] + sv[3]);
}
__device__ __forceinline__ void sm_update(OnlineSm& st, float s, const bf16* vp) {
    const float mn = fmaxf(st.m, s), sc = __expf(st.m - mn), p = __expf(s - mn);
    st.l = st.l * sc + p; st.m = mn;
#pragma unroll
    for (int i = 0; i < 8; ++i) { float f[8]; unpack8(*(const u32x4*)(vp + 8 * i), f);
        st.o[2 * i] = st.o[2 * i] * sc + (f32x4){f[0], f[1], f[2], f[3]} * p; st.o[2 * i + 1] = st.o[2 * i + 1] * sc + (f32x4){f[4], f[5], f[6], f[7]} * p; }
}
__device__ __forceinline__ void sm_store(const OnlineSm& st, bf16* yp) {
    const float inv = 1.0f / st.l;
#pragma unroll
    for (int i = 0; i < 8; ++i) { const f32x4 a = st.o[2 * i] * inv, b = st.o[2 * i + 1] * inv; u32x4 w; w.x = pk2(a[0], a[1]); w.y = pk2(a[2], a[3]); w.z = pk2(b[0], b[1]); w.w = pk2(b[2], b[3]); *(u32x4*)(yp + 8 * i) = w; }
}
__device__ __forceinline__ void phase_dilated(const bf16* H, bf16* Y, int bid, int tid) {
    const int g = bid * NTHR + tid, h = g >> 14, i = g & 16383;
    f32x4 q[16]; load_q64(H + (size_t)i * EVEN_IN + 2560 + h * 64, q);
    OnlineSm st; st.m = -1e30f; st.l = 0.f;
#pragma unroll
    for (int k = 0; k < 16; ++k) st.o[k] = (f32x4){0, 0, 0, 0};
    for (int b = 0; b < 3; ++b) {
        const int dil = (b == 0) ? 1 : ((b == 1) ? 4 : 16);
        for (int jj = -64; jj <= 64; ++jj) {
            const int j = i + dil * jj;
            if (j < 0 || j >= T) continue;
            const bf16* kp = H + (size_t)j * EVEN_IN + 3072 + h * 64;
            const float s = dot64(q, kp);
            sm_update(st, s, kp + 512);
        }
    }
    sm_store(st, Y + (size_t)i * D + 512 + h * 64);
}
__device__ __forceinline__ void phase_natten(const bf16* H, const float* rpb, bf16* Y, int bid, int tid) {
    for (int rep = 0; rep < 2; ++rep) {
        const int g = rep * (GRID * NTHR) + bid * NTHR + tid, h = g >> 14, i = g & 16383, r = i >> 6, c = i & 63;
        const int r0 = min(max(r - 4, 0), 248), c0 = min(max(c - 8, 0), 48);
        f32x4 q[16]; load_q64(H + (size_t)i * ODD_IN + h * 64, q);
        OnlineSm st; st.m = -1e30f; st.l = 0.f;
#pragma unroll
        for (int k = 0; k < 16; ++k) st.o[k] = (f32x4){0, 0, 0, 0};
        for (int ii = 0; ii < 8; ++ii)
            for (int jj = 0; jj < 16; ++jj) {
                const int kr = r0 + ii, kc = c0 + jj, j = kr * 64 + kc;
                const float bias = rpb[(h * 15 + (kr - r + 7)) * 31 + (kc - c + 15)];
                const bf16* kp = H + (size_t)j * ODD_IN + 1024 + h * 64;
                const float s = dot64(q, kp) + bias;
                sm_update(st, s, kp + 1024);
            }
        sm_store(st, Y + (size_t)i * D + h * 64);
    }
}

typedef short s16x4 __attribute__((ext_vector_type(4)));
__device__ __forceinline__ void tr_read8(unsigned a0, unsigned a1, unsigned a2, unsigned a3, s16x4 (&r)[8]) {
    asm volatile("ds_read_b64_tr_b16 %0, %8\n\tds_read_b64_tr_b16 %1, %8 offset:2048\n\tds_read_b64_tr_b16 %2, %9\n\tds_read_b64_tr_b16 %3, %9 offset:2048\n\t"
                 "ds_read_b64_tr_b16 %4, %10\n\tds_read_b64_tr_b16 %5, %10 offset:2048\n\tds_read_b64_tr_b16 %6, %11\n\tds_read_b64_tr_b16 %7, %11 offset:2048\n\ts_waitcnt lgkmcnt(0)"
                 : "=&v"(r[0]), "=&v"(r[1]), "=&v"(r[2]), "=&v"(r[3]), "=&v"(r[4]), "=&v"(r[5]), "=&v"(r[6]), "=&v"(r[7]) : "v"(a0), "v"(a1), "v"(a2), "v"(a3) : "memory");
}
struct LaneOffs { unsigned k0, k1, v[4]; };
__device__ __forceinline__ LaneOffs lane_offs(int lane) {
    const int i = lane & 15, g = lane >> 4, q = i >> 2, p = i & 3, vrow = 4 * g + q; LaneOffs o;
    o.k0 = (unsigned)(i * 128 + (((g) ^ (i & 7)) << 4)); o.k1 = (unsigned)(i * 128 + (((4 + g) ^ (i & 7)) << 4));
#pragma unroll
    for (int dt = 0; dt < 4; ++dt) o.v[dt] = (unsigned)(vrow * 128 + (((2 * dt + (p >> 1)) ^ (vrow & 7)) << 4) + 8 * (p & 1));
    return o;
}
__device__ __forceinline__ unsigned lds_addr(const LAS unsigned char* p) { return (unsigned)(size_t)p; }
__device__ __forceinline__ void qk_tile(const LAS unsigned char* Kt, const LaneOffs& lo, const bf16x8 q0, const bf16x8 q1, f32x4 (&sa)[2]) {
    const bf16x8 k00 = *(const LAS bf16x8*)(Kt + lo.k0), k01 = *(const LAS bf16x8*)(Kt + lo.k1), k10 = *(const LAS bf16x8*)(Kt + 2048 + lo.k0), k11 = *(const LAS bf16x8*)(Kt + 2048 + lo.k1);
    sa[0] = (f32x4){0.f, 0.f, 0.f, 0.f}; sa[1] = sa[0];
    sa[0] = __builtin_amdgcn_mfma_f32_16x16x32_bf16(k00, q0, sa[0], 0, 0, 0); sa[0] = __builtin_amdgcn_mfma_f32_16x16x32_bf16(k01, q1, sa[0], 0, 0, 0);
    sa[1] = __builtin_amdgcn_mfma_f32_16x16x32_bf16(k10, q0, sa[1], 0, 0, 0); sa[1] = __builtin_amdgcn_mfma_f32_16x16x32_bf16(k11, q1, sa[1], 0, 0, 0);
}
__device__ __forceinline__ void pv_tile(const LAS unsigned char* Vt, const LaneOffs& lo, const f32x4 p0, const f32x4 p1, f32x4 (&o)[4]) {
    const unsigned vb = lds_addr(Vt); s16x4 r[8];
    tr_read8(vb + lo.v[0], vb + lo.v[1], vb + lo.v[2], vb + lo.v[3], r);
    u32x4 pw;
    asm volatile("v_cvt_pk_bf16_f32 %0, %4, %5\n\tv_cvt_pk_bf16_f32 %1, %6, %7\n\tv_cvt_pk_bf16_f32 %2, %8, %9\n\tv_cvt_pk_bf16_f32 %3, %10, %11\n\ts_nop 1"
                 : "=&v"(pw.x), "=&v"(pw.y), "=&v"(pw.z), "=&v"(pw.w) : "v"(p0[0]), "v"(p0[1]), "v"(p0[2]), "v"(p0[3]), "v"(p1[0]), "v"(p1[1]), "v"(p1[2]), "v"(p1[3]));
    const bf16x8 pb = __builtin_bit_cast(bf16x8, pw);
#pragma unroll
    for (int dt = 0; dt < 4; ++dt) { const bf16x8 va = __builtin_shufflevector(r[2 * dt], r[2 * dt + 1], 0, 1, 2, 3, 4, 5, 6, 7); o[dt] = __builtin_amdgcn_mfma_f32_16x16x32_bf16(va, pb, o[dt], 0, 0, 0); }
}
struct SmState { float m, l; f32x4 o[4]; };
__device__ __forceinline__ void sm_init(SmState& st) { st.m = -1e30f; st.l = 0.f;
#pragma unroll
    for (int dt = 0; dt < 4; ++dt) st.o[dt] = (f32x4){0.f, 0.f, 0.f, 0.f}; }
__device__ __forceinline__ void sm_step(SmState& st, f32x4 (&sa)[2], const LAS unsigned char* Vt, const LaneOffs& lo) {
    float tm = fmaxf(fmaxf(fmaxf(sa[0][0], sa[0][1]), fmaxf(sa[0][2], sa[0][3])), fmaxf(fmaxf(sa[1][0], sa[1][1]), fmaxf(sa[1][2], sa[1][3])));
    tm = fmaxf(tm, __shfl_xor(tm, 16)); tm = fmaxf(tm, __shfl_xor(tm, 32));
    const float mn = fmaxf(st.m, tm), sc = exp2f(st.m - mn);
    float ps = 0.f;
#pragma unroll
    for (int a = 0; a < 2; ++a)
#pragma unroll
        for (int r = 0; r < 4; ++r) { sa[a][r] = exp2f(sa[a][r] - mn); ps += sa[a][r]; }
    st.l = st.l * sc + ps; st.m = mn;
#pragma unroll
    for (int dt = 0; dt < 4; ++dt) st.o[dt] = st.o[dt] * sc;
    pv_tile(Vt, lo, sa[0], sa[1], st.o);
}

constexpr int DIL_UNITS = 8 * 3 * 128;
__device__ __forceinline__ void dil_decode(int u, int& h, int& b, int& r, int& blk) { h = u / 384; const int rem = u - h * 384; b = rem >> 7; const int x = rem & 127; r = x >> (7 - 2 * b); blk = x & ((128 >> (2 * b)) - 1); }
__device__ __forceinline__ void dil_issue(const bf16* H, int u, int tid, u32x4 (&kr)[4], u32x4 (&vr)[4]) {
    int h, b, r, blk; dil_decode(u, h, b, r, blk); const int Lc = T >> (2 * b), base = 128 * blk - 64;
#pragma unroll
    for (int k = 0; k < 4; ++k) { const int id = tid + 512 * k, row = id >> 3, c = id & 7, ki = base + row; const bool ok = (ki >= 0) && (ki < Lc);
        const bf16* src = H + (size_t)(r + (ki << (2 * b))) * EVEN_IN + 3072 + h * 64 + c * 8;
        kr[k] = ok ? *(const u32x4*)src : (u32x4){0u, 0u, 0u, 0u}; vr[k] = ok ? *(const u32x4*)(src + 512) : (u32x4){0u, 0u, 0u, 0u}; }
}
__device__ __forceinline__ void dil_commit(LAS unsigned char* buf, int tid, const u32x4 (&kr)[4], const u32x4 (&vr)[4]) {
#pragma unroll
    for (int k = 0; k < 4; ++k) { const int id = tid + 512 * k, row = id >> 3, c = id & 7; const unsigned off = (unsigned)(row * 128 + ((c ^ (row & 7)) << 4));
        *(LAS u32x4*)(buf + off) = kr[k]; *(LAS u32x4*)(buf + 32768 + off) = vr[k]; }
}
__device__ __forceinline__ void phase_dilated_mfma(LAS unsigned char* lds, const bf16* H, bf16* OG, float* LSE, int bid, int tid) {
    const int wave = tid >> 6, lane = tid & 63, i16 = lane & 15, g = lane >> 4;
    const LaneOffs lo = lane_offs(lane);
    u32x4 kr[4], vr[4];
    __syncthreads();
    dil_issue(H, bid, tid, kr, vr); dil_commit(lds, tid, kr, vr);
    __syncthreads();
    int it = 0;
    for (int u = bid; u < DIL_UNITS; u += GRID, ++it) {
        LAS unsigned char* buf = lds + (it & 1) * 65536;
        const bool has_next = (u + GRID) < DIL_UNITS;
        if (has_next) dil_issue(H, u + GRID, tid, kr, vr);
        int h, b, r, blk; dil_decode(u, h, b, r, blk); const int Lc = T >> (2 * b), base = 128 * blk - 64;
        const int ql = 16 * wave + i16, tokq = r + ((128 * blk + ql) << (2 * b));
        const bf16* qp = H + (size_t)tokq * EVEN_IN + 2560 + h * 64 + 8 * g;
        const bf16x8 q0 = *(const bf16x8*)qp, q1 = *(const bf16x8*)(qp + 32);
        SmState st; sm_init(st);
        const int t0 = wave >> 1;
#pragma unroll 1
        for (int t = t0; t < t0 + 5; ++t) {
            f32x4 sa[2]; qk_tile(buf + t * 4096, lo, q0, q1, sa);
#pragma unroll
            for (int a = 0; a < 2; ++a)
#pragma unroll
                for (int rg = 0; rg < 4; ++rg) { const int kl = 32 * t + 16 * a + 4 * g + rg, ki = base + kl; const bool ok = (kl >= ql) && (kl <= ql + 128) && (ki >= 0) && (ki < Lc);
                    sa[a][rg] = ok ? sa[a][rg] * 1.4426950408889634f : -INFINITY; }
            sm_step(st, sa, buf + 32768 + t * 4096, lo);
        }
        float l = st.l; l += __shfl_xor(l, 16); l += __shfl_xor(l, 32);
        const float inv = 1.0f / l;
        bf16* op = OG + ((size_t)b * T + tokq) * 512 + h * 64 + 4 * g;
#pragma unroll
        for (int dt = 0; dt < 4; ++dt) { const f32x4 o = st.o[dt] * inv; u32x2 w; w.x = cvt_pk_bf16(o[0], o[1]); w.y = cvt_pk_bf16(o[2], o[3]); *(u32x2*)(op + 16 * dt) = w; }
        if (g == 0) LSE[((size_t)b * T + tokq) * 8 + h] = (st.m + log2f(l)) * 0.6931471805599453f;
        if (has_next) dil_commit(lds + ((it + 1) & 1) * 65536, tid, kr, vr);
        __syncthreads();
    }
}
__device__ __forceinline__ void phase_dil_merge(const bf16* OG, const float* LSE, bf16* Y, int bid, int tid) {
    for (int item = bid * NTHR + tid; item < T * 64; item += GRID * NTHR) {
        const int tok = item >> 6, h = (item >> 3) & 7, c = item & 7;
        const float l0 = LSE[((size_t)0 * T + tok) * 8 + h], l1 = LSE[((size_t)1 * T + tok) * 8 + h], l2 = LSE[((size_t)2 * T + tok) * 8 + h];
        const float mx = fmaxf(l0, fmaxf(l1, l2)); float w0 = __expf(l0 - mx), w1 = __expf(l1 - mx), w2 = __expf(l2 - mx); const float inv = 1.0f / (w0 + w1 + w2); w0 *= inv; w1 *= inv; w2 *= inv;
        float a[8], b[8], d[8];
        unpack8(*(const u32x4*)(OG + ((size_t)0 * T + tok) * 512 + h * 64 + c * 8), a); unpack8(*(const u32x4*)(OG + ((size_t)1 * T + tok) * 512 + h * 64 + c * 8), b); unpack8(*(const u32x4*)(OG + ((size_t)2 * T + tok) * 512 + h * 64 + c * 8), d);
        float y[8];
#pragma unroll
        for (int j = 0; j < 8; ++j) y[j] = w0 * a[j] + w1 * b[j] + w2 * d[j];
        u32x4 o; o.x = pk2(y[0], y[1]); o.y = pk2(y[2], y[3]); o.z = pk2(y[4], y[5]); o.w = pk2(y[6], y[7]);
        *(u32x4*)(Y + (size_t)tok * D + 512 + h * 64 + c * 8) = o;
    }
}

__device__ __forceinline__ void phase_natten_mfma(LAS unsigned char* lds, const bf16* H, const float* rpb, bf16* Y, int bid, int tid) {
    const int wave = tid >> 6, lane = tid & 63, i16 = lane & 15, g = lane >> 4, cb = wave & 3, half = wave >> 2;
    const LaneOffs lo = lane_offs(lane);
    LAS float* btab = (LAS float*)(lds + MISC_OFF + 4096);
    LAS float* mbuf = (LAS float*)lds;
    const int wc0 = (cb == 0) ? 0 : (cb == 1) ? 8 : (cb == 2) ? 24 : 32;
    const int c = 16 * cb + i16, cs = min(max(c - 8, 0), 48);
#pragma unroll 1
    for (int k = 0; k < 16; ++k) {
        const int u = bid * 16 + k, h = u >> 8, r = u & 255, r0 = min(max(r - 4, 0), 248);
        __syncthreads();
#pragma unroll
        for (int kk = 0; kk < 8; ++kk) { const int id = tid + 512 * kk, row = id >> 3, ch = id & 7; const unsigned off = (unsigned)(row * 128 + ((ch ^ (row & 7)) << 4));
            const bf16* src = H + (size_t)(r0 * 64 + row) * ODD_IN + 1024 + h * 64 + ch * 8;
            *(LAS u32x4*)(lds + off) = *(const u32x4*)src; *(LAS u32x4*)(lds + 65536 + off) = *(const u32x4*)(src + 1024); }
        if (tid < 465) btab[tid] = rpb[h * 465 + tid];
        __syncthreads();
        const int tokq = r * 64 + c;
        const bf16* qp = H + (size_t)tokq * ODD_IN + h * 64 + 8 * g;
        const bf16x8 q0 = *(const bf16x8*)qp, q1 = *(const bf16x8*)(qp + 32);
        SmState st; sm_init(st);
#pragma unroll 1
        for (int tt = 0; tt < 4; ++tt) {
            const int krl = 4 * half + tt; const unsigned tb = (unsigned)((krl * 64 + wc0) * 128);
            f32x4 sa[2]; qk_tile(lds + tb, lo, q0, q1, sa);
            const int brow = (r0 + krl - r + 7) * 31 - c + 15;
#pragma unroll
            for (int a = 0; a < 2; ++a)
#pragma unroll
                for (int rg = 0; rg < 4; ++rg) { const int col = wc0 + 16 * a + 4 * g + rg; const bool ok = (col >= cs) && (col < cs + 16);
                    const float bias = btab[ok ? (brow + col) : 0];
                    sa[a][rg] = ok ? (sa[a][rg] + bias) * 1.4426950408889634f : -INFINITY; }
            sm_step(st, sa, lds + 65536 + tb, lo);
        }
        float l = st.l; l += __shfl_xor(l, 16); l += __shfl_xor(l, 32);
        __syncthreads();
        if (half == 1) { LAS float* mb = mbuf + ((wave - 4) * 64 + lane) * 20; mb[0] = st.m; mb[1] = l;
#pragma unroll
            for (int dt = 0; dt < 4; ++dt) *(LAS f32x4*)(mb + 4 + 4 * dt) = st.o[dt]; }
        __syncthreads();
        if (half == 0) { const LAS float* mb = mbuf + (wave * 64 + lane) * 20; const float m2 = mb[0], l2 = mb[1];
            const float M = fmaxf(st.m, m2), a1 = exp2f(st.m - M), a2 = exp2f(m2 - M); const float inv = 1.0f / (l * a1 + l2 * a2);
            bf16* op = Y + (size_t)tokq * D + h * 64 + 4 * g;
#pragma unroll
            for (int dt = 0; dt < 4; ++dt) { const f32x4 o2 = *(const LAS f32x4*)(mb + 4 + 4 * dt); const f32x4 o = (st.o[dt] * a1 + o2 * a2) * inv;
                u32x2 w; w.x = cvt_pk_bf16(o[0], o[1]); w.y = cvt_pk_bf16(o[2], o[3]); *(u32x2*)(op + 16 * dt) = w; } }
    }
}

__device__ __forceinline__ void ret_issue(const bf16* H, int u, int tid, u32x4 (&kr)[2], u32x4 (&vr)[2]) {
    const int h = u >> 7, n = u & 127;
#pragma unroll
    for (int k = 0; k < 2; ++k) { const int id = tid + 512 * k, row = id >> 3, c = id & 7; const bf16* src = H + (size_t)(n * 128 + row) * EVEN_IN + 512 + h * 64 + c * 8;
        kr[k] = *(const u32x4*)src; vr[k] = *(const u32x4*)(src + 512); }
}
__device__ __forceinline__ void ret_commit(LAS unsigned char* buf, int tid, const u32x4 (&kr)[2], const u32x4 (&vr)[2]) {
#pragma unroll
    for (int k = 0; k < 2; ++k) { const int id = tid + 512 * k, row = id >> 3, c = id & 7; const unsigned off = (unsigned)(row * 128 + ((c ^ (row & 7)) << 4));
        *(LAS u32x4*)(buf + off) = kr[k]; *(LAS u32x4*)(buf + 16384 + off) = vr[k]; }
}
__device__ __forceinline__ void phase_ret_out_mfma(LAS unsigned char* lds, const bf16* H, const bf16* RT, const float* decay, bf16* Y, int bid, int tid) {
    const int wave = tid >> 6, lane = tid & 63, i16 = lane & 15, g = lane >> 4;
    const LaneOffs lo = lane_offs(lane);
    u32x4 kr[2], vr[2];
    __syncthreads();
    ret_issue(H, bid, tid, kr, vr); ret_commit(lds, tid, kr, vr);
    __syncthreads();
    int it = 0;
    for (int u = bid; u < 1024; u += GRID, ++it) {
        LAS unsigned char* buf = lds + (it & 1) * 32768;
        const bool has_next = (u + GRID) < 1024;
        if (has_next) ret_issue(H, u + GRID, tid, kr, vr);
        const int h = u >> 7, n = u & 127;
        const float lgf = log2_gamma(decay[h]), lgb = log2_gamma(decay[8 + h]);
        const int c = 16 * wave + i16, tok = n * 128 + c;
        const bf16* qp = H + (size_t)tok * EVEN_IN + h * 64 + 8 * g;
        const bf16x8 q0 = *(const bf16x8*)qp, q1 = *(const bf16x8*)(qp + 32);
        f32x4 of[4], ob[4];
#pragma unroll
        for (int dt = 0; dt < 4; ++dt) { of[dt] = (f32x4){0.f, 0.f, 0.f, 0.f}; ob[dt] = of[dt]; }
#pragma unroll 1
        for (int t = 0; t < 4; ++t) {
            f32x4 sa[2]; qk_tile(buf + t * 4096, lo, q0, q1, sa);
            f32x4 pf[2], pb[2];
#pragma unroll
            for (int a = 0; a < 2; ++a)
#pragma unroll
                for (int rg = 0; rg < 4; ++rg) { const int m = 32 * t + 16 * a + 4 * g + rg; const float df = (float)(c - m);
                    pf[a][rg] = (m <= c) ? sa[a][rg] * exp2f(lgf * df) : 0.0f; pb[a][rg] = (m > c) ? sa[a][rg] * exp2f(-lgb * df) : 0.0f; }
            if (32 * t <= 16 * wave + 15) pv_tile(buf + 16384 + t * 4096, lo, pf[0], pf[1], of);
            if (32 * t + 31 > 16 * wave) pv_tile(buf + 16384 + t * 4096, lo, pb[0], pb[1], ob);
        }
        const bf16* rtf = RT + ((size_t)(h) * 128 + n) * 4096 + i16 * 64 + 8 * g; const bf16* rtb = RT + ((size_t)(8 + h) * 128 + n) * 4096 + i16 * 64 + 8 * g;
        const float xif = exp2f(lgf * (float)(c + 1)), xib = exp2f(lgb * (float)(128 - c));
#pragma unroll
        for (int et = 0; et < 4; ++et) {
            f32x4 cf = {0.f, 0.f, 0.f, 0.f}, cb = cf;
            cf = __builtin_amdgcn_mfma_f32_16x16x32_bf16(*(const bf16x8*)(rtf + et * 1024), q0, cf, 0, 0, 0); cf = __builtin_amdgcn_mfma_f32_16x16x32_bf16(*(const bf16x8*)(rtf + et * 1024 + 32), q1, cf, 0, 0, 0);
            cb = __builtin_amdgcn_mfma_f32_16x16x32_bf16(*(const bf16x8*)(rtb + et * 1024), q0, cb, 0, 0, 0); cb = __builtin_amdgcn_mfma_f32_16x16x32_bf16(*(const bf16x8*)(rtb + et * 1024 + 32), q1, cb, 0, 0, 0);
            of[et] += cf * xif; ob[et] += cb * xib;
        }
        float sf = 0.f, sb = 0.f;
#pragma unroll
        for (int dt = 0; dt < 4; ++dt) { sf += (of[dt][0] + of[dt][1]) + (of[dt][2] + of[dt][3]); sb += (ob[dt][0] + ob[dt][1]) + (ob[dt][2] + ob[dt][3]); }
        sf += __shfl_xor(sf, 16); sf += __shfl_xor(sf, 32); sb += __shfl_xor(sb, 16); sb += __shfl_xor(sb, 32);
        const float muf = sf * (1.0f / 64.0f), mub = sb * (1.0f / 64.0f);
        float vfq = 0.f, vbq = 0.f;
#pragma unroll
        for (int dt = 0; dt < 4; ++dt) { of[dt] = of[dt] - muf; ob[dt] = ob[dt] - mub;
            vfq += (of[dt][0] * of[dt][0] + of[dt][1] * of[dt][1]) + (of[dt][2] * of[dt][2] + of[dt][3] * of[dt][3]);
            vbq += (ob[dt][0] * ob[dt][0] + ob[dt][1] * ob[dt][1]) + (ob[dt][2] * ob[dt][2] + ob[dt][3] * ob[dt][3]); }
        vfq += __shfl_xor(vfq, 16); vfq += __shfl_xor(vfq, 32); vbq += __shfl_xor(vbq, 16); vbq += __shfl_xor(vbq, 32);
        const float rsf = 1.0f / sqrtf(vfq * (1.0f / 64.0f) + GN_EPS), rsb = 1.0f / sqrtf(vbq * (1.0f / 64.0f) + GN_EPS);
        const bf16* gp = H + (size_t)tok * EVEN_IN + 1536 + h * 64 + 4 * g;
        bf16* yp = Y + (size_t)tok * D + h * 64 + 4 * g;
#pragma unroll
        for (int dt = 0; dt < 4; ++dt) {
            const u32x2 wf = *(const u32x2*)(gp + 16 * dt), wb = *(const u32x2*)(gp + 512 + 16 * dt);
            const f32x4 gf = {bflo(wf.x), bfhi(wf.x), bflo(wf.y), bfhi(wf.y)}, gb = {bflo(wb.x), bfhi(wb.x), bflo(wb.y), bfhi(wb.y)};
            f32x4 y;
#pragma unroll
            for (int j = 0; j < 4; ++j) y[j] = gf[j] * sigmoidf_(gf[j]) * (of[dt][j] * rsf) + gb[j] * sigmoidf_(gb[j]) * (ob[dt][j] * rsb);
            u32x2 w; w.x = cvt_pk_bf16(y[0], y[1]); w.y = cvt_pk_bf16(y[2], y[3]); *(u32x2*)(yp + 16 * dt) = w;
        }
        if (has_next) ret_commit(lds + ((it + 1) & 1) * 32768, tid, kr, vr);
        __syncthreads();
    }
}

__device__ __forceinline__ void phase_ln1_router(LAS unsigned char* lds, const float* U, const float* lng, const float* lnb, const float* rw, const float* rbias,
                                                 float* X1, bf16* X1b, int* tope, float* gate, int* lrank, int* cnt, int bid, int tid) {
    const int wave = tid >> 6, lane = tid & 63;
    LAS int* lcnt = (LAS int*)(lds + MISC_OFF + 1024);
    __syncthreads();
    for (int idx = tid; idx < 1024 * 8; idx += NTHR) { const int d = idx >> 3, c = idx & 7;
        *(LAS f32x4*)(lds + d * 128 + ((c ^ ((d >> 1) & 7)) << 4)) = *(const f32x4*)(rw + d * 32 + c * 4); }
    if (tid < 32) lcnt[tid] = 0;
    __syncthreads();
    float gg[16], bb[16];
#pragma unroll
    for (int i = 0; i < 16; ++i) { gg[i] = lng[64 * i + lane]; bb[i] = lnb[64 * i + lane]; }
    const float rbe = rbias[lane >> 1];
    for (int rr = 0; rr < 8; ++rr) {
        const int row = bid * 64 + wave * 8 + rr;
        float x[16]; float s = 0.f;
#pragma unroll
        for (int i = 0; i < 16; ++i) { x[i] = U[(size_t)row * D + 64 * i + lane]; s += x[i]; }
        const float mean = wave_sum(s) * (1.0f / D); float s2 = 0.f;
#pragma unroll
        for (int i = 0; i < 16; ++i) { x[i] -= mean; s2 += x[i] * x[i]; }
        const float rstd = 1.0f / sqrtf(wave_sum(s2) * (1.0f / D) + LN_EPS);
#pragma unroll
        for (int i = 0; i < 16; ++i) { x[i] = x[i] * rstd * gg[i] + bb[i]; X1[(size_t)row * D + 64 * i + lane] = x[i]; X1b[(size_t)row * D + 64 * i + lane] = (bf16)f2bf(x[i]); }
        float acc[32];
#pragma unroll
        for (int e = 0; e < 32; ++e) acc[e] = 0.f;
#pragma unroll
        for (int i = 0; i < 16; ++i) { const int d = 64 * i + lane;
#pragma unroll
            for (int c = 0; c < 8; ++c) { const f32x4 w = *(const LAS f32x4*)(lds + d * 128 + ((c ^ ((d >> 1) & 7)) << 4));
                acc[4 * c] += x[i] * w[0]; acc[4 * c + 1] += x[i] * w[1]; acc[4 * c + 2] += x[i] * w[2]; acc[4 * c + 3] += x[i] * w[3]; } }
#pragma unroll
        for (int t = 0; t < 16; ++t) { const bool up = (lane & 32) != 0; const float snd = up ? acc[t] : acc[t + 16]; const float rcv = __shfl_xor(snd, 32); acc[t] = (up ? acc[t + 16] : acc[t]) + rcv; }
#pragma unroll
        for (int t = 0; t < 8; ++t) { const bool up = (lane & 16) != 0; const float snd = up ? acc[t] : acc[t + 8]; const float rcv = __shfl_xor(snd, 16); acc[t] = (up ? acc[t + 8] : acc[t]) + rcv; }
#pragma unroll
        for (int t = 0; t < 4; ++t) { const bool up = (lane & 8) != 0; const float snd = up ? acc[t] : acc[t + 4]; const float rcv = __shfl_xor(snd, 8); acc[t] = (up ? acc[t + 4] : acc[t]) + rcv; }
#pragma unroll
        for (int t = 0; t < 2; ++t) { const bool up = (lane & 4) != 0; const float snd = up ? acc[t] : acc[t + 2]; const float rcv = __shfl_xor(snd, 4); acc[t] = (up ? acc[t + 2] : acc[t]) + rcv; }
        { const bool up = (lane & 2) != 0; const float snd = up ? acc[0] : acc[1]; const float rcv = __shfl_xor(snd, 2); acc[0] = (up ? acc[1] : acc[0]) + rcv; }
        float lv = acc[0] + __shfl_xor(acc[0], 1) + rbe;
        const int me = lane >> 1;
        float tv[4]; int ti[4];
#pragma unroll
        for (int k = 0; k < 4; ++k) {
            float bv = lv; int bi = me;
#pragma unroll
            for (int o = 32; o >= 1; o >>= 1) { const float ov = __shfl_xor(bv, o); const int oi = __shfl_xor(bi, o); if (ov > bv || (ov == bv && oi < bi)) { bv = ov; bi = oi; } }
            tv[k] = bv; ti[k] = bi; if (me == bi) lv = -INFINITY;
        }
        const float p1 = expf(tv[1] - tv[0]), p2 = expf(tv[2] - tv[0]), p3 = expf(tv[3] - tv[0]); const float inv = 1.0f / (1.0f + p1 + p2 + p3);
        if (lane < 4) {
            const int e = (lane == 0) ? ti[0] : (lane == 1) ? ti[1] : (lane == 2) ? ti[2] : ti[3];
            const float gk = ((lane == 0) ? 1.0f : (lane == 1) ? p1 : (lane == 2) ? p2 : p3) * inv;
            const int rk = __hip_atomic_fetch_add(lcnt + e, 1, __ATOMIC_RELAXED, __HIP_MEMORY_SCOPE_WORKGROUP);
            tope[row * 4 + lane] = e; gate[row * 4 + lane] = gk; lrank[row * 4 + lane] = rk;
        }
    }
    __syncthreads();
    if (tid < 32) cnt[bid * 32 + tid] = lcnt[tid];
}

__device__ __forceinline__ void phase_dispatch(LAS unsigned char* lds, const int* cnt, const int* tope, const int* lrank, int* slot, int* tiles, const bf16* X1b, bf16* Xperm, int bid, int tid) {
    LAS int* tot = (LAS int*)(lds + MISC_OFF + 1024); LAS int* pre = tot + 32; LAS int* pst = pre + 32; LAS int* ldest = pst + 40;
    const int wave = tid >> 6, lane = tid & 63;
    __syncthreads();
    if (tid < 32) { int t = 0, p = 0; for (int b2 = 0; b2 < GRID; ++b2) { const int v = cnt[b2 * 32 + tid]; t += v; p += (b2 < bid) ? v : 0; } tot[tid] = t; pre[tid] = p; }
    __syncthreads();
    if (tid == 0) { int ps = 0;
#pragma unroll 1
        for (int e = 0; e < NEXP; ++e) { pst[e] = ps; ps += ((tot[e] + 255) >> 8) << 8; }
        pst[NEXP] = ps; }
    __syncthreads();
    if (bid == 0 && tid < 1 + MAXTILES) {
        if (tid == 0) tiles[0] = pst[NEXP] >> 8;
        else { const int i = tid - 1; int ee = 0;
#pragma unroll 1
            for (int e = 0; e < NEXP; ++e) ee = ((pst[e] >> 8) <= i) ? e : ee;
            tiles[tid] = ee; }
    }
    if (tid < 256) { const int row = bid * 64 + (tid >> 2), k = tid & 3; const int e = tope[row * 4 + k]; const int dest = pst[e] + pre[e] + lrank[row * 4 + k]; slot[row * 4 + k] = dest; ldest[tid] = dest; }
    __syncthreads();
    for (int s = wave * 32; s < wave * 32 + 32; ++s) {
        const int row = bid * 64 + (s >> 2); const int dest = ldest[s];
        const u32x4* src = (const u32x4*)(X1b + (size_t)row * D); u32x4* dst = (u32x4*)(Xperm + (size_t)dest * D);
        const u32x4 a = src[lane], b = src[64 + lane]; dst[lane] = a; dst[64 + lane] = b;
    }
}

__device__ __forceinline__ void phase_combine_ln2(const float* X1, const bf16* Oslot, const int* slot, const float* gate, const float* lng, const float* lnb, float* Xout, bf16* Xb, int bid, int tid) {
    const int wave = tid >> 6, lane = tid & 63;
    f32x4 gg[4], bb[4];
#pragma unroll
    for (int j = 0; j < 4; ++j) { gg[j] = *(const f32x4*)(lng + 256 * j + 4 * lane); bb[j] = *(const f32x4*)(lnb + 256 * j + 4 * lane); }
    for (int rr = 0; rr < 8; ++rr) {
        const int row = bid * 64 + wave * 8 + rr;
        f32x4 v[4];
#pragma unroll
        for (int j = 0; j < 4; ++j) v[j] = *(const f32x4*)(X1 + (size_t)row * D + 256 * j + 4 * lane) * ALPHA;
#pragma unroll
        for (int k = 0; k < 4; ++k) { const int s = slot[row * 4 + k]; const float g = gate[row * 4 + k];
#pragma unroll
            for (int j = 0; j < 4; ++j) { const u32x2 w = *(const u32x2*)(Oslot + (size_t)s * D + 256 * j + 4 * lane); v[j] += (f32x4){bflo(w.x), bfhi(w.x), bflo(w.y), bfhi(w.y)} * g; } }
        float s = 0.f;
#pragma unroll
        for (int j = 0; j < 4; ++j) s += (v[j][0] + v[j][1]) + (v[j][2] + v[j][3]);
        const float mean = wave_sum(s) * (1.0f / D); float s2 = 0.f;
#pragma unroll
        for (int j = 0; j < 4; ++j) { v[j] = v[j] - mean; s2 += (v[j][0] * v[j][0] + v[j][1] * v[j][1]) + (v[j][2] * v[j][2] + v[j][3] * v[j][3]); }
        const float rstd = 1.0f / sqrtf(wave_sum(s2) * (1.0f / D) + LN_EPS);
#pragma unroll
        for (int j = 0; j < 4; ++j) { const f32x4 o = v[j] * rstd * gg[j] + bb[j]; *(f32x4*)(Xout + (size_t)row * D + 256 * j + 4 * lane) = o;
            if (Xb) { u32x2 w; w.x = pk2(o[0], o[1]); w.y = pk2(o[2], o[3]); *(u32x2*)(Xb + (size_t)row * D + 256 * j + 4 * lane) = w; } }
    }
}

constexpr int NPH = 10, N_PHASES = 1 + DEPTH * NPH;
struct Args { Ptrs p; int ph_lo, ph_hi; };
static_assert(sizeof(Args) == 17 * 8 + 8, "Args has no padding");
typedef __attribute__((address_space(4))) const Args CArgs;

__global__ void __launch_bounds__(NTHR, 2) fwd_kernel(Args args) {
    extern __shared__ __attribute__((aligned(16))) unsigned char lds_raw[];
    LAS unsigned char* lds0 = (LAS unsigned char*)lds_raw;
    const int tid0 = threadIdx.x, bid0 = blockIdx.x;
    const int lo = args.ph_lo, hi = args.ph_hi;
    volatile LAS unsigned* MISC = (volatile LAS unsigned*)(lds0 + MISC_OFF);
    if (tid0 < 64) MISC[tid0] = 0u;
    __syncthreads();
    XcdBarrier bar = xcd_barrier_post((unsigned*)(((CArgs*)__builtin_amdgcn_kernarg_segment_ptr())->p.ws + WS_CTL) + CW_BAR, MISC + 8);
#define IN(k) (lo <= (k) && (k) < hi)
#define SEAM(k) do { if (IN(k) && IN((k) + 1)) xcd_barrier(bar); } while (0)
#define SITE int tid = tid0, bid = bid0, L = L0; CArgs* ap = (CArgs*)__builtin_amdgcn_kernarg_segment_ptr(); asm volatile("" : "+v"(tid)); asm volatile("" : "+s"(bid)); asm volatile("" : "+s"(L)); asm volatile("" : "+s"(ap)); LAS unsigned char* lds = lds0; asm volatile("" : "+s"(lds)); \
    unsigned char* ws = ap->p.ws; const int jl = L >> 1; const bool odd = (L & 1) != 0; (void)jl; (void)odd; (void)tid; (void)bid; (void)ws;

    { const int L0 = 0; if (IN(0)) { SITE; Ptrs P{}; P.x = ap->p.x; P.ab_w_in = ap->p.ab_w_in; P.ab_w_out = ap->p.ab_w_out; P.c_w_in = ap->p.c_w_in; P.c_w_out = ap->p.c_w_out; P.w_up = ap->p.w_up; P.w_down = ap->p.w_down; P.ws = ws; phase_prologue(P, lds, bid, tid); } }
    SEAM(0);

    for (int L0 = 0; L0 < DEPTH; ++L0) {
        const int pb = 1 + L0 * NPH; const bool odd0 = (L0 & 1) != 0;
        if (IN(pb + 0)) {
            if (!odd0) { SITE; pg8::DenseOrder S{T / 256, EVEN_IN / 256, GRID, bid, (const char*)(ws + WS_XB), (const char*)(ws + WS_WIN_E) + (size_t)jl * EVEN_IN * 1024 * 2};
                pg8::EpiInEven E{(bf16*)(ws + WS_H), (const float*)(ws + WS_COS), (const float*)(ws + WS_SIN)}; pg8::gemm_phase<pg8::EpiInEven, pg8::DenseOrder>(lds, S, E, tid); }
            else { SITE; pg8::DenseOrder S{T / 256, ODD_IN / 256, GRID, bid, (const char*)(ws + WS_XB), (const char*)(ws + WS_WIN_O) + (size_t)jl * ODD_IN * 1024 * 2};
                pg8::EpiInOdd E{(bf16*)(ws + WS_H)}; pg8::gemm_phase<pg8::EpiInOdd, pg8::DenseOrder>(lds, S, E, tid); }
        }
        SEAM(pb + 0);
        if (IN(pb + 1)) {
            if (!odd0) { { SITE; phase_ret_states(lds, (const bf16*)(ws + WS_H), ap->p.ret_decay + jl * 16, (float*)(ws + WS_RS), bid, tid); }
                         { SITE; phase_dilated_mfma(lds, (const bf16*)(ws + WS_H), (bf16*)(ws + WS_ACT), (float*)(ws + WS_OSLOT), bid, tid); } }
            else { SITE; phase_natten_mfma(lds, (const bf16*)(ws + WS_H), ap->p.c_rpb + (size_t)jl * 16 * 15 * 31, (bf16*)(ws + WS_Y), bid, tid); }
        }
        SEAM(pb + 1);
        if (!odd0) {
            if (IN(pb + 2)) { { SITE; phase_ret_scan((const float*)(ws + WS_RS), (bf16*)(ws + WS_RR), ap->p.ret_decay + jl * 16, bid, tid); }
                              { SITE; phase_dil_merge((const bf16*)(ws + WS_ACT), (const float*)(ws + WS_OSLOT), (bf16*)(ws + WS_Y), bid, tid); } }
            SEAM(pb + 2);
            if (IN(pb + 3)) { SITE; phase_ret_out_mfma(lds, (const bf16*)(ws + WS_H), (const bf16*)(ws + WS_RR), ap->p.ret_decay + jl * 16, (bf16*)(ws + WS_Y), bid, tid); }
            SEAM(pb + 3);
        }
        if (IN(pb + 4)) { SITE;
            pg8::DenseOrder S{T / 256, D / 256, GRID, bid, (const char*)(ws + WS_Y), (const char*)(ws + (odd ? WS_WOUT_O : WS_WOUT_E)) + (size_t)jl * 1024 * 1024 * 2};
            pg8::EpiOut E{(L == 0) ? ap->p.x : (const float*)(ws + WS_X), (float*)(ws + WS_U)}; pg8::gemm_phase<pg8::EpiOut, pg8::DenseOrder>(lds, S, E, tid);
        }
        SEAM(pb + 4);
        if (IN(pb + 5)) { SITE; phase_ln1_router(lds, (const float*)(ws + WS_U), ap->p.ln_g + (size_t)(L * 2) * D, ap->p.ln_b + (size_t)(L * 2) * D, ap->p.router_w + (size_t)L * D * NEXP, ap->p.router_b + L * NEXP,
                                         (float*)(ws + WS_X1), (bf16*)(ws + WS_X1B), (int*)(ws + WS_TOPE), (float*)(ws + WS_GATE), (int*)(ws + WS_LRANK), (int*)(ws + WS_CNT), bid, tid); }
        SEAM(pb + 5);
        if (IN(pb + 6)) { SITE; phase_dispatch(lds, (const int*)(ws + WS_CNT), (const int*)(ws + WS_TOPE), (const int*)(ws + WS_LRANK), (int*)(ws + WS_SLOT), (int*)(ws + WS_TILES), (const bf16*)(ws + WS_X1B), (bf16*)(ws + WS_XPERM), bid, tid); }
        SEAM(pb + 6);
        if (IN(pb + 7)) { SITE;
            LAS int* ltile = (LAS int*)(lds + MISC_OFF + 2048); const int* tiles = (const int*)(ws + WS_TILES);
            __syncthreads();
            for (int i = tid; i < 1 + MAXTILES; i += NTHR) ltile[i] = tiles[i];
            __syncthreads();
            pg8::GroupOrder S{(int)ltile[0], 2048 / 256, GRID, bid, (const char*)(ws + WS_XPERM), (const char*)(ws + WS_WUP) + (size_t)L * 32 * 2048 * 1024 * 2, (size_t)2048 * 1024 * 2, ltile + 1};
            pg8::EpiUp E{(bf16*)(ws + WS_ACT), ap->p.b_up + (size_t)L * 32 * 2048}; pg8::gemm_phase<pg8::EpiUp, pg8::GroupOrder>(lds, S, E, tid);
        }
        SEAM(pb + 7);
        if (IN(pb + 8)) { SITE;
            LAS int* ltile = (LAS int*)(lds + MISC_OFF + 2048); const int* tiles = (const int*)(ws + WS_TILES);
            __syncthreads();
            for (int i = tid; i < 1 + MAXTILES; i += NTHR) ltile[i] = tiles[i];
            __syncthreads();
            pg8::GroupOrder S{(int)ltile[0], 1024 / 256, GRID, bid, (const char*)(ws + WS_ACT), (const char*)(ws + WS_WDN) + (size_t)L * 32 * 1024 * 1024 * 2, (size_t)1024 * 1024 * 2, ltile + 1};
            pg8::EpiDown E{(bf16*)(ws + WS_OSLOT), ap->p.b_down + (size_t)L * 32 * 1024}; pg8::gemm_phase<pg8::EpiDown, pg8::GroupOrder>(lds, S, E, tid);
        }
        SEAM(pb + 8);
        if (IN(pb + 9)) { SITE; phase_combine_ln2((const float*)(ws + WS_X1), (const bf16*)(ws + WS_OSLOT), (const int*)(ws + WS_SLOT), (const float*)(ws + WS_GATE), ap->p.ln_g + (size_t)(L * 2 + 1) * D, ap->p.ln_b + (size_t)(L * 2 + 1) * D,
                                          (L == DEPTH - 1) ? ap->p.out : (float*)(ws + WS_X), (L == DEPTH - 1) ? (bf16*)nullptr : (bf16*)(ws + WS_XB), bid, tid); }
        SEAM(pb + 9);
    }
#undef IN
#undef SEAM
#undef SITE
}

extern "C" void kernel_launch(void* const* d_in, const int* in_sizes, int n_in, void* d_out, int out_size, void* d_ws, size_t ws_size, hipStream_t stream) {
    static int ready = 0;
    if (ready == 0) {
        if (n_in != 15 || in_sizes[0] != T * D || out_size != T * D || ws_size < WS_END) {
            fprintf(stderr, "kernel_launch: unexpected problem (n_in %d, in0 %d, out %d, ws %zu); nothing launched\n", n_in, n_in > 0 ? in_sizes[0] : -1, out_size, ws_size); ready = -1; return; }
        if (hipFuncSetAttribute((const void*)fwd_kernel, hipFuncAttributeMaxDynamicSharedMemorySize, LDS_BYTES) != hipSuccess) { fprintf(stderr, "kernel_launch: hipFuncSetAttribute failed\n"); ready = -1; return; }
        int per_cu = 0;
        if (hipOccupancyMaxActiveBlocksPerMultiprocessor(&per_cu, (const void*)fwd_kernel, NTHR, LDS_BYTES) != hipSuccess || per_cu < 1) fprintf(stderr, "kernel_launch: occupancy query reports %d workgroups per CU\n", per_cu);
        (void)hipGetLastError();
        ready = 1;
    }
    if (ready < 0) return;
    (void)hipMemsetAsync((char*)d_ws + WS_CTL, 0, CTL_ZERO_BYTES, stream);
    Args a{};
    a.p.x = (const float*)d_in[0]; a.p.ab_w_in = (const float*)d_in[1]; a.p.ab_w_out = (const float*)d_in[2]; a.p.ret_decay = (const float*)d_in[3];
    a.p.c_w_in = (const float*)d_in[4]; a.p.c_w_out = (const float*)d_in[5]; a.p.c_rpb = (const float*)d_in[6]; a.p.ln_g = (const float*)d_in[7]; a.p.ln_b = (const float*)d_in[8];
    a.p.router_w = (const float*)d_in[9]; a.p.router_b = (const float*)d_in[10]; a.p.w_up = (const float*)d_in[11]; a.p.b_up = (const float*)d_in[12]; a.p.w_down = (const float*)d_in[13]; a.p.b_down = (const float*)d_in[14];
    a.p.out = (float*)d_out; a.p.ws = (unsigned char*)d_ws;
#if N_LAUNCH_MODE == 0
    a.ph_lo = 0; a.ph_hi = N_PHASES;
    hipLaunchKernelGGL(fwd_kernel, dim3(GRID), dim3(NTHR), LDS_BYTES, stream, a);
#else
    for (int ph = 0; ph < N_PHASES; ++ph) {
        if (ph >= 1) { const int L = (ph - 1) / NPH, p = (ph - 1) % NPH; if ((L & 1) && (p == 2 || p == 3)) continue; }
        a.ph_lo = ph; a.ph_hi = ph + 1;
        hipLaunchKernelGGL(fwd_kernel, dim3(GRID), dim3(NTHR), LDS_BYTES, stream, a);
    }
#endif
}
```

```cpp
#include <hip/hip_runtime.h>
#include <cstdio>
#include <cstdint>

#ifndef PROBE_MASK
#define PROBE_MASK 0
#endif
#define REP(id) for (int _r = 0; _r < 1 + ((PROBE_MASK >> (id)) & 1); ++_r)
#ifndef N_LAUNCH_MODE
#define N_LAUNCH_MODE 0
#endif

#define GAS __attribute__((address_space(1)))
#define LAS __attribute__((address_space(3)))
typedef unsigned short bf16;
typedef short bf16x8 __attribute__((ext_vector_type(8)));
typedef float f32x4 __attribute__((ext_vector_type(4)));
typedef float f32x2 __attribute__((ext_vector_type(2)));
typedef unsigned u32x4 __attribute__((ext_vector_type(4)));
typedef unsigned u32x2 __attribute__((ext_vector_type(2)));

constexpr int T = 16384, D = 1024, DEPTH = 4, HD = 64, NEXP = 32, TOPK = 4;
constexpr int EVEN_IN = 4096, ODD_IN = 3072;
constexpr int NPAD = T * TOPK + NEXP * 256;
constexpr int MAXTILES = NPAD / 256;
constexpr float LN_EPS = 1e-5f, GN_EPS = 1e-6f;
constexpr float ALPHA = 1.681792830507429f;
constexpr int NWAVES = 8, NTHR = 512, GRID = 256;

constexpr size_t MiB = 1u << 20;
constexpr size_t WS_CTL = 0, CTL_ZERO_BYTES = 1 * MiB;
constexpr size_t WS_COS = 1 * MiB, WS_SIN = 3 * MiB;
constexpr size_t WS_CNT = 5 * MiB;
constexpr size_t WS_TOPE = 6 * MiB, WS_GATE = 7 * MiB, WS_LRANK = 8 * MiB, WS_SLOT = 9 * MiB;
constexpr size_t WS_TILES = 10 * MiB;
constexpr size_t WS_RWT = 11 * MiB;
constexpr size_t WS_X1LO = 1744 * MiB;
constexpr size_t WS_WIN_E = 16 * MiB, WS_WOUT_E = 32 * MiB, WS_WIN_O = 36 * MiB, WS_WOUT_O = 48 * MiB;
constexpr size_t WS_WUP = 64 * MiB, WS_WDN = 576 * MiB;
constexpr size_t WS_X = 832 * MiB, WS_XB = 896 * MiB, WS_H = 928 * MiB, WS_Y = 1056 * MiB, WS_U = 1088 * MiB;
constexpr size_t WS_X1 = 1152 * MiB, WS_X1B = 1216 * MiB, WS_XPERM = 1248 * MiB, WS_ACT = 1392 * MiB, WS_OSLOT = 1536 * MiB;
constexpr size_t WS_RS = 1680 * MiB, WS_RR = 1712 * MiB, WS_END = 1776 * MiB;
static_assert((size_t)NPAD * 1024 * 2 <= 144 * MiB, "slot buffers");
constexpr int CW_BAR = 4096;

constexpr int RING_BYTES = 131072, MISC_OFF = 131072, LDS_BYTES = 147456;

__device__ __forceinline__ unsigned f2bf(float f) { unsigned u = __builtin_bit_cast(unsigned, f); return (u + 0x7fffu + ((u >> 16) & 1u)) >> 16; }
__device__ __forceinline__ unsigned pk2(float lo, float hi) { return f2bf(lo) | (f2bf(hi) << 16); }
__device__ __forceinline__ float bflo(unsigned w) { return __builtin_bit_cast(float, w << 16); }
__device__ __forceinline__ float bfhi(unsigned w) { return __builtin_bit_cast(float, w & 0xffff0000u); }
__device__ __forceinline__ unsigned cvt_pk_bf16(float lo, float hi) { unsigned r; asm volatile("v_cvt_pk_bf16_f32 %0, %1, %2" : "=v"(r) : "v"(lo), "v"(hi)); return r; }
__device__ __forceinline__ float wave_sum(float v) {
#pragma unroll
    for (int o = 1; o < 64; o <<= 1) v += __shfl_xor(v, o);
    return v;
}
__device__ __forceinline__ void unpack8(const u32x4 w, float* f) {
    f[0] = bflo(w.x); f[1] = bfhi(w.x); f[2] = bflo(w.y); f[3] = bfhi(w.y); f[4] = bflo(w.z); f[5] = bfhi(w.z); f[6] = bflo(w.w); f[7] = bfhi(w.w);
}
__device__ __forceinline__ float log2_gamma(float logit) { return -log1pf(expf(-logit)) * 1.4426950408889634f; }
__device__ __forceinline__ float sigmoidf_(float z) { return 1.0f / (1.0f + __expf(-z)); }

#define XB_TMO      128
#define XB_XCNT(j)  (256  + 64 * (j))
#define XB_XSUB(j)  (1280 + 64 * (j))
#define XB_XGEN(j)  (2304 + 64 * (j))
#define XB_TOP      3328
#define XB_TOPGEN   3392
#define XCD_BAR_WORDS 3456
#define XB_SPIN_CAP (1u << 18)

__device__ __forceinline__ unsigned xb_ld(unsigned* p)              { return __hip_atomic_load(p, __ATOMIC_RELAXED, __HIP_MEMORY_SCOPE_AGENT); }
__device__ __forceinline__ unsigned xb_add(unsigned* p, unsigned v) { return __hip_atomic_fetch_add(p, v, __ATOMIC_RELAXED, __HIP_MEMORY_SCOPE_AGENT); }
__device__ __forceinline__ unsigned xb_xcc_id() { return (unsigned)__builtin_amdgcn_s_getreg((3 << 11) | 20) & 0xFu; }
#define XB_SPIN(cond, bar) do { unsigned _sp = 0; while (cond) { __builtin_amdgcn_s_sleep(1); \
    if ((++_sp & 255u) == 0u) { if (xb_ld(&(bar)[XB_TMO])) break; if (_sp > XB_SPIN_CAP) { atomicAdd(&(bar)[XB_TMO], 1u); break; } } } } while (0)

struct XcdBarrier { unsigned* bar; unsigned x; volatile LAS unsigned* st; };

__device__ __forceinline__ XcdBarrier xcd_barrier_post(unsigned* bar, volatile LAS unsigned* st) {
    XcdBarrier b; b.bar = bar; b.x = xb_xcc_id(); b.st = st;
    if (threadIdx.x == 0) (void)xb_add(&bar[XB_XCNT(b.x)], 1u);
    return b;
}
__device__ __forceinline__ void xcd_barrier_complete(unsigned* bar, unsigned x, unsigned& nloc, unsigned& nx) {
    const unsigned G = gridDim.x * gridDim.y * gridDim.z;
    unsigned sum, cnt, mine, sp = 0u;
    for (;;) {
        sum = 0u; cnt = 0u; mine = 0u;
#pragma unroll
        for (unsigned j = 0; j < 16; ++j) { const unsigned c = xb_ld(&bar[XB_XCNT(j)]); sum += c; cnt += (c > 0u) ? 1u : 0u; mine = (j == x) ? c : mine; }
        if (sum == G) break;
        __builtin_amdgcn_s_sleep(1);
        if ((++sp & 255u) == 0u) { if (xb_ld(&bar[XB_TMO])) break; if (sp > XB_SPIN_CAP) { atomicAdd(&bar[XB_TMO], 1u); break; } }
    }
    nloc = mine > 0u ? mine : 1u; nx = cnt > 0u ? cnt : 1u;
}
__device__ __forceinline__ void xcd_barrier(const XcdBarrier& b0) {
    XcdBarrier b = b0; asm volatile("" : "+s"(b.bar)); asm volatile("" : "+s"(b.x));
    asm volatile("s_waitcnt vmcnt(0)" ::: "memory");
    __syncthreads();
    if (threadIdx.x == 0) {
        unsigned* bar = b.bar;
        __builtin_amdgcn_s_waitcnt(0);
        unsigned nloc = b.st[0], nx = b.st[1];
        if (nloc == 0u) { xcd_barrier_complete(bar, b.x, nloc, nx); b.st[0] = nloc; b.st[1] = nx; }
        const unsigned old = xb_add(&bar[XB_XSUB(b.x)], 1u);
        const unsigned gen = old / nloc;
        if (old + 1u == (gen + 1u) * nloc) {
            __builtin_amdgcn_fence(__ATOMIC_RELEASE, "agent");
            asm volatile("s_waitcnt vmcnt(0)" ::: "memory");
            const unsigned og = xb_add(&bar[XB_TOP], 1u);
            const unsigned tg = og / nx;
            if (og + 1u == (tg + 1u) * nx) xb_add(&bar[XB_TOPGEN], 1u);
            else XB_SPIN(xb_ld(&bar[XB_TOPGEN]) == tg, bar);
            __builtin_amdgcn_fence(__ATOMIC_ACQUIRE, "agent");
            xb_add(&bar[XB_XGEN(b.x)], 1u);
            asm volatile("s_waitcnt vmcnt(0)" ::: "memory");
        } else {
            XB_SPIN(xb_ld(&bar[XB_XGEN(b.x)]) == gen, bar);
            __builtin_amdgcn_fence(__ATOMIC_ACQUIRE, "agent");
            asm volatile("s_waitcnt vmcnt(0)" ::: "memory");
        }
    }
    __syncthreads();
}

namespace pg8 {
constexpr int BM = 256, BK = 64, HALF = 128, HTB = HALF * BK * 2, STAGE_BYTES = 8 * HTB, NXCD = 8, WGM = 8, KD = 1024;
constexpr size_t TILE_BYTES = (size_t)BM * KD * 2;

__host__ __device__ __forceinline__ int lds_byte(int r, int c) { const int st = (r >> 4) * 2 + (c >> 5), rr = r & 15, cc = c & 31, ob = rr * 64 + cc * 2; return st * 1024 + (ob ^ (((ob >> 9) & 1) << 5)); }
__host__ __device__ __forceinline__ void stage_rc(int b, int& R, int& C) { const int st = b / 1024, sb = b % 1024, swz = sb ^ (((sb >> 9) & 1) << 5); R = (st >> 1) * 16 + swz / 64; C = (st & 1) * 32 + (swz % 64) / 2; }
__host__ __device__ __forceinline__ int perm32(int rho) { const int n = rho >> 4, i = rho & 15; return 8 * (i >> 2) + 4 * n + (i & 3); }

struct Unit { int pm, pn, e; };

__device__ __forceinline__ bool order_next(int i, int G, int c, int nM, int nN, int& pm, int& pn) {
    const int nwg = nM * nN; const long L = (long)i * G + c; if (L >= nwg) return false;
    int wgid = (int)L; { const int q = nwg / NXCD, r = nwg % NXCD, xcd = wgid % NXCD, off = wgid / NXCD; wgid = (xcd < r ? xcd * (q + 1) : r * (q + 1) + (xcd - r) * q) + off; }
    const int nig = WGM * nN, gid = wgid / nig, fm = gid * WGM, gsz = (nM - fm) < WGM ? (nM - fm) : WGM;
    pm = fm + ((wgid % nig) % gsz); pn = (wgid % nig) / gsz; return true;
}
struct DenseOrder {
    int nM, nN, G, c; const char* A; const char* B;
    __device__ __forceinline__ bool next(int i, Unit& u) const { u.e = 0; return order_next(i, G, c, nM, nN, u.pm, u.pn); }
    __device__ __forceinline__ const char* a_base(const Unit& u) const { return A + (size_t)u.pm * TILE_BYTES; }
    __device__ __forceinline__ const char* b_base(const Unit& u) const { return B + (size_t)u.pn * TILE_BYTES; }
};
struct GroupOrder {
    int nM, nN, G, c; const char* A; const char* B; size_t bstride; const LAS int* tile_e;
    __device__ __forceinline__ bool next(int i, Unit& u) const { if (!order_next(i, G, c, nM, nN, u.pm, u.pn)) return false; u.e = tile_e[u.pm]; return true; }
    __device__ __forceinline__ const char* a_base(const Unit& u) const { return A + (size_t)u.pm * TILE_BYTES; }
    __device__ __forceinline__ const char* b_base(const Unit& u) const { return B + (size_t)u.e * bstride + (size_t)u.pn * TILE_BYTES; }
};

__device__ __forceinline__ void store8(bf16* p, const f32x4 v0, const f32x4 v1) {
    u32x4 w; w.x = cvt_pk_bf16(v0[0], v0[1]); w.y = cvt_pk_bf16(v0[2], v0[3]); w.z = cvt_pk_bf16(v1[0], v1[1]); w.w = cvt_pk_bf16(v1[2], v1[3]); *(u32x4*)p = w;
}
struct EpiInEven {
    static constexpr bool PERM = true, AFTER_DRAIN = false;
    bf16* H; const float* cs; const float* sn;
    __device__ __forceinline__ void operator()(const f32x4 (&acc)[2][2][4][2], const Unit& u, int wr, int wc, int fr, int fq) const {
        const int pn = u.pn; const bool rope = (pn < 4) || (pn >= 10 && pn < 14);
        const float sc = ((pn >= 2 && pn < 4) || (pn >= 10 && pn < 12)) ? 0.125f : 1.0f;
        const int row0 = u.pm * BM + wr * 64 + fr;
        if (rope) {
#pragma unroll
            for (int ai = 0; ai < 2; ++ai)
#pragma unroll
                for (int m = 0; m < 4; ++m) {
                    const int row = row0 + ai * HALF + m * 16;
                    const float* cr = cs + (size_t)row * 32 + 8 * fq; const float* sr = sn + (size_t)row * 32 + 8 * fq;
                    const f32x4 c0 = *(const f32x4*)cr, c1 = *(const f32x4*)(cr + 4), s0 = *(const f32x4*)sr, s1 = *(const f32x4*)(sr + 4);
                    const f32x4 x1a = acc[ai][0][m][0], x1b = acc[ai][0][m][1], x2a = acc[ai][1][m][0], x2b = acc[ai][1][m][1];
                    const f32x4 o1a = (x1a * c0 - x2a * s0) * sc, o1b = (x1b * c1 - x2b * s1) * sc, o2a = (x2a * c0 + x1a * s0) * sc, o2b = (x2b * c1 + x1b * s1) * sc;
                    bf16* rowp = H + (size_t)row * EVEN_IN + pn * BM + wc * 64 + 8 * fq;
                    store8(rowp, o1a, o1b); store8(rowp + 32, o2a, o2b);
                }
        } else {
#pragma unroll
            for (int ai = 0; ai < 2; ++ai)
#pragma unroll
                for (int m = 0; m < 4; ++m) {
                    bf16* rowp = H + (size_t)(row0 + ai * HALF + m * 16) * EVEN_IN + pn * BM + wc * 32 + 8 * fq;
#pragma unroll
                    for (int bj = 0; bj < 2; ++bj) store8(rowp + bj * HALF, acc[ai][bj][m][0], acc[ai][bj][m][1]);
                }
        }
    }
};
struct EpiInOdd {
    static constexpr bool PERM = true, AFTER_DRAIN = false;
    bf16* H;
    __device__ __forceinline__ void operator()(const f32x4 (&acc)[2][2][4][2], const Unit& u, int wr, int wc, int fr, int fq) const {
        const float sc = (u.pn < 4) ? 0.125f : 1.0f;
        const int row0 = u.pm * BM + wr * 64 + fr;
#pragma unroll
        for (int ai = 0; ai < 2; ++ai)
#pragma unroll
            for (int m = 0; m < 4; ++m) {
                bf16* rowp = H + (size_t)(row0 + ai * HALF + m * 16) * ODD_IN + u.pn * BM + wc * 32 + 8 * fq;
#pragma unroll
                for (int bj = 0; bj < 2; ++bj) store8(rowp + bj * HALF, acc[ai][bj][m][0] * sc, acc[ai][bj][m][1] * sc);
            }
    }
};
struct EpiOut {
    static constexpr bool PERM = false, AFTER_DRAIN = false;
    const float* Xres; float* U;
    __device__ __forceinline__ void operator()(const f32x4 (&acc)[2][2][4][2], const Unit& u, int wr, int wc, int fr, int fq) const {
        const int row0 = u.pm * BM + wr * 64 + fr, col0 = u.pn * BM + wc * 32 + 4 * fq;
#pragma unroll
        for (int ai = 0; ai < 2; ++ai)
#pragma unroll
            for (int m = 0; m < 4; ++m) {
                const size_t off = (size_t)(row0 + ai * HALF + m * 16) * D + col0;
#pragma unroll
                for (int bj = 0; bj < 2; ++bj)
#pragma unroll
                    for (int n = 0; n < 2; ++n) { const f32x4 xr = *(const f32x4*)(Xres + off + bj * HALF + n * 16); *(f32x4*)(U + off + bj * HALF + n * 16) = xr * ALPHA + acc[ai][bj][m][n]; }
            }
    }
};
struct EpiUp {
    static constexpr bool PERM = true, AFTER_DRAIN = false;
    bf16* Act; const float* bup;
    __device__ __forceinline__ void operator()(const f32x4 (&acc)[2][2][4][2], const Unit& u, int wr, int wc, int fr, int fq) const {
        const int row0 = u.pm * BM + wr * 64 + fr, f0 = u.pn * HALF + wc * 32 + 8 * fq;
        const float* bp = bup + (size_t)u.e * 2048 + 2 * f0;
        f32x4 bb[4];
#pragma unroll
        for (int i = 0; i < 4; ++i) bb[i] = *(const f32x4*)(bp + 4 * i);
#pragma unroll
        for (int ai = 0; ai < 2; ++ai)
#pragma unroll
            for (int m = 0; m < 4; ++m) {
                f32x4 o[2];
#pragma unroll
                for (int n = 0; n < 2; ++n) {
                    const f32x4 g = acc[ai][0][m][n], l = acc[ai][1][m][n];
#pragma unroll
                    for (int j = 0; j < 4; ++j) {
                        const float bg = bb[2 * n + (j >> 1)][(j & 1) * 2], bl = bb[2 * n + (j >> 1)][(j & 1) * 2 + 1];
                        const float xg = fminf(g[j] + bg, 7.0f), xl = fminf(fmaxf(l[j] + bl, -7.0f), 7.0f);
                        o[n][j] = xg * sigmoidf_(1.702f * xg) * (xl + 1.0f);
                    }
                }
                store8(Act + (size_t)(row0 + ai * HALF + m * 16) * 1024 + f0, o[0], o[1]);
            }
    }
};
struct EpiDown {
    static constexpr bool PERM = true, AFTER_DRAIN = false;
    bf16* O; const float* bdn;
    __device__ __forceinline__ void operator()(const f32x4 (&acc)[2][2][4][2], const Unit& u, int wr, int wc, int fr, int fq) const {
        const int row0 = u.pm * BM + wr * 64 + fr, col0 = u.pn * BM + wc * 32 + 8 * fq;
        const float* bp = bdn + (size_t)u.e * 1024 + col0;
        f32x4 bv[2][2];
#pragma unroll
        for (int bj = 0; bj < 2; ++bj)
#pragma unroll
            for (int n = 0; n < 2; ++n) bv[bj][n] = *(const f32x4*)(bp + bj * HALF + 4 * n);
#pragma unroll
        for (int ai = 0; ai < 2; ++ai)
#pragma unroll
            for (int m = 0; m < 4; ++m) {
                bf16* rowp = O + (size_t)(row0 + ai * HALF + m * 16) * 1024 + col0;
#pragma unroll
                for (int bj = 0; bj < 2; ++bj) store8(rowp + bj * HALF, acc[ai][bj][m][0] + bv[bj][0], acc[ai][bj][m][1] + bv[bj][1]);
            }
    }
};

template <class Epi, class Sched, bool ALIGN_EPI = true, bool SP2 = true>
__device__ __forceinline__ void gemm_phase(LAS unsigned char* lds, const Sched& S, const Epi& E, const int tid) {
    const int wid = __builtin_amdgcn_readfirstlane(tid >> 6), lane = tid & 63, wr = wid >> 2, wc = wid & 3, fr = lane & 15, fq = lane >> 4;
    constexpr int K = KD, nt = K / BK;
    unsigned voffA[2], voffB[2];
#pragma unroll
    for (int i = 0; i < 2; ++i) { int R, C; stage_rc(tid * 16 + i * 8192, R, C); const int Rb = Epi::PERM ? ((R & ~31) + perm32(R & 31)) : R;
        voffA[i] = (unsigned)(R * K + C) * 2u; voffB[i] = (unsigned)(Rb * K + C) * 2u; }
    const size_t kstep = (size_t)(BK * 2);
    const size_t hstep = (size_t)HALF * K * 2;
    const unsigned ldsw = (unsigned)wid * 1024u;
    const int aoff = lds_byte(wr * 64 + fr, fq * 8), boff = lds_byte(wc * 32 + fr, fq * 8);
#define PG8_SA(b, h) (((b) * 2 + (h)) * HTB)
#define PG8_SB(b, h) ((4 + (b) * 2 + (h)) * HTB)
#define PG8_STAGE(bufoff, gbase, voff) do { _Pragma("unroll") for (int _i = 0; _i < 2; ++_i) \
        __builtin_amdgcn_global_load_lds((const unsigned*)((const char*)(gbase) + (voff)[_i]), (LAS unsigned*)(lds + (bufoff) + ldsw + _i * 8192), 16, 0, 0); } while (0)
#define PG8_LDA(dst, b, h) do { _Pragma("unroll") for (int m = 0; m < 4; ++m) _Pragma("unroll") for (int k = 0; k < 2; ++k) dst[m][k] = *(const LAS bf16x8*)(lds + PG8_SA(b, h) + aoff + m * 2048 + k * 1024); } while (0)
#define PG8_LDB(dst, b, h) do { _Pragma("unroll") for (int n = 0; n < 2; ++n) _Pragma("unroll") for (int k = 0; k < 2; ++k) dst[n][k] = *(const LAS bf16x8*)(lds + PG8_SB(b, h) + boff + n * 2048 + k * 1024); } while (0)
#define PG8_MMA(ai, bj, At, Bt) do { __builtin_amdgcn_s_setprio(1); _Pragma("unroll") for (int m = 0; m < 4; ++m) _Pragma("unroll") for (int n = 0; n < 2; ++n) _Pragma("unroll") for (int k = 0; k < 2; ++k) \
        acc[ai][bj][m][n] = __builtin_amdgcn_mfma_f32_16x16x32_bf16(Bt[n][k], At[m][k], acc[ai][bj][m][n], 0, 0, 0); __builtin_amdgcn_s_setprio(0); } while (0)
#define PG8_WAIT_V(n) asm volatile("s_waitcnt vmcnt(" #n ")" ::: "memory")
#define PG8_WAIT_L(n) asm volatile("s_waitcnt lgkmcnt(" #n ")" ::: "memory")
#define PG8_BAR __builtin_amdgcn_s_barrier()
#define PG8_SCHED __builtin_amdgcn_sched_barrier(0)
    Unit cur, nxt; int ui = 0;
    if (!S.next(0, cur)) return;
    f32x4 acc[2][2][4][2];
#pragma unroll
    for (int a = 0; a < 2; ++a)
#pragma unroll
        for (int b = 0; b < 2; ++b)
#pragma unroll
            for (int m = 0; m < 4; ++m)
#pragma unroll
                for (int n = 0; n < 2; ++n) acc[a][b][m][n] = (f32x4){0.f, 0.f, 0.f, 0.f};
    bf16x8 At[4][2], B0[2][2], B1[2][2];
    const char* cA = S.a_base(cur); const char* cB = S.b_base(cur);
    if constexpr (SP2) {
        PG8_STAGE(PG8_SB(0, 0), cB, voffB); PG8_STAGE(PG8_SB(0, 1), cB + hstep, voffB); PG8_STAGE(PG8_SA(0, 0), cA, voffA); PG8_STAGE(PG8_SA(0, 1), cA + hstep, voffA);
        if (wr == 1) PG8_BAR;
        PG8_WAIT_V(2); PG8_BAR;
        PG8_STAGE(PG8_SB(1, 0), cB + kstep, voffB); PG8_STAGE(PG8_SA(1, 0), cA + kstep, voffA); PG8_STAGE(PG8_SB(1, 1), cB + hstep + kstep, voffB);
        PG8_WAIT_V(6); PG8_BAR;
    } else {
        PG8_STAGE(PG8_SB(0, 0), cB, voffB); PG8_STAGE(PG8_SA(0, 0), cA, voffA); PG8_STAGE(PG8_SB(0, 1), cB + hstep, voffB); PG8_STAGE(PG8_SA(0, 1), cA + hstep, voffA);
        if (wr == 1) PG8_BAR;
        PG8_WAIT_V(4); PG8_BAR;
        PG8_STAGE(PG8_SB(1, 0), cB + kstep, voffB); PG8_STAGE(PG8_SA(1, 0), cA + kstep, voffA); PG8_STAGE(PG8_SB(1, 1), cB + hstep + kstep, voffB);
        PG8_WAIT_V(6); PG8_BAR;
    }
    for (;;) {
        const bool has_next = S.next(ui + 1, nxt);
        const char* nA = has_next ? S.a_base(nxt) : cA; const char* nB = has_next ? S.b_base(nxt) : cB;
        for (int t = 0; t < nt; t += 2) {
            const bool last = (t == nt - 2);
            const char* a1 = cA + (size_t)(t + 1) * kstep;
            const char* a2 = last ? nA : cA + (size_t)(t + 2) * kstep; const char* b2 = last ? nB : cB + (size_t)(t + 2) * kstep;
            const char* a3 = a2 + kstep; const char* b3 = b2 + kstep;
            if constexpr (SP2) {
            PG8_LDB(B0, 0, 0); PG8_LDB(B1, 0, 1); PG8_SCHED; PG8_LDA(At, 0, 0); PG8_STAGE(PG8_SA(1, 1), a1 + hstep, voffA);
            PG8_WAIT_V(8); PG8_WAIT_L(0); PG8_BAR; PG8_MMA(0, 0, At, B0); PG8_MMA(0, 1, At, B1); PG8_BAR; PG8_SCHED;
            PG8_LDA(At, 0, 1); PG8_STAGE(PG8_SB(0, 0), b2, voffB); PG8_STAGE(PG8_SB(0, 1), b2 + hstep, voffB); PG8_STAGE(PG8_SA(0, 0), a2, voffA);
            PG8_WAIT_V(8); PG8_WAIT_L(0); PG8_BAR; PG8_MMA(1, 0, At, B0); PG8_MMA(1, 1, At, B1); PG8_BAR; PG8_SCHED;
            PG8_LDB(B0, 1, 0); PG8_LDB(B1, 1, 1); PG8_SCHED; PG8_LDA(At, 1, 0); PG8_STAGE(PG8_SA(0, 1), a2 + hstep, voffA);
            PG8_WAIT_V(8); PG8_WAIT_L(0); PG8_BAR; PG8_MMA(0, 0, At, B0); PG8_MMA(0, 1, At, B1); PG8_BAR; PG8_SCHED;
            PG8_LDA(At, 1, 1); PG8_STAGE(PG8_SB(1, 0), b3, voffB); PG8_STAGE(PG8_SB(1, 1), b3 + hstep, voffB); PG8_STAGE(PG8_SA(1, 0), a3, voffA);
            PG8_WAIT_V(8); PG8_WAIT_L(0); PG8_BAR; PG8_MMA(1, 0, At, B0); PG8_MMA(1, 1, At, B1); PG8_BAR; PG8_SCHED;
            } else {
            PG8_LDB(B0, 0, 0); PG8_SCHED; PG8_LDA(At, 0, 0); PG8_STAGE(PG8_SA(1, 1), a1 + hstep, voffA);
            PG8_WAIT_L(8); PG8_BAR; PG8_WAIT_L(0); PG8_MMA(0, 0, At, B0); PG8_BAR; PG8_SCHED;
            PG8_LDB(B1, 0, 1); PG8_STAGE(PG8_SB(0, 0), b2, voffB);
            PG8_BAR; PG8_WAIT_L(0); PG8_MMA(0, 1, At, B1); PG8_BAR;
            PG8_LDA(At, 0, 1); PG8_STAGE(PG8_SA(0, 0), a2, voffA);
            PG8_BAR; PG8_WAIT_L(0); PG8_MMA(1, 0, At, B0); PG8_BAR; PG8_SCHED;
            PG8_STAGE(PG8_SB(0, 1), b2 + hstep, voffB);
            PG8_WAIT_V(6); PG8_BAR; PG8_MMA(1, 1, At, B1); PG8_BAR;
            PG8_LDB(B0, 1, 0); PG8_SCHED; PG8_LDA(At, 1, 0); PG8_STAGE(PG8_SA(0, 1), a2 + hstep, voffA);
            PG8_WAIT_L(8); PG8_BAR; PG8_WAIT_L(0); PG8_MMA(0, 0, At, B0); PG8_BAR; PG8_SCHED;
            PG8_LDB(B1, 1, 1); PG8_STAGE(PG8_SB(1, 0), b3, voffB);
            PG8_BAR; PG8_WAIT_L(0); PG8_MMA(0, 1, At, B1); PG8_BAR;
            PG8_LDA(At, 1, 1); PG8_STAGE(PG8_SA(1, 0), a3, voffA);
            PG8_BAR; PG8_WAIT_L(0); PG8_MMA(1, 0, At, B0); PG8_BAR; PG8_SCHED;
            PG8_STAGE(PG8_SB(1, 1), b3 + hstep, voffB);
            PG8_WAIT_V(6); PG8_BAR; PG8_MMA(1, 1, At, B1); PG8_BAR;
            }
        }
        if constexpr (ALIGN_EPI) { if (wr == 0) PG8_BAR; }
        E(acc, cur, wr, wc, fr, fq);
        if (!has_next) break;
#pragma unroll
        for (int a = 0; a < 2; ++a)
#pragma unroll
            for (int b = 0; b < 2; ++b)
#pragma unroll
                for (int m = 0; m < 4; ++m)
#pragma unroll
                    for (int n = 0; n < 2; ++n) acc[a][b][m][n] = (f32x4){0.f, 0.f, 0.f, 0.f};
        cur = nxt; cA = nA; cB = nB; ++ui;
        if constexpr (ALIGN_EPI) { if (wr == 1) PG8_BAR; }
    }
    PG8_WAIT_V(0);
    if constexpr (!ALIGN_EPI) { if (wr == 0) PG8_BAR; }
    PG8_BAR;
#undef PG8_SA
#undef PG8_SB
#undef PG8_STAGE
#undef PG8_LDA
#undef PG8_LDB
#undef PG8_MMA
#undef PG8_WAIT_V
#undef PG8_WAIT_L
#undef PG8_BAR
#undef PG8_SCHED
}
}

__device__ __forceinline__ int rowmap(int mode, int c) {
    if (mode == 1) { const int pn = c >> 8; const bool rope = (pn < 4) || (pn >= 10 && pn < 14);
        return rope ? ((c & ~255) | (((c >> 5) & 1) << 7) | (((c >> 6) & 3) << 5) | (c & 31)) : c; }
    if (mode == 2) { const int f = c >> 1, bj = c & 1; return ((f >> 7) << 8) | (bj << 7) | (f & 127); }
    return c;
}
__device__ __forceinline__ void p0_transpose_item(const float* W, int N, bf16* WT, int mode, LAS float* scr, int item, int lane) {
    const int nblk = N / 32, kb = item / nblk, nb = item % nblk, k0 = 64 * kb, n0 = 32 * nb;
#pragma unroll 8
    for (int i = 0; i < 32; ++i) { const int kk = 2 * i + (lane >> 5); scr[kk * 33 + (lane & 31)] = W[(size_t)(k0 + kk) * N + n0 + (lane & 31)]; }
    asm volatile("s_waitcnt lgkmcnt(0)" ::: "memory");
    const int c = lane & 7;
#pragma unroll
    for (int j = 0; j < 4; ++j) { const int n = (lane >> 3) + 8 * j; const LAS float* s = scr + (8 * c) * 33 + n;
        u32x4 o; o.x = pk2(s[0 * 33], s[1 * 33]); o.y = pk2(s[2 * 33], s[3 * 33]); o.z = pk2(s[4 * 33], s[5 * 33]); o.w = pk2(s[6 * 33], s[7 * 33]);
        *(u32x4*)(WT + (size_t)rowmap(mode, n0 + n) * 1024 + k0 + 8 * c) = o; }
    asm volatile("s_waitcnt lgkmcnt(0)" ::: "memory");
}
__device__ const double INV_FREQ[32] = {1, 0.74989420933245587, 0.56234132519034907, 0.42169650342858223, 0.31622776601683794, 0.23713737056616552, 0.17782794100389229, 0.1333521432163324,
    0.10000000000000001, 0.074989420933245579, 0.056234132519034911, 0.042169650342858224, 0.031622776601683791, 0.023713737056616554, 0.017782794100389229, 0.013335214321633241,
    0.01, 0.0074989420933245579, 0.005623413251903491, 0.0042169650342858229, 0.0031622776601683794, 0.0023713737056616554, 0.0017782794100389228, 0.0013335214321633241,
    0.001, 0.00074989420933245586, 0.0005623413251903491, 0.00042169650342858224, 0.00031622776601683794, 0.00023713737056616554, 0.00017782794100389227, 0.0001333521432163324};

struct Ptrs {
    const float *x, *ab_w_in, *ab_w_out, *ret_decay, *c_w_in, *c_w_out, *c_rpb, *ln_g, *ln_b, *router_w, *router_b, *w_up, *b_up, *w_down, *b_down;
    float* out; unsigned char* ws;
};

__device__ __forceinline__ void phase_prologue(const Ptrs& P, LAS unsigned char* lds, int bid, int tid) {
    const int wave = tid >> 6, lane = tid & 63;
    LAS float* scr = (LAS float*)(lds + wave * 16384);
    const int gw = bid * NWAVES + wave, NGW = GRID * NWAVES;
    constexpr int I0 = 2 * 2048, I1 = 2 * 512, I2 = 2 * 1536, I3 = 2 * 512, I4 = 128 * 1024, I5 = 128 * 512;
    constexpr int NITEMS = I0 + I1 + I2 + I3 + I4 + I5;
    unsigned char* ws = P.ws;
    for (int it = gw; it < NITEMS; it += NGW) {
        int r = it;
        if (r < I0) { const int mi = r / 2048, ii = r % 2048; p0_transpose_item(P.ab_w_in + (size_t)mi * 1024 * 4096, 4096, (bf16*)(ws + WS_WIN_E) + (size_t)mi * 4096 * 1024, 1, scr, ii, lane); continue; } r -= I0;
        if (r < I1) { const int mi = r / 512, ii = r % 512; p0_transpose_item(P.ab_w_out + (size_t)mi * 1024 * 1024, 1024, (bf16*)(ws + WS_WOUT_E) + (size_t)mi * 1024 * 1024, 0, scr, ii, lane); continue; } r -= I1;
        if (r < I2) { const int mi = r / 1536, ii = r % 1536; p0_transpose_item(P.c_w_in + (size_t)mi * 1024 * 3072, 3072, (bf16*)(ws + WS_WIN_O) + (size_t)mi * 3072 * 1024, 0, scr, ii, lane); continue; } r -= I2;
        if (r < I3) { const int mi = r / 512, ii = r % 512; p0_transpose_item(P.c_w_out + (size_t)mi * 1024 * 1024, 1024, (bf16*)(ws + WS_WOUT_O) + (size_t)mi * 1024 * 1024, 0, scr, ii, lane); continue; } r -= I3;
        if (r < I4) { const int mi = r / 1024, ii = r % 1024; p0_transpose_item(P.w_up + (size_t)mi * 1024 * 2048, 2048, (bf16*)(ws + WS_WUP) + (size_t)mi * 2048 * 1024, 2, scr, ii, lane); continue; } r -= I4;
        { const int mi = r / 512, ii = r % 512; p0_transpose_item(P.w_down + (size_t)mi * 1024 * 1024, 1024, (bf16*)(ws + WS_WDN) + (size_t)mi * 1024 * 1024, 0, scr, ii, lane); }
    }
    float* cs = (float*)(ws + WS_COS); float* sn = (float*)(ws + WS_SIN);
    for (int g = bid * NTHR + tid; g < T * 32; g += GRID * NTHR) {
        const int pos = g >> 5, i = g & 31;
        const double rev = (double)pos * INV_FREQ[i] * 0.15915494309189535;
        const double fr = rev - __builtin_rint(rev);
        const float a = (float)(fr * 6.283185307179586);
        cs[g] = cosf(a); sn[g] = sinf(a);
    }
    { bf16* rwt = (bf16*)(ws + WS_RWT);
      for (int g = bid * NTHR + tid; g < DEPTH * NEXP * D; g += GRID * NTHR) { const int l = g >> 15, e = (g >> 10) & 31, d = g & 1023;
          const float w = P.router_w[((size_t)l * D + d) * NEXP + e]; const unsigned hi = f2bf(w); const float wl = w - __builtin_bit_cast(float, hi << 16);
          rwt[((size_t)(l * 2) * NEXP + e) * D + d] = (bf16)hi; rwt[((size_t)(l * 2 + 1) * NEXP + e) * D + d] = (bf16)f2bf(wl); } }
    bf16* xb = (bf16*)(ws + WS_XB);
    for (size_t g = (size_t)bid * NTHR + tid; g < (size_t)T * D / 8; g += (size_t)GRID * NTHR) {
        const f32x4 a = *(const f32x4*)(P.x + g * 8), b = *(const f32x4*)(P.x + g * 8 + 4);
        u32x4 o; o.x = pk2(a[0], a[1]); o.y = pk2(a[2], a[3]); o.z = pk2(b[0], b[1]); o.w = pk2(b[2], b[3]);
        *(u32x4*)(xb + g * 8) = o;
    }
}

__device__ __forceinline__ void load_panel_f32(LAS float* dst, const bf16* src, int ldh, int tid) {
    const int row = tid >> 2, c0 = (tid & 3) * 16;
    const bf16* p = src + (size_t)row * ldh + c0;
    const u32x4 a = *(const u32x4*)p, b = *(const u32x4*)(p + 8);
    float f[16]; unpack8(a, f); unpack8(b, f + 8);
    LAS f32x4* d = (LAS f32x4*)(dst + row * 64 + c0);
    d[0] = (f32x4){f[0], f[1], f[2], f[3]}; d[1] = (f32x4){f[4], f[5], f[6], f[7]}; d[2] = (f32x4){f[8], f[9], f[10], f[11]}; d[3] = (f32x4){f[12], f[13], f[14], f[15]};
}
__device__ __forceinline__ void phase_ret_states(LAS unsigned char* lds, const bf16* H, const float* decay, float* S, int bid, int tid) {
    LAS float* kf = (LAS float*)lds; LAS float* vf = kf + 128 * 64; LAS float* zt = (LAS float*)(lds + MISC_OFF + 4096);
    for (int unit = bid; unit < 1024; unit += GRID) {
        const int h = unit >> 7, n = unit & 127;
        const float lgf = log2_gamma(decay[h]), lgb = log2_gamma(decay[8 + h]);
        __syncthreads();
        load_panel_f32(kf, H + (size_t)(n * 128) * EVEN_IN + 512 + h * 64, EVEN_IN, tid);
        load_panel_f32(vf, H + (size_t)(n * 128) * EVEN_IN + 1024 + h * 64, EVEN_IN, tid);
        if (tid < 128) { zt[tid] = exp2f(lgf * (float)(127 - tid)); zt[128 + tid] = exp2f(lgb * (float)tid); }
        __syncthreads();
        const int e = tid >> 3, d0 = (tid & 7) * 8;
        f32x4 af0 = {0, 0, 0, 0}, af1 = af0, ab0 = af0, ab1 = af0;
        for (int m = 0; m < 128; ++m) {
            const float ve = vf[m * 64 + e]; const float a = ve * zt[m], b = ve * zt[128 + m];
            const f32x4 k0 = *(const LAS f32x4*)(kf + m * 64 + d0), k1 = *(const LAS f32x4*)(kf + m * 64 + d0 + 4);
            af0 += k0 * a; af1 += k1 * a; ab0 += k0 * b; ab1 += k1 * b;
        }
        float* sf = S + ((size_t)(h) * 128 + n) * 4096 + e * 64 + d0;
        float* sb = S + ((size_t)(8 + h) * 128 + n) * 4096 + e * 64 + d0;
        *(f32x4*)sf = af0; *(f32x4*)(sf + 4) = af1; *(f32x4*)sb = ab0; *(f32x4*)(sb + 4) = ab1;
    }
}
__device__ __forceinline__ void phase_ret_scan(const float* S, bf16* R, const float* decay, int bid, int tid) {
    for (int g = bid * NTHR + tid; g < 65536; g += GRID * NTHR) {
        const int dir = g >> 15, h = (g >> 12) & 7, de = g & 4095;
        const float gc = exp2f(log2_gamma(decay[dir * 8 + h]) * 128.0f);
        const float* s = S + ((size_t)(dir * 8 + h) * 128) * 4096 + de; bf16* r = R + ((size_t)(dir * 8 + h) * 128) * 4096 + de;
        float a = 0.f;
        if (dir == 0) { for (int n = 0; n < 128; ++n) { r[(size_t)n * 4096] = (bf16)f2bf(a); a = gc * a + s[(size_t)n * 4096]; } }
        else { for (int n = 127; n >= 0; --n) { r[(size_t)n * 4096] = (bf16)f2bf(a); a = gc * a + s[(size_t)n * 4096]; } }
    }
}
__device__ __forceinline__ void phase_ret_out(LAS unsigned char* lds, const bf16* H, const float* R, const float* decay, bf16* Y, int bid, int tid) {
    LAS float* qf = (LAS float*)lds; LAS float* kf = qf + 8192; LAS float* vf = kf + 8192; LAS float* rf = vf + 8192; LAS float* rb = rf + 4096;
    for (int unit = bid; unit < 1024; unit += GRID) {
        const int h = unit >> 7, n = unit & 127;
        const float lgf = log2_gamma(decay[h]), lgb = log2_gamma(decay[8 + h]);
        __syncthreads();
        const bf16* hp = H + (size_t)(n * 128) * EVEN_IN + h * 64;
        load_panel_f32(qf, hp, EVEN_IN, tid); load_panel_f32(kf, hp + 512, EVEN_IN, tid); load_panel_f32(vf, hp + 1024, EVEN_IN, tid);
        { const float* r0 = R + ((size_t)(h) * 128 + n) * 4096 + tid * 8; const float* r1 = R + ((size_t)(8 + h) * 128 + n) * 4096 + tid * 8;
          *(LAS f32x4*)(rf + tid * 8) = *(const f32x4*)r0; *(LAS f32x4*)(rf + tid * 8 + 4) = *(const f32x4*)(r0 + 4);
          *(LAS f32x4*)(rb + tid * 8) = *(const f32x4*)r1; *(LAS f32x4*)(rb + tid * 8 + 4) = *(const f32x4*)(r1 + 4); }
        __syncthreads();
        const int c = tid >> 2, e0 = (tid & 3) * 16;
        f32x4 q[16];
#pragma unroll
        for (int i = 0; i < 16; ++i) q[i] = *(const LAS f32x4*)(qf + c * 64 + 4 * i);
        f32x4 of[4], ob[4];
#pragma unroll
        for (int i = 0; i < 4; ++i) { of[i] = (f32x4){0, 0, 0, 0}; ob[i] = of[i]; }
        for (int m = 0; m < 128; ++m) {
            f32x4 sv = {0, 0, 0, 0};
#pragma unroll
            for (int i = 0; i < 16; ++i) sv += q[i] * *(const LAS f32x4*)(kf + m * 64 + 4 * i);
            const float s = (sv[0] + sv[1]) + (sv[2] + sv[3]);
            const float df = (float)(c - m);
            const float pf = (m <= c) ? exp2f(lgf * df) : 0.0f;
            const float pb = (m > c) ? exp2f(-lgb * df) : 0.0f;
            const float wf = s * pf, wb = s * pb;
#pragma unroll
            for (int i = 0; i < 4; ++i) { const f32x4 v = *(const LAS f32x4*)(vf + m * 64 + e0 + 4 * i); of[i] += v * wf; ob[i] += v * wb; }
        }
        f32x4 cf[4], cb[4];
#pragma unroll
        for (int i = 0; i < 4; ++i) { cf[i] = (f32x4){0, 0, 0, 0}; cb[i] = cf[i]; }
#pragma unroll
        for (int d4 = 0; d4 < 16; ++d4)
#pragma unroll
            for (int dd = 0; dd < 4; ++dd) {
                const float qd = q[d4][dd]; const int d = 4 * d4 + dd;
#pragma unroll
                for (int i = 0; i < 4; ++i) { cf[i] += *(const LAS f32x4*)(rf + d * 64 + e0 + 4 * i) * qd; cb[i] += *(const LAS f32x4*)(rb + d * 64 + e0 + 4 * i) * qd; }
            }
        const float xif = exp2f(lgf * (float)(c + 1)), xib = exp2f(lgb * (float)(128 - c));
        float sf = 0.f, sb = 0.f;
#pragma unroll
        for (int i = 0; i < 4; ++i) { of[i] += cf[i] * xif; ob[i] += cb[i] * xib; sf += (of[i][0] + of[i][1]) + (of[i][2] + of[i][3]); sb += (ob[i][0] + ob[i][1]) + (ob[i][2] + ob[i][3]); }
        sf += __shfl_xor(sf, 1); sf += __shfl_xor(sf, 2); sb += __shfl_xor(sb, 1); sb += __shfl_xor(sb, 2);
        const float muf = sf * (1.0f / 64.0f), mub = sb * (1.0f / 64.0f);
        float vfq = 0.f, vbq = 0.f;
#pragma unroll
        for (int i = 0; i < 4; ++i) { of[i] = of[i] - muf; ob[i] = ob[i] - mub;
            vfq += (of[i][0] * of[i][0] + of[i][1] * of[i][1]) + (of[i][2] * of[i][2] + of[i][3] * of[i][3]);
            vbq += (ob[i][0] * ob[i][0] + ob[i][1] * ob[i][1]) + (ob[i][2] * ob[i][2] + ob[i][3] * ob[i][3]); }
        vfq += __shfl_xor(vfq, 1); vfq += __shfl_xor(vfq, 2); vbq += __shfl_xor(vbq, 1); vbq += __shfl_xor(vbq, 2);
        const float rsf = 1.0f / sqrtf(vfq * (1.0f / 64.0f) + GN_EPS), rsb = 1.0f / sqrtf(vbq * (1.0f / 64.0f) + GN_EPS);
        const int tok = n * 128 + c;
        const bf16* gp = H + (size_t)tok * EVEN_IN + 1536 + h * 64 + e0;
        float gf[16], gb[16];
        unpack8(*(const u32x4*)gp, gf); unpack8(*(const u32x4*)(gp + 8), gf + 8); unpack8(*(const u32x4*)(gp + 512), gb); unpack8(*(const u32x4*)(gp + 520), gb + 8);
        float y[16];
#pragma unroll
        for (int i = 0; i < 16; ++i) { const float a = gf[i] * sigmoidf_(gf[i]), b = gb[i] * sigmoidf_(gb[i]); y[i] = a * (of[i >> 2][i & 3] * rsf) + b * (ob[i >> 2][i & 3] * rsb); }
        bf16* yp = Y + (size_t)tok * D + h * 64 + e0;
        u32x4 w0, w1; w0.x = pk2(y[0], y[1]); w0.y = pk2(y[2], y[3]); w0.z = pk2(y[4], y[5]); w0.w = pk2(y[6], y[7]); w1.x = pk2(y[8], y[9]); w1.y = pk2(y[10], y[11]); w1.z = pk2(y[12], y[13]); w1.w = pk2(y[14], y[15]);
        *(u32x4*)yp = w0; *(u32x4*)(yp + 8) = w1;
    }
}

struct OnlineSm { float m, l; f32x4 o[16]; };
__device__ __forceinline__ void load_q64(const bf16* p, f32x4 (&q)[16]) {
#pragma unroll
    for (int i = 0; i < 8; ++i) { float f[8]; unpack8(*(const u32x4*)(p + 8 * i), f); q[2 * i] = (f32x4){f[0], f[1], f[2], f[3]}; q[2 * i + 1] = (f32x4){f[4], f[5], f[6], f[7]}; }
}
__device__ __forceinline__ float dot64(const f32x4 (&q)[16], const bf16* kp) {
    f32x4 sv = {0, 0, 0, 0};
#pragma unroll
    for (int i = 0; i < 8; ++i) { float f[8]; unpack8(*(const u32x4*)(kp + 8 * i), f); sv += q[2 * i] * (f32x4){f[0], f[1], f[2], f[3]}; sv += q[2 * i + 1] * (f32x4){f[4], f[5], f[6], f[7]}; }
    return (sv[0] + sv[1]) + (sv[2] + sv[3]);
}
__device__ __forceinline__ void sm_update(OnlineSm& st, float s, const bf16* vp) {
    const float mn = fmaxf(st.m, s), sc = __expf(st.m - mn), p = __expf(s - mn);
    st.l = st.l * sc + p; st.m = mn;
#pragma unroll
    for (int i = 0; i < 8; ++i) { float f[8]; unpack8(*(const u32x4*)(vp + 8 * i), f);
        st.o[2 * i] = st.o[2 * i] * sc + (f32x4){f[0], f[1], f[2], f[3]} * p; st.o[2 * i + 1] = st.o[2 * i + 1] * sc + (f32x4){f[4], f[5], f[6], f[7]} * p; }
}
__device__ __forceinline__ void sm_store(const OnlineSm& st, bf16* yp) {
    const float inv = 1.0f / st.l;
#pragma unroll
    for (int i = 0; i < 8; ++i) { const f32x4 a = st.o[2 * i] * inv, b = st.o[2 * i + 1] * inv; u32x4 w; w.x = pk2(a[0], a[1]); w.y = pk2(a[2], a[3]); w.z = pk2(b[0], b[1]); w.w = pk2(b[2], b[3]); *(u32x4*)(yp + 8 * i) = w; }
}
__device__ __forceinline__ void phase_dilated(const bf16* H, bf16* Y, int bid, int tid) {
    const int g = bid * NTHR + tid, h = g >> 14, i = g & 16383;
    f32x4 q[16]; load_q64(H + (size_t)i * EVEN_IN + 2560 + h * 64, q);
    OnlineSm st; st.m = -1e30f; st.l = 0.f;
#pragma unroll
    for (int k = 0; k < 16; ++k) st.o[k] = (f32x4){0, 0, 0, 0};
    for (int b = 0; b < 3; ++b) {
        const int dil = (b == 0) ? 1 : ((b == 1) ? 4 : 16);
        for (int jj = -64; jj <= 64; ++jj) {
            const int j = i + dil * jj;
            if (j < 0 || j >= T) continue;
            const bf16* kp = H + (size_t)j * EVEN_IN + 3072 + h * 64;
            const float s = dot64(q, kp);
            sm_update(st, s, kp + 512);
        }
    }
    sm_store(st, Y + (size_t)i * D + 512 + h * 64);
}
__device__ __forceinline__ void phase_natten(const bf16* H, const float* rpb, bf16* Y, int bid, int tid) {
    for (int rep = 0; rep < 2; ++rep) {
        const int g = rep * (GRID * NTHR) + bid * NTHR + tid, h = g >> 14, i = g & 16383, r = i >> 6, c = i & 63;
        const int r0 = min(max(r - 4, 0), 248), c0 = min(max(c - 8, 0), 48);
        f32x4 q[16]; load_q64(H + (size_t)i * ODD_IN + h * 64, q);
        OnlineSm st; st.m = -1e30f; st.l = 0.f;
#pragma unroll
        for (int k = 0; k < 16; ++k) st.o[k] = (f32x4){0, 0, 0, 0};
        for (int ii = 0; ii < 8; ++ii)
            for (int jj = 0; jj < 16; ++jj) {
                const int kr = r0 + ii, kc = c0 + jj, j = kr * 64 + kc;
                const float bias = rpb[(h * 15 + (kr - r + 7)) * 31 + (kc - c + 15)];
                const bf16* kp = H + (size_t)j * ODD_IN + 1024 + h * 64;
                const float s = dot64(q, kp) + bias;
                sm_update(st, s, kp + 1024);
            }
        sm_store(st, Y + (size_t)i * D + h * 64);
    }
}

typedef short s16x4 __attribute__((ext_vector_type(4)));
__device__ __forceinline__ void tr_read8(unsigned a0, unsigned a1, unsigned a2, unsigned a3, s16x4 (&r)[8]) {
    asm volatile("ds_read_b64_tr_b16 %0, %8\n\tds_read_b64_tr_b16 %1, %8 offset:2048\n\tds_read_b64_tr_b16 %2, %9\n\tds_read_b64_tr_b16 %3, %9 offset:2048\n\t"
                 "ds_read_b64_tr_b16 %4, %10\n\tds_read_b64_tr_b16 %5, %10 offset:2048\n\tds_read_b64_tr_b16 %6, %11\n\tds_read_b64_tr_b16 %7, %11 offset:2048\n\ts_waitcnt lgkmcnt(0)"
                 : "=&v"(r[0]), "=&v"(r[1]), "=&v"(r[2]), "=&v"(r[3]), "=&v"(r[4]), "=&v"(r[5]), "=&v"(r[6]), "=&v"(r[7]) : "v"(a0), "v"(a1), "v"(a2), "v"(a3) : "memory");
}
struct LaneOffs { unsigned k0, k1, v[4]; };
__device__ __forceinline__ LaneOffs lane_offs(int lane) {
    const int i = lane & 15, g = lane >> 4, q = i >> 2, p = i & 3, vrow = 4 * g + q; LaneOffs o;
    o.k0 = (unsigned)(i * 128 + (((g) ^ (i & 7)) << 4)); o.k1 = (unsigned)(i * 128 + (((4 + g) ^ (i & 7)) << 4));
#pragma unroll
    for (int dt = 0; dt < 4; ++dt) o.v[dt] = (unsigned)(vrow * 128 + (((2 * dt + (p >> 1)) ^ (vrow & 7)) << 4) + 8 * (p & 1));
    return o;
}
__device__ __forceinline__ unsigned lds_addr(const LAS unsigned char* p) { return (unsigned)(size_t)p; }
__device__ __forceinline__ void qk_tile(const LAS unsigned char* Kt, const LaneOffs& lo, const bf16x8 q0, const bf16x8 q1, f32x4 (&sa)[2]) {
    const bf16x8 k00 = *(const LAS bf16x8*)(Kt + lo.k0), k01 = *(const LAS bf16x8*)(Kt + lo.k1), k10 = *(const LAS bf16x8*)(Kt + 2048 + lo.k0), k11 = *(const LAS bf16x8*)(Kt + 2048 + lo.k1);
    sa[0] = (f32x4){0.f, 0.f, 0.f, 0.f}; sa[1] = sa[0];
    sa[0] = __builtin_amdgcn_mfma_f32_16x16x32_bf16(k00, q0, sa[0], 0, 0, 0); sa[0] = __builtin_amdgcn_mfma_f32_16x16x32_bf16(k01, q1, sa[0], 0, 0, 0);
    sa[1] = __builtin_amdgcn_mfma_f32_16x16x32_bf16(k10, q0, sa[1], 0, 0, 0); sa[1] = __builtin_amdgcn_mfma_f32_16x16x32_bf16(k11, q1, sa[1], 0, 0, 0);
}
__device__ __forceinline__ void pv_tile(const LAS unsigned char* Vt, const LaneOffs& lo, const f32x4 p0, const f32x4 p1, f32x4 (&o)[4]) {
    const unsigned vb = lds_addr(Vt); s16x4 r[8];
    tr_read8(vb + lo.v[0], vb + lo.v[1], vb + lo.v[2], vb + lo.v[3], r);
    u32x4 pw;
    asm volatile("v_cvt_pk_bf16_f32 %0, %4, %5\n\tv_cvt_pk_bf16_f32 %1, %6, %7\n\tv_cvt_pk_bf16_f32 %2, %8, %9\n\tv_cvt_pk_bf16_f32 %3, %10, %11\n\ts_nop 1"
                 : "=&v"(pw.x), "=&v"(pw.y), "=&v"(pw.z), "=&v"(pw.w) : "v"(p0[0]), "v"(p0[1]), "v"(p0[2]), "v"(p0[3]), "v"(p1[0]), "v"(p1[1]), "v"(p1[2]), "v"(p1[3]));
    const bf16x8 pb = __builtin_bit_cast(bf16x8, pw);
#pragma unroll
    for (int dt = 0; dt < 4; ++dt) { const bf16x8 va = __builtin_shufflevector(r[2 * dt], r[2 * dt + 1], 0, 1, 2, 3, 4, 5, 6, 7); o[dt] = __builtin_amdgcn_mfma_f32_16x16x32_bf16(va, pb, o[dt], 0, 0, 0); }
}
struct SmState { float m, l; f32x4 o[4]; };
__device__ __forceinline__ void sm_init(SmState& st) { st.m = -1e30f; st.l = 0.f;
#pragma unroll
    for (int dt = 0; dt < 4; ++dt) st.o[dt] = (f32x4){0.f, 0.f, 0.f, 0.f}; }
__device__ __forceinline__ void sm_step(SmState& st, f32x4 (&sa)[2], const LAS unsigned char* Vt, const LaneOffs& lo) {
    float tm = fmaxf(fmaxf(fmaxf(sa[0][0], sa[0][1]), fmaxf(sa[0][2], sa[0][3])), fmaxf(fmaxf(sa[1][0], sa[1][1]), fmaxf(sa[1][2], sa[1][3])));
    tm = fmaxf(tm, __shfl_xor(tm, 16)); tm = fmaxf(tm, __shfl_xor(tm, 32));
    const float mn = fmaxf(st.m, tm), sc = exp2f(st.m - mn);
    float ps = 0.f;
#pragma unroll
    for (int a = 0; a < 2; ++a)
#pragma unroll
        for (int r = 0; r < 4; ++r) { sa[a][r] = exp2f(sa[a][r] - mn); ps += sa[a][r]; }
    st.l = st.l * sc + ps; st.m = mn;
#pragma unroll
    for (int dt = 0; dt < 4; ++dt) st.o[dt] = st.o[dt] * sc;
    pv_tile(Vt, lo, sa[0], sa[1], st.o);
}

constexpr int DIL_UNITS = 8 * 3 * 128;
__device__ __forceinline__ void dil_decode(int u, int& h, int& b, int& r, int& blk) { h = u / 384; const int rem = u - h * 384; b = rem >> 7; const int x = rem & 127; r = x >> (7 - 2 * b); blk = x & ((128 >> (2 * b)) - 1); }
__device__ __forceinline__ void dil_issue(const bf16* H, int u, int tid, u32x4 (&kr)[4], u32x4 (&vr)[4]) {
    int h, b, r, blk; dil_decode(u, h, b, r, blk); const int Lc = T >> (2 * b), base = 128 * blk - 64;
#pragma unroll
    for (int k = 0; k < 4; ++k) { const int id = tid + 512 * k, row = id >> 3, c = id & 7, ki = base + row; const bool ok = (ki >= 0) && (ki < Lc);
        const bf16* src = H + (size_t)(r + (ki << (2 * b))) * EVEN_IN + 3072 + h * 64 + c * 8;
        kr[k] = ok ? *(const u32x4*)src : (u32x4){0u, 0u, 0u, 0u}; vr[k] = ok ? *(const u32x4*)(src + 512) : (u32x4){0u, 0u, 0u, 0u}; }
}
__device__ __forceinline__ void dil_commit(LAS unsigned char* buf, int tid, const u32x4 (&kr)[4], const u32x4 (&vr)[4]) {
#pragma unroll
    for (int k = 0; k < 4; ++k) { const int id = tid + 512 * k, row = id >> 3, c = id & 7; const unsigned off = (unsigned)(row * 128 + ((c ^ (row & 7)) << 4));
        *(LAS u32x4*)(buf + off) = kr[k]; *(LAS u32x4*)(buf + 32768 + off) = vr[k]; }
}
__device__ __forceinline__ void phase_dilated_mfma(LAS unsigned char* lds, const bf16* H, bf16* OG, float* LSE, int bid, int tid) {
    const int wave = tid >> 6, lane = tid & 63, i16 = lane & 15, g = lane >> 4;
    const LaneOffs lo = lane_offs(lane);
    u32x4 kr[4], vr[4];
    __syncthreads();
    dil_issue(H, bid, tid, kr, vr); dil_commit(lds, tid, kr, vr);
    __syncthreads();
    int it = 0;
    for (int u = bid; u < DIL_UNITS; u += GRID, ++it) {
        LAS unsigned char* buf = lds + (it & 1) * 65536;
        const bool has_next = (u + GRID) < DIL_UNITS;
        if (has_next) dil_issue(H, u + GRID, tid, kr, vr);
        int h, b, r, blk; dil_decode(u, h, b, r, blk); const int Lc = T >> (2 * b), base = 128 * blk - 64;
        const int ql = 16 * wave + i16, tokq = r + ((128 * blk + ql) << (2 * b));
        const bf16* qp = H + (size_t)tokq * EVEN_IN + 2560 + h * 64 + 8 * g;
        const bf16x8 q0 = *(const bf16x8*)qp, q1 = *(const bf16x8*)(qp + 32);
        SmState st; sm_init(st);
        const int t0 = wave >> 1;
#pragma unroll 1
        for (int t = t0; t < t0 + 5; ++t) {
            f32x4 sa[2]; qk_tile(buf + t * 4096, lo, q0, q1, sa);
#pragma unroll
            for (int a = 0; a < 2; ++a)
#pragma unroll
                for (int rg = 0; rg < 4; ++rg) { const int kl = 32 * t + 16 * a + 4 * g + rg, ki = base + kl; const bool ok = (kl >= ql) && (kl <= ql + 128) && (ki >= 0) && (ki < Lc);
                    sa[a][rg] = ok ? sa[a][rg] * 1.4426950408889634f : -INFINITY; }
            sm_step(st, sa, buf + 32768 + t * 4096, lo);
        }
        float l = st.l; l += __shfl_xor(l, 16); l += __shfl_xor(l, 32);
        const float inv = 1.0f / l;
        bf16* op = OG + ((size_t)b * T + tokq) * 512 + h * 64 + 4 * g;
#pragma unroll
        for (int dt = 0; dt < 4; ++dt) { const f32x4 o = st.o[dt] * inv; u32x2 w; w.x = cvt_pk_bf16(o[0], o[1]); w.y = cvt_pk_bf16(o[2], o[3]); *(u32x2*)(op + 16 * dt) = w; }
        if (g == 0) LSE[((size_t)b * T + tokq) * 8 + h] = (st.m + log2f(l)) * 0.6931471805599453f;
        if (has_next) dil_commit(lds + ((it + 1) & 1) * 65536, tid, kr, vr);
        __syncthreads();
    }
}
__device__ __forceinline__ void phase_dil_merge(const bf16* OG, const float* LSE, bf16* Y, int bid, int tid) {
    for (int item = bid * NTHR + tid; item < T * 64; item += GRID * NTHR) {
        const int tok = item >> 6, h = (item >> 3) & 7, c = item & 7;
        const float l0 = LSE[((size_t)0 * T + tok) * 8 + h], l1 = LSE[((size_t)1 * T + tok) * 8 + h], l2 = LSE[((size_t)2 * T + tok) * 8 + h];
        const float mx = fmaxf(l0, fmaxf(l1, l2)); float w0 = __expf(l0 - mx), w1 = __expf(l1 - mx), w2 = __expf(l2 - mx); const float inv = 1.0f / (w0 + w1 + w2); w0 *= inv; w1 *= inv; w2 *= inv;
        float a[8], b[8], d[8];
        unpack8(*(const u32x4*)(OG + ((size_t)0 * T + tok) * 512 + h * 64 + c * 8), a); unpack8(*(const u32x4*)(OG + ((size_t)1 * T + tok) * 512 + h * 64 + c * 8), b); unpack8(*(const u32x4*)(OG + ((size_t)2 * T + tok) * 512 + h * 64 + c * 8), d);
        float y[8];
#pragma unroll
        for (int j = 0; j < 8; ++j) y[j] = w0 * a[j] + w1 * b[j] + w2 * d[j];
        u32x4 o; o.x = pk2(y[0], y[1]); o.y = pk2(y[2], y[3]); o.z = pk2(y[4], y[5]); o.w = pk2(y[6], y[7]);
        *(u32x4*)(Y + (size_t)tok * D + 512 + h * 64 + c * 8) = o;
    }
}

__device__ __forceinline__ void phase_natten_mfma(LAS unsigned char* lds, const bf16* H, const float* rpb, bf16* Y, int bid, int tid) {
    const int wave = tid >> 6, lane = tid & 63, i16 = lane & 15, g = lane >> 4, cb = wave & 3, half = wave >> 2;
    const LaneOffs lo = lane_offs(lane);
    LAS float* btab = (LAS float*)(lds + MISC_OFF + 4096);
    LAS float* mbuf = (LAS float*)lds;
    const int wc0 = (cb == 0) ? 0 : (cb == 1) ? 8 : (cb == 2) ? 24 : 32;
    const int c = 16 * cb + i16, cs = min(max(c - 8, 0), 48);
#pragma unroll 1
    for (int k = 0; k < 16; ++k) {
        const int u = bid * 16 + k, h = u >> 8, r = u & 255, r0 = min(max(r - 4, 0), 248);
        __syncthreads();
#pragma unroll
        for (int kk = 0; kk < 8; ++kk) { const int id = tid + 512 * kk, row = id >> 3, ch = id & 7; const unsigned off = (unsigned)(row * 128 + ((ch ^ (row & 7)) << 4));
            const bf16* src = H + (size_t)(r0 * 64 + row) * ODD_IN + 1024 + h * 64 + ch * 8;
            *(LAS u32x4*)(lds + off) = *(const u32x4*)src; *(LAS u32x4*)(lds + 65536 + off) = *(const u32x4*)(src + 1024); }
        if (tid < 465) btab[tid] = rpb[h * 465 + tid];
        __syncthreads();
        const int tokq = r * 64 + c;
        const bf16* qp = H + (size_t)tokq * ODD_IN + h * 64 + 8 * g;
        const bf16x8 q0 = *(const bf16x8*)qp, q1 = *(const bf16x8*)(qp + 32);
        SmState st; sm_init(st);
#pragma unroll 1
        for (int tt = 0; tt < 4; ++tt) {
            const int krl = 4 * half + tt; const unsigned tb = (unsigned)((krl * 64 + wc0) * 128);
            f32x4 sa[2]; qk_tile(lds + tb, lo, q0, q1, sa);
            const int brow = (r0 + krl - r + 7) * 31 - c + 15;
#pragma unroll
            for (int a = 0; a < 2; ++a)
#pragma unroll
                for (int rg = 0; rg < 4; ++rg) { const int col = wc0 + 16 * a + 4 * g + rg; const bool ok = (col >= cs) && (col < cs + 16);
                    const float bias = btab[ok ? (brow + col) : 0];
                    sa[a][rg] = ok ? (sa[a][rg] + bias) * 1.4426950408889634f : -INFINITY; }
            sm_step(st, sa, lds + 65536 + tb, lo);
        }
        float l = st.l; l += __shfl_xor(l, 16); l += __shfl_xor(l, 32);
        __syncthreads();
        if (half == 1) { LAS float* mb = mbuf + ((wave - 4) * 64 + lane) * 20; mb[0] = st.m; mb[1] = l;
#pragma unroll
            for (int dt = 0; dt < 4; ++dt) *(LAS f32x4*)(mb + 4 + 4 * dt) = st.o[dt]; }
        __syncthreads();
        if (half == 0) { const LAS float* mb = mbuf + (wave * 64 + lane) * 20; const float m2 = mb[0], l2 = mb[1];
            const float M = fmaxf(st.m, m2), a1 = exp2f(st.m - M), a2 = exp2f(m2 - M); const float inv = 1.0f / (l * a1 + l2 * a2);
            bf16* op = Y + (size_t)tokq * D + h * 64 + 4 * g;
#pragma unroll
            for (int dt = 0; dt < 4; ++dt) { const f32x4 o2 = *(const LAS f32x4*)(mb + 4 + 4 * dt); const f32x4 o = (st.o[dt] * a1 + o2 * a2) * inv;
                u32x2 w; w.x = cvt_pk_bf16(o[0], o[1]); w.y = cvt_pk_bf16(o[2], o[3]); *(u32x2*)(op + 16 * dt) = w; } }
    }
}

__device__ __forceinline__ void ret_issue(const bf16* H, int u, int tid, u32x4 (&kr)[2], u32x4 (&vr)[2]) {
    const int h = u >> 7, n = u & 127;
#pragma unroll
    for (int k = 0; k < 2; ++k) { const int id = tid + 512 * k, row = id >> 3, c = id & 7; const bf16* src = H + (size_t)(n * 128 + row) * EVEN_IN + 512 + h * 64 + c * 8;
        kr[k] = *(const u32x4*)src; vr[k] = *(const u32x4*)(src + 512); }
}
__device__ __forceinline__ void ret_commit(LAS unsigned char* buf, int tid, const u32x4 (&kr)[2], const u32x4 (&vr)[2]) {
#pragma unroll
    for (int k = 0; k < 2; ++k) { const int id = tid + 512 * k, row = id >> 3, c = id & 7; const unsigned off = (unsigned)(row * 128 + ((c ^ (row & 7)) << 4));
        *(LAS u32x4*)(buf + off) = kr[k]; *(LAS u32x4*)(buf + 16384 + off) = vr[k]; }
}
__device__ __forceinline__ void phase_ret_out_mfma(LAS unsigned char* lds, const bf16* H, const bf16* RT, const float* decay, bf16* Y, int bid, int tid) {
    const int wave = tid >> 6, lane = tid & 63, i16 = lane & 15, g = lane >> 4;
    const LaneOffs lo = lane_offs(lane);
    u32x4 kr[2], vr[2];
    __syncthreads();
    ret_issue(H, bid, tid, kr, vr); ret_commit(lds, tid, kr, vr);
    __syncthreads();
    int it = 0;
    for (int u = bid; u < 1024; u += GRID, ++it) {
        LAS unsigned char* buf = lds + (it & 1) * 32768;
        const bool has_next = (u + GRID) < 1024;
        if (has_next) ret_issue(H, u + GRID, tid, kr, vr);
        const int h = u >> 7, n = u & 127;
        const float lgf = log2_gamma(decay[h]), lgb = log2_gamma(decay[8 + h]);
        const int c = 16 * wave + i16, tok = n * 128 + c;
        const bf16* qp = H + (size_t)tok * EVEN_IN + h * 64 + 8 * g;
        const bf16x8 q0 = *(const bf16x8*)qp, q1 = *(const bf16x8*)(qp + 32);
        f32x4 of[4], ob[4];
#pragma unroll
        for (int dt = 0; dt < 4; ++dt) { of[dt] = (f32x4){0.f, 0.f, 0.f, 0.f}; ob[dt] = of[dt]; }
#pragma unroll 1
        for (int t = 0; t < 4; ++t) {
            f32x4 sa[2]; qk_tile(buf + t * 4096, lo, q0, q1, sa);
            f32x4 pf[2], pb[2];
#pragma unroll
            for (int a = 0; a < 2; ++a)
#pragma unroll
                for (int rg = 0; rg < 4; ++rg) { const int m = 32 * t + 16 * a + 4 * g + rg; const float df = (float)(c - m);
                    pf[a][rg] = (m <= c) ? sa[a][rg] * exp2f(lgf * df) : 0.0f; pb[a][rg] = (m > c) ? sa[a][rg] * exp2f(-lgb * df) : 0.0f; }
            if (32 * t <= 16 * wave + 15) pv_tile(buf + 16384 + t * 4096, lo, pf[0], pf[1], of);
            if (32 * t + 31 > 16 * wave) pv_tile(buf + 16384 + t * 4096, lo, pb[0], pb[1], ob);
        }
        const bf16* rtf = RT + ((size_t)(h) * 128 + n) * 4096 + i16 * 64 + 8 * g; const bf16* rtb = RT + ((size_t)(8 + h) * 128 + n) * 4096 + i16 * 64 + 8 * g;
        const float xif = exp2f(lgf * (float)(c + 1)), xib = exp2f(lgb * (float)(128 - c));
#pragma unroll
        for (int et = 0; et < 4; ++et) {
            f32x4 cf = {0.f, 0.f, 0.f, 0.f}, cb = cf;
            cf = __builtin_amdgcn_mfma_f32_16x16x32_bf16(*(const bf16x8*)(rtf + et * 1024), q0, cf, 0, 0, 0); cf = __builtin_amdgcn_mfma_f32_16x16x32_bf16(*(const bf16x8*)(rtf + et * 1024 + 32), q1, cf, 0, 0, 0);
            cb = __builtin_amdgcn_mfma_f32_16x16x32_bf16(*(const bf16x8*)(rtb + et * 1024), q0, cb, 0, 0, 0); cb = __builtin_amdgcn_mfma_f32_16x16x32_bf16(*(const bf16x8*)(rtb + et * 1024 + 32), q1, cb, 0, 0, 0);
            of[et] += cf * xif; ob[et] += cb * xib;
        }
        float sf = 0.f, sb = 0.f;
#pragma unroll
        for (int dt = 0; dt < 4; ++dt) { sf += (of[dt][0] + of[dt][1]) + (of[dt][2] + of[dt][3]); sb += (ob[dt][0] + ob[dt][1]) + (ob[dt][2] + ob[dt][3]); }
        sf += __shfl_xor(sf, 16); sf += __shfl_xor(sf, 32); sb += __shfl_xor(sb, 16); sb += __shfl_xor(sb, 32);
        const float muf = sf * (1.0f / 64.0f), mub = sb * (1.0f / 64.0f);
        float vfq = 0.f, vbq = 0.f;
#pragma unroll
        for (int dt = 0; dt < 4; ++dt) { of[dt] = of[dt] - muf; ob[dt] = ob[dt] - mub;
            vfq += (of[dt][0] * of[dt][0] + of[dt][1] * of[dt][1]) + (of[dt][2] * of[dt][2] + of[dt][3] * of[dt][3]);
            vbq += (ob[dt][0] * ob[dt][0] + ob[dt][1] * ob[dt][1]) + (ob[dt][2] * ob[dt][2] + ob[dt][3] * ob[dt][3]); }
        vfq += __shfl_xor(vfq, 16); vfq += __shfl_xor(vfq, 32); vbq += __shfl_xor(vbq, 16); vbq += __shfl_xor(vbq, 32);
        const float rsf = 1.0f / sqrtf(vfq * (1.0f / 64.0f) + GN_EPS), rsb = 1.0f / sqrtf(vbq * (1.0f / 64.0f) + GN_EPS);
        const bf16* gp = H + (size_t)tok * EVEN_IN + 1536 + h * 64 + 4 * g;
        bf16* yp = Y + (size_t)tok * D + h * 64 + 4 * g;
#pragma unroll
        for (int dt = 0; dt < 4; ++dt) {
            const u32x2 wf = *(const u32x2*)(gp + 16 * dt), wb = *(const u32x2*)(gp + 512 + 16 * dt);
            const f32x4 gf = {bflo(wf.x), bfhi(wf.x), bflo(wf.y), bfhi(wf.y)}, gb = {bflo(wb.x), bfhi(wb.x), bflo(wb.y), bfhi(wb.y)};
            f32x4 y;
#pragma unroll
            for (int j = 0; j < 4; ++j) y[j] = gf[j] * sigmoidf_(gf[j]) * (of[dt][j] * rsf) + gb[j] * sigmoidf_(gb[j]) * (ob[dt][j] * rsb);
            u32x2 w; w.x = cvt_pk_bf16(y[0], y[1]); w.y = cvt_pk_bf16(y[2], y[3]); *(u32x2*)(yp + 16 * dt) = w;
        }
        if (has_next) ret_commit(lds + ((it + 1) & 1) * 32768, tid, kr, vr);
        __syncthreads();
    }
}

__device__ __forceinline__ void phase_ln1_router(LAS unsigned char* lds, const float* U, const float* lng, const float* lnb, const float* rw, const float* rbias,
                                                 float* X1, bf16* X1b, int* tope, float* gate, int* lrank, int* cnt, int bid, int tid) {
    const int wave = tid >> 6, lane = tid & 63;
    LAS int* lcnt = (LAS int*)(lds + MISC_OFF + 1024);
    __syncthreads();
    for (int idx = tid; idx < 1024 * 8; idx += NTHR) { const int d = idx >> 3, c = idx & 7;
        *(LAS f32x4*)(lds + d * 128 + ((c ^ ((d >> 1) & 7)) << 4)) = *(const f32x4*)(rw + d * 32 + c * 4); }
    if (tid < 32) lcnt[tid] = 0;
    __syncthreads();
    float gg[16], bb[16];
#pragma unroll
    for (int i = 0; i < 16; ++i) { gg[i] = lng[64 * i + lane]; bb[i] = lnb[64 * i + lane]; }
    const float rbe = rbias[lane >> 1];
    for (int rr = 0; rr < 8; ++rr) {
        const int row = bid * 64 + wave * 8 + rr;
        float x[16]; float s = 0.f;
#pragma unroll
        for (int i = 0; i < 16; ++i) { x[i] = U[(size_t)row * D + 64 * i + lane]; s += x[i]; }
        const float mean = wave_sum(s) * (1.0f / D); float s2 = 0.f;
#pragma unroll
        for (int i = 0; i < 16; ++i) { x[i] -= mean; s2 += x[i] * x[i]; }
        const float rstd = 1.0f / sqrtf(wave_sum(s2) * (1.0f / D) + LN_EPS);
#pragma unroll
        for (int i = 0; i < 16; ++i) { x[i] = x[i] * rstd * gg[i] + bb[i]; X1[(size_t)row * D + 64 * i + lane] = x[i]; X1b[(size_t)row * D + 64 * i + lane] = (bf16)f2bf(x[i]); }
        float acc[32];
#pragma unroll
        for (int e = 0; e < 32; ++e) acc[e] = 0.f;
#pragma unroll
        for (int i = 0; i < 16; ++i) { const int d = 64 * i + lane;
#pragma unroll
            for (int c = 0; c < 8; ++c) { const f32x4 w = *(const LAS f32x4*)(lds + d * 128 + ((c ^ ((d >> 1) & 7)) << 4));
                acc[4 * c] += x[i] * w[0]; acc[4 * c + 1] += x[i] * w[1]; acc[4 * c + 2] += x[i] * w[2]; acc[4 * c + 3] += x[i] * w[3]; } }
#pragma unroll
        for (int t = 0; t < 16; ++t) { const bool up = (lane & 32) != 0; const float snd = up ? acc[t] : acc[t + 16]; const float rcv = __shfl_xor(snd, 32); acc[t] = (up ? acc[t + 16] : acc[t]) + rcv; }
#pragma unroll
        for (int t = 0; t < 8; ++t) { const bool up = (lane & 16) != 0; const float snd = up ? acc[t] : acc[t + 8]; const float rcv = __shfl_xor(snd, 16); acc[t] = (up ? acc[t + 8] : acc[t]) + rcv; }
#pragma unroll
        for (int t = 0; t < 4; ++t) { const bool up = (lane & 8) != 0; const float snd = up ? acc[t] : acc[t + 4]; const float rcv = __shfl_xor(snd, 8); acc[t] = (up ? acc[t + 4] : acc[t]) + rcv; }
#pragma unroll
        for (int t = 0; t < 2; ++t) { const bool up = (lane & 4) != 0; const float snd = up ? acc[t] : acc[t + 2]; const float rcv = __shfl_xor(snd, 4); acc[t] = (up ? acc[t + 2] : acc[t]) + rcv; }
        { const bool up = (lane & 2) != 0; const float snd = up ? acc[0] : acc[1]; const float rcv = __shfl_xor(snd, 2); acc[0] = (up ? acc[1] : acc[0]) + rcv; }
        float lv = acc[0] + __shfl_xor(acc[0], 1) + rbe;
        const int me = lane >> 1;
        float tv[4]; int ti[4];
#pragma unroll
        for (int k = 0; k < 4; ++k) {
            float bv = lv; int bi = me;
#pragma unroll
            for (int o = 32; o >= 1; o >>= 1) { const float ov = __shfl_xor(bv, o); const int oi = __shfl_xor(bi, o); if (ov > bv || (ov == bv && oi < bi)) { bv = ov; bi = oi; } }
            tv[k] = bv; ti[k] = bi; if (me == bi) lv = -INFINITY;
        }
        const float p1 = expf(tv[1] - tv[0]), p2 = expf(tv[2] - tv[0]), p3 = expf(tv[3] - tv[0]); const float inv = 1.0f / (1.0f + p1 + p2 + p3);
        if (lane < 4) {
            const int e = (lane == 0) ? ti[0] : (lane == 1) ? ti[1] : (lane == 2) ? ti[2] : ti[3];
            const float gk = ((lane == 0) ? 1.0f : (lane == 1) ? p1 : (lane == 2) ? p2 : p3) * inv;
            const int rk = __hip_atomic_fetch_add(lcnt + e, 1, __ATOMIC_RELAXED, __HIP_MEMORY_SCOPE_WORKGROUP);
            tope[row * 4 + lane] = e; gate[row * 4 + lane] = gk; lrank[row * 4 + lane] = rk;
        }
    }
    __syncthreads();
    if (tid < 32) cnt[bid * 32 + tid] = lcnt[tid];
}

__device__ __forceinline__ void phase_ln1_router_mfma(LAS unsigned char* lds, const float* U, const float* lng, const float* lnb, const bf16* rwt, const float* rbias,
                                                      float* X1, bf16* X1b, bf16* X1lo, int* tope, float* gate, int* lrank, int* cnt, int bid, int tid) {
    const int wave = tid >> 6, lane = tid & 63, i16 = lane & 15, g = lane >> 4;
    LAS int* lcnt = (LAS int*)(lds + MISC_OFF + 1024);
    LAS float* pbuf = (LAS float*)lds;
    __syncthreads();
    if (tid < 32) lcnt[tid] = 0;
    {   f32x4 gg[4], bb[4];
#pragma unroll
        for (int j = 0; j < 4; ++j) { gg[j] = *(const f32x4*)(lng + 256 * j + 4 * lane); bb[j] = *(const f32x4*)(lnb + 256 * j + 4 * lane); }
#pragma unroll 2
        for (int rr = 0; rr < 8; ++rr) {
            const size_t ro = (size_t)(bid * 64 + wave * 8 + rr) * D + 4 * lane;
            f32x4 v[4]; float s = 0.f;
#pragma unroll
            for (int j = 0; j < 4; ++j) { v[j] = *(const f32x4*)(U + ro + 256 * j); s += (v[j][0] + v[j][1]) + (v[j][2] + v[j][3]); }
            const float mean = wave_sum(s) * (1.0f / D); float s2 = 0.f;
#pragma unroll
            for (int j = 0; j < 4; ++j) { v[j] = v[j] - mean; s2 += (v[j][0] * v[j][0] + v[j][1] * v[j][1]) + (v[j][2] * v[j][2] + v[j][3] * v[j][3]); }
            const float rstd = 1.0f / sqrtf(wave_sum(s2) * (1.0f / D) + LN_EPS);
#pragma unroll
            for (int j = 0; j < 4; ++j) { const f32x4 o = v[j] * rstd * gg[j] + bb[j]; *(f32x4*)(X1 + ro + 256 * j) = o;
                const unsigned h0 = f2bf(o[0]), h1 = f2bf(o[1]), h2 = f2bf(o[2]), h3 = f2bf(o[3]);
                u32x2 wh; wh.x = h0 | (h1 << 16); wh.y = h2 | (h3 << 16); *(u32x2*)(X1b + ro + 256 * j) = wh;
                u32x2 wl; wl.x = pk2(o[0] - __builtin_bit_cast(float, h0 << 16), o[1] - __builtin_bit_cast(float, h1 << 16)); wl.y = pk2(o[2] - __builtin_bit_cast(float, h2 << 16), o[3] - __builtin_bit_cast(float, h3 << 16));
                *(u32x2*)(X1lo + ro + 256 * j) = wl; }
        }
    }
    asm volatile("s_waitcnt vmcnt(0)" ::: "memory");
    __syncthreads();
    const int rt = wave & 3, kh = wave >> 2;
    f32x4 acc[2]; acc[0] = (f32x4){0.f, 0.f, 0.f, 0.f}; acc[1] = acc[0];
    {   const size_t ao = (size_t)(bid * 64 + rt * 16 + i16) * D + kh * 512 + 8 * g;
        const bf16* bh = rwt + (size_t)i16 * D + kh * 512 + 8 * g; const bf16* bl = bh + (size_t)NEXP * D;
#pragma unroll 4
        for (int s = 0; s < 16; ++s) {
            const bf16x8 ah = *(const bf16x8*)(X1b + ao + 32 * s), al = *(const bf16x8*)(X1lo + ao + 32 * s);
#pragma unroll
            for (int et = 0; et < 2; ++et) { const bf16x8 wh = *(const bf16x8*)(bh + (size_t)et * 16 * D + 32 * s), wl = *(const bf16x8*)(bl + (size_t)et * 16 * D + 32 * s);
                acc[et] = __builtin_amdgcn_mfma_f32_16x16x32_bf16(ah, wh, acc[et], 0, 0, 0); acc[et] = __builtin_amdgcn_mfma_f32_16x16x32_bf16(ah, wl, acc[et], 0, 0, 0); acc[et] = __builtin_amdgcn_mfma_f32_16x16x32_bf16(al, wh, acc[et], 0, 0, 0); }
        }
    }
    if (kh == 1) { LAS f32x4* pb = (LAS f32x4*)(pbuf + ((wave - 4) * 64 + lane) * 8); pb[0] = acc[0]; pb[1] = acc[1]; }
    __syncthreads();
    if (kh == 0) {
        const LAS f32x4* pb = (const LAS f32x4*)(pbuf + (wave * 64 + lane) * 8);
        const float b0 = rbias[i16], b1 = rbias[16 + i16];
        const f32x4 l0 = acc[0] + pb[0] + b0, l1 = acc[1] + pb[1] + b1;
#pragma unroll
        for (int reg = 0; reg < 4; ++reg) {
            float v0 = l0[reg], v1 = l1[reg]; float tv[4]; int ti[4];
#pragma unroll
            for (int k = 0; k < 4; ++k) {
                float bv = (v0 >= v1) ? v0 : v1; int bi = (v0 >= v1) ? i16 : 16 + i16;
#pragma unroll
                for (int o = 1; o < 16; o <<= 1) { const float ov = __shfl_xor(bv, o); const int oi = __shfl_xor(bi, o); if (ov > bv || (ov == bv && oi < bi)) { bv = ov; bi = oi; } }
                tv[k] = bv; ti[k] = bi; if (bi == i16) v0 = -INFINITY; if (bi == 16 + i16) v1 = -INFINITY;
            }
            const float p1 = expf(tv[1] - tv[0]), p2 = expf(tv[2] - tv[0]), p3 = expf(tv[3] - tv[0]); const float inv = 1.0f / (1.0f + p1 + p2 + p3);
            if (i16 < 4) {
                const int row = bid * 64 + rt * 16 + 4 * g + reg;
                const int e = (i16 == 0) ? ti[0] : (i16 == 1) ? ti[1] : (i16 == 2) ? ti[2] : ti[3];
                const float gk = ((i16 == 0) ? 1.0f : (i16 == 1) ? p1 : (i16 == 2) ? p2 : p3) * inv;
                const int rk = __hip_atomic_fetch_add(lcnt + e, 1, __ATOMIC_RELAXED, __HIP_MEMORY_SCOPE_WORKGROUP);
                tope[row * 4 + i16] = e; gate[row * 4 + i16] = gk; lrank[row * 4 + i16] = rk;
            }
        }
    }
    __syncthreads();
    if (tid < 32) cnt[bid * 32 + tid] = lcnt[tid];
}

__device__ __forceinline__ void phase_dispatch(LAS unsigned char* lds, const int* cnt, const int* tope, const int* lrank, int* slot, int* tiles, const bf16* X1b, bf16* Xperm, int bid, int tid) {
    LAS int* tot = (LAS int*)(lds + MISC_OFF + 1024); LAS int* pre = tot + 32; LAS int* pst = pre + 32; LAS int* ldest = pst + 40;
    const int wave = tid >> 6, lane = tid & 63;
    __syncthreads();
    if (tid < 32) { int t = 0, p = 0; for (int b2 = 0; b2 < GRID; ++b2) { const int v = cnt[b2 * 32 + tid]; t += v; p += (b2 < bid) ? v : 0; } tot[tid] = t; pre[tid] = p; }
    __syncthreads();
    if (tid == 0) { int ps = 0;
#pragma unroll 1
        for (int e = 0; e < NEXP; ++e) { pst[e] = ps; ps += ((tot[e] + 255) >> 8) << 8; }
        pst[NEXP] = ps; }
    __syncthreads();
    if (bid == 0 && tid < 1 + MAXTILES) {
        if (tid == 0) tiles[0] = pst[NEXP] >> 8;
        else { const int i = tid - 1; int ee = 0;
#pragma unroll 1
            for (int e = 0; e < NEXP; ++e) ee = ((pst[e] >> 8) <= i) ? e : ee;
            tiles[tid] = ee; }
    }
    if (tid < 256) { const int row = bid * 64 + (tid >> 2), k = tid & 3; const int e = tope[row * 4 + k]; const int dest = pst[e] + pre[e] + lrank[row * 4 + k]; slot[row * 4 + k] = dest; ldest[tid] = dest; }
    __syncthreads();
    for (int s = wave * 32; s < wave * 32 + 32; ++s) {
        const int row = bid * 64 + (s >> 2); const int dest = ldest[s];
        const u32x4* src = (const u32x4*)(X1b + (size_t)row * D); u32x4* dst = (u32x4*)(Xperm + (size_t)dest * D);
        const u32x4 a = src[lane], b = src[64 + lane]; dst[lane] = a; dst[64 + lane] = b;
    }
}

__device__ __forceinline__ void phase_combine_ln2(const float* X1, const bf16* Oslot, const int* slot, const float* gate, const float* lng, const float* lnb, float* Xout, bf16* Xb, int bid, int tid) {
    const int wave = tid >> 6, lane = tid & 63;
    f32x4 gg[4], bb[4];
#pragma unroll
    for (int j = 0; j < 4; ++j) { gg[j] = *(const f32x4*)(lng + 256 * j + 4 * lane); bb[j] = *(const f32x4*)(lnb + 256 * j + 4 * lane); }
    for (int rr = 0; rr < 8; ++rr) {
        const int row = bid * 64 + wave * 8 + rr;
        f32x4 v[4];
#pragma unroll
        for (int j = 0; j < 4; ++j) v[j] = *(const f32x4*)(X1 + (size_t)row * D + 256 * j + 4 * lane) * ALPHA;
#pragma unroll
        for (int k = 0; k < 4; ++k) { const int s = slot[row * 4 + k]; const float g = gate[row * 4 + k];
#pragma unroll
            for (int j = 0; j < 4; ++j) { const u32x2 w = *(const u32x2*)(Oslot + (size_t)s * D + 256 * j + 4 * lane); v[j] += (f32x4){bflo(w.x), bfhi(w.x), bflo(w.y), bfhi(w.y)} * g; } }
        float s = 0.f;
#pragma unroll
        for (int j = 0; j < 4; ++j) s += (v[j][0] + v[j][1]) + (v[j][2] + v[j][3]);
        const float mean = wave_sum(s) * (1.0f / D); float s2 = 0.f;
#pragma unroll
        for (int j = 0; j < 4; ++j) { v[j] = v[j] - mean; s2 += (v[j][0] * v[j][0] + v[j][1] * v[j][1]) + (v[j][2] * v[j][2] + v[j][3] * v[j][3]); }
        const float rstd = 1.0f / sqrtf(wave_sum(s2) * (1.0f / D) + LN_EPS);
#pragma unroll
        for (int j = 0; j < 4; ++j) { const f32x4 o = v[j] * rstd * gg[j] + bb[j]; *(f32x4*)(Xout + (size_t)row * D + 256 * j + 4 * lane) = o;
            if (Xb) { u32x2 w; w.x = pk2(o[0], o[1]); w.y = pk2(o[2], o[3]); *(u32x2*)(Xb + (size_t)row * D + 256 * j + 4 * lane) = w; } }
    }
}

constexpr int NPH = 10, N_PHASES = 1 + DEPTH * NPH;
struct Args { Ptrs p; int ph_lo, ph_hi; };
static_assert(sizeof(Args) == 17 * 8 + 8, "Args has no padding");
typedef __attribute__((address_space(4))) const Args CArgs;

__global__ void __launch_bounds__(NTHR, 2) fwd_kernel(Args args) {
    extern __shared__ __attribute__((aligned(16))) unsigned char lds_raw[];
    LAS unsigned char* lds0 = (LAS unsigned char*)lds_raw;
    const int tid0 = threadIdx.x, bid0 = blockIdx.x;
    const int lo = args.ph_lo, hi = args.ph_hi;
    volatile LAS unsigned* MISC = (volatile LAS unsigned*)(lds0 + MISC_OFF);
    if (tid0 < 64) MISC[tid0] = 0u;
    __syncthreads();
    XcdBarrier bar = xcd_barrier_post((unsigned*)(((CArgs*)__builtin_amdgcn_kernarg_segment_ptr())->p.ws + WS_CTL) + CW_BAR, MISC + 8);
#define IN(k) (lo <= (k) && (k) < hi)
#define SEAM(k) do { if (IN(k) && IN((k) + 1)) xcd_barrier(bar); } while (0)
#define SITE int tid = tid0, bid = bid0, L = L0; CArgs* ap = (CArgs*)__builtin_amdgcn_kernarg_segment_ptr(); asm volatile("" : "+v"(tid)); asm volatile("" : "+s"(bid)); asm volatile("" : "+s"(L)); asm volatile("" : "+s"(ap)); LAS unsigned char* lds = lds0; asm volatile("" : "+s"(lds)); \
    unsigned char* ws = ap->p.ws; const int jl = L >> 1; const bool odd = (L & 1) != 0; (void)jl; (void)odd; (void)tid; (void)bid; (void)ws;

    { const int L0 = 0; if (IN(0)) REP(10) { SITE; Ptrs P{}; P.x = ap->p.x; P.ab_w_in = ap->p.ab_w_in; P.ab_w_out = ap->p.ab_w_out; P.c_w_in = ap->p.c_w_in; P.c_w_out = ap->p.c_w_out; P.w_up = ap->p.w_up; P.w_down = ap->p.w_down; P.router_w = ap->p.router_w; P.ws = ws; phase_prologue(P, lds, bid, tid); } }
    SEAM(0);

    for (int L0 = 0; L0 < DEPTH; ++L0) {
        const int pb = 1 + L0 * NPH; const bool odd0 = (L0 & 1) != 0;
        if (IN(pb + 0)) REP(0) {
            if (!odd0) { SITE; pg8::DenseOrder S{T / 256, EVEN_IN / 256, GRID, bid, (const char*)(ws + WS_XB), (const char*)(ws + WS_WIN_E) + (size_t)jl * EVEN_IN * 1024 * 2};
                pg8::EpiInEven E{(bf16*)(ws + WS_H), (const float*)(ws + WS_COS), (const float*)(ws + WS_SIN)}; pg8::gemm_phase<pg8::EpiInEven, pg8::DenseOrder>(lds, S, E, tid); }
            else { SITE; pg8::DenseOrder S{T / 256, ODD_IN / 256, GRID, bid, (const char*)(ws + WS_XB), (const char*)(ws + WS_WIN_O) + (size_t)jl * ODD_IN * 1024 * 2};
                pg8::EpiInOdd E{(bf16*)(ws + WS_H)}; pg8::gemm_phase<pg8::EpiInOdd, pg8::DenseOrder>(lds, S, E, tid); }
        }
        SEAM(pb + 0);
        if (IN(pb + 1)) REP(1) {
            if (!odd0) { { SITE; phase_ret_states(lds, (const bf16*)(ws + WS_H), ap->p.ret_decay + jl * 16, (float*)(ws + WS_RS), bid, tid); }
                         { SITE; phase_dilated_mfma(lds, (const bf16*)(ws + WS_H), (bf16*)(ws + WS_ACT), (float*)(ws + WS_OSLOT), bid, tid); } }
            else { SITE; phase_natten_mfma(lds, (const bf16*)(ws + WS_H), ap->p.c_rpb + (size_t)jl * 16 * 15 * 31, (bf16*)(ws + WS_Y), bid, tid); }
        }
        SEAM(pb + 1);
        if (!odd0) {
            if (IN(pb + 2)) REP(2) { { SITE; phase_ret_scan((const float*)(ws + WS_RS), (bf16*)(ws + WS_RR), ap->p.ret_decay + jl * 16, bid, tid); }
                              { SITE; phase_dil_merge((const bf16*)(ws + WS_ACT), (const float*)(ws + WS_OSLOT), (bf16*)(ws + WS_Y), bid, tid); } }
            SEAM(pb + 2);
            if (IN(pb + 3)) REP(3) { SITE; phase_ret_out_mfma(lds, (const bf16*)(ws + WS_H), (const bf16*)(ws + WS_RR), ap->p.ret_decay + jl * 16, (bf16*)(ws + WS_Y), bid, tid); }
            SEAM(pb + 3);
        }
        if (IN(pb + 4)) REP(4) { SITE;
            pg8::DenseOrder S{T / 256, D / 256, GRID, bid, (const char*)(ws + WS_Y), (const char*)(ws + (odd ? WS_WOUT_O : WS_WOUT_E)) + (size_t)jl * 1024 * 1024 * 2};
            pg8::EpiOut E{(L == 0) ? ap->p.x : (const float*)(ws + WS_X), (float*)(ws + WS_U)}; pg8::gemm_phase<pg8::EpiOut, pg8::DenseOrder>(lds, S, E, tid);
        }
        SEAM(pb + 4);
        if (IN(pb + 5)) REP(5) { SITE; phase_ln1_router_mfma(lds, (const float*)(ws + WS_U), ap->p.ln_g + (size_t)(L * 2) * D, ap->p.ln_b + (size_t)(L * 2) * D, (const bf16*)(ws + WS_RWT) + (size_t)L * 2 * NEXP * D, ap->p.router_b + L * NEXP,
                                         (float*)(ws + WS_X1), (bf16*)(ws + WS_X1B), (bf16*)(ws + WS_X1LO), (int*)(ws + WS_TOPE), (float*)(ws + WS_GATE), (int*)(ws + WS_LRANK), (int*)(ws + WS_CNT), bid, tid); }
        SEAM(pb + 5);
        if (IN(pb + 6)) REP(6) { SITE; phase_dispatch(lds, (const int*)(ws + WS_CNT), (const int*)(ws + WS_TOPE), (const int*)(ws + WS_LRANK), (int*)(ws + WS_SLOT), (int*)(ws + WS_TILES), (const bf16*)(ws + WS_X1B), (bf16*)(ws + WS_XPERM), bid, tid); }
        SEAM(pb + 6);
        if (IN(pb + 7)) REP(7) { SITE;
            LAS int* ltile = (LAS int*)(lds + MISC_OFF + 2048); const int* tiles = (const int*)(ws + WS_TILES);
            __syncthreads();
            for (int i = tid; i < 1 + MAXTILES; i += NTHR) ltile[i] = tiles[i];
            __syncthreads();
            pg8::GroupOrder S{(int)ltile[0], 2048 / 256, GRID, bid, (const char*)(ws + WS_XPERM), (const char*)(ws + WS_WUP) + (size_t)L * 32 * 2048 * 1024 * 2, (size_t)2048 * 1024 * 2, ltile + 1};
            pg8::EpiUp E{(bf16*)(ws + WS_ACT), ap->p.b_up + (size_t)L * 32 * 2048}; pg8::gemm_phase<pg8::EpiUp, pg8::GroupOrder>(lds, S, E, tid);
        }
        SEAM(pb + 7);
        if (IN(pb + 8)) REP(8) { SITE;
            LAS int* ltile = (LAS int*)(lds + MISC_OFF + 2048); const int* tiles = (const int*)(ws + WS_TILES);
            __syncthreads();
            for (int i = tid; i < 1 + MAXTILES; i += NTHR) ltile[i] = tiles[i];
            __syncthreads();
            pg8::GroupOrder S{(int)ltile[0], 1024 / 256, GRID, bid, (const char*)(ws + WS_ACT), (const char*)(ws + WS_WDN) + (size_t)L * 32 * 1024 * 1024 * 2, (size_t)1024 * 1024 * 2, ltile + 1};
            pg8::EpiDown E{(bf16*)(ws + WS_OSLOT), ap->p.b_down + (size_t)L * 32 * 1024}; pg8::gemm_phase<pg8::EpiDown, pg8::GroupOrder>(lds, S, E, tid);
        }
        SEAM(pb + 8);
        if (IN(pb + 9)) REP(9) { SITE; phase_combine_ln2((const float*)(ws + WS_X1), (const bf16*)(ws + WS_OSLOT), (const int*)(ws + WS_SLOT), (const float*)(ws + WS_GATE), ap->p.ln_g + (size_t)(L * 2 + 1) * D, ap->p.ln_b + (size_t)(L * 2 + 1) * D,
                                          (L == DEPTH - 1) ? ap->p.out : (float*)(ws + WS_X), (L == DEPTH - 1) ? (bf16*)nullptr : (bf16*)(ws + WS_XB), bid, tid); }
        SEAM(pb + 9);
    }
#undef IN
#undef SEAM
#undef SITE
}

extern "C" void kernel_launch(void* const* d_in, const int* in_sizes, int n_in, void* d_out, int out_size, void* d_ws, size_t ws_size, hipStream_t stream) {
    static int ready = 0;
    if (ready == 0) {
        if (n_in != 15 || in_sizes[0] != T * D || out_size != T * D || ws_size < WS_END) {
            fprintf(stderr, "kernel_launch: unexpected problem (n_in %d, in0 %d, out %d, ws %zu); nothing launched\n", n_in, n_in > 0 ? in_sizes[0] : -1, out_size, ws_size); ready = -1; return; }
        if (hipFuncSetAttribute((const void*)fwd_kernel, hipFuncAttributeMaxDynamicSharedMemorySize, LDS_BYTES) != hipSuccess) { fprintf(stderr, "kernel_launch: hipFuncSetAttribute failed\n"); ready = -1; return; }
        int per_cu = 0;
        if (hipOccupancyMaxActiveBlocksPerMultiprocessor(&per_cu, (const void*)fwd_kernel, NTHR, LDS_BYTES) != hipSuccess || per_cu < 1) fprintf(stderr, "kernel_launch: occupancy query reports %d workgroups per CU\n", per_cu);
        (void)hipGetLastError();
        ready = 1;
    }
    if (ready < 0) return;
    (void)hipMemsetAsync((char*)d_ws + WS_CTL, 0, CTL_ZERO_BYTES, stream);
    Args a{};
    a.p.x = (const float*)d_in[0]; a.p.ab_w_in = (const float*)d_in[1]; a.p.ab_w_out = (const float*)d_in[2]; a.p.ret_decay = (const float*)d_in[3];
    a.p.c_w_in = (const float*)d_in[4]; a.p.c_w_out = (const float*)d_in[5]; a.p.c_rpb = (const float*)d_in[6]; a.p.ln_g = (const float*)d_in[7]; a.p.ln_b = (const float*)d_in[8];
    a.p.router_w = (const float*)d_in[9]; a.p.router_b = (const float*)d_in[10]; a.p.w_up = (const float*)d_in[11]; a.p.b_up = (const float*)d_in[12]; a.p.w_down = (const float*)d_in[13]; a.p.b_down = (const float*)d_in[14];
    a.p.out = (float*)d_out; a.p.ws = (unsigned char*)d_ws;
#if N_LAUNCH_MODE == 0
    a.ph_lo = 0; a.ph_hi = N_PHASES;
    hipLaunchKernelGGL(fwd_kernel, dim3(GRID), dim3(NTHR), LDS_BYTES, stream, a);
#else
    for (int ph = 0; ph < N_PHASES; ++ph) {
        if (ph >= 1) { const int L = (ph - 1) / NPH, p = (ph - 1) % NPH; if ((L & 1) && (p == 2 || p == 3)) continue; }
        a.ph_lo = ph; a.ph_hi = ph + 1;
        hipLaunchKernelGGL(fwd_kernel, dim3(GRID), dim3(NTHR), LDS_BYTES, stream, a);
    }
#endif
}
```

```cpp
#include <hip/hip_runtime.h>
#include <cstdio>
#include <cstdint>

#ifndef PROBE_MASK
#define PROBE_MASK 0
#endif
#define REP(id) for (int _r = 0; _r < 1 + ((PROBE_MASK >> (id)) & 1); ++_r)
#ifndef N_LAUNCH_MODE
#define N_LAUNCH_MODE 0
#endif

#define GAS __attribute__((address_space(1)))
#define LAS __attribute__((address_space(3)))
typedef unsigned short bf16;
typedef short bf16x8 __attribute__((ext_vector_type(8)));
typedef float f32x4 __attribute__((ext_vector_type(4)));
typedef float f32x2 __attribute__((ext_vector_type(2)));
typedef unsigned u32x4 __attribute__((ext_vector_type(4)));
typedef unsigned u32x2 __attribute__((ext_vector_type(2)));

constexpr int T = 16384, D = 1024, DEPTH = 4, HD = 64, NEXP = 32, TOPK = 4;
constexpr int EVEN_IN = 4096, ODD_IN = 3072;
constexpr int NPAD = T * TOPK + NEXP * 256;
constexpr int MAXTILES = NPAD / 256;
constexpr float LN_EPS = 1e-5f, GN_EPS = 1e-6f;
constexpr float ALPHA = 1.681792830507429f;
constexpr int NWAVES = 8, NTHR = 512, GRID = 256;

constexpr size_t MiB = 1u << 20;
constexpr size_t WS_CTL = 0, CTL_ZERO_BYTES = 1 * MiB;
constexpr size_t WS_COS = 1 * MiB, WS_SIN = 3 * MiB;
constexpr size_t WS_CNT = 5 * MiB;
constexpr size_t WS_TOPE = 6 * MiB, WS_GATE = 7 * MiB, WS_LRANK = 8 * MiB, WS_SLOT = 9 * MiB;
constexpr size_t WS_TILES = 10 * MiB;
constexpr size_t WS_ROWIDX = 10 * MiB + 65536;
constexpr size_t WS_RWT = 11 * MiB;
constexpr size_t WS_X1LO = 1744 * MiB;
constexpr size_t WS_WIN_E = 16 * MiB, WS_WOUT_E = 32 * MiB, WS_WIN_O = 36 * MiB, WS_WOUT_O = 48 * MiB;
constexpr size_t WS_WUP = 64 * MiB, WS_WDN = 576 * MiB;
constexpr size_t WS_X = 832 * MiB, WS_XB = 896 * MiB, WS_H = 928 * MiB, WS_Y = 1056 * MiB, WS_U = 1088 * MiB;
constexpr size_t WS_X1 = 1152 * MiB, WS_X1B = 1216 * MiB, WS_XPERM = 1248 * MiB, WS_ACT = 1392 * MiB, WS_OSLOT = 1536 * MiB;
constexpr size_t WS_RS = 1680 * MiB, WS_RR = 1712 * MiB, WS_END = 1776 * MiB;
static_assert((size_t)NPAD * 1024 * 2 <= 144 * MiB, "slot buffers");
constexpr int CW_BAR = 4096;

constexpr int RING_BYTES = 131072, MISC_OFF = 131072, LDS_BYTES = 147456;

__device__ __forceinline__ unsigned f2bf(float f) { unsigned u = __builtin_bit_cast(unsigned, f); return (u + 0x7fffu + ((u >> 16) & 1u)) >> 16; }
__device__ __forceinline__ unsigned pk2(float lo, float hi) { return f2bf(lo) | (f2bf(hi) << 16); }
__device__ __forceinline__ float bflo(unsigned w) { return __builtin_bit_cast(float, w << 16); }
__device__ __forceinline__ float bfhi(unsigned w) { return __builtin_bit_cast(float, w & 0xffff0000u); }
__device__ __forceinline__ unsigned cvt_pk_bf16(float lo, float hi) { unsigned r; asm volatile("v_cvt_pk_bf16_f32 %0, %1, %2" : "=v"(r) : "v"(lo), "v"(hi)); return r; }
__device__ __forceinline__ float wave_sum(float v) {
#pragma unroll
    for (int o = 1; o < 64; o <<= 1) v += __shfl_xor(v, o);
    return v;
}
__device__ __forceinline__ void unpack8(const u32x4 w, float* f) {
    f[0] = bflo(w.x); f[1] = bfhi(w.x); f[2] = bflo(w.y); f[3] = bfhi(w.y); f[4] = bflo(w.z); f[5] = bfhi(w.z); f[6] = bflo(w.w); f[7] = bfhi(w.w);
}
__device__ __forceinline__ float log2_gamma(float logit) { return -log1pf(expf(-logit)) * 1.4426950408889634f; }
__device__ __forceinline__ float sigmoidf_(float z) { return 1.0f / (1.0f + __expf(-z)); }

#define XB_TMO      128
#define XB_XCNT(j)  (256  + 64 * (j))
#define XB_XSUB(j)  (1280 + 64 * (j))
#define XB_XGEN(j)  (2304 + 64 * (j))
#define XB_TOP      3328
#define XB_TOPGEN   3392
#define XCD_BAR_WORDS 3456
#define XB_SPIN_CAP (1u << 18)

__device__ __forceinline__ unsigned xb_ld(unsigned* p)              { return __hip_atomic_load(p, __ATOMIC_RELAXED, __HIP_MEMORY_SCOPE_AGENT); }
__device__ __forceinline__ unsigned xb_add(unsigned* p, unsigned v) { return __hip_atomic_fetch_add(p, v, __ATOMIC_RELAXED, __HIP_MEMORY_SCOPE_AGENT); }
__device__ __forceinline__ unsigned xb_xcc_id() { return (unsigned)__builtin_amdgcn_s_getreg((3 << 11) | 20) & 0xFu; }
#define XB_SPIN(cond, bar) do { unsigned _sp = 0; while (cond) { __builtin_amdgcn_s_sleep(1); \
    if ((++_sp & 255u) == 0u) { if (xb_ld(&(bar)[XB_TMO])) break; if (_sp > XB_SPIN_CAP) { atomicAdd(&(bar)[XB_TMO], 1u); break; } } } } while (0)

struct XcdBarrier { unsigned* bar; unsigned x; volatile LAS unsigned* st; };

__device__ __forceinline__ XcdBarrier xcd_barrier_post(unsigned* bar, volatile LAS unsigned* st) {
    XcdBarrier b; b.bar = bar; b.x = xb_xcc_id(); b.st = st;
    if (threadIdx.x == 0) (void)xb_add(&bar[XB_XCNT(b.x)], 1u);
    return b;
}
__device__ __forceinline__ void xcd_barrier_complete(unsigned* bar, unsigned x, unsigned& nloc, unsigned& nx) {
    const unsigned G = gridDim.x * gridDim.y * gridDim.z;
    unsigned sum, cnt, mine, sp = 0u;
    for (;;) {
        sum = 0u; cnt = 0u; mine = 0u;
#pragma unroll
        for (unsigned j = 0; j < 16; ++j) { const unsigned c = xb_ld(&bar[XB_XCNT(j)]); sum += c; cnt += (c > 0u) ? 1u : 0u; mine = (j == x) ? c : mine; }
        if (sum == G) break;
        __builtin_amdgcn_s_sleep(1);
        if ((++sp & 255u) == 0u) { if (xb_ld(&bar[XB_TMO])) break; if (sp > XB_SPIN_CAP) { atomicAdd(&bar[XB_TMO], 1u); break; } }
    }
    nloc = mine > 0u ? mine : 1u; nx = cnt > 0u ? cnt : 1u;
}
__device__ __forceinline__ void xcd_barrier(const XcdBarrier& b0) {
    XcdBarrier b = b0; asm volatile("" : "+s"(b.bar)); asm volatile("" : "+s"(b.x));
    asm volatile("s_waitcnt vmcnt(0)" ::: "memory");
    __syncthreads();
    if (threadIdx.x == 0) {
        unsigned* bar = b.bar;
        __builtin_amdgcn_s_waitcnt(0);
        unsigned nloc = b.st[0], nx = b.st[1];
        if (nloc == 0u) { xcd_barrier_complete(bar, b.x, nloc, nx); b.st[0] = nloc; b.st[1] = nx; }
        const unsigned old = xb_add(&bar[XB_XSUB(b.x)], 1u);
        const unsigned gen = old / nloc;
        if (old + 1u == (gen + 1u) * nloc) {
            __builtin_amdgcn_fence(__ATOMIC_RELEASE, "agent");
            asm volatile("s_waitcnt vmcnt(0)" ::: "memory");
            const unsigned og = xb_add(&bar[XB_TOP], 1u);
            const unsigned tg = og / nx;
            if (og + 1u == (tg + 1u) * nx) xb_add(&bar[XB_TOPGEN], 1u);
            else XB_SPIN(xb_ld(&bar[XB_TOPGEN]) == tg, bar);
            __builtin_amdgcn_fence(__ATOMIC_ACQUIRE, "agent");
            xb_add(&bar[XB_XGEN(b.x)], 1u);
            asm volatile("s_waitcnt vmcnt(0)" ::: "memory");
        } else {
            XB_SPIN(xb_ld(&bar[XB_XGEN(b.x)]) == gen, bar);
            __builtin_amdgcn_fence(__ATOMIC_ACQUIRE, "agent");
            asm volatile("s_waitcnt vmcnt(0)" ::: "memory");
        }
    }
    __syncthreads();
}

namespace pg8 {
constexpr int BM = 256, BK = 64, HALF = 128, HTB = HALF * BK * 2, STAGE_BYTES = 8 * HTB, NXCD = 8, WGM = 8, KD = 1024;
constexpr size_t TILE_BYTES = (size_t)BM * KD * 2;

__host__ __device__ __forceinline__ int lds_byte(int r, int c) { const int st = (r >> 4) * 2 + (c >> 5), rr = r & 15, cc = c & 31, ob = rr * 64 + cc * 2; return st * 1024 + (ob ^ (((ob >> 9) & 1) << 5)); }
__host__ __device__ __forceinline__ void stage_rc(int b, int& R, int& C) { const int st = b / 1024, sb = b % 1024, swz = sb ^ (((sb >> 9) & 1) << 5); R = (st >> 1) * 16 + swz / 64; C = (st & 1) * 32 + (swz % 64) / 2; }
__host__ __device__ __forceinline__ int perm32(int rho) { const int n = rho >> 4, i = rho & 15; return 8 * (i >> 2) + 4 * n + (i & 3); }

struct Unit { int pm, pn, e; };

__device__ __forceinline__ bool order_next(int i, int G, int c, int nM, int nN, int& pm, int& pn) {
    const int nwg = nM * nN; const long L = (long)i * G + c; if (L >= nwg) return false;
    int wgid = (int)L; { const int q = nwg / NXCD, r = nwg % NXCD, xcd = wgid % NXCD, off = wgid / NXCD; wgid = (xcd < r ? xcd * (q + 1) : r * (q + 1) + (xcd - r) * q) + off; }
    const int nig = WGM * nN, gid = wgid / nig, fm = gid * WGM, gsz = (nM - fm) < WGM ? (nM - fm) : WGM;
    pm = fm + ((wgid % nig) % gsz); pn = (wgid % nig) / gsz; return true;
}
struct DenseOrder {
    int nM, nN, G, c; const char* A; const char* B; const int* rowidx;
    __device__ __forceinline__ bool next(int i, Unit& u) const { u.e = 0; return order_next(i, G, c, nM, nN, u.pm, u.pn); }
    __device__ __forceinline__ const char* a_base(const Unit& u) const { return A + (size_t)u.pm * TILE_BYTES; }
    __device__ __forceinline__ const char* b_base(const Unit& u) const { return B + (size_t)u.pn * TILE_BYTES; }
};
struct GroupOrder {
    int nM, nN, G, c; const char* A; const char* B; size_t bstride; const LAS int* tile_e; const int* rowidx;
    __device__ __forceinline__ bool next(int i, Unit& u) const { if (!order_next(i, G, c, nM, nN, u.pm, u.pn)) return false; u.e = tile_e[u.pm]; return true; }
    __device__ __forceinline__ const char* a_base(const Unit& u) const { return A + (size_t)u.pm * TILE_BYTES; }
    __device__ __forceinline__ const char* b_base(const Unit& u) const { return B + (size_t)u.e * bstride + (size_t)u.pn * TILE_BYTES; }
};

__device__ __forceinline__ void store8(bf16* p, const f32x4 v0, const f32x4 v1) {
    u32x4 w; w.x = cvt_pk_bf16(v0[0], v0[1]); w.y = cvt_pk_bf16(v0[2], v0[3]); w.z = cvt_pk_bf16(v1[0], v1[1]); w.w = cvt_pk_bf16(v1[2], v1[3]); *(u32x4*)p = w;
}
struct EpiInEven {
    static constexpr bool PERM = true, AFTER_DRAIN = false;
    bf16* H; const float* cs; const float* sn;
    __device__ __forceinline__ void operator()(const f32x4 (&acc)[2][2][4][2], const Unit& u, int wr, int wc, int fr, int fq) const {
        const int pn = u.pn; const bool rope = (pn < 4) || (pn >= 10 && pn < 14);
        const float sc = ((pn >= 2 && pn < 4) || (pn >= 10 && pn < 12)) ? 0.125f : 1.0f;
        const int row0 = u.pm * BM + wr * 64 + fr;
        if (rope) {
#pragma unroll
            for (int ai = 0; ai < 2; ++ai)
#pragma unroll
                for (int m = 0; m < 4; ++m) {
                    const int row = row0 + ai * HALF + m * 16;
                    const float* cr = cs + (size_t)row * 32 + 8 * fq; const float* sr = sn + (size_t)row * 32 + 8 * fq;
                    const f32x4 c0 = *(const f32x4*)cr, c1 = *(const f32x4*)(cr + 4), s0 = *(const f32x4*)sr, s1 = *(const f32x4*)(sr + 4);
                    const f32x4 x1a = acc[ai][0][m][0], x1b = acc[ai][0][m][1], x2a = acc[ai][1][m][0], x2b = acc[ai][1][m][1];
                    const f32x4 o1a = (x1a * c0 - x2a * s0) * sc, o1b = (x1b * c1 - x2b * s1) * sc, o2a = (x2a * c0 + x1a * s0) * sc, o2b = (x2b * c1 + x1b * s1) * sc;
                    bf16* rowp = H + (size_t)row * EVEN_IN + pn * BM + wc * 64 + 8 * fq;
                    store8(rowp, o1a, o1b); store8(rowp + 32, o2a, o2b);
                }
        } else {
#pragma unroll
            for (int ai = 0; ai < 2; ++ai)
#pragma unroll
                for (int m = 0; m < 4; ++m) {
                    bf16* rowp = H + (size_t)(row0 + ai * HALF + m * 16) * EVEN_IN + pn * BM + wc * 32 + 8 * fq;
#pragma unroll
                    for (int bj = 0; bj < 2; ++bj) store8(rowp + bj * HALF, acc[ai][bj][m][0], acc[ai][bj][m][1]);
                }
        }
    }
};
struct EpiInOdd {
    static constexpr bool PERM = true, AFTER_DRAIN = false;
    bf16* H;
    __device__ __forceinline__ void operator()(const f32x4 (&acc)[2][2][4][2], const Unit& u, int wr, int wc, int fr, int fq) const {
        const float sc = (u.pn < 4) ? 0.125f : 1.0f;
        const int row0 = u.pm * BM + wr * 64 + fr;
#pragma unroll
        for (int ai = 0; ai < 2; ++ai)
#pragma unroll
            for (int m = 0; m < 4; ++m) {
                bf16* rowp = H + (size_t)(row0 + ai * HALF + m * 16) * ODD_IN + u.pn * BM + wc * 32 + 8 * fq;
#pragma unroll
                for (int bj = 0; bj < 2; ++bj) store8(rowp + bj * HALF, acc[ai][bj][m][0] * sc, acc[ai][bj][m][1] * sc);
            }
    }
};
struct EpiOut {
    static constexpr bool PERM = false, AFTER_DRAIN = false;
    const float* Xres; float* U;
    __device__ __forceinline__ void operator()(const f32x4 (&acc)[2][2][4][2], const Unit& u, int wr, int wc, int fr, int fq) const {
        const int row0 = u.pm * BM + wr * 64 + fr, col0 = u.pn * BM + wc * 32 + 4 * fq;
#pragma unroll
        for (int ai = 0; ai < 2; ++ai)
#pragma unroll
            for (int m = 0; m < 4; ++m) {
                const size_t off = (size_t)(row0 + ai * HALF + m * 16) * D + col0;
#pragma unroll
                for (int bj = 0; bj < 2; ++bj)
#pragma unroll
                    for (int n = 0; n < 2; ++n) { const f32x4 xr = *(const f32x4*)(Xres + off + bj * HALF + n * 16); *(f32x4*)(U + off + bj * HALF + n * 16) = xr * ALPHA + acc[ai][bj][m][n]; }
            }
    }
};
struct EpiUp {
    static constexpr bool PERM = true, AFTER_DRAIN = false;
    bf16* Act; const float* bup;
    __device__ __forceinline__ void operator()(const f32x4 (&acc)[2][2][4][2], const Unit& u, int wr, int wc, int fr, int fq) const {
        const int row0 = u.pm * BM + wr * 64 + fr, f0 = u.pn * HALF + wc * 32 + 8 * fq;
        const float* bp = bup + (size_t)u.e * 2048 + 2 * f0;
        f32x4 bb[4];
#pragma unroll
        for (int i = 0; i < 4; ++i) bb[i] = *(const f32x4*)(bp + 4 * i);
#pragma unroll
        for (int ai = 0; ai < 2; ++ai)
#pragma unroll
            for (int m = 0; m < 4; ++m) {
                f32x4 o[2];
#pragma unroll
                for (int n = 0; n < 2; ++n) {
                    const f32x4 g = acc[ai][0][m][n], l = acc[ai][1][m][n];
#pragma unroll
                    for (int j = 0; j < 4; ++j) {
                        const float bg = bb[2 * n + (j >> 1)][(j & 1) * 2], bl = bb[2 * n + (j >> 1)][(j & 1) * 2 + 1];
                        const float xg = fminf(g[j] + bg, 7.0f), xl = fminf(fmaxf(l[j] + bl, -7.0f), 7.0f);
                        o[n][j] = xg * sigmoidf_(1.702f * xg) * (xl + 1.0f);
                    }
                }
                store8(Act + (size_t)(row0 + ai * HALF + m * 16) * 1024 + f0, o[0], o[1]);
            }
    }
};
struct EpiDown {
    static constexpr bool PERM = true, AFTER_DRAIN = false;
    bf16* O; const float* bdn;
    __device__ __forceinline__ void operator()(const f32x4 (&acc)[2][2][4][2], const Unit& u, int wr, int wc, int fr, int fq) const {
        const int row0 = u.pm * BM + wr * 64 + fr, col0 = u.pn * BM + wc * 32 + 8 * fq;
        const float* bp = bdn + (size_t)u.e * 1024 + col0;
        f32x4 bv[2][2];
#pragma unroll
        for (int bj = 0; bj < 2; ++bj)
#pragma unroll
            for (int n = 0; n < 2; ++n) bv[bj][n] = *(const f32x4*)(bp + bj * HALF + 4 * n);
#pragma unroll
        for (int ai = 0; ai < 2; ++ai)
#pragma unroll
            for (int m = 0; m < 4; ++m) {
                bf16* rowp = O + (size_t)(row0 + ai * HALF + m * 16) * 1024 + col0;
#pragma unroll
                for (int bj = 0; bj < 2; ++bj) store8(rowp + bj * HALF, acc[ai][bj][m][0] + bv[bj][0], acc[ai][bj][m][1] + bv[bj][1]);
            }
    }
};

template <class Epi, class Sched, bool GATHER = false, bool ALIGN_EPI = true, bool SP2 = true>
__device__ __forceinline__ void gemm_phase(LAS unsigned char* lds, const Sched& S, const Epi& E, const int tid) {
    const int wid = __builtin_amdgcn_readfirstlane(tid >> 6), lane = tid & 63, wr = wid >> 2, wc = wid & 3, fr = lane & 15, fq = lane >> 4;
    constexpr int K = KD, nt = K / BK;
    unsigned voffB[2]; int Ra[2], Ca[2];
#pragma unroll
    for (int i = 0; i < 2; ++i) { int R, C; stage_rc(tid * 16 + i * 8192, R, C); const int Rb = Epi::PERM ? ((R & ~31) + perm32(R & 31)) : R;
        Ra[i] = R; Ca[i] = C; voffB[i] = (unsigned)(Rb * K + C) * 2u; }
    unsigned vA[2][2], nvA[2][2];
#define PG8_VA(dst, unit) do { _Pragma("unroll") for (int _h = 0; _h < 2; ++_h) _Pragma("unroll") for (int _i = 0; _i < 2; ++_i) \
        dst[_h][_i] = GATHER ? ((unsigned)S.rowidx[(unit).pm * BM + _h * HALF + Ra[_i]] * (unsigned)(K * 2) + (unsigned)(Ca[_i] * 2)) : (unsigned)(((_h * HALF + Ra[_i]) * K + Ca[_i]) * 2); } while (0)
    const size_t kstep = (size_t)(BK * 2);
    const size_t hstep = (size_t)HALF * K * 2;
    const unsigned ldsw = (unsigned)wid * 1024u;
    const int aoff = lds_byte(wr * 64 + fr, fq * 8), boff = lds_byte(wc * 32 + fr, fq * 8);
#define PG8_SA(b, h) (((b) * 2 + (h)) * HTB)
#define PG8_SB(b, h) ((4 + (b) * 2 + (h)) * HTB)
#define PG8_STAGE(bufoff, gbase, voff) do { _Pragma("unroll") for (int _i = 0; _i < 2; ++_i) \
        __builtin_amdgcn_global_load_lds((const unsigned*)((const char*)(gbase) + (voff)[_i]), (LAS unsigned*)(lds + (bufoff) + ldsw + _i * 8192), 16, 0, 0); } while (0)
#define PG8_LDA(dst, b, h) do { _Pragma("unroll") for (int m = 0; m < 4; ++m) _Pragma("unroll") for (int k = 0; k < 2; ++k) dst[m][k] = *(const LAS bf16x8*)(lds + PG8_SA(b, h) + aoff + m * 2048 + k * 1024); } while (0)
#define PG8_LDB(dst, b, h) do { _Pragma("unroll") for (int n = 0; n < 2; ++n) _Pragma("unroll") for (int k = 0; k < 2; ++k) dst[n][k] = *(const LAS bf16x8*)(lds + PG8_SB(b, h) + boff + n * 2048 + k * 1024); } while (0)
#define PG8_MMA(ai, bj, At, Bt) do { __builtin_amdgcn_s_setprio(1); _Pragma("unroll") for (int m = 0; m < 4; ++m) _Pragma("unroll") for (int n = 0; n < 2; ++n) _Pragma("unroll") for (int k = 0; k < 2; ++k) \
        acc[ai][bj][m][n] = __builtin_amdgcn_mfma_f32_16x16x32_bf16(Bt[n][k], At[m][k], acc[ai][bj][m][n], 0, 0, 0); __builtin_amdgcn_s_setprio(0); } while (0)
#define PG8_WAIT_V(n) asm volatile("s_waitcnt vmcnt(" #n ")" ::: "memory")
#define PG8_WAIT_L(n) asm volatile("s_waitcnt lgkmcnt(" #n ")" ::: "memory")
#define PG8_BAR __builtin_amdgcn_s_barrier()
#define PG8_SCHED __builtin_amdgcn_sched_barrier(0)
    Unit cur, nxt; int ui = 0;
    if (!S.next(0, cur)) return;
    f32x4 acc[2][2][4][2];
#pragma unroll
    for (int a = 0; a < 2; ++a)
#pragma unroll
        for (int b = 0; b < 2; ++b)
#pragma unroll
            for (int m = 0; m < 4; ++m)
#pragma unroll
                for (int n = 0; n < 2; ++n) acc[a][b][m][n] = (f32x4){0.f, 0.f, 0.f, 0.f};
    bf16x8 At[4][2], B0[2][2], B1[2][2];
    const char* cA = GATHER ? S.A : S.a_base(cur); const char* cB = S.b_base(cur);
    PG8_VA(vA, cur);
    if constexpr (SP2) {
        PG8_STAGE(PG8_SB(0, 0), cB, voffB); PG8_STAGE(PG8_SB(0, 1), cB + hstep, voffB); PG8_STAGE(PG8_SA(0, 0), cA, vA[0]); PG8_STAGE(PG8_SA(0, 1), cA, vA[1]);
        if (wr == 1) PG8_BAR;
        PG8_WAIT_V(2); PG8_BAR;
        PG8_STAGE(PG8_SB(1, 0), cB + kstep, voffB); PG8_STAGE(PG8_SA(1, 0), cA + kstep, vA[0]); PG8_STAGE(PG8_SB(1, 1), cB + hstep + kstep, voffB);
        PG8_WAIT_V(6); PG8_BAR;
    } else {
        PG8_STAGE(PG8_SB(0, 0), cB, voffB); PG8_STAGE(PG8_SA(0, 0), cA, vA[0]); PG8_STAGE(PG8_SB(0, 1), cB + hstep, voffB); PG8_STAGE(PG8_SA(0, 1), cA, vA[1]);
        if (wr == 1) PG8_BAR;
        PG8_WAIT_V(4); PG8_BAR;
        PG8_STAGE(PG8_SB(1, 0), cB + kstep, voffB); PG8_STAGE(PG8_SA(1, 0), cA + kstep, vA[0]); PG8_STAGE(PG8_SB(1, 1), cB + hstep + kstep, voffB);
        PG8_WAIT_V(6); PG8_BAR;
    }
    for (;;) {
        const bool has_next = S.next(ui + 1, nxt);
        const char* nA = (has_next && !GATHER) ? S.a_base(nxt) : cA; const char* nB = has_next ? S.b_base(nxt) : cB;
        if (GATHER && has_next) PG8_VA(nvA, nxt); else { _Pragma("unroll") for (int _h = 0; _h < 2; ++_h) _Pragma("unroll") for (int _i = 0; _i < 2; ++_i) nvA[_h][_i] = vA[_h][_i]; }
        for (int t = 0; t < nt; t += 2) {
            const bool last = (t == nt - 2);
            const char* a1 = cA + (size_t)(t + 1) * kstep;
            const char* a2 = last ? nA : cA + (size_t)(t + 2) * kstep; const char* b2 = last ? nB : cB + (size_t)(t + 2) * kstep;
            const char* a3 = a2 + kstep; const char* b3 = b2 + kstep;
            unsigned w0[2], w1[2];
            w0[0] = last ? nvA[0][0] : vA[0][0]; w0[1] = last ? nvA[0][1] : vA[0][1]; w1[0] = last ? nvA[1][0] : vA[1][0]; w1[1] = last ? nvA[1][1] : vA[1][1];
            if constexpr (SP2) {
            PG8_LDB(B0, 0, 0); PG8_LDB(B1, 0, 1); PG8_SCHED; PG8_LDA(At, 0, 0); PG8_STAGE(PG8_SA(1, 1), a1, vA[1]);
            PG8_WAIT_V(8); PG8_WAIT_L(0); PG8_BAR; PG8_MMA(0, 0, At, B0); PG8_MMA(0, 1, At, B1); PG8_BAR; PG8_SCHED;
            PG8_LDA(At, 0, 1); PG8_STAGE(PG8_SB(0, 0), b2, voffB); PG8_STAGE(PG8_SB(0, 1), b2 + hstep, voffB); PG8_STAGE(PG8_SA(0, 0), a2, w0);
            PG8_WAIT_V(8); PG8_WAIT_L(0); PG8_BAR; PG8_MMA(1, 0, At, B0); PG8_MMA(1, 1, At, B1); PG8_BAR; PG8_SCHED;
            PG8_LDB(B0, 1, 0); PG8_LDB(B1, 1, 1); PG8_SCHED; PG8_LDA(At, 1, 0); PG8_STAGE(PG8_SA(0, 1), a2, w1);
            PG8_WAIT_V(8); PG8_WAIT_L(0); PG8_BAR; PG8_MMA(0, 0, At, B0); PG8_MMA(0, 1, At, B1); PG8_BAR; PG8_SCHED;
            PG8_LDA(At, 1, 1); PG8_STAGE(PG8_SB(1, 0), b3, voffB); PG8_STAGE(PG8_SB(1, 1), b3 + hstep, voffB); PG8_STAGE(PG8_SA(1, 0), a3, w0);
            PG8_WAIT_V(8); PG8_WAIT_L(0); PG8_BAR; PG8_MMA(1, 0, At, B0); PG8_MMA(1, 1, At, B1); PG8_BAR; PG8_SCHED;
            } else {
            PG8_LDB(B0, 0, 0); PG8_SCHED; PG8_LDA(At, 0, 0); PG8_STAGE(PG8_SA(1, 1), a1, vA[1]);
            PG8_WAIT_L(8); PG8_BAR; PG8_WAIT_L(0); PG8_MMA(0, 0, At, B0); PG8_BAR; PG8_SCHED;
            PG8_LDB(B1, 0, 1); PG8_STAGE(PG8_SB(0, 0), b2, voffB);
            PG8_BAR; PG8_WAIT_L(0); PG8_MMA(0, 1, At, B1); PG8_BAR;
            PG8_LDA(At, 0, 1); PG8_STAGE(PG8_SA(0, 0), a2, w0);
            PG8_BAR; PG8_WAIT_L(0); PG8_MMA(1, 0, At, B0); PG8_BAR; PG8_SCHED;
            PG8_STAGE(PG8_SB(0, 1), b2 + hstep, voffB);
            PG8_WAIT_V(6); PG8_BAR; PG8_MMA(1, 1, At, B1); PG8_BAR;
            PG8_LDB(B0, 1, 0); PG8_SCHED; PG8_LDA(At, 1, 0); PG8_STAGE(PG8_SA(0, 1), a2, w1);
            PG8_WAIT_L(8); PG8_BAR; PG8_WAIT_L(0); PG8_MMA(0, 0, At, B0); PG8_BAR; PG8_SCHED;
            PG8_LDB(B1, 1, 1); PG8_STAGE(PG8_SB(1, 0), b3, voffB);
            PG8_BAR; PG8_WAIT_L(0); PG8_MMA(0, 1, At, B1); PG8_BAR;
            PG8_LDA(At, 1, 1); PG8_STAGE(PG8_SA(1, 0), a3, w0);
            PG8_BAR; PG8_WAIT_L(0); PG8_MMA(1, 0, At, B0); PG8_BAR; PG8_SCHED;
            PG8_STAGE(PG8_SB(1, 1), b3 + hstep, voffB);
            PG8_WAIT_V(6); PG8_BAR; PG8_MMA(1, 1, At, B1); PG8_BAR;
            }
        }
        if constexpr (ALIGN_EPI) { if (wr == 0) PG8_BAR; }
        E(acc, cur, wr, wc, fr, fq);
        if (!has_next) break;
#pragma unroll
        for (int a = 0; a < 2; ++a)
#pragma unroll
            for (int b = 0; b < 2; ++b)
#pragma unroll
                for (int m = 0; m < 4; ++m)
#pragma unroll
                    for (int n = 0; n < 2; ++n) acc[a][b][m][n] = (f32x4){0.f, 0.f, 0.f, 0.f};
        cur = nxt; cA = nA; cB = nB; ++ui;
#pragma unroll
        for (int _h = 0; _h < 2; ++_h)
#pragma unroll
            for (int _i = 0; _i < 2; ++_i) vA[_h][_i] = nvA[_h][_i];
        if constexpr (ALIGN_EPI) { if (wr == 1) PG8_BAR; }
    }
    PG8_WAIT_V(0);
    if constexpr (!ALIGN_EPI) { if (wr == 0) PG8_BAR; }
    PG8_BAR;
#undef PG8_VA
#undef PG8_SA
#undef PG8_SB
#undef PG8_STAGE
#undef PG8_LDA
#undef PG8_LDB
#undef PG8_MMA
#undef PG8_WAIT_V
#undef PG8_WAIT_L
#undef PG8_BAR
#undef PG8_SCHED
}
}

__device__ __forceinline__ int rowmap(int mode, int c) {
    if (mode == 1) { const int pn = c >> 8; const bool rope = (pn < 4) || (pn >= 10 && pn < 14);
        return rope ? ((c & ~255) | (((c >> 5) & 1) << 7) | (((c >> 6) & 3) << 5) | (c & 31)) : c; }
    if (mode == 2) { const int f = c >> 1, bj = c & 1; return ((f >> 7) << 8) | (bj << 7) | (f & 127); }
    return c;
}
__device__ __forceinline__ void p0_transpose_item(const float* W, int N, bf16* WT, int mode, LAS float* scr, int item, int lane) {
    const int nblk = N / 32, kb = item / nblk, nb = item % nblk, k0 = 64 * kb, n0 = 32 * nb;
#pragma unroll 8
    for (int i = 0; i < 32; ++i) { const int kk = 2 * i + (lane >> 5); scr[kk * 33 + (lane & 31)] = W[(size_t)(k0 + kk) * N + n0 + (lane & 31)]; }
    asm volatile("s_waitcnt lgkmcnt(0)" ::: "memory");
    const int c = lane & 7;
#pragma unroll
    for (int j = 0; j < 4; ++j) { const int n = (lane >> 3) + 8 * j; const LAS float* s = scr + (8 * c) * 33 + n;
        u32x4 o; o.x = pk2(s[0 * 33], s[1 * 33]); o.y = pk2(s[2 * 33], s[3 * 33]); o.z = pk2(s[4 * 33], s[5 * 33]); o.w = pk2(s[6 * 33], s[7 * 33]);
        *(u32x4*)(WT + (size_t)rowmap(mode, n0 + n) * 1024 + k0 + 8 * c) = o; }
    asm volatile("s_waitcnt lgkmcnt(0)" ::: "memory");
}
__device__ const double INV_FREQ[32] = {1, 0.74989420933245587, 0.56234132519034907, 0.42169650342858223, 0.31622776601683794, 0.23713737056616552, 0.17782794100389229, 0.1333521432163324,
    0.10000000000000001, 0.074989420933245579, 0.056234132519034911, 0.042169650342858224, 0.031622776601683791, 0.023713737056616554, 0.017782794100389229, 0.013335214321633241,
    0.01, 0.0074989420933245579, 0.005623413251903491, 0.0042169650342858229, 0.0031622776601683794, 0.0023713737056616554, 0.0017782794100389228, 0.0013335214321633241,
    0.001, 0.00074989420933245586, 0.0005623413251903491, 0.00042169650342858224, 0.00031622776601683794, 0.00023713737056616554, 0.00017782794100389227, 0.0001333521432163324};

struct Ptrs {
    const float *x, *ab_w_in, *ab_w_out, *ret_decay, *c_w_in, *c_w_out, *c_rpb, *ln_g, *ln_b, *router_w, *router_b, *w_up, *b_up, *w_down, *b_down;
    float* out; unsigned char* ws;
};

__device__ __forceinline__ void phase_prologue(const Ptrs& P, LAS unsigned char* lds, int bid, int tid) {
    const int wave = tid >> 6, lane = tid & 63;
    LAS float* scr = (LAS float*)(lds + wave * 16384);
    const int gw = bid * NWAVES + wave, NGW = GRID * NWAVES;
    constexpr int I0 = 2 * 2048, I1 = 2 * 512, I2 = 2 * 1536, I3 = 2 * 512, I4 = 128 * 1024, I5 = 128 * 512;
    constexpr int NITEMS = I0 + I1 + I2 + I3 + I4 + I5;
    unsigned char* ws = P.ws;
    for (int it = gw; it < NITEMS; it += NGW) {
        int r = it;
        if (r < I0) { const int mi = r / 2048, ii = r % 2048; p0_transpose_item(P.ab_w_in + (size_t)mi * 1024 * 4096, 4096, (bf16*)(ws + WS_WIN_E) + (size_t)mi * 4096 * 1024, 1, scr, ii, lane); continue; } r -= I0;
        if (r < I1) { const int mi = r / 512, ii = r % 512; p0_transpose_item(P.ab_w_out + (size_t)mi * 1024 * 1024, 1024, (bf16*)(ws + WS_WOUT_E) + (size_t)mi * 1024 * 1024, 0, scr, ii, lane); continue; } r -= I1;
        if (r < I2) { const int mi = r / 1536, ii = r % 1536; p0_transpose_item(P.c_w_in + (size_t)mi * 1024 * 3072, 3072, (bf16*)(ws + WS_WIN_O) + (size_t)mi * 3072 * 1024, 0, scr, ii, lane); continue; } r -= I2;
        if (r < I3) { const int mi = r / 512, ii = r % 512; p0_transpose_item(P.c_w_out + (size_t)mi * 1024 * 1024, 1024, (bf16*)(ws + WS_WOUT_O) + (size_t)mi * 1024 * 1024, 0, scr, ii, lane); continue; } r -= I3;
        if (r < I4) { const int mi = r / 1024, ii = r % 1024; p0_transpose_item(P.w_up + (size_t)mi * 1024 * 2048, 2048, (bf16*)(ws + WS_WUP) + (size_t)mi * 2048 * 1024, 2, scr, ii, lane); continue; } r -= I4;
        { const int mi = r / 512, ii = r % 512; p0_transpose_item(P.w_down + (size_t)mi * 1024 * 1024, 1024, (bf16*)(ws + WS_WDN) + (size_t)mi * 1024 * 1024, 0, scr, ii, lane); }
    }
    float* cs = (float*)(ws + WS_COS); float* sn = (float*)(ws + WS_SIN);
    for (int g = bid * NTHR + tid; g < T * 32; g += GRID * NTHR) {
        const int pos = g >> 5, i = g & 31;
        const double rev = (double)pos * INV_FREQ[i] * 0.15915494309189535;
        const double fr = rev - __builtin_rint(rev);
        const float a = (float)(fr * 6.283185307179586);
        cs[g] = cosf(a); sn[g] = sinf(a);
    }
    { bf16* rwt = (bf16*)(ws + WS_RWT);
      for (int g = bid * NTHR + tid; g < DEPTH * NEXP * D; g += GRID * NTHR) { const int l = g >> 15, e = (g >> 10) & 31, d = g & 1023;
          const float w = P.router_w[((size_t)l * D + d) * NEXP + e]; const unsigned hi = f2bf(w); const float wl = w - __builtin_bit_cast(float, hi << 16);
          rwt[((size_t)(l * 2) * NEXP + e) * D + d] = (bf16)hi; rwt[((size_t)(l * 2 + 1) * NEXP + e) * D + d] = (bf16)f2bf(wl); } }
    bf16* xb = (bf16*)(ws + WS_XB);
    for (size_t g = (size_t)bid * NTHR + tid; g < (size_t)T * D / 8; g += (size_t)GRID * NTHR) {
        const f32x4 a = *(const f32x4*)(P.x + g * 8), b = *(const f32x4*)(P.x + g * 8 + 4);
        u32x4 o; o.x = pk2(a[0], a[1]); o.y = pk2(a[2], a[3]); o.z = pk2(b[0], b[1]); o.w = pk2(b[2], b[3]);
        *(u32x4*)(xb + g * 8) = o;
    }
}

__device__ __forceinline__ void load_panel_f32(LAS float* dst, const bf16* src, int ldh, int tid) {
    const int row = tid >> 2, c0 = (tid & 3) * 16;
    const bf16* p = src + (size_t)row * ldh + c0;
    const u32x4 a = *(const u32x4*)p, b = *(const u32x4*)(p + 8);
    float f[16]; unpack8(a, f); unpack8(b, f + 8);
    LAS f32x4* d = (LAS f32x4*)(dst + row * 64 + c0);
    d[0] = (f32x4){f[0], f[1], f[2], f[3]}; d[1] = (f32x4){f[4], f[5], f[6], f[7]}; d[2] = (f32x4){f[8], f[9], f[10], f[11]}; d[3] = (f32x4){f[12], f[13], f[14], f[15]};
}
__device__ __forceinline__ void phase_ret_states(LAS unsigned char* lds, const bf16* H, const float* decay, float* S, int bid, int tid) {
    LAS float* kf = (LAS float*)lds; LAS float* vf = kf + 128 * 64; LAS float* zt = (LAS float*)(lds + MISC_OFF + 4096);
    for (int unit = bid; unit < 1024; unit += GRID) {
        const int h = unit >> 7, n = unit & 127;
        const float lgf = log2_gamma(decay[h]), lgb = log2_gamma(decay[8 + h]);
        __syncthreads();
        load_panel_f32(kf, H + (size_t)(n * 128) * EVEN_IN + 512 + h * 64, EVEN_IN, tid);
        load_panel_f32(vf, H + (size_t)(n * 128) * EVEN_IN + 1024 + h * 64, EVEN_IN, tid);
        if (tid < 128) { zt[tid] = exp2f(lgf * (float)(127 - tid)); zt[128 + tid] = exp2f(lgb * (float)tid); }
        __syncthreads();
        const int e = tid >> 3, d0 = (tid & 7) * 8;
        f32x4 af0 = {0, 0, 0, 0}, af1 = af0, ab0 = af0, ab1 = af0;
        for (int m = 0; m < 128; ++m) {
            const float ve = vf[m * 64 + e]; const float a = ve * zt[m], b = ve * zt[128 + m];
            const f32x4 k0 = *(const LAS f32x4*)(kf + m * 64 + d0), k1 = *(const LAS f32x4*)(kf + m * 64 + d0 + 4);
            af0 += k0 * a; af1 += k1 * a; ab0 += k0 * b; ab1 += k1 * b;
        }
        float* sf = S + ((size_t)(h) * 128 + n) * 4096 + e * 64 + d0;
        float* sb = S + ((size_t)(8 + h) * 128 + n) * 4096 + e * 64 + d0;
        *(f32x4*)sf = af0; *(f32x4*)(sf + 4) = af1; *(f32x4*)sb = ab0; *(f32x4*)(sb + 4) = ab1;
    }
}
__device__ __forceinline__ void phase_ret_scan(const float* S, bf16* R, const float* decay, int bid, int tid) {
    for (int g = bid * NTHR + tid; g < 65536; g += GRID * NTHR) {
        const int dir = g >> 15, h = (g >> 12) & 7, de = g & 4095;
        const float gc = exp2f(log2_gamma(decay[dir * 8 + h]) * 128.0f);
        const float* s = S + ((size_t)(dir * 8 + h) * 128) * 4096 + de; bf16* r = R + ((size_t)(dir * 8 + h) * 128) * 4096 + de;
        float a = 0.f;
        if (dir == 0) { for (int n = 0; n < 128; ++n) { r[(size_t)n * 4096] = (bf16)f2bf(a); a = gc * a + s[(size_t)n * 4096]; } }
        else { for (int n = 127; n >= 0; --n) { r[(size_t)n * 4096] = (bf16)f2bf(a); a = gc * a + s[(size_t)n * 4096]; } }
    }
}
__device__ __forceinline__ void phase_ret_out(LAS unsigned char* lds, const bf16* H, const float* R, const float* decay, bf16* Y, int bid, int tid) {
    LAS float* qf = (LAS float*)lds; LAS float* kf = qf + 8192; LAS float* vf = kf + 8192; LAS float* rf = vf + 8192; LAS float* rb = rf + 4096;
    for (int unit = bid; unit < 1024; unit += GRID) {
        const int h = unit >> 7, n = unit & 127;
        const float lgf = log2_gamma(decay[h]), lgb = log2_gamma(decay[8 + h]);
        __syncthreads();
        const bf16* hp = H + (size_t)(n * 128) * EVEN_IN + h * 64;
        load_panel_f32(qf, hp, EVEN_IN, tid); load_panel_f32(kf, hp + 512, EVEN_IN, tid); load_panel_f32(vf, hp + 1024, EVEN_IN, tid);
        { const float* r0 = R + ((size_t)(h) * 128 + n) * 4096 + tid * 8; const float* r1 = R + ((size_t)(8 + h) * 128 + n) * 4096 + tid * 8;
          *(LAS f32x4*)(rf + tid * 8) = *(const f32x4*)r0; *(LAS f32x4*)(rf + tid * 8 + 4) = *(const f32x4*)(r0 + 4);
          *(LAS f32x4*)(rb + tid * 8) = *(const f32x4*)r1; *(LAS f32x4*)(rb + tid * 8 + 4) = *(const f32x4*)(r1 + 4); }
        __syncthreads();
        const int c = tid >> 2, e0 = (tid & 3) * 16;
        f32x4 q[16];
#pragma unroll
        for (int i = 0; i < 16; ++i) q[i] = *(const LAS f32x4*)(qf + c * 64 + 4 * i);
        f32x4 of[4], ob[4];
#pragma unroll
        for (int i = 0; i < 4; ++i) { of[i] = (f32x4){0, 0, 0, 0}; ob[i] = of[i]; }
        for (int m = 0; m < 128; ++m) {
            f32x4 sv = {0, 0, 0, 0};
#pragma unroll
            for (int i = 0; i < 16; ++i) sv += q[i] * *(const LAS f32x4*)(kf + m * 64 + 4 * i);
            const float s = (sv[0] + sv[1]) + (sv[2] + sv[3]);
            const float df = (float)(c - m);
            const float pf = (m <= c) ? exp2f(lgf * df) : 0.0f;
            const float pb = (m > c) ? exp2f(-lgb * df) : 0.0f;
            const float wf = s * pf, wb = s * pb;
#pragma unroll
            for (int i = 0; i < 4; ++i) { const f32x4 v = *(const LAS f32x4*)(vf + m * 64 + e0 + 4 * i); of[i] += v * wf; ob[i] += v * wb; }
        }
        f32x4 cf[4], cb[4];
#pragma unroll
        for (int i = 0; i < 4; ++i) { cf[i] = (f32x4){0, 0, 0, 0}; cb[i] = cf[i]; }
#pragma unroll
        for (int d4 = 0; d4 < 16; ++d4)
#pragma unroll
            for (int dd = 0; dd < 4; ++dd) {
                const float qd = q[d4][dd]; const int d = 4 * d4 + dd;
#pragma unroll
                for (int i = 0; i < 4; ++i) { cf[i] += *(const LAS f32x4*)(rf + d * 64 + e0 + 4 * i) * qd; cb[i] += *(const LAS f32x4*)(rb + d * 64 + e0 + 4 * i) * qd; }
            }
        const float xif = exp2f(lgf * (float)(c + 1)), xib = exp2f(lgb * (float)(128 - c));
        float sf = 0.f, sb = 0.f;
#pragma unroll
        for (int i = 0; i < 4; ++i) { of[i] += cf[i] * xif; ob[i] += cb[i] * xib; sf += (of[i][0] + of[i][1]) + (of[i][2] + of[i][3]); sb += (ob[i][0] + ob[i][1]) + (ob[i][2] + ob[i][3]); }
        sf += __shfl_xor(sf, 1); sf += __shfl_xor(sf, 2); sb += __shfl_xor(sb, 1); sb += __shfl_xor(sb, 2);
        const float muf = sf * (1.0f / 64.0f), mub = sb * (1.0f / 64.0f);
        float vfq = 0.f, vbq = 0.f;
#pragma unroll
        for (int i = 0; i < 4; ++i) { of[i] = of[i] - muf; ob[i] = ob[i] - mub;
            vfq += (of[i][0] * of[i][0] + of[i][1] * of[i][1]) + (of[i][2] * of[i][2] + of[i][3] * of[i][3]);
            vbq += (ob[i][0] * ob[i][0] + ob[i][1] * ob[i][1]) + (ob[i][2] * ob[i][2] + ob[i][3] * ob[i][3]); }
        vfq += __shfl_xor(vfq, 1); vfq += __shfl_xor(vfq, 2); vbq += __shfl_xor(vbq, 1); vbq += __shfl_xor(vbq, 2);
        const float rsf = 1.0f / sqrtf(vfq * (1.0f / 64.0f) + GN_EPS), rsb = 1.0f / sqrtf(vbq * (1.0f / 64.0f) + GN_EPS);
        const int tok = n * 128 + c;
        const bf16* gp = H + (size_t)tok * EVEN_IN + 1536 + h * 64 + e0;
        float gf[16], gb[16];
        unpack8(*(const u32x4*)gp, gf); unpack8(*(const u32x4*)(gp + 8), gf + 8); unpack8(*(const u32x4*)(gp + 512), gb); unpack8(*(const u32x4*)(gp + 520), gb + 8);
        float y[16];
#pragma unroll
        for (int i = 0; i < 16; ++i) { const float a = gf[i] * sigmoidf_(gf[i]), b = gb[i] * sigmoidf_(gb[i]); y[i] = a * (of[i >> 2][i & 3] * rsf) + b * (ob[i >> 2][i & 3] * rsb); }
        bf16* yp = Y + (size_t)tok * D + h * 64 + e0;
        u32x4 w0, w1; w0.x = pk2(y[0], y[1]); w0.y = pk2(y[2], y[3]); w0.z = pk2(y[4], y[5]); w0.w = pk2(y[6], y[7]); w1.x = pk2(y[8], y[9]); w1.y = pk2(y[10], y[11]); w1.z = pk2(y[12], y[13]); w1.w = pk2(y[14], y[15]);
        *(u32x4*)yp = w0; *(u32x4*)(yp + 8) = w1;
    }
}

struct OnlineSm { float m, l; f32x4 o[16]; };
__device__ __forceinline__ void load_q64(const bf16* p, f32x4 (&q)[16]) {
#pragma unroll
    for (int i = 0; i < 8; ++i) { float f[8]; unpack8(*(const u32x4*)(p + 8 * i), f); q[2 * i] = (f32x4){f[0], f[1], f[2], f[3]}; q[2 * i + 1] = (f32x4){f[4], f[5], f[6], f[7]}; }
}
__device__ __forceinline__ float dot64(const f32x4 (&q)[16], const bf16* kp) {
    f32x4 sv = {0, 0, 0, 0};
#pragma unroll
    for (int i = 0; i < 8; ++i) { float f[8]; unpack8(*(const u32x4*)(kp + 8 * i), f); sv += q[2 * i] * (f32x4){f[0], f[1], f[2], f[3]}; sv += q[2 * i + 1] * (f32x4){f[4], f[5], f[6], f[7]}; }
    return (sv[0] + sv[1]) + (sv[2] + sv[3]);
}
__device__ __forceinline__ void sm_update(OnlineSm& st, float s, const bf16* vp) {
    const float mn = fmaxf(st.m, s), sc = __expf(st.m - mn), p = __expf(s - mn);
    st.l = st.l * sc + p; st.m = mn;
#pragma unroll
    for (int i = 0; i < 8; ++i) { float f[8]; unpack8(*(const u32x4*)(vp + 8 * i), f);
        st.o[2 * i] = st.o[2 * i] * sc + (f32x4){f[0], f[1], f[2], f[3]} * p; st.o[2 * i + 1] = st.o[2 * i + 1] * sc + (f32x4){f[4], f[5], f[6], f[7]} * p; }
}
__device__ __forceinline__ void sm_store(const OnlineSm& st, bf16* yp) {
    const float inv = 1.0f / st.l;
#pragma unroll
    for (int i = 0; i < 8; ++i) { const f32x4 a = st.o[2 * i] * inv, b = st.o[2 * i + 1] * inv; u32x4 w; w.x = pk2(a[0], a[1]); w.y = pk2(a[2], a[3]); w.z = pk2(b[0], b[1]); w.w = pk2(b[2], b[3]); *(u32x4*)(yp + 8 * i) = w; }
}
__device__ __forceinline__ void phase_dilated(const bf16* H, bf16* Y, int bid, int tid) {
    const int g = bid * NTHR + tid, h = g >> 14, i = g & 16383;
    f32x4 q[16]; load_q64(H + (size_t)i * EVEN_IN + 2560 + h * 64, q);
    OnlineSm st; st.m = -1e30f; st.l = 0.f;
#pragma unroll
    for (int k = 0; k < 16; ++k) st.o[k] = (f32x4){0, 0, 0, 0};
    for (int b = 0; b < 3; ++b) {
        const int dil = (b == 0) ? 1 : ((b == 1) ? 4 : 16);
        for (int jj = -64; jj <= 64; ++jj) {
            const int j = i + dil * jj;
            if (j < 0 || j >= T) continue;
            const bf16* kp = H + (size_t)j * EVEN_IN + 3072 + h * 64;
            const float s = dot64(q, kp);
            sm_update(st, s, kp + 512);
        }
    }
    sm_store(st, Y + (size_t)i * D + 512 + h * 64);
}
__device__ __forceinline__ void phase_natten(const bf16* H, const float* rpb, bf16* Y, int bid, int tid) {
    for (int rep = 0; rep < 2; ++rep) {
        const int g = rep * (GRID * NTHR) + bid * NTHR + tid, h = g >> 14, i = g & 16383, r = i >> 6, c = i & 63;
        const int r0 = min(max(r - 4, 0), 248), c0 = min(max(c - 8, 0), 48);
        f32x4 q[16]; load_q64(H + (size_t)i * ODD_IN + h * 64, q);
        OnlineSm st; st.m = -1e30f; st.l = 0.f;
#pragma unroll
        for (int k = 0; k < 16; ++k) st.o[k] = (f32x4){0, 0, 0, 0};
        for (int ii = 0; ii < 8; ++ii)
            for (int jj = 0; jj < 16; ++jj) {
                const int kr = r0 + ii, kc = c0 + jj, j = kr * 64 + kc;
                const float bias = rpb[(h * 15 + (kr - r + 7)) * 31 + (kc - c + 15)];
                const bf16* kp = H + (size_t)j * ODD_IN + 1024 + h * 64;
                const float s = dot64(q, kp) + bias;
                sm_update(st, s, kp + 1024);
            }
        sm_store(st, Y + (size_t)i * D + h * 64);
    }
}

typedef short s16x4 __attribute__((ext_vector_type(4)));
__device__ __forceinline__ void tr_read8(unsigned a0, unsigned a1, unsigned a2, unsigned a3, s16x4 (&r)[8]) {
    asm volatile("ds_read_b64_tr_b16 %0, %8\n\tds_read_b64_tr_b16 %1, %8 offset:2048\n\tds_read_b64_tr_b16 %2, %9\n\tds_read_b64_tr_b16 %3, %9 offset:2048\n\t"
                 "ds_read_b64_tr_b16 %4, %10\n\tds_read_b64_tr_b16 %5, %10 offset:2048\n\tds_read_b64_tr_b16 %6, %11\n\tds_read_b64_tr_b16 %7, %11 offset:2048\n\ts_waitcnt lgkmcnt(0)"
                 : "=&v"(r[0]), "=&v"(r[1]), "=&v"(r[2]), "=&v"(r[3]), "=&v"(r[4]), "=&v"(r[5]), "=&v"(r[6]), "=&v"(r[7]) : "v"(a0), "v"(a1), "v"(a2), "v"(a3) : "memory");
}
struct LaneOffs { unsigned k0, k1, v[4]; };
__device__ __forceinline__ LaneOffs lane_offs(int lane) {
    const int i = lane & 15, g = lane >> 4, q = i >> 2, p = i & 3, vrow = 4 * g + q; LaneOffs o;
    o.k0 = (unsigned)(i * 128 + (((g) ^ (i & 7)) << 4)); o.k1 = (unsigned)(i * 128 + (((4 + g) ^ (i & 7)) << 4));
#pragma unroll
    for (int dt = 0; dt < 4; ++dt) o.v[dt] = (unsigned)(vrow * 128 + (((2 * dt + (p >> 1)) ^ (vrow & 7)) << 4) + 8 * (p & 1));
    return o;
}
__device__ __forceinline__ unsigned lds_addr(const LAS unsigned char* p) { return (unsigned)(size_t)p; }
__device__ __forceinline__ void qk_tile(const LAS unsigned char* Kt, const LaneOffs& lo, const bf16x8 q0, const bf16x8 q1, f32x4 (&sa)[2]) {
    const bf16x8 k00 = *(const LAS bf16x8*)(Kt + lo.k0), k01 = *(const LAS bf16x8*)(Kt + lo.k1), k10 = *(const LAS bf16x8*)(Kt + 2048 + lo.k0), k11 = *(const LAS bf16x8*)(Kt + 2048 + lo.k1);
    sa[0] = (f32x4){0.f, 0.f, 0.f, 0.f}; sa[1] = sa[0];
    sa[0] = __builtin_amdgcn_mfma_f32_16x16x32_bf16(k00, q0, sa[0], 0, 0, 0); sa[0] = __builtin_amdgcn_mfma_f32_16x16x32_bf16(k01, q1, sa[0], 0, 0, 0);
    sa[1] = __builtin_amdgcn_mfma_f32_16x16x32_bf16(k10, q0, sa[1], 0, 0, 0); sa[1] = __builtin_amdgcn_mfma_f32_16x16x32_bf16(k11, q1, sa[1], 0, 0, 0);
}
__device__ __forceinline__ void pv_tile(const LAS unsigned char* Vt, const LaneOffs& lo, const f32x4 p0, const f32x4 p1, f32x4 (&o)[4]) {
    const unsigned vb = lds_addr(Vt); s16x4 r[8];
    tr_read8(vb + lo.v[0], vb + lo.v[1], vb + lo.v[2], vb + lo.v[3], r);
    u32x4 pw;
    asm volatile("v_cvt_pk_bf16_f32 %0, %4, %5\n\tv_cvt_pk_bf16_f32 %1, %6, %7\n\tv_cvt_pk_bf16_f32 %2, %8, %9\n\tv_cvt_pk_bf16_f32 %3, %10, %11\n\ts_nop 1"
                 : "=&v"(pw.x), "=&v"(pw.y), "=&v"(pw.z), "=&v"(pw.w) : "v"(p0[0]), "v"(p0[1]), "v"(p0[2]), "v"(p0[3]), "v"(p1[0]), "v"(p1[1]), "v"(p1[2]), "v"(p1[3]));
    const bf16x8 pb = __builtin_bit_cast(bf16x8, pw);
#pragma unroll
    for (int dt = 0; dt < 4; ++dt) { const bf16x8 va = __builtin_shufflevector(r[2 * dt], r[2 * dt + 1], 0, 1, 2, 3, 4, 5, 6, 7); o[dt] = __builtin_amdgcn_mfma_f32_16x16x32_bf16(va, pb, o[dt], 0, 0, 0); }
}
struct SmState { float m, l; f32x4 o[4]; };
__device__ __forceinline__ void sm_init(SmState& st) { st.m = -1e30f; st.l = 0.f;
#pragma unroll
    for (int dt = 0; dt < 4; ++dt) st.o[dt] = (f32x4){0.f, 0.f, 0.f, 0.f}; }
__device__ __forceinline__ void sm_step(SmState& st, f32x4 (&sa)[2], const LAS unsigned char* Vt, const LaneOffs& lo) {
    float tm = fmaxf(fmaxf(fmaxf(sa[0][0], sa[0][1]), fmaxf(sa[0][2], sa[0][3])), fmaxf(fmaxf(sa[1][0], sa[1][1]), fmaxf(sa[1][2], sa[1][3])));
    tm = fmaxf(tm, __shfl_xor(tm, 16)); tm = fmaxf(tm, __shfl_xor(tm, 32));
    const float mn = fmaxf(st.m, tm), sc = exp2f(st.m - mn);
    float ps = 0.f;
#pragma unroll
    for (int a = 0; a < 2; ++a)
#pragma unroll
        for (int r = 0; r < 4; ++r) { sa[a][r] = exp2f(sa[a][r] - mn); ps += sa[a][r]; }
    st.l = st.l * sc + ps; st.m = mn;
#pragma unroll
    for (int dt = 0; dt < 4; ++dt) st.o[dt] = st.o[dt] * sc;
    pv_tile(Vt, lo, sa[0], sa[1], st.o);
}

constexpr int DIL_UNITS = 8 * 3 * 128;
__device__ __forceinline__ void dil_decode(int u, int& h, int& b, int& r, int& blk) { h = u / 384; const int rem = u - h * 384; b = rem >> 7; const int x = rem & 127; r = x >> (7 - 2 * b); blk = x & ((128 >> (2 * b)) - 1); }
__device__ __forceinline__ void dil_issue(const bf16* H, int u, int tid, u32x4 (&kr)[4], u32x4 (&vr)[4]) {
    int h, b, r, blk; dil_decode(u, h, b, r, blk); const int Lc = T >> (2 * b), base = 128 * blk - 64;
#pragma unroll
    for (int k = 0; k < 4; ++k) { const int id = tid + 512 * k, row = id >> 3, c = id & 7, ki = base + row; const bool ok = (ki >= 0) && (ki < Lc);
        const bf16* src = H + (size_t)(r + (ki << (2 * b))) * EVEN_IN + 3072 + h * 64 + c * 8;
        kr[k] = ok ? *(const u32x4*)src : (u32x4){0u, 0u, 0u, 0u}; vr[k] = ok ? *(const u32x4*)(src + 512) : (u32x4){0u, 0u, 0u, 0u}; }
}
__device__ __forceinline__ void dil_commit(LAS unsigned char* buf, int tid, const u32x4 (&kr)[4], const u32x4 (&vr)[4]) {
#pragma unroll
    for (int k = 0; k < 4; ++k) { const int id = tid + 512 * k, row = id >> 3, c = id & 7; const unsigned off = (unsigned)(row * 128 + ((c ^ (row & 7)) << 4));
        *(LAS u32x4*)(buf + off) = kr[k]; *(LAS u32x4*)(buf + 32768 + off) = vr[k]; }
}
__device__ __forceinline__ void phase_dilated_mfma(LAS unsigned char* lds, const bf16* H, bf16* OG, float* LSE, int bid, int tid) {
    const int wave = tid >> 6, lane = tid & 63, i16 = lane & 15, g = lane >> 4;
    const LaneOffs lo = lane_offs(lane);
    u32x4 kr[4], vr[4];
    __syncthreads();
    dil_issue(H, bid, tid, kr, vr); dil_commit(lds, tid, kr, vr);
    __syncthreads();
    int it = 0;
    for (int u = bid; u < DIL_UNITS; u += GRID, ++it) {
        LAS unsigned char* buf = lds + (it & 1) * 65536;
        const bool has_next = (u + GRID) < DIL_UNITS;
        if (has_next) dil_issue(H, u + GRID, tid, kr, vr);
        int h, b, r, blk; dil_decode(u, h, b, r, blk); const int Lc = T >> (2 * b), base = 128 * blk - 64;
        const int ql = 16 * wave + i16, tokq = r + ((128 * blk + ql) << (2 * b));
        const bf16* qp = H + (size_t)tokq * EVEN_IN + 2560 + h * 64 + 8 * g;
        const bf16x8 q0 = *(const bf16x8*)qp, q1 = *(const bf16x8*)(qp + 32);
        SmState st; sm_init(st);
        const int t0 = wave >> 1;
#pragma unroll 1
        for (int t = t0; t < t0 + 5; ++t) {
            f32x4 sa[2]; qk_tile(buf + t * 4096, lo, q0, q1, sa);
#pragma unroll
            for (int a = 0; a < 2; ++a)
#pragma unroll
                for (int rg = 0; rg < 4; ++rg) { const int kl = 32 * t + 16 * a + 4 * g + rg, ki = base + kl; const bool ok = (kl >= ql) && (kl <= ql + 128) && (ki >= 0) && (ki < Lc);
                    sa[a][rg] = ok ? sa[a][rg] * 1.4426950408889634f : -INFINITY; }
            sm_step(st, sa, buf + 32768 + t * 4096, lo);
        }
        float l = st.l; l += __shfl_xor(l, 16); l += __shfl_xor(l, 32);
        const float inv = 1.0f / l;
        bf16* op = OG + ((size_t)b * T + tokq) * 512 + h * 64 + 4 * g;
#pragma unroll
        for (int dt = 0; dt < 4; ++dt) { const f32x4 o = st.o[dt] * inv; u32x2 w; w.x = cvt_pk_bf16(o[0], o[1]); w.y = cvt_pk_bf16(o[2], o[3]); *(u32x2*)(op + 16 * dt) = w; }
        if (g == 0) LSE[((size_t)b * T + tokq) * 8 + h] = (st.m + log2f(l)) * 0.6931471805599453f;
        if (has_next) dil_commit(lds + ((it + 1) & 1) * 65536, tid, kr, vr);
        __syncthreads();
    }
}
__device__ __forceinline__ void phase_dil_merge(const bf16* OG, const float* LSE, bf16* Y, int bid, int tid) {
    for (int item = bid * NTHR + tid; item < T * 64; item += GRID * NTHR) {
        const int tok = item >> 6, h = (item >> 3) & 7, c = item & 7;
        const float l0 = LSE[((size_t)0 * T + tok) * 8 + h], l1 = LSE[((size_t)1 * T + tok) * 8 + h], l2 = LSE[((size_t)2 * T + tok) * 8 + h];
        const float mx = fmaxf(l0, fmaxf(l1, l2)); float w0 = __expf(l0 - mx), w1 = __expf(l1 - mx), w2 = __expf(l2 - mx); const float inv = 1.0f / (w0 + w1 + w2); w0 *= inv; w1 *= inv; w2 *= inv;
        float a[8], b[8], d[8];
        unpack8(*(const u32x4*)(OG + ((size_t)0 * T + tok) * 512 + h * 64 + c * 8), a); unpack8(*(const u32x4*)(OG + ((size_t)1 * T + tok) * 512 + h * 64 + c * 8), b); unpack8(*(const u32x4*)(OG + ((size_t)2 * T + tok) * 512 + h * 64 + c * 8), d);
        float y[8];
#pragma unroll
        for (int j = 0; j < 8; ++j) y[j] = w0 * a[j] + w1 * b[j] + w2 * d[j];
        u32x4 o; o.x = pk2(y[0], y[1]); o.y = pk2(y[2], y[3]); o.z = pk2(y[4], y[5]); o.w = pk2(y[6], y[7]);
        *(u32x4*)(Y + (size_t)tok * D + 512 + h * 64 + c * 8) = o;
    }
}

__device__ __forceinline__ void phase_natten_mfma(LAS unsigned char* lds, const bf16* H, const float* rpb, bf16* Y, int bid, int tid) {
    const int wave = tid >> 6, lane = tid & 63, i16 = lane & 15, g = lane >> 4, cb = wave & 3, half = wave >> 2;
    const LaneOffs lo = lane_offs(lane);
    LAS float* btab = (LAS float*)(lds + MISC_OFF + 4096);
    LAS float* mbuf = (LAS float*)lds;
    const int wc0 = (cb == 0) ? 0 : (cb == 1) ? 8 : (cb == 2) ? 24 : 32;
    const int c = 16 * cb + i16, cs = min(max(c - 8, 0), 48);
#pragma unroll 1
    for (int k = 0; k < 16; ++k) {
        const int u = bid * 16 + k, h = u >> 8, r = u & 255, r0 = min(max(r - 4, 0), 248);
        __syncthreads();
#pragma unroll
        for (int kk = 0; kk < 8; ++kk) { const int id = tid + 512 * kk, row = id >> 3, ch = id & 7; const unsigned off = (unsigned)(row * 128 + ((ch ^ (row & 7)) << 4));
            const bf16* src = H + (size_t)(r0 * 64 + row) * ODD_IN + 1024 + h * 64 + ch * 8;
            *(LAS u32x4*)(lds + off) = *(const u32x4*)src; *(LAS u32x4*)(lds + 65536 + off) = *(const u32x4*)(src + 1024); }
        if (tid < 465) btab[tid] = rpb[h * 465 + tid];
        __syncthreads();
        const int tokq = r * 64 + c;
        const bf16* qp = H + (size_t)tokq * ODD_IN + h * 64 + 8 * g;
        const bf16x8 q0 = *(const bf16x8*)qp, q1 = *(const bf16x8*)(qp + 32);
        SmState st; sm_init(st);
#pragma unroll 1
        for (int tt = 0; tt < 4; ++tt) {
            const int krl = 4 * half + tt; const unsigned tb = (unsigned)((krl * 64 + wc0) * 128);
            f32x4 sa[2]; qk_tile(lds + tb, lo, q0, q1, sa);
            const int brow = (r0 + krl - r + 7) * 31 - c + 15;
#pragma unroll
            for (int a = 0; a < 2; ++a)
#pragma unroll
                for (int rg = 0; rg < 4; ++rg) { const int col = wc0 + 16 * a + 4 * g + rg; const bool ok = (col >= cs) && (col < cs + 16);
                    const float bias = btab[ok ? (brow + col) : 0];
                    sa[a][rg] = ok ? (sa[a][rg] + bias) * 1.4426950408889634f : -INFINITY; }
            sm_step(st, sa, lds + 65536 + tb, lo);
        }
        float l = st.l; l += __shfl_xor(l, 16); l += __shfl_xor(l, 32);
        __syncthreads();
        if (half == 1) { LAS float* mb = mbuf + ((wave - 4) * 64 + lane) * 20; mb[0] = st.m; mb[1] = l;
#pragma unroll
            for (int dt = 0; dt < 4; ++dt) *(LAS f32x4*)(mb + 4 + 4 * dt) = st.o[dt]; }
        __syncthreads();
        if (half == 0) { const LAS float* mb = mbuf + (wave * 64 + lane) * 20; const float m2 = mb[0], l2 = mb[1];
            const float M = fmaxf(st.m, m2), a1 = exp2f(st.m - M), a2 = exp2f(m2 - M); const float inv = 1.0f / (l * a1 + l2 * a2);
            bf16* op = Y + (size_t)tokq * D + h * 64 + 4 * g;
#pragma unroll
            for (int dt = 0; dt < 4; ++dt) { const f32x4 o2 = *(const LAS f32x4*)(mb + 4 + 4 * dt); const f32x4 o = (st.o[dt] * a1 + o2 * a2) * inv;
                u32x2 w; w.x = cvt_pk_bf16(o[0], o[1]); w.y = cvt_pk_bf16(o[2], o[3]); *(u32x2*)(op + 16 * dt) = w; } }
    }
}

__device__ __forceinline__ void ret_issue(const bf16* H, int u, int tid, u32x4 (&kr)[2], u32x4 (&vr)[2]) {
    const int h = u >> 7, n = u & 127;
#pragma unroll
    for (int k = 0; k < 2; ++k) { const int id = tid + 512 * k, row = id >> 3, c = id & 7; const bf16* src = H + (size_t)(n * 128 + row) * EVEN_IN + 512 + h * 64 + c * 8;
        kr[k] = *(const u32x4*)src; vr[k] = *(const u32x4*)(src + 512); }
}
__device__ __forceinline__ void ret_commit(LAS unsigned char* buf, int tid, const u32x4 (&kr)[2], const u32x4 (&vr)[2]) {
#pragma unroll
    for (int k = 0; k < 2; ++k) { const int id = tid + 512 * k, row = id >> 3, c = id & 7; const unsigned off = (unsigned)(row * 128 + ((c ^ (row & 7)) << 4));
        *(LAS u32x4*)(buf + off) = kr[k]; *(LAS u32x4*)(buf + 16384 + off) = vr[k]; }
}
__device__ __forceinline__ void phase_ret_out_mfma(LAS unsigned char* lds, const bf16* H, const bf16* RT, const float* decay, bf16* Y, int bid, int tid) {
    const int wave = tid >> 6, lane = tid & 63, i16 = lane & 15, g = lane >> 4;
    const LaneOffs lo = lane_offs(lane);
    u32x4 kr[2], vr[2];
    __syncthreads();
    ret_issue(H, bid, tid, kr, vr); ret_commit(lds, tid, kr, vr);
    __syncthreads();
    int it = 0;
    for (int u = bid; u < 1024; u += GRID, ++it) {
        LAS unsigned char* buf = lds + (it & 1) * 32768;
        const bool has_next = (u + GRID) < 1024;
        if (has_next) ret_issue(H, u + GRID, tid, kr, vr);
        const int h = u >> 7, n = u & 127;
        const float lgf = log2_gamma(decay[h]), lgb = log2_gamma(decay[8 + h]);
        const int c = 16 * wave + i16, tok = n * 128 + c;
        const bf16* qp = H + (size_t)tok * EVEN_IN + h * 64 + 8 * g;
        const bf16x8 q0 = *(const bf16x8*)qp, q1 = *(const bf16x8*)(qp + 32);
        f32x4 of[4], ob[4];
#pragma unroll
        for (int dt = 0; dt < 4; ++dt) { of[dt] = (f32x4){0.f, 0.f, 0.f, 0.f}; ob[dt] = of[dt]; }
#pragma unroll 1
        for (int t = 0; t < 4; ++t) {
            f32x4 sa[2]; qk_tile(buf + t * 4096, lo, q0, q1, sa);
            f32x4 pf[2], pb[2];
#pragma unroll
            for (int a = 0; a < 2; ++a)
#pragma unroll
                for (int rg = 0; rg < 4; ++rg) { const int m = 32 * t + 16 * a + 4 * g + rg; const float df = (float)(c - m);
                    pf[a][rg] = (m <= c) ? sa[a][rg] * exp2f(lgf * df) : 0.0f; pb[a][rg] = (m > c) ? sa[a][rg] * exp2f(-lgb * df) : 0.0f; }
            if (32 * t <= 16 * wave + 15) pv_tile(buf + 16384 + t * 4096, lo, pf[0], pf[1], of);
            if (32 * t + 31 > 16 * wave) pv_tile(buf + 16384 + t * 4096, lo, pb[0], pb[1], ob);
        }
        const bf16* rtf = RT + ((size_t)(h) * 128 + n) * 4096 + i16 * 64 + 8 * g; const bf16* rtb = RT + ((size_t)(8 + h) * 128 + n) * 4096 + i16 * 64 + 8 * g;
        const float xif = exp2f(lgf * (float)(c + 1)), xib = exp2f(lgb * (float)(128 - c));
#pragma unroll
        for (int et = 0; et < 4; ++et) {
            f32x4 cf = {0.f, 0.f, 0.f, 0.f}, cb = cf;
            cf = __builtin_amdgcn_mfma_f32_16x16x32_bf16(*(const bf16x8*)(rtf + et * 1024), q0, cf, 0, 0, 0); cf = __builtin_amdgcn_mfma_f32_16x16x32_bf16(*(const bf16x8*)(rtf + et * 1024 + 32), q1, cf, 0, 0, 0);
            cb = __builtin_amdgcn_mfma_f32_16x16x32_bf16(*(const bf16x8*)(rtb + et * 1024), q0, cb, 0, 0, 0); cb = __builtin_amdgcn_mfma_f32_16x16x32_bf16(*(const bf16x8*)(rtb + et * 1024 + 32), q1, cb, 0, 0, 0);
            of[et] += cf * xif; ob[et] += cb * xib;
        }
        float sf = 0.f, sb = 0.f;
#pragma unroll
        for (int dt = 0; dt < 4; ++dt) { sf += (of[dt][0] + of[dt][1]) + (of[dt][2] + of[dt][3]); sb += (ob[dt][0] + ob[dt][1]) + (ob[dt][2] + ob[dt][3]); }
        sf += __shfl_xor(sf, 16); sf += __shfl_xor(sf, 32); sb += __shfl_xor(sb, 16); sb += __shfl_xor(sb, 32);
        const float muf = sf * (1.0f / 64.0f), mub = sb * (1.0f / 64.0f);
        float vfq = 0.f, vbq = 0.f;
#pragma unroll
        for (int dt = 0; dt < 4; ++dt) { of[dt] = of[dt] - muf; ob[dt] = ob[dt] - mub;
            vfq += (of[dt][0] * of[dt][0] + of[dt][1] * of[dt][1]) + (of[dt][2] * of[dt][2] + of[dt][3] * of[dt][3]);
            vbq += (ob[dt][0] * ob[dt][0] + ob[dt][1] * ob[dt][1]) + (ob[dt][2] * ob[dt][2] + ob[dt][3] * ob[dt][3]); }
        vfq += __shfl_xor(vfq, 16); vfq += __shfl_xor(vfq, 32); vbq += __shfl_xor(vbq, 16); vbq += __shfl_xor(vbq, 32);
        const float rsf = 1.0f / sqrtf(vfq * (1.0f / 64.0f) + GN_EPS), rsb = 1.0f / sqrtf(vbq * (1.0f / 64.0f) + GN_EPS);
        const bf16* gp = H + (size_t)tok * EVEN_IN + 1536 + h * 64 + 4 * g;
        bf16* yp = Y + (size_t)tok * D + h * 64 + 4 * g;
#pragma unroll
        for (int dt = 0; dt < 4; ++dt) {
            const u32x2 wf = *(const u32x2*)(gp + 16 * dt), wb = *(const u32x2*)(gp + 512 + 16 * dt);
            const f32x4 gf = {bflo(wf.x), bfhi(wf.x), bflo(wf.y), bfhi(wf.y)}, gb = {bflo(wb.x), bfhi(wb.x), bflo(wb.y), bfhi(wb.y)};
            f32x4 y;
#pragma unroll
            for (int j = 0; j < 4; ++j) y[j] = gf[j] * sigmoidf_(gf[j]) * (of[dt][j] * rsf) + gb[j] * sigmoidf_(gb[j]) * (ob[dt][j] * rsb);
            u32x2 w; w.x = cvt_pk_bf16(y[0], y[1]); w.y = cvt_pk_bf16(y[2], y[3]); *(u32x2*)(yp + 16 * dt) = w;
        }
        if (has_next) ret_commit(lds + ((it + 1) & 1) * 32768, tid, kr, vr);
        __syncthreads();
    }
}

__device__ __forceinline__ void phase_ln1_router(LAS unsigned char* lds, const float* U, const float* lng, const float* lnb, const float* rw, const float* rbias,
                                                 float* X1, bf16* X1b, int* tope, float* gate, int* lrank, int* cnt, int bid, int tid) {
    const int wave = tid >> 6, lane = tid & 63;
    LAS int* lcnt = (LAS int*)(lds + MISC_OFF + 1024);
    __syncthreads();
    for (int idx = tid; idx < 1024 * 8; idx += NTHR) { const int d = idx >> 3, c = idx & 7;
        *(LAS f32x4*)(lds + d * 128 + ((c ^ ((d >> 1) & 7)) << 4)) = *(const f32x4*)(rw + d * 32 + c * 4); }
    if (tid < 32) lcnt[tid] = 0;
    __syncthreads();
    float gg[16], bb[16];
#pragma unroll
    for (int i = 0; i < 16; ++i) { gg[i] = lng[64 * i + lane]; bb[i] = lnb[64 * i + lane]; }
    const float rbe = rbias[lane >> 1];
    for (int rr = 0; rr < 8; ++rr) {
        const int row = bid * 64 + wave * 8 + rr;
        float x[16]; float s = 0.f;
#pragma unroll
        for (int i = 0; i < 16; ++i) { x[i] = U[(size_t)row * D + 64 * i + lane]; s += x[i]; }
        const float mean = wave_sum(s) * (1.0f / D); float s2 = 0.f;
#pragma unroll
        for (int i = 0; i < 16; ++i) { x[i] -= mean; s2 += x[i] * x[i]; }
        const float rstd = 1.0f / sqrtf(wave_sum(s2) * (1.0f / D) + LN_EPS);
#pragma unroll
        for (int i = 0; i < 16; ++i) { x[i] = x[i] * rstd * gg[i] + bb[i]; X1[(size_t)row * D + 64 * i + lane] = x[i]; X1b[(size_t)row * D + 64 * i + lane] = (bf16)f2bf(x[i]); }
        float acc[32];
#pragma unroll
        for (int e = 0; e < 32; ++e) acc[e] = 0.f;
#pragma unroll
        for (int i = 0; i < 16; ++i) { const int d = 64 * i + lane;
#pragma unroll
            for (int c = 0; c < 8; ++c) { const f32x4 w = *(const LAS f32x4*)(lds + d * 128 + ((c ^ ((d >> 1) & 7)) << 4));
                acc[4 * c] += x[i] * w[0]; acc[4 * c + 1] += x[i] * w[1]; acc[4 * c + 2] += x[i] * w[2]; acc[4 * c + 3] += x[i] * w[3]; } }
#pragma unroll
        for (int t = 0; t < 16; ++t) { const bool up = (lane & 32) != 0; const float snd = up ? acc[t] : acc[t + 16]; const float rcv = __shfl_xor(snd, 32); acc[t] = (up ? acc[t + 16] : acc[t]) + rcv; }
#pragma unroll
        for (int t = 0; t < 8; ++t) { const bool up = (lane & 16) != 0; const float snd = up ? acc[t] : acc[t + 8]; const float rcv = __shfl_xor(snd, 16); acc[t] = (up ? acc[t + 8] : acc[t]) + rcv; }
#pragma unroll
        for (int t = 0; t < 4; ++t) { const bool up = (lane & 8) != 0; const float snd = up ? acc[t] : acc[t + 4]; const float rcv = __shfl_xor(snd, 8); acc[t] = (up ? acc[t + 4] : acc[t]) + rcv; }
#pragma unroll
        for (int t = 0; t < 2; ++t) { const bool up = (lane & 4) != 0; const float snd = up ? acc[t] : acc[t + 2]; const float rcv = __shfl_xor(snd, 4); acc[t] = (up ? acc[t + 2] : acc[t]) + rcv; }
        { const bool up = (lane & 2) != 0; const float snd = up ? acc[0] : acc[1]; const float rcv = __shfl_xor(snd, 2); acc[0] = (up ? acc[1] : acc[0]) + rcv; }
        float lv = acc[0] + __shfl_xor(acc[0], 1) + rbe;
        const int me = lane >> 1;
        float tv[4]; int ti[4];
#pragma unroll
        for (int k = 0; k < 4; ++k) {
            float bv = lv; int bi = me;
#pragma unroll
            for (int o = 32; o >= 1; o >>= 1) { const float ov = __shfl_xor(bv, o); const int oi = __shfl_xor(bi, o); if (ov > bv || (ov == bv && oi < bi)) { bv = ov; bi = oi; } }
            tv[k] = bv; ti[k] = bi; if (me == bi) lv = -INFINITY;
        }
        const float p1 = expf(tv[1] - tv[0]), p2 = expf(tv[2] - tv[0]), p3 = expf(tv[3] - tv[0]); const float inv = 1.0f / (1.0f + p1 + p2 + p3);
        if (lane < 4) {
            const int e = (lane == 0) ? ti[0] : (lane == 1) ? ti[1] : (lane == 2) ? ti[2] : ti[3];
            const float gk = ((lane == 0) ? 1.0f : (lane == 1) ? p1 : (lane == 2) ? p2 : p3) * inv;
            const int rk = __hip_atomic_fetch_add(lcnt + e, 1, __ATOMIC_RELAXED, __HIP_MEMORY_SCOPE_WORKGROUP);
            tope[row * 4 + lane] = e; gate[row * 4 + lane] = gk; lrank[row * 4 + lane] = rk;
        }
    }
    __syncthreads();
    if (tid < 32) cnt[bid * 32 + tid] = lcnt[tid];
}

__device__ __forceinline__ void phase_ln1_router_mfma(LAS unsigned char* lds, const float* U, const float* lng, const float* lnb, const bf16* rwt, const float* rbias,
                                                      float* X1, bf16* X1b, bf16* X1lo, int* tope, float* gate, int* lrank, int* cnt, int bid, int tid) {
    const int wave = tid >> 6, lane = tid & 63, i16 = lane & 15, g = lane >> 4;
    LAS int* lcnt = (LAS int*)(lds + MISC_OFF + 1024);
    LAS float* pbuf = (LAS float*)lds;
    __syncthreads();
    if (tid < 32) lcnt[tid] = 0;
    {   f32x4 gg[4], bb[4];
#pragma unroll
        for (int j = 0; j < 4; ++j) { gg[j] = *(const f32x4*)(lng + 256 * j + 4 * lane); bb[j] = *(const f32x4*)(lnb + 256 * j + 4 * lane); }
#pragma unroll 2
        for (int rr = 0; rr < 8; ++rr) {
            const size_t ro = (size_t)(bid * 64 + wave * 8 + rr) * D + 4 * lane;
            f32x4 v[4]; float s = 0.f;
#pragma unroll
            for (int j = 0; j < 4; ++j) { v[j] = *(const f32x4*)(U + ro + 256 * j); s += (v[j][0] + v[j][1]) + (v[j][2] + v[j][3]); }
            const float mean = wave_sum(s) * (1.0f / D); float s2 = 0.f;
#pragma unroll
            for (int j = 0; j < 4; ++j) { v[j] = v[j] - mean; s2 += (v[j][0] * v[j][0] + v[j][1] * v[j][1]) + (v[j][2] * v[j][2] + v[j][3] * v[j][3]); }
            const float rstd = 1.0f / sqrtf(wave_sum(s2) * (1.0f / D) + LN_EPS);
#pragma unroll
            for (int j = 0; j < 4; ++j) { const f32x4 o = v[j] * rstd * gg[j] + bb[j]; *(f32x4*)(X1 + ro + 256 * j) = o;
                const unsigned h0 = f2bf(o[0]), h1 = f2bf(o[1]), h2 = f2bf(o[2]), h3 = f2bf(o[3]);
                u32x2 wh; wh.x = h0 | (h1 << 16); wh.y = h2 | (h3 << 16); *(u32x2*)(X1b + ro + 256 * j) = wh;
                u32x2 wl; wl.x = pk2(o[0] - __builtin_bit_cast(float, h0 << 16), o[1] - __builtin_bit_cast(float, h1 << 16)); wl.y = pk2(o[2] - __builtin_bit_cast(float, h2 << 16), o[3] - __builtin_bit_cast(float, h3 << 16));
                *(u32x2*)(X1lo + ro + 256 * j) = wl; }
        }
    }
    asm volatile("s_waitcnt vmcnt(0)" ::: "memory");
    __syncthreads();
    const int rt = wave & 3, kh = wave >> 2;
    f32x4 acc[2]; acc[0] = (f32x4){0.f, 0.f, 0.f, 0.f}; acc[1] = acc[0];
    {   const size_t ao = (size_t)(bid * 64 + rt * 16 + i16) * D + kh * 512 + 8 * g;
        const bf16* bh = rwt + (size_t)i16 * D + kh * 512 + 8 * g; const bf16* bl = bh + (size_t)NEXP * D;
#pragma unroll 4
        for (int s = 0; s < 16; ++s) {
            const bf16x8 ah = *(const bf16x8*)(X1b + ao + 32 * s), al = *(const bf16x8*)(X1lo + ao + 32 * s);
#pragma unroll
            for (int et = 0; et < 2; ++et) { const bf16x8 wh = *(const bf16x8*)(bh + (size_t)et * 16 * D + 32 * s), wl = *(const bf16x8*)(bl + (size_t)et * 16 * D + 32 * s);
                acc[et] = __builtin_amdgcn_mfma_f32_16x16x32_bf16(ah, wh, acc[et], 0, 0, 0); acc[et] = __builtin_amdgcn_mfma_f32_16x16x32_bf16(ah, wl, acc[et], 0, 0, 0); acc[et] = __builtin_amdgcn_mfma_f32_16x16x32_bf16(al, wh, acc[et], 0, 0, 0); }
        }
    }
    if (kh == 1) { LAS f32x4* pb = (LAS f32x4*)(pbuf + ((wave - 4) * 64 + lane) * 8); pb[0] = acc[0]; pb[1] = acc[1]; }
    __syncthreads();
    if (kh == 0) {
        const LAS f32x4* pb = (const LAS f32x4*)(pbuf + (wave * 64 + lane) * 8);
        const float b0 = rbias[i16], b1 = rbias[16 + i16];
        const f32x4 l0 = acc[0] + pb[0] + b0, l1 = acc[1] + pb[1] + b1;
#pragma unroll
        for (int reg = 0; reg < 4; ++reg) {
            float v0 = l0[reg], v1 = l1[reg]; float tv[4]; int ti[4];
#pragma unroll
            for (int k = 0; k < 4; ++k) {
                float bv = (v0 >= v1) ? v0 : v1; int bi = (v0 >= v1) ? i16 : 16 + i16;
#pragma unroll
                for (int o = 1; o < 16; o <<= 1) { const float ov = __shfl_xor(bv, o); const int oi = __shfl_xor(bi, o); if (ov > bv || (ov == bv && oi < bi)) { bv = ov; bi = oi; } }
                tv[k] = bv; ti[k] = bi; if (bi == i16) v0 = -INFINITY; if (bi == 16 + i16) v1 = -INFINITY;
            }
            const float p1 = expf(tv[1] - tv[0]), p2 = expf(tv[2] - tv[0]), p3 = expf(tv[3] - tv[0]); const float inv = 1.0f / (1.0f + p1 + p2 + p3);
            if (i16 < 4) {
                const int row = bid * 64 + rt * 16 + 4 * g + reg;
                const int e = (i16 == 0) ? ti[0] : (i16 == 1) ? ti[1] : (i16 == 2) ? ti[2] : ti[3];
                const float gk = ((i16 == 0) ? 1.0f : (i16 == 1) ? p1 : (i16 == 2) ? p2 : p3) * inv;
                const int rk = __hip_atomic_fetch_add(lcnt + e, 1, __ATOMIC_RELAXED, __HIP_MEMORY_SCOPE_WORKGROUP);
                tope[row * 4 + i16] = e; gate[row * 4 + i16] = gk; lrank[row * 4 + i16] = rk;
            }
        }
    }
    __syncthreads();
    if (tid < 32) cnt[bid * 32 + tid] = lcnt[tid];
}

__device__ __forceinline__ void phase_dispatch(LAS unsigned char* lds, const int* cnt, const int* tope, const int* lrank, int* slot, int* tiles, int* rowidx, int bid, int tid) {
    LAS int* tot = (LAS int*)(lds + MISC_OFF + 1024); LAS int* pre = tot + 32; LAS int* pst = pre + 32;
    __syncthreads();
    if (tid < 32) { int t = 0, p = 0; for (int b2 = 0; b2 < GRID; ++b2) { const int v = cnt[b2 * 32 + tid]; t += v; p += (b2 < bid) ? v : 0; } tot[tid] = t; pre[tid] = p; }
    __syncthreads();
    if (tid == 0) { int ps = 0;
#pragma unroll 1
        for (int e = 0; e < NEXP; ++e) { pst[e] = ps; ps += ((tot[e] + 255) >> 8) << 8; }
        pst[NEXP] = ps; }
    __syncthreads();
    if (bid == 0 && tid < 1 + MAXTILES) {
        if (tid == 0) tiles[0] = pst[NEXP] >> 8;
        else { const int i = tid - 1; int ee = 0;
#pragma unroll 1
            for (int e = 0; e < NEXP; ++e) ee = ((pst[e] >> 8) <= i) ? e : ee;
            tiles[tid] = ee; }
    }
    if (bid < NEXP) { const int e = bid, lo = pst[e] + tot[e], hi = pst[e + 1]; for (int i = lo + tid; i < hi; i += NTHR) rowidx[i] = 0; }
    if (tid < 256) { const int row = bid * 64 + (tid >> 2), k = tid & 3; const int e = tope[row * 4 + k]; const int dest = pst[e] + pre[e] + lrank[row * 4 + k]; slot[row * 4 + k] = dest; rowidx[dest] = row; }
}

__device__ __forceinline__ void phase_combine_ln2(const float* X1, const bf16* Oslot, const int* slot, const float* gate, const float* lng, const float* lnb, float* Xout, bf16* Xb, int bid, int tid) {
    const int wave = tid >> 6, lane = tid & 63;
    f32x4 gg[4], bb[4];
#pragma unroll
    for (int j = 0; j < 4; ++j) { gg[j] = *(const f32x4*)(lng + 256 * j + 4 * lane); bb[j] = *(const f32x4*)(lnb + 256 * j + 4 * lane); }
    for (int rr = 0; rr < 8; ++rr) {
        const int row = bid * 64 + wave * 8 + rr;
        f32x4 v[4];
#pragma unroll
        for (int j = 0; j < 4; ++j) v[j] = *(const f32x4*)(X1 + (size_t)row * D + 256 * j + 4 * lane) * ALPHA;
#pragma unroll
        for (int k = 0; k < 4; ++k) { const int s = slot[row * 4 + k]; const float g = gate[row * 4 + k];
#pragma unroll
            for (int j = 0; j < 4; ++j) { const u32x2 w = *(const u32x2*)(Oslot + (size_t)s * D + 256 * j + 4 * lane); v[j] += (f32x4){bflo(w.x), bfhi(w.x), bflo(w.y), bfhi(w.y)} * g; } }
        float s = 0.f;
#pragma unroll
        for (int j = 0; j < 4; ++j) s += (v[j][0] + v[j][1]) + (v[j][2] + v[j][3]);
        const float mean = wave_sum(s) * (1.0f / D); float s2 = 0.f;
#pragma unroll
        for (int j = 0; j < 4; ++j) { v[j] = v[j] - mean; s2 += (v[j][0] * v[j][0] + v[j][1] * v[j][1]) + (v[j][2] * v[j][2] + v[j][3] * v[j][3]); }
        const float rstd = 1.0f / sqrtf(wave_sum(s2) * (1.0f / D) + LN_EPS);
#pragma unroll
        for (int j = 0; j < 4; ++j) { const f32x4 o = v[j] * rstd * gg[j] + bb[j]; *(f32x4*)(Xout + (size_t)row * D + 256 * j + 4 * lane) = o;
            if (Xb) { u32x2 w; w.x = pk2(o[0], o[1]); w.y = pk2(o[2], o[3]); *(u32x2*)(Xb + (size_t)row * D + 256 * j + 4 * lane) = w; } }
    }
}

constexpr int NPH = 10, N_PHASES = 1 + DEPTH * NPH;
struct Args { Ptrs p; int ph_lo, ph_hi; };
static_assert(sizeof(Args) == 17 * 8 + 8, "Args has no padding");
typedef __attribute__((address_space(4))) const Args CArgs;

__global__ void __launch_bounds__(NTHR, 2) fwd_kernel(Args args) {
    extern __shared__ __attribute__((aligned(16))) unsigned char lds_raw[];
    LAS unsigned char* lds0 = (LAS unsigned char*)lds_raw;
    const int tid0 = threadIdx.x, bid0 = blockIdx.x;
    const int lo = args.ph_lo, hi = args.ph_hi;
    volatile LAS unsigned* MISC = (volatile LAS unsigned*)(lds0 + MISC_OFF);
    if (tid0 < 64) MISC[tid0] = 0u;
    __syncthreads();
    XcdBarrier bar = xcd_barrier_post((unsigned*)(((CArgs*)__builtin_amdgcn_kernarg_segment_ptr())->p.ws + WS_CTL) + CW_BAR, MISC + 8);
#define IN(k) (lo <= (k) && (k) < hi)
#define SEAM(k) do { if (IN(k) && IN((k) + 1)) xcd_barrier(bar); } while (0)
#define SITE int tid = tid0, bid = bid0, L = L0; CArgs* ap = (CArgs*)__builtin_amdgcn_kernarg_segment_ptr(); asm volatile("" : "+v"(tid)); asm volatile("" : "+s"(bid)); asm volatile("" : "+s"(L)); asm volatile("" : "+s"(ap)); LAS unsigned char* lds = lds0; asm volatile("" : "+s"(lds)); \
    unsigned char* ws = ap->p.ws; const int jl = L >> 1; const bool odd = (L & 1) != 0; (void)jl; (void)odd; (void)tid; (void)bid; (void)ws;

    { const int L0 = 0; if (IN(0)) REP(10) { SITE; Ptrs P{}; P.x = ap->p.x; P.ab_w_in = ap->p.ab_w_in; P.ab_w_out = ap->p.ab_w_out; P.c_w_in = ap->p.c_w_in; P.c_w_out = ap->p.c_w_out; P.w_up = ap->p.w_up; P.w_down = ap->p.w_down; P.router_w = ap->p.router_w; P.ws = ws; phase_prologue(P, lds, bid, tid); } }
    SEAM(0);

    for (int L0 = 0; L0 < DEPTH; ++L0) {
        const int pb = 1 + L0 * NPH; const bool odd0 = (L0 & 1) != 0;
        if (IN(pb + 0)) REP(0) {
            if (!odd0) { SITE; pg8::DenseOrder S{T / 256, EVEN_IN / 256, GRID, bid, (const char*)(ws + WS_XB), (const char*)(ws + WS_WIN_E) + (size_t)jl * EVEN_IN * 1024 * 2, nullptr};
                pg8::EpiInEven E{(bf16*)(ws + WS_H), (const float*)(ws + WS_COS), (const float*)(ws + WS_SIN)}; pg8::gemm_phase<pg8::EpiInEven, pg8::DenseOrder>(lds, S, E, tid); }
            else { SITE; pg8::DenseOrder S{T / 256, ODD_IN / 256, GRID, bid, (const char*)(ws + WS_XB), (const char*)(ws + WS_WIN_O) + (size_t)jl * ODD_IN * 1024 * 2, nullptr};
                pg8::EpiInOdd E{(bf16*)(ws + WS_H)}; pg8::gemm_phase<pg8::EpiInOdd, pg8::DenseOrder>(lds, S, E, tid); }
        }
        SEAM(pb + 0);
        if (IN(pb + 1)) REP(1) {
            if (!odd0) { { SITE; phase_ret_states(lds, (const bf16*)(ws + WS_H), ap->p.ret_decay + jl * 16, (float*)(ws + WS_RS), bid, tid); }
                         { SITE; phase_dilated_mfma(lds, (const bf16*)(ws + WS_H), (bf16*)(ws + WS_ACT), (float*)(ws + WS_OSLOT), bid, tid); } }
            else { SITE; phase_natten_mfma(lds, (const bf16*)(ws + WS_H), ap->p.c_rpb + (size_t)jl * 16 * 15 * 31, (bf16*)(ws + WS_Y), bid, tid); }
        }
        SEAM(pb + 1);
        if (!odd0) {
            if (IN(pb + 2)) REP(2) { { SITE; phase_ret_scan((const float*)(ws + WS_RS), (bf16*)(ws + WS_RR), ap->p.ret_decay + jl * 16, bid, tid); }
                              { SITE; phase_dil_merge((const bf16*)(ws + WS_ACT), (const float*)(ws + WS_OSLOT), (bf16*)(ws + WS_Y), bid, tid); } }
            SEAM(pb + 2);
            if (IN(pb + 3)) REP(3) { SITE; phase_ret_out_mfma(lds, (const bf16*)(ws + WS_H), (const bf16*)(ws + WS_RR), ap->p.ret_decay + jl * 16, (bf16*)(ws + WS_Y), bid, tid); }
            SEAM(pb + 3);
        }
        if (IN(pb + 4)) REP(4) { SITE;
            pg8::DenseOrder S{T / 256, D / 256, GRID, bid, (const char*)(ws + WS_Y), (const char*)(ws + (odd ? WS_WOUT_O : WS_WOUT_E)) + (size_t)jl * 1024 * 1024 * 2, nullptr};
            pg8::EpiOut E{(L == 0) ? ap->p.x : (const float*)(ws + WS_X), (float*)(ws + WS_U)}; pg8::gemm_phase<pg8::EpiOut, pg8::DenseOrder>(lds, S, E, tid);
        }
        SEAM(pb + 4);
        if (IN(pb + 5)) REP(5) { SITE; phase_ln1_router_mfma(lds, (const float*)(ws + WS_U), ap->p.ln_g + (size_t)(L * 2) * D, ap->p.ln_b + (size_t)(L * 2) * D, (const bf16*)(ws + WS_RWT) + (size_t)L * 2 * NEXP * D, ap->p.router_b + L * NEXP,
                                         (float*)(ws + WS_X1), (bf16*)(ws + WS_X1B), (bf16*)(ws + WS_X1LO), (int*)(ws + WS_TOPE), (float*)(ws + WS_GATE), (int*)(ws + WS_LRANK), (int*)(ws + WS_CNT), bid, tid); }
        SEAM(pb + 5);
        if (IN(pb + 6)) REP(6) { SITE; phase_dispatch(lds, (const int*)(ws + WS_CNT), (const int*)(ws + WS_TOPE), (const int*)(ws + WS_LRANK), (int*)(ws + WS_SLOT), (int*)(ws + WS_TILES), (int*)(ws + WS_ROWIDX), bid, tid); }
        SEAM(pb + 6);
        if (IN(pb + 7)) REP(7) { SITE;
            LAS int* ltile = (LAS int*)(lds + MISC_OFF + 2048); const int* tiles = (const int*)(ws + WS_TILES);
            __syncthreads();
            for (int i = tid; i < 1 + MAXTILES; i += NTHR) ltile[i] = tiles[i];
            __syncthreads();
            pg8::GroupOrder S{(int)ltile[0], 2048 / 256, GRID, bid, (const char*)(ws + WS_X1B), (const char*)(ws + WS_WUP) + (size_t)L * 32 * 2048 * 1024 * 2, (size_t)2048 * 1024 * 2, ltile + 1, (const int*)(ws + WS_ROWIDX)};
            pg8::EpiUp E{(bf16*)(ws + WS_ACT), ap->p.b_up + (size_t)L * 32 * 2048}; pg8::gemm_phase<pg8::EpiUp, pg8::GroupOrder, true>(lds, S, E, tid);
        }
        SEAM(pb + 7);
        if (IN(pb + 8)) REP(8) { SITE;
            LAS int* ltile = (LAS int*)(lds + MISC_OFF + 2048); const int* tiles = (const int*)(ws + WS_TILES);
            __syncthreads();
            for (int i = tid; i < 1 + MAXTILES; i += NTHR) ltile[i] = tiles[i];
            __syncthreads();
            pg8::GroupOrder S{(int)ltile[0], 1024 / 256, GRID, bid, (const char*)(ws + WS_ACT), (const char*)(ws + WS_WDN) + (size_t)L * 32 * 1024 * 1024 * 2, (size_t)1024 * 1024 * 2, ltile + 1, nullptr};
            pg8::EpiDown E{(bf16*)(ws + WS_OSLOT), ap->p.b_down + (size_t)L * 32 * 1024}; pg8::gemm_phase<pg8::EpiDown, pg8::GroupOrder>(lds, S, E, tid);
        }
        SEAM(pb + 8);
        if (IN(pb + 9)) REP(9) { SITE; phase_combine_ln2((const float*)(ws + WS_X1), (const bf16*)(ws + WS_OSLOT), (const int*)(ws + WS_SLOT), (const float*)(ws + WS_GATE), ap->p.ln_g + (size_t)(L * 2 + 1) * D, ap->p.ln_b + (size_t)(L * 2 + 1) * D,
                                          (L == DEPTH - 1) ? ap->p.out : (float*)(ws + WS_X), (L == DEPTH - 1) ? (bf16*)nullptr : (bf16*)(ws + WS_XB), bid, tid); }
        SEAM(pb + 9);
    }
#undef IN
#undef SEAM
#undef SITE
}

extern "C" void kernel_launch(void* const* d_in, const int* in_sizes, int n_in, void* d_out, int out_size, void* d_ws, size_t ws_size, hipStream_t stream) {
    static int ready = 0;
    if (ready == 0) {
        if (n_in != 15 || in_sizes[0] != T * D || out_size != T * D || ws_size < WS_END) {
            fprintf(stderr, "kernel_launch: unexpected problem (n_in %d, in0 %d, out %d, ws %zu); nothing launched\n", n_in, n_in > 0 ? in_sizes[0] : -1, out_size, ws_size); ready = -1; return; }
        if (hipFuncSetAttribute((const void*)fwd_kernel, hipFuncAttributeMaxDynamicSharedMemorySize, LDS_BYTES) != hipSuccess) { fprintf(stderr, "kernel_launch: hipFuncSetAttribute failed\n"); ready = -1; return; }
        int per_cu = 0;
        if (hipOccupancyMaxActiveBlocksPerMultiprocessor(&per_cu, (const void*)fwd_kernel, NTHR, LDS_BYTES) != hipSuccess || per_cu < 1) fprintf(stderr, "kernel_launch: occupancy query reports %d workgroups per CU\n", per_cu);
        (void)hipGetLastError();
        ready = 1;
    }
    if (ready < 0) return;
    (void)hipMemsetAsync((char*)d_ws + WS_CTL, 0, CTL_ZERO_BYTES, stream);
    Args a{};
    a.p.x = (const float*)d_in[0]; a.p.ab_w_in = (const float*)d_in[1]; a.p.ab_w_out = (const float*)d_in[2]; a.p.ret_decay = (const float*)d_in[3];
    a.p.c_w_in = (const float*)d_in[4]; a.p.c_w_out = (const float*)d_in[5]; a.p.c_rpb = (const float*)d_in[6]; a.p.ln_g = (const float*)d_in[7]; a.p.ln_b = (const float*)d_in[8];
    a.p.router_w = (const float*)d_in[9]; a.p.router_b = (const float*)d_in[10]; a.p.w_up = (const float*)d_in[11]; a.p.b_up = (const float*)d_in[12]; a.p.w_down = (const float*)d_in[13]; a.p.b_down = (const float*)d_in[14];
    a.p.out = (float*)d_out; a.p.ws = (unsigned char*)d_ws;
#if N_LAUNCH_MODE == 0
    a.ph_lo = 0; a.ph_hi = N_PHASES;
    hipLaunchKernelGGL(fwd_kernel, dim3(GRID), dim3(NTHR), LDS_BYTES, stream, a);
#else
    for (int ph = 0; ph < N_PHASES; ++ph) {
        if (ph >= 1) { const int L = (ph - 1) / NPH, p = (ph - 1) % NPH; if ((L & 1) && (p == 2 || p == 3)) continue; }
        a.ph_lo = ph; a.ph_hi = ph + 1;
        hipLaunchKernelGGL(fwd_kernel, dim3(GRID), dim3(NTHR), LDS_BYTES, stream, a);
    }
#endif
}
```

```cpp
#include <hip/hip_runtime.h>
#include <cstdio>
#include <cstdint>

#ifndef PROBE_MASK
#define PROBE_MASK 0
#endif
#define REP(id) for (int _r = 0; _r < 1 + ((PROBE_MASK >> (id)) & 1); ++_r)
#ifndef N_LAUNCH_MODE
#define N_LAUNCH_MODE 0
#endif

#define GAS __attribute__((address_space(1)))
#define LAS __attribute__((address_space(3)))
typedef unsigned short bf16;
typedef short bf16x8 __attribute__((ext_vector_type(8)));
typedef float f32x4 __attribute__((ext_vector_type(4)));
typedef float f32x2 __attribute__((ext_vector_type(2)));
typedef unsigned u32x4 __attribute__((ext_vector_type(4)));
typedef unsigned u32x2 __attribute__((ext_vector_type(2)));

constexpr int T = 16384, D = 1024, DEPTH = 4, HD = 64, NEXP = 32, TOPK = 4;
constexpr int EVEN_IN = 4096, ODD_IN = 3072;
constexpr int NPAD = T * TOPK + NEXP * 256;
constexpr int MAXTILES = NPAD / 256;
constexpr float LN_EPS = 1e-5f, GN_EPS = 1e-6f;
constexpr float ALPHA = 1.681792830507429f;
constexpr int NWAVES = 8, NTHR = 512, GRID = 256;

constexpr size_t MiB = 1u << 20;
constexpr size_t WS_CTL = 0, CTL_ZERO_BYTES = 1 * MiB;
constexpr size_t WS_COS = 1 * MiB, WS_SIN = 3 * MiB;
constexpr size_t WS_CNT = 5 * MiB;
constexpr size_t WS_TOPE = 6 * MiB, WS_GATE = 7 * MiB, WS_LRANK = 8 * MiB, WS_SLOT = 9 * MiB;
constexpr size_t WS_TILES = 10 * MiB;
constexpr size_t WS_ROWIDX = 10 * MiB + 65536;
constexpr size_t WS_RWT = 11 * MiB;
constexpr size_t WS_X1LO = 1744 * MiB;
constexpr size_t WS_WIN_E = 16 * MiB, WS_WOUT_E = 32 * MiB, WS_WIN_O = 36 * MiB, WS_WOUT_O = 48 * MiB;
constexpr size_t WS_WUP = 64 * MiB, WS_WDN = 576 * MiB;
constexpr size_t WS_X = 832 * MiB, WS_XB = 896 * MiB, WS_H = 928 * MiB, WS_Y = 1056 * MiB, WS_U = 1088 * MiB;
constexpr size_t WS_X1 = 1152 * MiB, WS_X1B = 1216 * MiB, WS_XPERM = 1248 * MiB, WS_ACT = 1392 * MiB, WS_OSLOT = 1536 * MiB;
constexpr size_t WS_RS = 1680 * MiB, WS_RR = 1712 * MiB, WS_END = 1776 * MiB;
static_assert((size_t)NPAD * 1024 * 2 <= 144 * MiB, "slot buffers");
constexpr int CW_TMO = 0;
constexpr int CW_MCNT = 16384;
constexpr int CW_BAR = 4096;

constexpr int RING_BYTES = 131072, MISC_OFF = 147456, LDS_BYTES = 163840;

__device__ __forceinline__ unsigned f2bf(float f) { unsigned u = __builtin_bit_cast(unsigned, f); return (u + 0x7fffu + ((u >> 16) & 1u)) >> 16; }
__device__ __forceinline__ unsigned pk2(float lo, float hi) { return f2bf(lo) | (f2bf(hi) << 16); }
__device__ __forceinline__ float bflo(unsigned w) { return __builtin_bit_cast(float, w << 16); }
__device__ __forceinline__ float bfhi(unsigned w) { return __builtin_bit_cast(float, w & 0xffff0000u); }
__device__ __forceinline__ unsigned cvt_pk_bf16(float lo, float hi) { unsigned r; asm volatile("v_cvt_pk_bf16_f32 %0, %1, %2" : "=v"(r) : "v"(lo), "v"(hi)); return r; }
__device__ __forceinline__ int lane_id_nohoist() { int l; asm volatile("v_mbcnt_lo_u32_b32 %0, -1, 0\n\tv_mbcnt_hi_u32_b32 %0, -1, %0" : "=v"(l)); return l; }
__device__ __forceinline__ int shx(int v, int m) { return __builtin_amdgcn_ds_bpermute((lane_id_nohoist() ^ m) << 2, v); }
__device__ __forceinline__ float shx(float v, int m) { return __builtin_bit_cast(float, __builtin_amdgcn_ds_bpermute((lane_id_nohoist() ^ m) << 2, __builtin_bit_cast(int, v))); }
__device__ __forceinline__ float wave_sum(float v) {
#pragma unroll
    for (int o = 1; o < 64; o <<= 1) v += shx(v, o);
    return v;
}
__device__ __forceinline__ void unpack8(const u32x4 w, float* f) {
    f[0] = bflo(w.x); f[1] = bfhi(w.x); f[2] = bflo(w.y); f[3] = bfhi(w.y); f[4] = bflo(w.z); f[5] = bfhi(w.z); f[6] = bflo(w.w); f[7] = bfhi(w.w);
}
__device__ __forceinline__ float log2_gamma(float logit) { return -log1pf(expf(-logit)) * 1.4426950408889634f; }
__device__ __forceinline__ float sigmoidf_(float z) { return 1.0f / (1.0f + __expf(-z)); }

#define XB_TMO      128
#define XB_XCNT(j)  (256  + 64 * (j))
#define XB_XSUB(j)  (1280 + 64 * (j))
#define XB_XGEN(j)  (2304 + 64 * (j))
#define XB_TOP      3328
#define XB_TOPGEN   3392
#define XCD_BAR_WORDS 3456
#define XB_SPIN_CAP (1u << 18)

__device__ __forceinline__ unsigned xb_ld(unsigned* p)              { return __hip_atomic_load(p, __ATOMIC_RELAXED, __HIP_MEMORY_SCOPE_AGENT); }
__device__ __forceinline__ unsigned xb_add(unsigned* p, unsigned v) { return __hip_atomic_fetch_add(p, v, __ATOMIC_RELAXED, __HIP_MEMORY_SCOPE_AGENT); }
__device__ __forceinline__ unsigned xb_xcc_id() { return (unsigned)__builtin_amdgcn_s_getreg((3 << 11) | 20) & 0xFu; }
#define XB_SPIN(cond, bar) do { unsigned _sp = 0; while (cond) { __builtin_amdgcn_s_sleep(1); \
    if ((++_sp & 255u) == 0u) { if (xb_ld(&(bar)[XB_TMO])) break; if (_sp > XB_SPIN_CAP) { atomicAdd(&(bar)[XB_TMO], 1u); break; } } } } while (0)

struct XcdBarrier { unsigned* bar; unsigned x; volatile LAS unsigned* st; };

__device__ __forceinline__ XcdBarrier xcd_barrier_post(unsigned* bar, volatile LAS unsigned* st) {
    XcdBarrier b; b.bar = bar; b.x = xb_xcc_id(); b.st = st;
    if (threadIdx.x == 0) (void)xb_add(&bar[XB_XCNT(b.x)], 1u);
    return b;
}
__device__ __forceinline__ void xcd_barrier_complete(unsigned* bar, unsigned x, unsigned& nloc, unsigned& nx) {
    const unsigned G = gridDim.x * gridDim.y * gridDim.z;
    unsigned sum, cnt, mine, sp = 0u;
    for (;;) {
        sum = 0u; cnt = 0u; mine = 0u;
#pragma unroll
        for (unsigned j = 0; j < 16; ++j) { const unsigned c = xb_ld(&bar[XB_XCNT(j)]); sum += c; cnt += (c > 0u) ? 1u : 0u; mine = (j == x) ? c : mine; }
        if (sum == G) break;
        __builtin_amdgcn_s_sleep(1);
        if ((++sp & 255u) == 0u) { if (xb_ld(&bar[XB_TMO])) break; if (sp > XB_SPIN_CAP) { atomicAdd(&bar[XB_TMO], 1u); break; } }
    }
    nloc = mine > 0u ? mine : 1u; nx = cnt > 0u ? cnt : 1u;
}
__device__ __forceinline__ void xcd_barrier(const XcdBarrier& b0, const bool leader) {
    XcdBarrier b = b0; asm volatile("" : "+s"(b.bar)); asm volatile("" : "+s"(b.x));
    asm volatile("s_waitcnt vmcnt(0)" ::: "memory");
    __syncthreads();
    if (leader) {
        unsigned* bar = b.bar;
        __builtin_amdgcn_s_waitcnt(0);
        unsigned nloc = b.st[0], nx = b.st[1];
        if (nloc == 0u) { xcd_barrier_complete(bar, b.x, nloc, nx); b.st[0] = nloc; b.st[1] = nx; }
        const unsigned old = xb_add(&bar[XB_XSUB(b.x)], 1u);
        const unsigned gen = old / nloc;
        if (old + 1u == (gen + 1u) * nloc) {
            __builtin_amdgcn_fence(__ATOMIC_RELEASE, "agent");
            asm volatile("s_waitcnt vmcnt(0)" ::: "memory");
            const unsigned og = xb_add(&bar[XB_TOP], 1u);
            const unsigned tg = og / nx;
            if (og + 1u == (tg + 1u) * nx) xb_add(&bar[XB_TOPGEN], 1u);
            else XB_SPIN(xb_ld(&bar[XB_TOPGEN]) == tg, bar);
            __builtin_amdgcn_fence(__ATOMIC_ACQUIRE, "agent");
            xb_add(&bar[XB_XGEN(b.x)], 1u);
            asm volatile("s_waitcnt vmcnt(0)" ::: "memory");
        } else {
            XB_SPIN(xb_ld(&bar[XB_XGEN(b.x)]) == gen, bar);
            __builtin_amdgcn_fence(__ATOMIC_ACQUIRE, "agent");
            asm volatile("s_waitcnt vmcnt(0)" ::: "memory");
        }
    }
    __syncthreads();
}

namespace pg8 {
constexpr int BM = 256, BK = 64, HALF = 128, HTB = HALF * BK * 2, STAGE_BYTES = 8 * HTB, NXCD = 8, WGM = 8, KD = 1024;
constexpr size_t TILE_BYTES = (size_t)BM * KD * 2;

__host__ __device__ __forceinline__ int lds_byte(int r, int c) { const int st = (r >> 4) * 2 + (c >> 5), rr = r & 15, cc = c & 31, ob = rr * 64 + cc * 2; return st * 1024 + (ob ^ (((ob >> 9) & 1) << 5)); }
__host__ __device__ __forceinline__ void stage_rc(int b, int& R, int& C) { const int st = b / 1024, sb = b % 1024, swz = sb ^ (((sb >> 9) & 1) << 5); R = (st >> 1) * 16 + swz / 64; C = (st & 1) * 32 + (swz % 64) / 2; }
__host__ __device__ __forceinline__ int perm32(int rho) { const int n = rho >> 4, i = rho & 15; return 8 * (i >> 2) + 4 * n + (i & 3); }

struct Unit { int pm, pn, e; };

template <int nN> __device__ __forceinline__ bool order_next(int i, int c, int nM, int& pm, int& pn) {
    constexpr int G = GRID;
    const int nwg = nM * nN; const long L = (long)i * G + c; if (L >= nwg) return false;
    int wgid = (int)L; { const int q = nwg / NXCD, r = nwg % NXCD, xcd = wgid % NXCD, off = wgid / NXCD; wgid = (xcd < r ? xcd * (q + 1) : r * (q + 1) + (xcd - r) * q) + off; }
    const int nig = WGM * nN, gid = wgid / nig, fm = gid * WGM, gsz = (nM - fm) < WGM ? (nM - fm) : WGM;
    pm = fm + ((wgid % nig) % gsz); pn = (wgid % nig) / gsz; return true;
}
template <int NM, int NN> struct DenseOrder {
    int c; const char* A; const char* B; const int* rowidx;
    __device__ __forceinline__ bool next(int i, Unit& u) const { u.e = 0; return order_next<NN>(i, c, NM, u.pm, u.pn); }
    __device__ __forceinline__ const char* a_base(const Unit& u) const { return A + (size_t)u.pm * TILE_BYTES; }
    __device__ __forceinline__ const char* b_base(const Unit& u) const { return B + (size_t)u.pn * TILE_BYTES; }
    __device__ __forceinline__ void a_ready(const Unit&, int, int) const {}
    __device__ __forceinline__ void done(int, int) const {}
};
template <int NN, int MODE> struct GroupOrder {
    static constexpr int mode = MODE; static constexpr size_t bstride = (size_t)NN * 256 * 1024 * 2;
    int nM, c; const char* A; const char* B; const LAS int* tile_e; const int* rowidx;
    unsigned* ctl; int moff; unsigned premask;
    __device__ __forceinline__ bool next(int i, Unit& u) const { if (!order_next<NN>(i, c, nM, u.pm, u.pn)) return false; u.e = tile_e[u.pm]; return true; }
    __device__ __forceinline__ const char* a_base(const Unit& u) const { return A + (size_t)u.pm * TILE_BYTES; }
    __device__ __forceinline__ const char* b_base(const Unit& u) const { return B + (size_t)u.e * bstride + (size_t)u.pn * TILE_BYTES; }
    __device__ __forceinline__ void a_ready(const Unit& u, int idx, int tid) const {
        if (mode != 2) return;
        if (tid < 64 && !((premask >> idx) & 1u)) {
            unsigned* dep = ctl + moff; unsigned* tmo = ctl; const unsigned need = 64u;
            const unsigned long long t0 = __builtin_amdgcn_s_memrealtime(); unsigned polls = 0;
            while ((unsigned)__builtin_amdgcn_readfirstlane(__hip_atomic_load(dep + 64 * u.pm, __ATOMIC_RELAXED, __HIP_MEMORY_SCOPE_AGENT)) < need) {
                if ((++polls & 255u) == 0u && __builtin_amdgcn_readfirstlane(__hip_atomic_load(tmo, __ATOMIC_RELAXED, __HIP_MEMORY_SCOPE_AGENT)) != 0u) break;
                if (__builtin_amdgcn_s_memrealtime() - t0 > 2000000ull) { if (tid == 0) __hip_atomic_store(tmo, 1u, __ATOMIC_RELAXED, __HIP_MEMORY_SCOPE_AGENT); break; }
                __builtin_amdgcn_s_sleep(2); }
            __builtin_amdgcn_fence(__ATOMIC_ACQUIRE, "agent");
            asm volatile("s_waitcnt vmcnt(0)" ::: "memory");
        }
        asm volatile("" ::: "memory"); __builtin_amdgcn_s_barrier(); asm volatile("" ::: "memory");
    }
    __device__ __forceinline__ void done(int pm, int lane) const { if (mode == 1 && lane == 0) __hip_atomic_fetch_add(ctl + moff + 64 * pm, 1u, __ATOMIC_RELAXED, __HIP_MEMORY_SCOPE_AGENT); }
};

__device__ __forceinline__ void store8(bf16* p, const f32x4 v0, const f32x4 v1) {
    u32x4 w; w.x = cvt_pk_bf16(v0[0], v0[1]); w.y = cvt_pk_bf16(v0[2], v0[3]); w.z = cvt_pk_bf16(v1[0], v1[1]); w.w = cvt_pk_bf16(v1[2], v1[3]); *(u32x4*)p = w;
}
struct EpiInEven {
    static constexpr bool PERM = true, AFTER_DRAIN = false;
    bf16* H; const float* cs; const float* sn;
    __device__ __forceinline__ void operator()(const f32x4 (&acc)[2][2][4][2], const Unit& u, int wr, int wc, int fr, int fq) const {
        const int pn = u.pn; const bool rope = (pn < 4) || (pn >= 10 && pn < 14);
        const float sc = ((pn >= 2 && pn < 4) || (pn >= 10 && pn < 12)) ? 0.125f : 1.0f;
        const int row0 = u.pm * BM + wr * 64 + fr;
        if (rope) {
#pragma unroll
            for (int ai = 0; ai < 2; ++ai)
#pragma unroll
                for (int m = 0; m < 4; ++m) {
                    const int row = row0 + ai * HALF + m * 16;
                    const float* cr = cs + (size_t)row * 32 + 8 * fq; const float* sr = sn + (size_t)row * 32 + 8 * fq;
                    const f32x4 c0 = *(const f32x4*)cr, c1 = *(const f32x4*)(cr + 4), s0 = *(const f32x4*)sr, s1 = *(const f32x4*)(sr + 4);
                    const f32x4 x1a = acc[ai][0][m][0], x1b = acc[ai][0][m][1], x2a = acc[ai][1][m][0], x2b = acc[ai][1][m][1];
                    const f32x4 o1a = (x1a * c0 - x2a * s0) * sc, o1b = (x1b * c1 - x2b * s1) * sc, o2a = (x2a * c0 + x1a * s0) * sc, o2b = (x2b * c1 + x1b * s1) * sc;
                    bf16* rowp = H + (size_t)row * EVEN_IN + pn * BM + wc * 64 + 8 * fq;
                    store8(rowp, o1a, o1b); store8(rowp + 32, o2a, o2b);
                }
        } else {
#pragma unroll
            for (int ai = 0; ai < 2; ++ai)
#pragma unroll
                for (int m = 0; m < 4; ++m) {
                    bf16* rowp = H + (size_t)(row0 + ai * HALF + m * 16) * EVEN_IN + pn * BM + wc * 32 + 8 * fq;
#pragma unroll
                    for (int bj = 0; bj < 2; ++bj) store8(rowp + bj * HALF, acc[ai][bj][m][0], acc[ai][bj][m][1]);
                }
        }
    }
};
struct EpiInOdd {
    static constexpr bool PERM = true, AFTER_DRAIN = false;
    bf16* H;
    __device__ __forceinline__ void operator()(const f32x4 (&acc)[2][2][4][2], const Unit& u, int wr, int wc, int fr, int fq) const {
        const float sc = (u.pn < 4) ? 0.125f : 1.0f;
        const int row0 = u.pm * BM + wr * 64 + fr;
#pragma unroll
        for (int ai = 0; ai < 2; ++ai)
#pragma unroll
            for (int m = 0; m < 4; ++m) {
                bf16* rowp = H + (size_t)(row0 + ai * HALF + m * 16) * ODD_IN + u.pn * BM + wc * 32 + 8 * fq;
#pragma unroll
                for (int bj = 0; bj < 2; ++bj) store8(rowp + bj * HALF, acc[ai][bj][m][0] * sc, acc[ai][bj][m][1] * sc);
            }
    }
};
struct EpiOut {
    static constexpr bool PERM = false, AFTER_DRAIN = false;
    const float* Xres; float* U;
    __device__ __forceinline__ void operator()(const f32x4 (&acc)[2][2][4][2], const Unit& u, int wr, int wc, int fr, int fq) const {
        const int row0 = u.pm * BM + wr * 64 + fr, col0 = u.pn * BM + wc * 32 + 4 * fq;
#pragma unroll
        for (int ai = 0; ai < 2; ++ai)
#pragma unroll
            for (int m = 0; m < 4; ++m) {
                const size_t off = (size_t)(row0 + ai * HALF + m * 16) * D + col0;
#pragma unroll
                for (int bj = 0; bj < 2; ++bj)
#pragma unroll
                    for (int n = 0; n < 2; ++n) { const f32x4 xr = *(const f32x4*)(Xres + off + bj * HALF + n * 16); *(f32x4*)(U + off + bj * HALF + n * 16) = xr * ALPHA + acc[ai][bj][m][n]; }
            }
    }
};
struct EpiUp {
    static constexpr bool PERM = true, AFTER_DRAIN = false;
    bf16* Act; const float* bup;
    __device__ __forceinline__ void operator()(const f32x4 (&acc)[2][2][4][2], const Unit& u, int wr, int wc, int fr, int fq) const {
        const int row0 = u.pm * BM + wr * 64 + fr, f0 = u.pn * HALF + wc * 32 + 8 * fq;
        const float* bp = bup + (size_t)u.e * 2048 + 2 * f0;
        f32x4 bb[4];
#pragma unroll
        for (int i = 0; i < 4; ++i) bb[i] = *(const f32x4*)(bp + 4 * i);
#pragma unroll
        for (int ai = 0; ai < 2; ++ai)
#pragma unroll
            for (int m = 0; m < 4; ++m) {
                f32x4 o[2];
#pragma unroll
                for (int n = 0; n < 2; ++n) {
                    const f32x4 g = acc[ai][0][m][n], l = acc[ai][1][m][n];
#pragma unroll
                    for (int j = 0; j < 4; ++j) {
                        const float bg = bb[2 * n + (j >> 1)][(j & 1) * 2], bl = bb[2 * n + (j >> 1)][(j & 1) * 2 + 1];
                        const float xg = fminf(g[j] + bg, 7.0f), xl = fminf(fmaxf(l[j] + bl, -7.0f), 7.0f);
                        o[n][j] = xg * sigmoidf_(1.702f * xg) * (xl + 1.0f);
                    }
                }
                u32x4 w; w.x = cvt_pk_bf16(o[0][0], o[0][1]); w.y = cvt_pk_bf16(o[0][2], o[0][3]); w.z = cvt_pk_bf16(o[1][0], o[1][1]); w.w = cvt_pk_bf16(o[1][2], o[1][3]);
                *(u32x4*)(Act + (size_t)(row0 + ai * HALF + m * 16) * 1024 + f0) = w;
            }
    }
};
struct EpiDown {
    static constexpr bool PERM = true, AFTER_DRAIN = false;
    bf16* O; const float* bdn;
    __device__ __forceinline__ void operator()(const f32x4 (&acc)[2][2][4][2], const Unit& u, int wr, int wc, int fr, int fq) const {
        const int row0 = u.pm * BM + wr * 64 + fr, col0 = u.pn * BM + wc * 32 + 8 * fq;
        const float* bp = bdn + (size_t)u.e * 1024 + col0;
        f32x4 bv[2][2];
#pragma unroll
        for (int bj = 0; bj < 2; ++bj)
#pragma unroll
            for (int n = 0; n < 2; ++n) bv[bj][n] = *(const f32x4*)(bp + bj * HALF + 4 * n);
#pragma unroll
        for (int ai = 0; ai < 2; ++ai)
#pragma unroll
            for (int m = 0; m < 4; ++m) {
                bf16* rowp = O + (size_t)(row0 + ai * HALF + m * 16) * 1024 + col0;
#pragma unroll
                for (int bj = 0; bj < 2; ++bj) store8(rowp + bj * HALF, acc[ai][bj][m][0] + bv[bj][0], acc[ai][bj][m][1] + bv[bj][1]);
            }
    }
};

template <class Epi, class Sched, bool GATHER = false, bool ALIGN_EPI = true, bool SP2 = true>
__device__ __forceinline__ void gemm_phase(LAS unsigned char* lds, const Sched& S, const Epi& E, const int tid) {
    const int wid = __builtin_amdgcn_readfirstlane(tid >> 6), lane = tid & 63, wr = wid >> 2, wc = wid & 3, fr = lane & 15, fq = lane >> 4;
    constexpr int K = KD, nt = K / BK;
    unsigned voffB[2]; int Ra[2], Ca[2];
#pragma unroll
    for (int i = 0; i < 2; ++i) { int R, C; stage_rc(tid * 16 + i * 8192, R, C); const int Rb = Epi::PERM ? ((R & ~31) + perm32(R & 31)) : R;
        Ra[i] = R; Ca[i] = C; voffB[i] = (unsigned)(Rb * K + C) * 2u; }
    unsigned vA[2][2], nvA[2][2];
#define PG8_VA(dst, unit) do { _Pragma("unroll") for (int _h = 0; _h < 2; ++_h) _Pragma("unroll") for (int _i = 0; _i < 2; ++_i) \
        dst[_h][_i] = GATHER ? ((unsigned)S.rowidx[(unit).pm * BM + _h * HALF + Ra[_i]] * (unsigned)(K * 2) + (unsigned)(Ca[_i] * 2)) : (unsigned)(((_h * HALF + Ra[_i]) * K + Ca[_i]) * 2); } while (0)
    const size_t kstep = (size_t)(BK * 2);
    const size_t hstep = (size_t)HALF * K * 2;
    const unsigned ldsw = (unsigned)wid * 1024u;
    const int aoff = lds_byte(wr * 64 + fr, fq * 8), boff = lds_byte(wc * 32 + fr, fq * 8);
#define PG8_SA(b, h) (((b) * 2 + (h)) * HTB)
#define PG8_SB(b, h) ((4 + (b) * 2 + (h)) * HTB)
#define PG8_STAGE(bufoff, gbase, voff) do { _Pragma("unroll") for (int _i = 0; _i < 2; ++_i) \
        __builtin_amdgcn_global_load_lds((const unsigned*)((const char*)(gbase) + (voff)[_i]), (LAS unsigned*)(lds + (bufoff) + ldsw + _i * 8192), 16, 0, 0); } while (0)
#define PG8_LDA(dst, b, h) do { _Pragma("unroll") for (int m = 0; m < 4; ++m) _Pragma("unroll") for (int k = 0; k < 2; ++k) dst[m][k] = *(const LAS bf16x8*)(lds + PG8_SA(b, h) + aoff + m * 2048 + k * 1024); } while (0)
#define PG8_LDB(dst, b, h) do { _Pragma("unroll") for (int n = 0; n < 2; ++n) _Pragma("unroll") for (int k = 0; k < 2; ++k) dst[n][k] = *(const LAS bf16x8*)(lds + PG8_SB(b, h) + boff + n * 2048 + k * 1024); } while (0)
#define PG8_MMA(ai, bj, At, Bt) do { __builtin_amdgcn_s_setprio(1); _Pragma("unroll") for (int m = 0; m < 4; ++m) _Pragma("unroll") for (int n = 0; n < 2; ++n) _Pragma("unroll") for (int k = 0; k < 2; ++k) \
        acc[ai][bj][m][n] = __builtin_amdgcn_mfma_f32_16x16x32_bf16(Bt[n][k], At[m][k], acc[ai][bj][m][n], 0, 0, 0); __builtin_amdgcn_s_setprio(0); } while (0)
#define PG8_WAIT_V(n) asm volatile("s_waitcnt vmcnt(" #n ")" ::: "memory")
#define PG8_WAIT_L(n) asm volatile("s_waitcnt lgkmcnt(" #n ")" ::: "memory")
#define PG8_BAR __builtin_amdgcn_s_barrier()
#define PG8_SCHED __builtin_amdgcn_sched_barrier(0)
    Unit cur, nxt; int ui = 0;
    if (!S.next(0, cur)) return;
    f32x4 acc[2][2][4][2];
#pragma unroll
    for (int a = 0; a < 2; ++a)
#pragma unroll
        for (int b = 0; b < 2; ++b)
#pragma unroll
            for (int m = 0; m < 4; ++m)
#pragma unroll
                for (int n = 0; n < 2; ++n) acc[a][b][m][n] = (f32x4){0.f, 0.f, 0.f, 0.f};
    bf16x8 At[4][2], B0[2][2], B1[2][2];
    const char* cA = GATHER ? S.A : S.a_base(cur); const char* cB = S.b_base(cur);
    PG8_VA(vA, cur);
    int pub_pm = -1;
    S.a_ready(cur, 0, tid);
    if constexpr (SP2) {
        PG8_STAGE(PG8_SB(0, 0), cB, voffB); PG8_STAGE(PG8_SB(0, 1), cB + hstep, voffB); PG8_STAGE(PG8_SA(0, 0), cA, vA[0]); PG8_STAGE(PG8_SA(0, 1), cA, vA[1]);
        if (wr == 1) PG8_BAR;
        PG8_WAIT_V(2); PG8_BAR;
        PG8_STAGE(PG8_SB(1, 0), cB + kstep, voffB); PG8_STAGE(PG8_SA(1, 0), cA + kstep, vA[0]); PG8_STAGE(PG8_SB(1, 1), cB + hstep + kstep, voffB);
        PG8_WAIT_V(6); PG8_BAR;
    } else {
        PG8_STAGE(PG8_SB(0, 0), cB, voffB); PG8_STAGE(PG8_SA(0, 0), cA, vA[0]); PG8_STAGE(PG8_SB(0, 1), cB + hstep, voffB); PG8_STAGE(PG8_SA(0, 1), cA, vA[1]);
        if (wr == 1) PG8_BAR;
        PG8_WAIT_V(4); PG8_BAR;
        PG8_STAGE(PG8_SB(1, 0), cB + kstep, voffB); PG8_STAGE(PG8_SA(1, 0), cA + kstep, vA[0]); PG8_STAGE(PG8_SB(1, 1), cB + hstep + kstep, voffB);
        PG8_WAIT_V(6); PG8_BAR;
    }
    for (;;) {
        const bool has_next = S.next(ui + 1, nxt);
        const char* nA = (has_next && !GATHER) ? S.a_base(nxt) : cA; const char* nB = has_next ? S.b_base(nxt) : cB;
        if (GATHER && has_next) PG8_VA(nvA, nxt); else { _Pragma("unroll") for (int _h = 0; _h < 2; ++_h) _Pragma("unroll") for (int _i = 0; _i < 2; ++_i) nvA[_h][_i] = vA[_h][_i]; }
        for (int t = 0; t < nt; t += 2) {
            const bool last = (t == nt - 2);
            const char* a1 = cA + (size_t)(t + 1) * kstep;
            const char* a2 = last ? nA : cA + (size_t)(t + 2) * kstep; const char* b2 = last ? nB : cB + (size_t)(t + 2) * kstep;
            const char* a3 = a2 + kstep; const char* b3 = b2 + kstep;
            if (last) { if (has_next) S.a_ready(nxt, ui + 1, tid);
                        if (pub_pm >= 0) { S.done(pub_pm, lane); pub_pm = -1; } }
            unsigned w0[2], w1[2];
            w0[0] = last ? nvA[0][0] : vA[0][0]; w0[1] = last ? nvA[0][1] : vA[0][1]; w1[0] = last ? nvA[1][0] : vA[1][0]; w1[1] = last ? nvA[1][1] : vA[1][1];
            if constexpr (SP2) {
            PG8_LDB(B0, 0, 0); PG8_LDB(B1, 0, 1); PG8_SCHED; PG8_LDA(At, 0, 0); PG8_STAGE(PG8_SA(1, 1), a1, vA[1]);
            PG8_WAIT_V(8); PG8_WAIT_L(0); PG8_BAR; PG8_MMA(0, 0, At, B0); PG8_MMA(0, 1, At, B1); PG8_BAR; PG8_SCHED;
            PG8_LDA(At, 0, 1); PG8_STAGE(PG8_SB(0, 0), b2, voffB); PG8_STAGE(PG8_SB(0, 1), b2 + hstep, voffB); PG8_STAGE(PG8_SA(0, 0), a2, w0);
            PG8_WAIT_V(8); PG8_WAIT_L(0); PG8_BAR; PG8_MMA(1, 0, At, B0); PG8_MMA(1, 1, At, B1); PG8_BAR; PG8_SCHED;
            PG8_LDB(B0, 1, 0); PG8_LDB(B1, 1, 1); PG8_SCHED; PG8_LDA(At, 1, 0); PG8_STAGE(PG8_SA(0, 1), a2, w1);
            PG8_WAIT_V(8); PG8_WAIT_L(0); PG8_BAR; PG8_MMA(0, 0, At, B0); PG8_MMA(0, 1, At, B1); PG8_BAR; PG8_SCHED;
            PG8_LDA(At, 1, 1); PG8_STAGE(PG8_SB(1, 0), b3, voffB); PG8_STAGE(PG8_SB(1, 1), b3 + hstep, voffB); PG8_STAGE(PG8_SA(1, 0), a3, w0);
            PG8_WAIT_V(8); PG8_WAIT_L(0); PG8_BAR; PG8_MMA(1, 0, At, B0); PG8_MMA(1, 1, At, B1); PG8_BAR; PG8_SCHED;
            } else {
            PG8_LDB(B0, 0, 0); PG8_SCHED; PG8_LDA(At, 0, 0); PG8_STAGE(PG8_SA(1, 1), a1, vA[1]);
            PG8_WAIT_L(8); PG8_BAR; PG8_WAIT_L(0); PG8_MMA(0, 0, At, B0); PG8_BAR; PG8_SCHED;
            PG8_LDB(B1, 0, 1); PG8_STAGE(PG8_SB(0, 0), b2, voffB);
            PG8_BAR; PG8_WAIT_L(0); PG8_MMA(0, 1, At, B1); PG8_BAR;
            PG8_LDA(At, 0, 1); PG8_STAGE(PG8_SA(0, 0), a2, w0);
            PG8_BAR; PG8_WAIT_L(0); PG8_MMA(1, 0, At, B0); PG8_BAR; PG8_SCHED;
            PG8_STAGE(PG8_SB(0, 1), b2 + hstep, voffB);
            PG8_WAIT_V(6); PG8_BAR; PG8_MMA(1, 1, At, B1); PG8_BAR;
            PG8_LDB(B0, 1, 0); PG8_SCHED; PG8_LDA(At, 1, 0); PG8_STAGE(PG8_SA(0, 1), a2, w1);
            PG8_WAIT_L(8); PG8_BAR; PG8_WAIT_L(0); PG8_MMA(0, 0, At, B0); PG8_BAR; PG8_SCHED;
            PG8_LDB(B1, 1, 1); PG8_STAGE(PG8_SB(1, 0), b3, voffB);
            PG8_BAR; PG8_WAIT_L(0); PG8_MMA(0, 1, At, B1); PG8_BAR;
            PG8_LDA(At, 1, 1); PG8_STAGE(PG8_SA(1, 0), a3, w0);
            PG8_BAR; PG8_WAIT_L(0); PG8_MMA(1, 0, At, B0); PG8_BAR; PG8_SCHED;
            PG8_STAGE(PG8_SB(1, 1), b3 + hstep, voffB);
            PG8_WAIT_V(6); PG8_BAR; PG8_MMA(1, 1, At, B1); PG8_BAR;
            }
        }
        if constexpr (ALIGN_EPI) { if (wr == 0) PG8_BAR; }
        E(acc, cur, wr, wc, fr, fq); pub_pm = cur.pm;
        if (!has_next) break;
#pragma unroll
        for (int a = 0; a < 2; ++a)
#pragma unroll
            for (int b = 0; b < 2; ++b)
#pragma unroll
                for (int m = 0; m < 4; ++m)
#pragma unroll
                    for (int n = 0; n < 2; ++n) acc[a][b][m][n] = (f32x4){0.f, 0.f, 0.f, 0.f};
        cur = nxt; cA = nA; cB = nB; ++ui;
#pragma unroll
        for (int _h = 0; _h < 2; ++_h)
#pragma unroll
            for (int _i = 0; _i < 2; ++_i) vA[_h][_i] = nvA[_h][_i];
        if constexpr (ALIGN_EPI) { if (wr == 1) PG8_BAR; }
    }
    PG8_WAIT_V(0);
    if (pub_pm >= 0) S.done(pub_pm, lane);
    if constexpr (!ALIGN_EPI) { if (wr == 0) PG8_BAR; }
    PG8_BAR;
#undef PG8_VA
#undef PG8_SA
#undef PG8_SB
#undef PG8_STAGE
#undef PG8_LDA
#undef PG8_LDB
#undef PG8_MMA
#undef PG8_WAIT_V
#undef PG8_WAIT_L
#undef PG8_BAR
#undef PG8_SCHED
}
}

__device__ __forceinline__ int rowmap(int mode, int c) {
    if (mode == 1) { const int pn = c >> 8; const bool rope = (pn < 4) || (pn >= 10 && pn < 14);
        return rope ? ((c & ~255) | (((c >> 5) & 1) << 7) | (((c >> 6) & 3) << 5) | (c & 31)) : c; }
    if (mode == 2) { const int f = c >> 1, bj = c & 1; return ((f >> 7) << 8) | (bj << 7) | (f & 127); }
    return c;
}
__device__ __forceinline__ void p0_transpose_item(const float* W, int N, bf16* WT, int mode, LAS float* scr, int item, int lane) {
    const int nblk = N / 32, kb = item / nblk, nb = item % nblk, k0 = 64 * kb, n0 = 32 * nb;
#pragma unroll 8
    for (int i = 0; i < 32; ++i) { const int kk = 2 * i + (lane >> 5); scr[kk * 33 + (lane & 31)] = W[(size_t)(k0 + kk) * N + n0 + (lane & 31)]; }
    asm volatile("s_waitcnt lgkmcnt(0)" ::: "memory");
    const int c = lane & 7;
#pragma unroll
    for (int j = 0; j < 4; ++j) { const int n = (lane >> 3) + 8 * j; const LAS float* s = scr + (8 * c) * 33 + n;
        u32x4 o; o.x = pk2(s[0 * 33], s[1 * 33]); o.y = pk2(s[2 * 33], s[3 * 33]); o.z = pk2(s[4 * 33], s[5 * 33]); o.w = pk2(s[6 * 33], s[7 * 33]);
        *(u32x4*)(WT + (size_t)rowmap(mode, n0 + n) * 1024 + k0 + 8 * c) = o; }
    asm volatile("s_waitcnt lgkmcnt(0)" ::: "memory");
}
__device__ const double INV_FREQ[32] = {1, 0.74989420933245587, 0.56234132519034907, 0.42169650342858223, 0.31622776601683794, 0.23713737056616552, 0.17782794100389229, 0.1333521432163324,
    0.10000000000000001, 0.074989420933245579, 0.056234132519034911, 0.042169650342858224, 0.031622776601683791, 0.023713737056616554, 0.017782794100389229, 0.013335214321633241,
    0.01, 0.0074989420933245579, 0.005623413251903491, 0.0042169650342858229, 0.0031622776601683794, 0.0023713737056616554, 0.0017782794100389228, 0.0013335214321633241,
    0.001, 0.00074989420933245586, 0.0005623413251903491, 0.00042169650342858224, 0.00031622776601683794, 0.00023713737056616554, 0.00017782794100389227, 0.0001333521432163324};

struct Ptrs {
    const float *x, *ab_w_in, *ab_w_out, *ret_decay, *c_w_in, *c_w_out, *c_rpb, *ln_g, *ln_b, *router_w, *router_b, *w_up, *b_up, *w_down, *b_down;
    float* out; unsigned char* ws;
};

__device__ __forceinline__ void phase_prologue(const Ptrs& P, LAS unsigned char* lds, int bid, int tid) {
    const int wave = tid >> 6, lane = tid & 63;
    LAS float* scr = (LAS float*)(lds + wave * 16384);
    const int gw = bid * NWAVES + wave, NGW = GRID * NWAVES;
    constexpr int I0 = 2 * 2048, I1 = 2 * 512, I2 = 2 * 1536, I3 = 2 * 512, I4 = 128 * 1024, I5 = 128 * 512;
    constexpr int NITEMS = I0 + I1 + I2 + I3 + I4 + I5;
    unsigned char* ws = P.ws;
    for (int it = gw; it < NITEMS; it += NGW) {
        int r = it;
        if (r < I0) { const int mi = r / 2048, ii = r % 2048; p0_transpose_item(P.ab_w_in + (size_t)mi * 1024 * 4096, 4096, (bf16*)(ws + WS_WIN_E) + (size_t)mi * 4096 * 1024, 1, scr, ii, lane); continue; } r -= I0;
        if (r < I1) { const int mi = r / 512, ii = r % 512; p0_transpose_item(P.ab_w_out + (size_t)mi * 1024 * 1024, 1024, (bf16*)(ws + WS_WOUT_E) + (size_t)mi * 1024 * 1024, 0, scr, ii, lane); continue; } r -= I1;
        if (r < I2) { const int mi = r / 1536, ii = r % 1536; p0_transpose_item(P.c_w_in + (size_t)mi * 1024 * 3072, 3072, (bf16*)(ws + WS_WIN_O) + (size_t)mi * 3072 * 1024, 0, scr, ii, lane); continue; } r -= I2;
        if (r < I3) { const int mi = r / 512, ii = r % 512; p0_transpose_item(P.c_w_out + (size_t)mi * 1024 * 1024, 1024, (bf16*)(ws + WS_WOUT_O) + (size_t)mi * 1024 * 1024, 0, scr, ii, lane); continue; } r -= I3;
        if (r < I4) { const int mi = r / 1024, ii = r % 1024; p0_transpose_item(P.w_up + (size_t)mi * 1024 * 2048, 2048, (bf16*)(ws + WS_WUP) + (size_t)mi * 2048 * 1024, 2, scr, ii, lane); continue; } r -= I4;
        { const int mi = r / 512, ii = r % 512; p0_transpose_item(P.w_down + (size_t)mi * 1024 * 1024, 1024, (bf16*)(ws + WS_WDN) + (size_t)mi * 1024 * 1024, 0, scr, ii, lane); }
    }
    float* cs = (float*)(ws + WS_COS); float* sn = (float*)(ws + WS_SIN);
    for (int g = bid * NTHR + tid; g < T * 32; g += GRID * NTHR) {
        const int pos = g >> 5, i = g & 31;
        const double rev = (double)pos * INV_FREQ[i] * 0.15915494309189535;
        const double fr = rev - __builtin_rint(rev);
        const float a = (float)(fr * 6.283185307179586);
        cs[g] = cosf(a); sn[g] = sinf(a);
    }
    { bf16* rwt = (bf16*)(ws + WS_RWT);
      for (int g = bid * NTHR + tid; g < DEPTH * NEXP * D; g += GRID * NTHR) { const int l = g >> 15, e = (g >> 10) & 31, d = g & 1023;
          const float w = P.router_w[((size_t)l * D + d) * NEXP + e]; const unsigned hi = f2bf(w); const float wl = w - __builtin_bit_cast(float, hi << 16);
          rwt[((size_t)(l * 2) * NEXP + e) * D + d] = (bf16)hi; rwt[((size_t)(l * 2 + 1) * NEXP + e) * D + d] = (bf16)f2bf(wl); } }
    bf16* xb = (bf16*)(ws + WS_XB);
    for (size_t g = (size_t)bid * NTHR + tid; g < (size_t)T * D / 8; g += (size_t)GRID * NTHR) {
        const f32x4 a = *(const f32x4*)(P.x + g * 8), b = *(const f32x4*)(P.x + g * 8 + 4);
        u32x4 o; o.x = pk2(a[0], a[1]); o.y = pk2(a[2], a[3]); o.z = pk2(b[0], b[1]); o.w = pk2(b[2], b[3]);
        *(u32x4*)(xb + g * 8) = o;
    }
}

__device__ __forceinline__ void load_panel_f32(LAS float* dst, const bf16* src, int ldh, int tid) {
    const int row = tid >> 2, c0 = (tid & 3) * 16;
    const bf16* p = src + (size_t)row * ldh + c0;
    const u32x4 a = *(const u32x4*)p, b = *(const u32x4*)(p + 8);
    float f[16]; unpack8(a, f); unpack8(b, f + 8);
    LAS f32x4* d = (LAS f32x4*)(dst + row * 64 + c0);
    d[0] = (f32x4){f[0], f[1], f[2], f[3]}; d[1] = (f32x4){f[4], f[5], f[6], f[7]}; d[2] = (f32x4){f[8], f[9], f[10], f[11]}; d[3] = (f32x4){f[12], f[13], f[14], f[15]};
}
__device__ __forceinline__ void phase_ret_states(LAS unsigned char* lds, const bf16* H, const float* decay, float* S, int bid, int tid) {
    LAS float* kf = (LAS float*)lds; LAS float* vf = kf + 128 * 64; LAS float* zt = (LAS float*)(lds + MISC_OFF + 4096);
    for (int unit = bid; unit < 1024; unit += GRID) {
        const int h = unit >> 7, n = unit & 127;
        const float lgf = log2_gamma(decay[h]), lgb = log2_gamma(decay[8 + h]);
        __syncthreads();
        load_panel_f32(kf, H + (size_t)(n * 128) * EVEN_IN + 512 + h * 64, EVEN_IN, tid);
        load_panel_f32(vf, H + (size_t)(n * 128) * EVEN_IN + 1024 + h * 64, EVEN_IN, tid);
        if (tid < 128) { zt[tid] = exp2f(lgf * (float)(127 - tid)); zt[128 + tid] = exp2f(lgb * (float)tid); }
        __syncthreads();
        const int e = tid >> 3, d0 = (tid & 7) * 8;
        f32x4 af0 = {0, 0, 0, 0}, af1 = af0, ab0 = af0, ab1 = af0;
        for (int m = 0; m < 128; ++m) {
            const float ve = vf[m * 64 + e]; const float a = ve * zt[m], b = ve * zt[128 + m];
            const f32x4 k0 = *(const LAS f32x4*)(kf + m * 64 + d0), k1 = *(const LAS f32x4*)(kf + m * 64 + d0 + 4);
            af0 += k0 * a; af1 += k1 * a; ab0 += k0 * b; ab1 += k1 * b;
        }
        float* sf = S + ((size_t)(h) * 128 + n) * 4096 + e * 64 + d0;
        float* sb = S + ((size_t)(8 + h) * 128 + n) * 4096 + e * 64 + d0;
        *(f32x4*)sf = af0; *(f32x4*)(sf + 4) = af1; *(f32x4*)sb = ab0; *(f32x4*)(sb + 4) = ab1;
    }
}
__device__ __forceinline__ void phase_ret_scan(const float* S, bf16* R, const float* decay, int bid, int tid) {
    for (int g = bid * NTHR + tid; g < 65536; g += GRID * NTHR) {
        const int dir = g >> 15, h = (g >> 12) & 7, de = g & 4095;
        const float gc = exp2f(log2_gamma(decay[dir * 8 + h]) * 128.0f);
        const float* s = S + ((size_t)(dir * 8 + h) * 128) * 4096 + de; bf16* r = R + ((size_t)(dir * 8 + h) * 128) * 4096 + de;
        float a = 0.f;
        if (dir == 0) { for (int n = 0; n < 128; ++n) { r[(size_t)n * 4096] = (bf16)f2bf(a); a = gc * a + s[(size_t)n * 4096]; } }
        else { for (int n = 127; n >= 0; --n) { r[(size_t)n * 4096] = (bf16)f2bf(a); a = gc * a + s[(size_t)n * 4096]; } }
    }
}
__device__ __forceinline__ void phase_ret_out(LAS unsigned char* lds, const bf16* H, const float* R, const float* decay, bf16* Y, int bid, int tid) {
    LAS float* qf = (LAS float*)lds; LAS float* kf = qf + 8192; LAS float* vf = kf + 8192; LAS float* rf = vf + 8192; LAS float* rb = rf + 4096;
    for (int unit = bid; unit < 1024; unit += GRID) {
        const int h = unit >> 7, n = unit & 127;
        const float lgf = log2_gamma(decay[h]), lgb = log2_gamma(decay[8 + h]);
        __syncthreads();
        const bf16* hp = H + (size_t)(n * 128) * EVEN_IN + h * 64;
        load_panel_f32(qf, hp, EVEN_IN, tid); load_panel_f32(kf, hp + 512, EVEN_IN, tid); load_panel_f32(vf, hp + 1024, EVEN_IN, tid);
        { const float* r0 = R + ((size_t)(h) * 128 + n) * 4096 + tid * 8; const float* r1 = R + ((size_t)(8 + h) * 128 + n) * 4096 + tid * 8;
          *(LAS f32x4*)(rf + tid * 8) = *(const f32x4*)r0; *(LAS f32x4*)(rf + tid * 8 + 4) = *(const f32x4*)(r0 + 4);
          *(LAS f32x4*)(rb + tid * 8) = *(const f32x4*)r1; *(LAS f32x4*)(rb + tid * 8 + 4) = *(const f32x4*)(r1 + 4); }
        __syncthreads();
        const int c = tid >> 2, e0 = (tid & 3) * 16;
        f32x4 q[16];
#pragma unroll
        for (int i = 0; i < 16; ++i) q[i] = *(const LAS f32x4*)(qf + c * 64 + 4 * i);
        f32x4 of[4], ob[4];
#pragma unroll
        for (int i = 0; i < 4; ++i) { of[i] = (f32x4){0, 0, 0, 0}; ob[i] = of[i]; }
        for (int m = 0; m < 128; ++m) {
            f32x4 sv = {0, 0, 0, 0};
#pragma unroll
            for (int i = 0; i < 16; ++i) sv += q[i] * *(const LAS f32x4*)(kf + m * 64 + 4 * i);
            const float s = (sv[0] + sv[1]) + (sv[2] + sv[3]);
            const float df = (float)(c - m);
            const float pf = (m <= c) ? exp2f(lgf * df) : 0.0f;
            const float pb = (m > c) ? exp2f(-lgb * df) : 0.0f;
            const float wf = s * pf, wb = s * pb;
#pragma unroll
            for (int i = 0; i < 4; ++i) { const f32x4 v = *(const LAS f32x4*)(vf + m * 64 + e0 + 4 * i); of[i] += v * wf; ob[i] += v * wb; }
        }
        f32x4 cf[4], cb[4];
#pragma unroll
        for (int i = 0; i < 4; ++i) { cf[i] = (f32x4){0, 0, 0, 0}; cb[i] = cf[i]; }
#pragma unroll
        for (int d4 = 0; d4 < 16; ++d4)
#pragma unroll
            for (int dd = 0; dd < 4; ++dd) {
                const float qd = q[d4][dd]; const int d = 4 * d4 + dd;
#pragma unroll
                for (int i = 0; i < 4; ++i) { cf[i] += *(const LAS f32x4*)(rf + d * 64 + e0 + 4 * i) * qd; cb[i] += *(const LAS f32x4*)(rb + d * 64 + e0 + 4 * i) * qd; }
            }
        const float xif = exp2f(lgf * (float)(c + 1)), xib = exp2f(lgb * (float)(128 - c));
        float sf = 0.f, sb = 0.f;
#pragma unroll
        for (int i = 0; i < 4; ++i) { of[i] += cf[i] * xif; ob[i] += cb[i] * xib; sf += (of[i][0] + of[i][1]) + (of[i][2] + of[i][3]); sb += (ob[i][0] + ob[i][1]) + (ob[i][2] + ob[i][3]); }
        sf += shx(sf, 1); sf += shx(sf, 2); sb += shx(sb, 1); sb += shx(sb, 2);
        const float muf = sf * (1.0f / 64.0f), mub = sb * (1.0f / 64.0f);
        float vfq = 0.f, vbq = 0.f;
#pragma unroll
        for (int i = 0; i < 4; ++i) { of[i] = of[i] - muf; ob[i] = ob[i] - mub;
            vfq += (of[i][0] * of[i][0] + of[i][1] * of[i][1]) + (of[i][2] * of[i][2] + of[i][3] * of[i][3]);
            vbq += (ob[i][0] * ob[i][0] + ob[i][1] * ob[i][1]) + (ob[i][2] * ob[i][2] + ob[i][3] * ob[i][3]); }
        vfq += shx(vfq, 1); vfq += shx(vfq, 2); vbq += shx(vbq, 1); vbq += shx(vbq, 2);
        const float rsf = 1.0f / sqrtf(vfq * (1.0f / 64.0f) + GN_EPS), rsb = 1.0f / sqrtf(vbq * (1.0f / 64.0f) + GN_EPS);
        const int tok = n * 128 + c;
        const bf16* gp = H + (size_t)tok * EVEN_IN + 1536 + h * 64 + e0;
        float gf[16], gb[16];
        unpack8(*(const u32x4*)gp, gf); unpack8(*(const u32x4*)(gp + 8), gf + 8); unpack8(*(const u32x4*)(gp + 512), gb); unpack8(*(const u32x4*)(gp + 520), gb + 8);
        float y[16];
#pragma unroll
        for (int i = 0; i < 16; ++i) { const float a = gf[i] * sigmoidf_(gf[i]), b = gb[i] * sigmoidf_(gb[i]); y[i] = a * (of[i >> 2][i & 3] * rsf) + b * (ob[i >> 2][i & 3] * rsb); }
        bf16* yp = Y + (size_t)tok * D + h * 64 + e0;
        u32x4 w0, w1; w0.x = pk2(y[0], y[1]); w0.y = pk2(y[2], y[3]); w0.z = pk2(y[4], y[5]); w0.w = pk2(y[6], y[7]); w1.x = pk2(y[8], y[9]); w1.y = pk2(y[10], y[11]); w1.z = pk2(y[12], y[13]); w1.w = pk2(y[14], y[15]);
        *(u32x4*)yp = w0; *(u32x4*)(yp + 8) = w1;
    }
}

struct OnlineSm { float m, l; f32x4 o[16]; };
__device__ __forceinline__ void load_q64(const bf16* p, f32x4 (&q)[16]) {
#pragma unroll
    for (int i = 0; i < 8; ++i) { float f[8]; unpack8(*(const u32x4*)(p + 8 * i), f); q[2 * i] = (f32x4){f[0], f[1], f[2], f[3]}; q[2 * i + 1] = (f32x4){f[4], f[5], f[6], f[7]}; }
}
__device__ __forceinline__ float dot64(const f32x4 (&q)[16], const bf16* kp) {
    f32x4 sv = {0, 0, 0, 0};
#pragma unroll
    for (int i = 0; i < 8; ++i) { float f[8]; unpack8(*(const u32x4*)(kp + 8 * i), f); sv += q[2 * i] * (f32x4){f[0], f[1], f[2], f[3]}; sv += q[2 * i + 1] * (f32x4){f[4], f[5], f[6], f[7]}; }
    return (sv[0] + sv[1]) + (sv[2] + sv[3]);
}
__device__ __forceinline__ void sm_update(OnlineSm& st, float s, const bf16* vp) {
    const float mn = fmaxf(st.m, s), sc = __expf(st.m - mn), p = __expf(s - mn);
    st.l = st.l * sc + p; st.m = mn;
#pragma unroll
    for (int i = 0; i < 8; ++i) { float f[8]; unpack8(*(const u32x4*)(vp + 8 * i), f);
        st.o[2 * i] = st.o[2 * i] * sc + (f32x4){f[0], f[1], f[2], f[3]} * p; st.o[2 * i + 1] = st.o[2 * i + 1] * sc + (f32x4){f[4], f[5], f[6], f[7]} * p; }
}
__device__ __forceinline__ void sm_store(const OnlineSm& st, bf16* yp) {
    const float inv = 1.0f / st.l;
#pragma unroll
    for (int i = 0; i < 8; ++i) { const f32x4 a = st.o[2 * i] * inv, b = st.o[2 * i + 1] * inv; u32x4 w; w.x = pk2(a[0], a[1]); w.y = pk2(a[2], a[3]); w.z = pk2(b[0], b[1]); w.w = pk2(b[2], b[3]); *(u32x4*)(yp + 8 * i) = w; }
}
__device__ __forceinline__ void phase_dilated(const bf16* H, bf16* Y, int bid, int tid) {
    const int g = bid * NTHR + tid, h = g >> 14, i = g & 16383;
    f32x4 q[16]; load_q64(H + (size_t)i * EVEN_IN + 2560 + h * 64, q);
    OnlineSm st; st.m = -1e30f; st.l = 0.f;
#pragma unroll
    for (int k = 0; k < 16; ++k) st.o[k] = (f32x4){0, 0, 0, 0};
    for (int b = 0; b < 3; ++b) {
        const int dil = (b == 0) ? 1 : ((b == 1) ? 4 : 16);
        for (int jj = -64; jj <= 64; ++jj) {
            const int j = i + dil * jj;
            if (j < 0 || j >= T) continue;
            const bf16* kp = H + (size_t)j * EVEN_IN + 3072 + h * 64;
            const float s = dot64(q, kp);
            sm_update(st, s, kp + 512);
        }
    }
    sm_store(st, Y + (size_t)i * D + 512 + h * 64);
}
__device__ __forceinline__ void phase_natten(const bf16* H, const float* rpb, bf16* Y, int bid, int tid) {
    for (int rep = 0; rep < 2; ++rep) {
        const int g = rep * (GRID * NTHR) + bid * NTHR + tid, h = g >> 14, i = g & 16383, r = i >> 6, c = i & 63;
        const int r0 = min(max(r - 4, 0), 248), c0 = min(max(c - 8, 0), 48);
        f32x4 q[16]; load_q64(H + (size_t)i * ODD_IN + h * 64, q);
        OnlineSm st; st.m = -1e30f; st.l = 0.f;
#pragma unroll
        for (int k = 0; k < 16; ++k) st.o[k] = (f32x4){0, 0, 0, 0};
        for (int ii = 0; ii < 8; ++ii)
            for (int jj = 0; jj < 16; ++jj) {
                const int kr = r0 + ii, kc = c0 + jj, j = kr * 64 + kc;
                const float bias = rpb[(h * 15 + (kr - r + 7)) * 31 + (kc - c + 15)];
                const bf16* kp = H + (size_t)j * ODD_IN + 1024 + h * 64;
                const float s = dot64(q, kp) + bias;
                sm_update(st, s, kp + 1024);
            }
        sm_store(st, Y + (size_t)i * D + h * 64);
    }
}

typedef short s16x4 __attribute__((ext_vector_type(4)));
__device__ __forceinline__ void tr_read8(unsigned a0, unsigned a1, unsigned a2, unsigned a3, s16x4 (&r)[8]) {
    asm volatile("ds_read_b64_tr_b16 %0, %8\n\tds_read_b64_tr_b16 %1, %8 offset:2048\n\tds_read_b64_tr_b16 %2, %9\n\tds_read_b64_tr_b16 %3, %9 offset:2048\n\t"
                 "ds_read_b64_tr_b16 %4, %10\n\tds_read_b64_tr_b16 %5, %10 offset:2048\n\tds_read_b64_tr_b16 %6, %11\n\tds_read_b64_tr_b16 %7, %11 offset:2048\n\ts_waitcnt lgkmcnt(0)"
                 : "=&v"(r[0]), "=&v"(r[1]), "=&v"(r[2]), "=&v"(r[3]), "=&v"(r[4]), "=&v"(r[5]), "=&v"(r[6]), "=&v"(r[7]) : "v"(a0), "v"(a1), "v"(a2), "v"(a3) : "memory");
}
struct LaneOffs { unsigned k0, k1, v[4]; };
__device__ __forceinline__ LaneOffs lane_offs(int lane) {
    const int i = lane & 15, g = lane >> 4, q = i >> 2, p = i & 3, vrow = 4 * g + q; LaneOffs o;
    o.k0 = (unsigned)(i * 128 + (((g) ^ (i & 7)) << 4)); o.k1 = (unsigned)(i * 128 + (((4 + g) ^ (i & 7)) << 4));
#pragma unroll
    for (int dt = 0; dt < 4; ++dt) o.v[dt] = (unsigned)(vrow * 128 + (((2 * dt + (p >> 1)) ^ (vrow & 7)) << 4) + 8 * (p & 1));
    return o;
}
__device__ __forceinline__ unsigned lds_addr(const LAS unsigned char* p) { return (unsigned)(size_t)p; }
__device__ __forceinline__ void qk_tile(const LAS unsigned char* Kt, const LaneOffs& lo, const bf16x8 q0, const bf16x8 q1, f32x4 (&sa)[2]) {
    const bf16x8 k00 = *(const LAS bf16x8*)(Kt + lo.k0), k01 = *(const LAS bf16x8*)(Kt + lo.k1), k10 = *(const LAS bf16x8*)(Kt + 2048 + lo.k0), k11 = *(const LAS bf16x8*)(Kt + 2048 + lo.k1);
    sa[0] = (f32x4){0.f, 0.f, 0.f, 0.f}; sa[1] = sa[0];
    sa[0] = __builtin_amdgcn_mfma_f32_16x16x32_bf16(k00, q0, sa[0], 0, 0, 0); sa[0] = __builtin_amdgcn_mfma_f32_16x16x32_bf16(k01, q1, sa[0], 0, 0, 0);
    sa[1] = __builtin_amdgcn_mfma_f32_16x16x32_bf16(k10, q0, sa[1], 0, 0, 0); sa[1] = __builtin_amdgcn_mfma_f32_16x16x32_bf16(k11, q1, sa[1], 0, 0, 0);
}
__device__ __forceinline__ void pv_tile(const LAS unsigned char* Vt, const LaneOffs& lo, const f32x4 p0, const f32x4 p1, f32x4 (&o)[4]) {
    const unsigned vb = lds_addr(Vt); s16x4 r[8];
    tr_read8(vb + lo.v[0], vb + lo.v[1], vb + lo.v[2], vb + lo.v[3], r);
    u32x4 pw;
    asm volatile("v_cvt_pk_bf16_f32 %0, %4, %5\n\tv_cvt_pk_bf16_f32 %1, %6, %7\n\tv_cvt_pk_bf16_f32 %2, %8, %9\n\tv_cvt_pk_bf16_f32 %3, %10, %11\n\ts_nop 1"
                 : "=&v"(pw.x), "=&v"(pw.y), "=&v"(pw.z), "=&v"(pw.w) : "v"(p0[0]), "v"(p0[1]), "v"(p0[2]), "v"(p0[3]), "v"(p1[0]), "v"(p1[1]), "v"(p1[2]), "v"(p1[3]));
    const bf16x8 pb = __builtin_bit_cast(bf16x8, pw);
#pragma unroll
    for (int dt = 0; dt < 4; ++dt) { const bf16x8 va = __builtin_shufflevector(r[2 * dt], r[2 * dt + 1], 0, 1, 2, 3, 4, 5, 6, 7); o[dt] = __builtin_amdgcn_mfma_f32_16x16x32_bf16(va, pb, o[dt], 0, 0, 0); }
}
struct SmState { float m, l; f32x4 o[4]; };
__device__ __forceinline__ void sm_init(SmState& st) { st.m = -1e30f; st.l = 0.f;
#pragma unroll
    for (int dt = 0; dt < 4; ++dt) st.o[dt] = (f32x4){0.f, 0.f, 0.f, 0.f}; }
__device__ __forceinline__ void sm_step(SmState& st, f32x4 (&sa)[2], const LAS unsigned char* Vt, const LaneOffs& lo) {
    float tm = fmaxf(fmaxf(fmaxf(sa[0][0], sa[0][1]), fmaxf(sa[0][2], sa[0][3])), fmaxf(fmaxf(sa[1][0], sa[1][1]), fmaxf(sa[1][2], sa[1][3])));
    tm = fmaxf(tm, shx(tm, 16)); tm = fmaxf(tm, shx(tm, 32));
    const float mn = fmaxf(st.m, tm), sc = exp2f(st.m - mn);
    float ps = 0.f;
#pragma unroll
    for (int a = 0; a < 2; ++a)
#pragma unroll
        for (int r = 0; r < 4; ++r) { sa[a][r] = exp2f(sa[a][r] - mn); ps += sa[a][r]; }
    st.l = st.l * sc + ps; st.m = mn;
#pragma unroll
    for (int dt = 0; dt < 4; ++dt) st.o[dt] = st.o[dt] * sc;
    pv_tile(Vt, lo, sa[0], sa[1], st.o);
}

constexpr int DIL_UNITS = 8 * 3 * 128;
__device__ __forceinline__ void dil_decode(int u, int& h, int& b, int& r, int& blk) { h = u / 384; const int rem = u - h * 384; b = rem >> 7; const int x = rem & 127; r = x >> (7 - 2 * b); blk = x & ((128 >> (2 * b)) - 1); }
__device__ __forceinline__ void dil_issue(const bf16* H, int u, int tid, u32x4 (&kr)[4], u32x4 (&vr)[4]) {
    int h, b, r, blk; dil_decode(u, h, b, r, blk); const int Lc = T >> (2 * b), base = 128 * blk - 64;
#pragma unroll
    for (int k = 0; k < 4; ++k) { const int id = tid + 512 * k, row = id >> 3, c = id & 7, ki = base + row; const bool ok = (ki >= 0) && (ki < Lc);
        const bf16* src = H + (size_t)(r + (ki << (2 * b))) * EVEN_IN + 3072 + h * 64 + c * 8;
        kr[k] = ok ? *(const u32x4*)src : (u32x4){0u, 0u, 0u, 0u}; vr[k] = ok ? *(const u32x4*)(src + 512) : (u32x4){0u, 0u, 0u, 0u}; }
}
__device__ __forceinline__ void dil_commit(LAS unsigned char* buf, int tid, const u32x4 (&kr)[4], const u32x4 (&vr)[4]) {
#pragma unroll
    for (int k = 0; k < 4; ++k) { const int id = tid + 512 * k, row = id >> 3, c = id & 7; const unsigned off = (unsigned)(row * 128 + ((c ^ (row & 7)) << 4));
        *(LAS u32x4*)(buf + off) = kr[k]; *(LAS u32x4*)(buf + 32768 + off) = vr[k]; }
}
__device__ __forceinline__ void phase_dilated_mfma(LAS unsigned char* lds, const bf16* H, bf16* OG, float* LSE, int bid, int tid) {
    const int wave = tid >> 6, lane = tid & 63, i16 = lane & 15, g = lane >> 4;
    const LaneOffs lo = lane_offs(lane);
    u32x4 kr[4], vr[4];
    __syncthreads();
    dil_issue(H, bid, tid, kr, vr); dil_commit(lds, tid, kr, vr);
    __syncthreads();
    int it = 0;
    for (int u = bid; u < DIL_UNITS; u += GRID, ++it) {
        LAS unsigned char* buf = lds + (it & 1) * 65536;
        const bool has_next = (u + GRID) < DIL_UNITS;
        if (has_next) dil_issue(H, u + GRID, tid, kr, vr);
        int h, b, r, blk; dil_decode(u, h, b, r, blk); const int Lc = T >> (2 * b), base = 128 * blk - 64;
        const int ql = 16 * wave + i16, tokq = r + ((128 * blk + ql) << (2 * b));
        const bf16* qp = H + (size_t)tokq * EVEN_IN + 2560 + h * 64 + 8 * g;
        const bf16x8 q0 = *(const bf16x8*)qp, q1 = *(const bf16x8*)(qp + 32);
        SmState st; sm_init(st);
        const int t0 = wave >> 1;
#pragma unroll 1
        for (int t = t0; t < t0 + 5; ++t) {
            f32x4 sa[2]; qk_tile(buf + t * 4096, lo, q0, q1, sa);
#pragma unroll
            for (int a = 0; a < 2; ++a)
#pragma unroll
                for (int rg = 0; rg < 4; ++rg) { const int kl = 32 * t + 16 * a + 4 * g + rg, ki = base + kl; const bool ok = (kl >= ql) && (kl <= ql + 128) && (ki >= 0) && (ki < Lc);
                    sa[a][rg] = ok ? sa[a][rg] * 1.4426950408889634f : -INFINITY; }
            sm_step(st, sa, buf + 32768 + t * 4096, lo);
        }
        float l = st.l; l += shx(l, 16); l += shx(l, 32);
        const float inv = 1.0f / l;
        bf16* op = OG + ((size_t)b * T + tokq) * 512 + h * 64 + 4 * g;
#pragma unroll
        for (int dt = 0; dt < 4; ++dt) { const f32x4 o = st.o[dt] * inv; u32x2 w; w.x = cvt_pk_bf16(o[0], o[1]); w.y = cvt_pk_bf16(o[2], o[3]); *(u32x2*)(op + 16 * dt) = w; }
        if (g == 0) LSE[((size_t)b * T + tokq) * 8 + h] = (st.m + log2f(l)) * 0.6931471805599453f;
        if (has_next) dil_commit(lds + ((it + 1) & 1) * 65536, tid, kr, vr);
        __syncthreads();
    }
}
__device__ __forceinline__ void phase_dil_merge(const bf16* OG, const float* LSE, bf16* Y, int bid, int tid) {
    for (int item = bid * NTHR + tid; item < T * 64; item += GRID * NTHR) {
        const int tok = item >> 6, h = (item >> 3) & 7, c = item & 7;
        const float l0 = LSE[((size_t)0 * T + tok) * 8 + h], l1 = LSE[((size_t)1 * T + tok) * 8 + h], l2 = LSE[((size_t)2 * T + tok) * 8 + h];
        const float mx = fmaxf(l0, fmaxf(l1, l2)); float w0 = __expf(l0 - mx), w1 = __expf(l1 - mx), w2 = __expf(l2 - mx); const float inv = 1.0f / (w0 + w1 + w2); w0 *= inv; w1 *= inv; w2 *= inv;
        float a[8], b[8], d[8];
        unpack8(*(const u32x4*)(OG + ((size_t)0 * T + tok) * 512 + h * 64 + c * 8), a); unpack8(*(const u32x4*)(OG + ((size_t)1 * T + tok) * 512 + h * 64 + c * 8), b); unpack8(*(const u32x4*)(OG + ((size_t)2 * T + tok) * 512 + h * 64 + c * 8), d);
        float y[8];
#pragma unroll
        for (int j = 0; j < 8; ++j) y[j] = w0 * a[j] + w1 * b[j] + w2 * d[j];
        u32x4 o; o.x = pk2(y[0], y[1]); o.y = pk2(y[2], y[3]); o.z = pk2(y[4], y[5]); o.w = pk2(y[6], y[7]);
        *(u32x4*)(Y + (size_t)tok * D + 512 + h * 64 + c * 8) = o;
    }
}

__device__ __forceinline__ void phase_natten_mfma(LAS unsigned char* lds, const bf16* H, const float* rpb, bf16* Y, int bid, int tid) {
    const int wave = tid >> 6, lane = tid & 63, i16 = lane & 15, g = lane >> 4, cb = wave & 3, half = wave >> 2;
    const LaneOffs lo = lane_offs(lane);
    LAS float* btab = (LAS float*)(lds + MISC_OFF + 4096);
    LAS float* mbuf = (LAS float*)lds;
    const int wc0 = (cb == 0) ? 0 : (cb == 1) ? 8 : (cb == 2) ? 24 : 32;
    const int c = 16 * cb + i16, cs = min(max(c - 8, 0), 48);
#pragma unroll 1
    for (int k = 0; k < 16; ++k) {
        const int u = bid * 16 + k, h = u >> 8, r = u & 255, r0 = min(max(r - 4, 0), 248);
        __syncthreads();
#pragma unroll
        for (int kk = 0; kk < 8; ++kk) { const int id = tid + 512 * kk, row = id >> 3, ch = id & 7; const unsigned off = (unsigned)(row * 128 + ((ch ^ (row & 7)) << 4));
            const bf16* src = H + (size_t)(r0 * 64 + row) * ODD_IN + 1024 + h * 64 + ch * 8;
            *(LAS u32x4*)(lds + off) = *(const u32x4*)src; *(LAS u32x4*)(lds + 65536 + off) = *(const u32x4*)(src + 1024); }
        if (tid < 465) btab[tid] = rpb[h * 465 + tid];
        __syncthreads();
        const int tokq = r * 64 + c;
        const bf16* qp = H + (size_t)tokq * ODD_IN + h * 64 + 8 * g;
        const bf16x8 q0 = *(const bf16x8*)qp, q1 = *(const bf16x8*)(qp + 32);
        SmState st; sm_init(st);
#pragma unroll 1
        for (int tt = 0; tt < 4; ++tt) {
            const int krl = 4 * half + tt; const unsigned tb = (unsigned)((krl * 64 + wc0) * 128);
            f32x4 sa[2]; qk_tile(lds + tb, lo, q0, q1, sa);
            const int brow = (r0 + krl - r + 7) * 31 - c + 15;
#pragma unroll
            for (int a = 0; a < 2; ++a)
#pragma unroll
                for (int rg = 0; rg < 4; ++rg) { const int col = wc0 + 16 * a + 4 * g + rg; const bool ok = (col >= cs) && (col < cs + 16);
                    const float bias = btab[ok ? (brow + col) : 0];
                    sa[a][rg] = ok ? (sa[a][rg] + bias) * 1.4426950408889634f : -INFINITY; }
            sm_step(st, sa, lds + 65536 + tb, lo);
        }
        float l = st.l; l += shx(l, 16); l += shx(l, 32);
        __syncthreads();
        if (half == 1) { LAS float* mb = mbuf + ((wave - 4) * 64 + lane) * 20; mb[0] = st.m; mb[1] = l;
#pragma unroll
            for (int dt = 0; dt < 4; ++dt) *(LAS f32x4*)(mb + 4 + 4 * dt) = st.o[dt]; }
        __syncthreads();
        if (half == 0) { const LAS float* mb = mbuf + (wave * 64 + lane) * 20; const float m2 = mb[0], l2 = mb[1];
            const float M = fmaxf(st.m, m2), a1 = exp2f(st.m - M), a2 = exp2f(m2 - M); const float inv = 1.0f / (l * a1 + l2 * a2);
            bf16* op = Y + (size_t)tokq * D + h * 64 + 4 * g;
#pragma unroll
            for (int dt = 0; dt < 4; ++dt) { const f32x4 o2 = *(const LAS f32x4*)(mb + 4 + 4 * dt); const f32x4 o = (st.o[dt] * a1 + o2 * a2) * inv;
                u32x2 w; w.x = cvt_pk_bf16(o[0], o[1]); w.y = cvt_pk_bf16(o[2], o[3]); *(u32x2*)(op + 16 * dt) = w; } }
    }
}

__device__ __forceinline__ void ret_issue(const bf16* H, int u, int tid, u32x4 (&kr)[2], u32x4 (&vr)[2]) {
    const int h = u >> 7, n = u & 127;
#pragma unroll
    for (int k = 0; k < 2; ++k) { const int id = tid + 512 * k, row = id >> 3, c = id & 7; const bf16* src = H + (size_t)(n * 128 + row) * EVEN_IN + 512 + h * 64 + c * 8;
        kr[k] = *(const u32x4*)src; vr[k] = *(const u32x4*)(src + 512); }
}
__device__ __forceinline__ void ret_commit(LAS unsigned char* buf, int tid, const u32x4 (&kr)[2], const u32x4 (&vr)[2]) {
#pragma unroll
    for (int k = 0; k < 2; ++k) { const int id = tid + 512 * k, row = id >> 3, c = id & 7; const unsigned off = (unsigned)(row * 128 + ((c ^ (row & 7)) << 4));
        *(LAS u32x4*)(buf + off) = kr[k]; *(LAS u32x4*)(buf + 16384 + off) = vr[k]; }
}
__device__ __forceinline__ void phase_ret_out_mfma(LAS unsigned char* lds, const bf16* H, const bf16* RT, const float* decay, bf16* Y, int bid, int tid) {
    const int wave = tid >> 6, lane = tid & 63, i16 = lane & 15, g = lane >> 4;
    const LaneOffs lo = lane_offs(lane);
    u32x4 kr[2], vr[2];
    __syncthreads();
    ret_issue(H, bid, tid, kr, vr); ret_commit(lds, tid, kr, vr);
    __syncthreads();
    int it = 0;
    bf16x8 nq0, nq1;
    { const bf16* qp = H + (size_t)((bid & 127) * 128 + 16 * wave + i16) * EVEN_IN + (bid >> 7) * 64 + 8 * g; nq0 = *(const bf16x8*)qp; nq1 = *(const bf16x8*)(qp + 32); }
    for (int u = bid; u < 1024; u += GRID, ++it) {
        LAS unsigned char* buf = lds + (it & 1) * 32768;
        const bool has_next = (u + GRID) < 1024;
        if (has_next) ret_issue(H, u + GRID, tid, kr, vr);
        const int h = u >> 7, n = u & 127;
        const float lgf = log2_gamma(decay[h]), lgb = log2_gamma(decay[8 + h]);
        const int c = 16 * wave + i16, tok = n * 128 + c;
        const bf16x8 q0 = nq0, q1 = nq1;
        if (has_next) { const int u2 = u + GRID; const bf16* qp = H + (size_t)((u2 & 127) * 128 + c) * EVEN_IN + (u2 >> 7) * 64 + 8 * g; nq0 = *(const bf16x8*)qp; nq1 = *(const bf16x8*)(qp + 32); }
        f32x4 of[4], ob[4];
#pragma unroll
        for (int dt = 0; dt < 4; ++dt) { of[dt] = (f32x4){0.f, 0.f, 0.f, 0.f}; ob[dt] = of[dt]; }
#pragma unroll 1
        for (int t = 0; t < 4; ++t) {
            f32x4 sa[2]; qk_tile(buf + t * 4096, lo, q0, q1, sa);
            f32x4 pf[2], pb[2];
#pragma unroll
            for (int a = 0; a < 2; ++a)
#pragma unroll
                for (int rg = 0; rg < 4; ++rg) { const int m = 32 * t + 16 * a + 4 * g + rg; const float df = (float)(c - m);
                    pf[a][rg] = (m <= c) ? sa[a][rg] * exp2f(lgf * df) : 0.0f; pb[a][rg] = (m > c) ? sa[a][rg] * exp2f(-lgb * df) : 0.0f; }
            if (32 * t <= 16 * wave + 15) pv_tile(buf + 16384 + t * 4096, lo, pf[0], pf[1], of);
            if (32 * t + 31 > 16 * wave) pv_tile(buf + 16384 + t * 4096, lo, pb[0], pb[1], ob);
        }
        const bf16* rtf = RT + ((size_t)(h) * 128 + n) * 4096 + i16 * 64 + 8 * g; const bf16* rtb = RT + ((size_t)(8 + h) * 128 + n) * 4096 + i16 * 64 + 8 * g;
        const float xif = exp2f(lgf * (float)(c + 1)), xib = exp2f(lgb * (float)(128 - c));
#pragma unroll
        for (int et = 0; et < 4; ++et) {
            f32x4 cf = {0.f, 0.f, 0.f, 0.f}, cb = cf;
            cf = __builtin_amdgcn_mfma_f32_16x16x32_bf16(*(const bf16x8*)(rtf + et * 1024), q0, cf, 0, 0, 0); cf = __builtin_amdgcn_mfma_f32_16x16x32_bf16(*(const bf16x8*)(rtf + et * 1024 + 32), q1, cf, 0, 0, 0);
            cb = __builtin_amdgcn_mfma_f32_16x16x32_bf16(*(const bf16x8*)(rtb + et * 1024), q0, cb, 0, 0, 0); cb = __builtin_amdgcn_mfma_f32_16x16x32_bf16(*(const bf16x8*)(rtb + et * 1024 + 32), q1, cb, 0, 0, 0);
            of[et] += cf * xif; ob[et] += cb * xib;
        }
        float sf = 0.f, sb = 0.f;
#pragma unroll
        for (int dt = 0; dt < 4; ++dt) { sf += (of[dt][0] + of[dt][1]) + (of[dt][2] + of[dt][3]); sb += (ob[dt][0] + ob[dt][1]) + (ob[dt][2] + ob[dt][3]); }
        sf += shx(sf, 16); sf += shx(sf, 32); sb += shx(sb, 16); sb += shx(sb, 32);
        const float muf = sf * (1.0f / 64.0f), mub = sb * (1.0f / 64.0f);
        float vfq = 0.f, vbq = 0.f;
#pragma unroll
        for (int dt = 0; dt < 4; ++dt) { of[dt] = of[dt] - muf; ob[dt] = ob[dt] - mub;
            vfq += (of[dt][0] * of[dt][0] + of[dt][1] * of[dt][1]) + (of[dt][2] * of[dt][2] + of[dt][3] * of[dt][3]);
            vbq += (ob[dt][0] * ob[dt][0] + ob[dt][1] * ob[dt][1]) + (ob[dt][2] * ob[dt][2] + ob[dt][3] * ob[dt][3]); }
        vfq += shx(vfq, 16); vfq += shx(vfq, 32); vbq += shx(vbq, 16); vbq += shx(vbq, 32);
        const float rsf = 1.0f / sqrtf(vfq * (1.0f / 64.0f) + GN_EPS), rsb = 1.0f / sqrtf(vbq * (1.0f / 64.0f) + GN_EPS);
        const bf16* gp = H + (size_t)tok * EVEN_IN + 1536 + h * 64 + 4 * g;
        bf16* yp = Y + (size_t)tok * D + h * 64 + 4 * g;
#pragma unroll
        for (int dt = 0; dt < 4; ++dt) {
            const u32x2 wf = *(const u32x2*)(gp + 16 * dt), wb = *(const u32x2*)(gp + 512 + 16 * dt);
            const f32x4 gf = {bflo(wf.x), bfhi(wf.x), bflo(wf.y), bfhi(wf.y)}, gb = {bflo(wb.x), bfhi(wb.x), bflo(wb.y), bfhi(wb.y)};
            f32x4 y;
#pragma unroll
            for (int j = 0; j < 4; ++j) y[j] = gf[j] * sigmoidf_(gf[j]) * (of[dt][j] * rsf) + gb[j] * sigmoidf_(gb[j]) * (ob[dt][j] * rsb);
            u32x2 w; w.x = cvt_pk_bf16(y[0], y[1]); w.y = cvt_pk_bf16(y[2], y[3]); *(u32x2*)(yp + 16 * dt) = w;
        }
        if (has_next) ret_commit(lds + ((it + 1) & 1) * 32768, tid, kr, vr);
        __syncthreads();
    }
}

template <int NT> __device__ __forceinline__ void sf_finish(f32x4 (&sc)[NT][2], const unsigned (&vt)[NT], const LaneOffs& lo, f32x4 (&o)[4], float& m_out, float& l_out) {
    float m = -1e30f;
#pragma unroll
    for (int t = 0; t < NT; ++t)
#pragma unroll
        for (int a = 0; a < 2; ++a) m = fmaxf(m, fmaxf(fmaxf(sc[t][a][0], sc[t][a][1]), fmaxf(sc[t][a][2], sc[t][a][3])));
    m = fmaxf(m, shx(m, 16)); m = fmaxf(m, shx(m, 32));
    float l = 0.f;
#pragma unroll
    for (int t = 0; t < NT; ++t)
#pragma unroll
        for (int a = 0; a < 2; ++a)
#pragma unroll
            for (int r = 0; r < 4; ++r) { sc[t][a][r] = exp2f(sc[t][a][r] - m); l += sc[t][a][r]; }
#pragma unroll
    for (int dt = 0; dt < 4; ++dt) o[dt] = (f32x4){0.f, 0.f, 0.f, 0.f};
#pragma unroll
    for (int t = 0; t < NT; ++t) {
        s16x4 r[8]; tr_read8(vt[t] + lo.v[0], vt[t] + lo.v[1], vt[t] + lo.v[2], vt[t] + lo.v[3], r);
        u32x4 pw;
        asm volatile("v_cvt_pk_bf16_f32 %0, %4, %5\n\tv_cvt_pk_bf16_f32 %1, %6, %7\n\tv_cvt_pk_bf16_f32 %2, %8, %9\n\tv_cvt_pk_bf16_f32 %3, %10, %11\n\ts_nop 1"
                     : "=&v"(pw.x), "=&v"(pw.y), "=&v"(pw.z), "=&v"(pw.w) : "v"(sc[t][0][0]), "v"(sc[t][0][1]), "v"(sc[t][0][2]), "v"(sc[t][0][3]), "v"(sc[t][1][0]), "v"(sc[t][1][1]), "v"(sc[t][1][2]), "v"(sc[t][1][3]));
        const bf16x8 pb = __builtin_bit_cast(bf16x8, pw);
#pragma unroll
        for (int dt = 0; dt < 4; ++dt) { const bf16x8 va = __builtin_shufflevector(r[2 * dt], r[2 * dt + 1], 0, 1, 2, 3, 4, 5, 6, 7); o[dt] = __builtin_amdgcn_mfma_f32_16x16x32_bf16(va, pb, o[dt], 0, 0, 0); }
    }
    l += shx(l, 16); l += shx(l, 32);
    m_out = m; l_out = l;
}

__device__ __forceinline__ void phase_dilated_sf(LAS unsigned char* lds, const bf16* H, bf16* OG, float* LSE, int bid, int tid) {
    const int wave = tid >> 6, lane = tid & 63, i16 = lane & 15, g = lane >> 4;
    const LaneOffs lo = lane_offs(lane);
    u32x4 kr[4], vr[4];
    __syncthreads();
    dil_issue(H, bid, tid, kr, vr); dil_commit(lds, tid, kr, vr);
    __syncthreads();
    int it = 0;
    bf16x8 nq0, nq1;
    { int h, b, r, blk; dil_decode(bid, h, b, r, blk); const bf16* qp = H + (size_t)(r + ((128 * blk + 16 * wave + i16) << (2 * b))) * EVEN_IN + 2560 + h * 64 + 8 * g; nq0 = *(const bf16x8*)qp; nq1 = *(const bf16x8*)(qp + 32); }
    for (int u = bid; u < DIL_UNITS; u += GRID, ++it) {
        LAS unsigned char* buf = lds + (it & 1) * 65536;
        const bool has_next = (u + GRID) < DIL_UNITS;
        if (has_next) dil_issue(H, u + GRID, tid, kr, vr);
        int h, b, r, blk; dil_decode(u, h, b, r, blk); const int Lc = T >> (2 * b), base = 128 * blk - 64;
        const int ql = 16 * wave + i16, tokq = r + ((128 * blk + ql) << (2 * b));
        const bf16x8 q0 = nq0, q1 = nq1;
        if (has_next) { int h2, b2, r2, blk2; dil_decode(u + GRID, h2, b2, r2, blk2); const bf16* qp = H + (size_t)(r2 + ((128 * blk2 + ql) << (2 * b2))) * EVEN_IN + 2560 + h2 * 64 + 8 * g; nq0 = *(const bf16x8*)qp; nq1 = *(const bf16x8*)(qp + 32); }
        const int t0 = wave >> 1;
        f32x4 sc[5][2]; unsigned vt[5];
#pragma unroll
        for (int tt = 0; tt < 5; ++tt) { const int t = t0 + tt; qk_tile(buf + t * 4096, lo, q0, q1, sc[tt]); vt[tt] = lds_addr(buf + 32768 + t * 4096);
#pragma unroll
            for (int a = 0; a < 2; ++a)
#pragma unroll
                for (int rg = 0; rg < 4; ++rg) { const int kl = 32 * t + 16 * a + 4 * g + rg, ki = base + kl; const bool ok = (kl >= ql) && (kl <= ql + 128) && (ki >= 0) && (ki < Lc);
                    sc[tt][a][rg] = ok ? sc[tt][a][rg] * 1.4426950408889634f : -INFINITY; } }
        f32x4 o[4]; float m, l; sf_finish<5>(sc, vt, lo, o, m, l);
        const float inv = 1.0f / l;
        bf16* op = OG + ((size_t)b * T + tokq) * 512 + h * 64 + 4 * g;
#pragma unroll
        for (int dt = 0; dt < 4; ++dt) { const f32x4 ov = o[dt] * inv; u32x2 w; w.x = cvt_pk_bf16(ov[0], ov[1]); w.y = cvt_pk_bf16(ov[2], ov[3]); *(u32x2*)(op + 16 * dt) = w; }
        if (g == 0) LSE[((size_t)b * T + tokq) * 8 + h] = (m + log2f(l)) * 0.6931471805599453f;
        if (has_next) dil_commit(lds + ((it + 1) & 1) * 65536, tid, kr, vr);
        __syncthreads();
    }
}

__device__ __forceinline__ int na_r0(int r) { return min(max(r - 4, 0), 248); }
__device__ __forceinline__ void na_issue(const bf16* H, int h, int row_lo, int nrows, int tid, u32x4 (&pr)[4]) {
#pragma unroll
    for (int k = 0; k < 4; ++k) { const int id = tid + 512 * k, which = id >> 10, rs = (id >> 9) & 1, key = (id >> 3) & 63, ch = id & 7;
        if (rs < nrows) pr[k] = *(const u32x4*)(H + (size_t)((row_lo + rs) * 64 + key) * ODD_IN + 1024 + which * 1024 + h * 64 + ch * 8); }
}
__device__ __forceinline__ void na_commit(LAS unsigned char* lds, int row_lo, int nrows, int tid, const u32x4 (&pr)[4]) {
#pragma unroll
    for (int k = 0; k < 4; ++k) { const int id = tid + 512 * k, which = id >> 10, rs = (id >> 9) & 1, key = (id >> 3) & 63, ch = id & 7;
        if (rs < nrows) *(LAS u32x4*)(lds + which * 73728 + ((row_lo + rs) % 9) * 8192 + key * 128 + ((ch ^ (key & 7)) << 4)) = pr[k]; }
}
__device__ __forceinline__ void phase_natten_sf(LAS unsigned char* lds, const bf16* H, const float* rpb, bf16* Y, int bid, int tid) {
    const int wave = tid >> 6, lane = tid & 63, i16 = lane & 15, g = lane >> 4, cb = wave & 3, rq = wave >> 2;
    const LaneOffs lo = lane_offs(lane);
    LAS float* btab = (LAS float*)(lds + MISC_OFF + 4096);
    const int wc0 = (cb == 0) ? 0 : (cb == 1) ? 8 : (cb == 2) ? 24 : 32;
    const int c = 16 * cb + i16, cs = min(max(c - 8, 0), 48);
    const int h = bid >> 4, rbase = (bid & 15) * 16;
    __syncthreads();
    if (tid < 465) btab[tid] = rpb[h * 465 + tid];
    u32x4 pr[4];
    {
        const int wlo = na_r0(rbase), whi = na_r0(rbase + 1) + 7;
        u32x4 p5[5][4];
#pragma unroll
        for (int i = 0; i < 5; ++i) { const int rr = wlo + 2 * i; na_issue(H, h, rr, min(2, max(whi - rr + 1, 0)), tid, p5[i]); }
#pragma unroll
        for (int i = 0; i < 5; ++i) { const int rr = wlo + 2 * i; na_commit(lds, rr, min(2, max(whi - rr + 1, 0)), tid, p5[i]); }
    }
    bf16x8 nq0, nq1;
    { const bf16* qp = H + (size_t)((rbase + rq) * 64 + c) * ODD_IN + h * 64 + 8 * g; nq0 = *(const bf16x8*)qp; nq1 = *(const bf16x8*)(qp + 32); }
    __syncthreads();
#pragma unroll 1
    for (int k = 0; k < 8; ++k) {
        const int r = rbase + 2 * k, rme = r + rq, r0 = na_r0(rme);
        const int whi = na_r0(r + 1) + 7, nhi = (k < 7) ? (na_r0(r + 3) + 7) : whi, nnew = nhi - whi;
        if (nnew > 0) na_issue(H, h, whi + 1, nnew, tid, pr);
        const int tokq = rme * 64 + c;
        const bf16x8 q0 = nq0, q1 = nq1;
        if (k < 7) { const bf16* qp = H + (size_t)(tokq + 128) * ODD_IN + h * 64 + 8 * g; nq0 = *(const bf16x8*)qp; nq1 = *(const bf16x8*)(qp + 32); }
        f32x4 sc[8][2]; unsigned vt[8];
#pragma unroll
        for (int t = 0; t < 8; ++t) { const int kr = r0 + t; const unsigned tb = (unsigned)((kr % 9) * 8192 + wc0 * 128);
            qk_tile(lds + tb, lo, q0, q1, sc[t]); vt[t] = lds_addr(lds + 73728 + tb);
            const int brow = (kr - rme + 7) * 31 - c + 15;
#pragma unroll
            for (int a = 0; a < 2; ++a)
#pragma unroll
                for (int rg = 0; rg < 4; ++rg) { const int col = wc0 + 16 * a + 4 * g + rg; const bool ok = (col >= cs) && (col < cs + 16);
                    const float bias = btab[ok ? (brow + col) : 0];
                    sc[t][a][rg] = ok ? (sc[t][a][rg] + bias) * 1.4426950408889634f : -INFINITY; } }
        f32x4 o[4]; float m, l; sf_finish<8>(sc, vt, lo, o, m, l);
        const float inv = 1.0f / l;
        bf16* op = Y + (size_t)tokq * D + h * 64 + 4 * g;
#pragma unroll
        for (int dt = 0; dt < 4; ++dt) { const f32x4 ov = o[dt] * inv; u32x2 w; w.x = cvt_pk_bf16(ov[0], ov[1]); w.y = cvt_pk_bf16(ov[2], ov[3]); *(u32x2*)(op + 16 * dt) = w; }
        __syncthreads();
        if (nnew > 0) na_commit(lds, whi + 1, nnew, tid, pr);
        __syncthreads();
    }
}

__device__ __forceinline__ void phase_ln1_router(LAS unsigned char* lds, const float* U, const float* lng, const float* lnb, const float* rw, const float* rbias,
                                                 float* X1, bf16* X1b, int* tope, float* gate, int* lrank, int* cnt, int bid, int tid) {
    const int wave = tid >> 6, lane = tid & 63;
    LAS int* lcnt = (LAS int*)(lds + MISC_OFF + 1024);
    __syncthreads();
    for (int idx = tid; idx < 1024 * 8; idx += NTHR) { const int d = idx >> 3, c = idx & 7;
        *(LAS f32x4*)(lds + d * 128 + ((c ^ ((d >> 1) & 7)) << 4)) = *(const f32x4*)(rw + d * 32 + c * 4); }
    if (tid < 32) lcnt[tid] = 0;
    __syncthreads();
    float gg[16], bb[16];
#pragma unroll
    for (int i = 0; i < 16; ++i) { gg[i] = lng[64 * i + lane]; bb[i] = lnb[64 * i + lane]; }
    const float rbe = rbias[lane >> 1];
    for (int rr = 0; rr < 8; ++rr) {
        const int row = bid * 64 + wave * 8 + rr;
        float x[16]; float s = 0.f;
#pragma unroll
        for (int i = 0; i < 16; ++i) { x[i] = U[(size_t)row * D + 64 * i + lane]; s += x[i]; }
        const float mean = wave_sum(s) * (1.0f / D); float s2 = 0.f;
#pragma unroll
        for (int i = 0; i < 16; ++i) { x[i] -= mean; s2 += x[i] * x[i]; }
        const float rstd = 1.0f / sqrtf(wave_sum(s2) * (1.0f / D) + LN_EPS);
#pragma unroll
        for (int i = 0; i < 16; ++i) { x[i] = x[i] * rstd * gg[i] + bb[i]; X1[(size_t)row * D + 64 * i + lane] = x[i]; X1b[(size_t)row * D + 64 * i + lane] = (bf16)f2bf(x[i]); }
        float acc[32];
#pragma unroll
        for (int e = 0; e < 32; ++e) acc[e] = 0.f;
#pragma unroll
        for (int i = 0; i < 16; ++i) { const int d = 64 * i + lane;
#pragma unroll
            for (int c = 0; c < 8; ++c) { const f32x4 w = *(const LAS f32x4*)(lds + d * 128 + ((c ^ ((d >> 1) & 7)) << 4));
                acc[4 * c] += x[i] * w[0]; acc[4 * c + 1] += x[i] * w[1]; acc[4 * c + 2] += x[i] * w[2]; acc[4 * c + 3] += x[i] * w[3]; } }
#pragma unroll
        for (int t = 0; t < 16; ++t) { const bool up = (lane & 32) != 0; const float snd = up ? acc[t] : acc[t + 16]; const float rcv = shx(snd, 32); acc[t] = (up ? acc[t + 16] : acc[t]) + rcv; }
#pragma unroll
        for (int t = 0; t < 8; ++t) { const bool up = (lane & 16) != 0; const float snd = up ? acc[t] : acc[t + 8]; const float rcv = shx(snd, 16); acc[t] = (up ? acc[t + 8] : acc[t]) + rcv; }
#pragma unroll
        for (int t = 0; t < 4; ++t) { const bool up = (lane & 8) != 0; const float snd = up ? acc[t] : acc[t + 4]; const float rcv = shx(snd, 8); acc[t] = (up ? acc[t + 4] : acc[t]) + rcv; }
#pragma unroll
        for (int t = 0; t < 2; ++t) { const bool up = (lane & 4) != 0; const float snd = up ? acc[t] : acc[t + 2]; const float rcv = shx(snd, 4); acc[t] = (up ? acc[t + 2] : acc[t]) + rcv; }
        { const bool up = (lane & 2) != 0; const float snd = up ? acc[0] : acc[1]; const float rcv = shx(snd, 2); acc[0] = (up ? acc[1] : acc[0]) + rcv; }
        float lv = acc[0] + shx(acc[0], 1) + rbe;
        const int me = lane >> 1;
        float tv[4]; int ti[4];
#pragma unroll
        for (int k = 0; k < 4; ++k) {
            float bv = lv; int bi = me;
#pragma unroll
            for (int o = 32; o >= 1; o >>= 1) { const float ov = shx(bv, o); const int oi = shx(bi, o); if (ov > bv || (ov == bv && oi < bi)) { bv = ov; bi = oi; } }
            tv[k] = bv; ti[k] = bi; if (me == bi) lv = -INFINITY;
        }
        const float p1 = expf(tv[1] - tv[0]), p2 = expf(tv[2] - tv[0]), p3 = expf(tv[3] - tv[0]); const float inv = 1.0f / (1.0f + p1 + p2 + p3);
        if (lane < 4) {
            const int e = (lane == 0) ? ti[0] : (lane == 1) ? ti[1] : (lane == 2) ? ti[2] : ti[3];
            const float gk = ((lane == 0) ? 1.0f : (lane == 1) ? p1 : (lane == 2) ? p2 : p3) * inv;
            const int rk = __hip_atomic_fetch_add(lcnt + e, 1, __ATOMIC_RELAXED, __HIP_MEMORY_SCOPE_WORKGROUP);
            tope[row * 4 + lane] = e; gate[row * 4 + lane] = gk; lrank[row * 4 + lane] = rk;
        }
    }
    __syncthreads();
    if (tid < 32) cnt[bid * 32 + tid] = lcnt[tid];
}

__device__ __forceinline__ void phase_ln1_router_mfma(LAS unsigned char* lds, const float* U, const float* lng, const float* lnb, const bf16* rwt, const float* rbias,
                                                      float* X1, bf16* X1b, bf16* X1lo, int* tope, float* gate, int* lrank, int* cnt, int bid, int tid) {
    const int wave = tid >> 6, lane = tid & 63, i16 = lane & 15, g = lane >> 4;
    LAS int* lcnt = (LAS int*)(lds + MISC_OFF + 1024);
    LAS float* pbuf = (LAS float*)lds;
    __syncthreads();
    if (tid < 32) lcnt[tid] = 0;
    {   f32x4 gg[4], bb[4];
#pragma unroll
        for (int j = 0; j < 4; ++j) { gg[j] = *(const f32x4*)(lng + 256 * j + 4 * lane); bb[j] = *(const f32x4*)(lnb + 256 * j + 4 * lane); }
#pragma unroll 2
        for (int rr = 0; rr < 8; ++rr) {
            const size_t ro = (size_t)(bid * 64 + wave * 8 + rr) * D + 4 * lane;
            f32x4 v[4]; float s = 0.f;
#pragma unroll
            for (int j = 0; j < 4; ++j) { v[j] = *(const f32x4*)(U + ro + 256 * j); s += (v[j][0] + v[j][1]) + (v[j][2] + v[j][3]); }
            const float mean = wave_sum(s) * (1.0f / D); float s2 = 0.f;
#pragma unroll
            for (int j = 0; j < 4; ++j) { v[j] = v[j] - mean; s2 += (v[j][0] * v[j][0] + v[j][1] * v[j][1]) + (v[j][2] * v[j][2] + v[j][3] * v[j][3]); }
            const float rstd = 1.0f / sqrtf(wave_sum(s2) * (1.0f / D) + LN_EPS);
#pragma unroll
            for (int j = 0; j < 4; ++j) { const f32x4 o = v[j] * rstd * gg[j] + bb[j]; *(f32x4*)(X1 + ro + 256 * j) = o;
                const unsigned h0 = f2bf(o[0]), h1 = f2bf(o[1]), h2 = f2bf(o[2]), h3 = f2bf(o[3]);
                u32x2 wh; wh.x = h0 | (h1 << 16); wh.y = h2 | (h3 << 16); *(u32x2*)(X1b + ro + 256 * j) = wh;
                u32x2 wl; wl.x = pk2(o[0] - __builtin_bit_cast(float, h0 << 16), o[1] - __builtin_bit_cast(float, h1 << 16)); wl.y = pk2(o[2] - __builtin_bit_cast(float, h2 << 16), o[3] - __builtin_bit_cast(float, h3 << 16));
                *(u32x2*)(X1lo + ro + 256 * j) = wl; }
        }
    }
    asm volatile("s_waitcnt vmcnt(0)" ::: "memory");
    __syncthreads();
    const int rt = wave & 3, kh = wave >> 2;
    f32x4 acc[2]; acc[0] = (f32x4){0.f, 0.f, 0.f, 0.f}; acc[1] = acc[0];
    {   const size_t ao = (size_t)(bid * 64 + rt * 16 + i16) * D + kh * 512 + 8 * g;
        const bf16* bh = rwt + (size_t)i16 * D + kh * 512 + 8 * g; const bf16* bl = bh + (size_t)NEXP * D;
#pragma unroll 4
        for (int s = 0; s < 16; ++s) {
            const bf16x8 ah = *(const bf16x8*)(X1b + ao + 32 * s), al = *(const bf16x8*)(X1lo + ao + 32 * s);
#pragma unroll
            for (int et = 0; et < 2; ++et) { const bf16x8 wh = *(const bf16x8*)(bh + (size_t)et * 16 * D + 32 * s), wl = *(const bf16x8*)(bl + (size_t)et * 16 * D + 32 * s);
                acc[et] = __builtin_amdgcn_mfma_f32_16x16x32_bf16(ah, wh, acc[et], 0, 0, 0); acc[et] = __builtin_amdgcn_mfma_f32_16x16x32_bf16(ah, wl, acc[et], 0, 0, 0); acc[et] = __builtin_amdgcn_mfma_f32_16x16x32_bf16(al, wh, acc[et], 0, 0, 0); }
        }
    }
    if (kh == 1) { LAS f32x4* pb = (LAS f32x4*)(pbuf + ((wave - 4) * 64 + lane) * 8); pb[0] = acc[0]; pb[1] = acc[1]; }
    __syncthreads();
    if (kh == 0) {
        const LAS f32x4* pb = (const LAS f32x4*)(pbuf + (wave * 64 + lane) * 8);
        const float b0 = rbias[i16], b1 = rbias[16 + i16];
        const f32x4 l0 = acc[0] + pb[0] + b0, l1 = acc[1] + pb[1] + b1;
#pragma unroll
        for (int reg = 0; reg < 4; ++reg) {
            float v0 = l0[reg], v1 = l1[reg]; float tv[4]; int ti[4];
#pragma unroll
            for (int k = 0; k < 4; ++k) {
                float bv = (v0 >= v1) ? v0 : v1; int bi = (v0 >= v1) ? i16 : 16 + i16;
#pragma unroll
                for (int o = 1; o < 16; o <<= 1) { const float ov = shx(bv, o); const int oi = shx(bi, o); if (ov > bv || (ov == bv && oi < bi)) { bv = ov; bi = oi; } }
                tv[k] = bv; ti[k] = bi; if (bi == i16) v0 = -INFINITY; if (bi == 16 + i16) v1 = -INFINITY;
            }
            const float p1 = expf(tv[1] - tv[0]), p2 = expf(tv[2] - tv[0]), p3 = expf(tv[3] - tv[0]); const float inv = 1.0f / (1.0f + p1 + p2 + p3);
            if (i16 < 4) {
                const int row = bid * 64 + rt * 16 + 4 * g + reg;
                const int e = (i16 == 0) ? ti[0] : (i16 == 1) ? ti[1] : (i16 == 2) ? ti[2] : ti[3];
                const float gk = ((i16 == 0) ? 1.0f : (i16 == 1) ? p1 : (i16 == 2) ? p2 : p3) * inv;
                const int rk = __hip_atomic_fetch_add(lcnt + e, 1, __ATOMIC_RELAXED, __HIP_MEMORY_SCOPE_WORKGROUP);
                tope[row * 4 + i16] = e; gate[row * 4 + i16] = gk; lrank[row * 4 + i16] = rk;
            }
        }
    }
    __syncthreads();
    if (tid < 32) cnt[bid * 32 + tid] = lcnt[tid];
}

__device__ __forceinline__ void phase_dispatch(LAS unsigned char* lds, const int* cnt, const int* tope, const int* lrank, int* slot, int* tiles, int* rowidx, int bid, int tid) {
    LAS int* tot = (LAS int*)(lds + MISC_OFF + 1024); LAS int* pre = tot + 32; LAS int* pst = pre + 32;
    __syncthreads();
    if (tid < 32) { int t = 0, p = 0; for (int b2 = 0; b2 < GRID; ++b2) { const int v = cnt[b2 * 32 + tid]; t += v; p += (b2 < bid) ? v : 0; } tot[tid] = t; pre[tid] = p; }
    __syncthreads();
    if (tid == 0) { int ps = 0;
#pragma unroll 1
        for (int e = 0; e < NEXP; ++e) { pst[e] = ps; ps += ((tot[e] + 255) >> 8) << 8; }
        pst[NEXP] = ps; }
    __syncthreads();
    if (bid == 0 && tid < 1 + MAXTILES) {
        if (tid == 0) tiles[0] = pst[NEXP] >> 8;
        else { const int i = tid - 1; int ee = 0;
#pragma unroll 1
            for (int e = 0; e < NEXP; ++e) ee = ((pst[e] >> 8) <= i) ? e : ee;
            tiles[tid] = ee; }
    }
    if (bid < NEXP) { const int e = bid, lo = pst[e] + tot[e], hi = pst[e + 1]; for (int i = lo + tid; i < hi; i += NTHR) rowidx[i] = 0; }
    if (tid < 256) { const int row = bid * 64 + (tid >> 2), k = tid & 3; const int e = tope[row * 4 + k]; const int dest = pst[e] + pre[e] + lrank[row * 4 + k]; slot[row * 4 + k] = dest; rowidx[dest] = row; }
}

__device__ __forceinline__ void phase_combine_ln2(const float* X1, const bf16* Oslot, const int* slot, const float* gate, const float* lng, const float* lnb, float* Xout, bf16* Xb, int bid, int tid) {
    const int wave = tid >> 6, lane = tid & 63;
    f32x4 gg[4], bb[4];
#pragma unroll
    for (int j = 0; j < 4; ++j) { gg[j] = *(const f32x4*)(lng + 256 * j + 4 * lane); bb[j] = *(const f32x4*)(lnb + 256 * j + 4 * lane); }
    for (int rr = 0; rr < 8; ++rr) {
        const int row = bid * 64 + wave * 8 + rr;
        f32x4 v[4];
#pragma unroll
        for (int j = 0; j < 4; ++j) v[j] = *(const f32x4*)(X1 + (size_t)row * D + 256 * j + 4 * lane) * ALPHA;
#pragma unroll
        for (int k = 0; k < 4; ++k) { const int s = slot[row * 4 + k]; const float g = gate[row * 4 + k];
#pragma unroll
            for (int j = 0; j < 4; ++j) { const u32x2 w = *(const u32x2*)(Oslot + (size_t)s * D + 256 * j + 4 * lane); v[j] += (f32x4){bflo(w.x), bfhi(w.x), bflo(w.y), bfhi(w.y)} * g; } }
        float s = 0.f;
#pragma unroll
        for (int j = 0; j < 4; ++j) s += (v[j][0] + v[j][1]) + (v[j][2] + v[j][3]);
        const float mean = wave_sum(s) * (1.0f / D); float s2 = 0.f;
#pragma unroll
        for (int j = 0; j < 4; ++j) { v[j] = v[j] - mean; s2 += (v[j][0] * v[j][0] + v[j][1] * v[j][1]) + (v[j][2] * v[j][2] + v[j][3] * v[j][3]); }
        const float rstd = 1.0f / sqrtf(wave_sum(s2) * (1.0f / D) + LN_EPS);
#pragma unroll
        for (int j = 0; j < 4; ++j) { const f32x4 o = v[j] * rstd * gg[j] + bb[j]; *(f32x4*)(Xout + (size_t)row * D + 256 * j + 4 * lane) = o;
            if (Xb) { u32x2 w; w.x = pk2(o[0], o[1]); w.y = pk2(o[2], o[3]); *(u32x2*)(Xb + (size_t)row * D + 256 * j + 4 * lane) = w; } }
    }
}

constexpr int NPH = 10, N_PHASES = 1 + DEPTH * NPH;
struct Args { Ptrs p; int ph_lo, ph_hi; };
static_assert(sizeof(Args) == 17 * 8 + 8, "Args has no padding");
typedef __attribute__((address_space(4))) const Args CArgs;

__global__ void __launch_bounds__(NTHR, 2) fwd_kernel(Args args) {
    extern __shared__ __attribute__((aligned(16))) unsigned char lds_raw[];
    LAS unsigned char* lds0 = (LAS unsigned char*)lds_raw;
    const int tid0 = threadIdx.x, bid0 = blockIdx.x; const int wave0 = __builtin_amdgcn_readfirstlane(tid0 >> 6);
    const int lo = args.ph_lo, hi = args.ph_hi;
    volatile LAS unsigned* MISC = (volatile LAS unsigned*)(lds0 + MISC_OFF);
    if (tid0 < 64) MISC[tid0] = 0u;
    __syncthreads();
    XcdBarrier bar = xcd_barrier_post((unsigned*)(((CArgs*)__builtin_amdgcn_kernarg_segment_ptr())->p.ws + WS_CTL) + CW_BAR, MISC + 8);
#define IN(k) (lo <= (k) && (k) < hi)
#define SEAM(k) do { if (IN(k) && IN((k) + 1)) xcd_barrier(bar, wave0 == 0 && lane_id_nohoist() == 0); } while (0)
#define SITE int tid = wave0 * 64 + lane_id_nohoist(), bid = bid0, L = L0; CArgs* ap = (CArgs*)__builtin_amdgcn_kernarg_segment_ptr(); asm volatile("" : "+v"(tid)); asm volatile("" : "+s"(bid)); asm volatile("" : "+s"(L)); asm volatile("" : "+s"(ap)); LAS unsigned char* lds = lds0; asm volatile("" : "+s"(lds)); \
    unsigned char* ws = ap->p.ws; const int jl = L >> 1; const bool odd = (L & 1) != 0; (void)jl; (void)odd; (void)tid; (void)bid; (void)ws;

    { const int L0 = 0; if (IN(0)) REP(10) { SITE; Ptrs P{}; P.x = ap->p.x; P.ab_w_in = ap->p.ab_w_in; P.ab_w_out = ap->p.ab_w_out; P.c_w_in = ap->p.c_w_in; P.c_w_out = ap->p.c_w_out; P.w_up = ap->p.w_up; P.w_down = ap->p.w_down; P.router_w = ap->p.router_w; P.ws = ws; phase_prologue(P, lds, bid, tid); } }
    SEAM(0);

    for (int L0 = 0; L0 < DEPTH; ++L0) {
        const int pb = 1 + L0 * NPH; const bool odd0 = (L0 & 1) != 0;
        if (IN(pb + 0)) REP(0) {
            if (!odd0) { SITE; pg8::DenseOrder<T / 256, EVEN_IN / 256> S{bid, (const char*)(ws + WS_XB), (const char*)(ws + WS_WIN_E) + (size_t)jl * EVEN_IN * 1024 * 2, nullptr};
                pg8::EpiInEven E{(bf16*)(ws + WS_H), (const float*)(ws + WS_COS), (const float*)(ws + WS_SIN)}; pg8::gemm_phase<pg8::EpiInEven, pg8::DenseOrder<T / 256, EVEN_IN / 256>>(lds, S, E, tid); }
            else { SITE; pg8::DenseOrder<T / 256, ODD_IN / 256> S{bid, (const char*)(ws + WS_XB), (const char*)(ws + WS_WIN_O) + (size_t)jl * ODD_IN * 1024 * 2, nullptr};
                pg8::EpiInOdd E{(bf16*)(ws + WS_H)}; pg8::gemm_phase<pg8::EpiInOdd, pg8::DenseOrder<T / 256, ODD_IN / 256>>(lds, S, E, tid); }
        }
        SEAM(pb + 0);
        if (IN(pb + 1)) REP(1) {
            if (!odd0) { REP(11) { SITE; phase_ret_states(lds, (const bf16*)(ws + WS_H), ap->p.ret_decay + jl * 16, (float*)(ws + WS_RS), bid, tid); }
                         REP(12) { SITE; phase_dilated_sf(lds, (const bf16*)(ws + WS_H), (bf16*)(ws + WS_ACT), (float*)(ws + WS_OSLOT), bid, tid); } }
            else REP(13) { SITE; phase_natten_sf(lds, (const bf16*)(ws + WS_H), ap->p.c_rpb + (size_t)jl * 16 * 15 * 31, (bf16*)(ws + WS_Y), bid, tid); }
        }
        SEAM(pb + 1);
        if (!odd0) {
            if (IN(pb + 2)) REP(2) { { SITE; phase_ret_scan((const float*)(ws + WS_RS), (bf16*)(ws + WS_RR), ap->p.ret_decay + jl * 16, bid, tid); }
                              { SITE; phase_dil_merge((const bf16*)(ws + WS_ACT), (const float*)(ws + WS_OSLOT), (bf16*)(ws + WS_Y), bid, tid); } }
            SEAM(pb + 2);
            if (IN(pb + 3)) REP(3) { SITE; phase_ret_out_mfma(lds, (const bf16*)(ws + WS_H), (const bf16*)(ws + WS_RR), ap->p.ret_decay + jl * 16, (bf16*)(ws + WS_Y), bid, tid); }
            SEAM(pb + 3);
        }
        if (IN(pb + 4)) REP(4) { SITE;
            pg8::DenseOrder<T / 256, D / 256> S{bid, (const char*)(ws + WS_Y), (const char*)(ws + (odd ? WS_WOUT_O : WS_WOUT_E)) + (size_t)jl * 1024 * 1024 * 2, nullptr};
            pg8::EpiOut E{(L == 0) ? ap->p.x : (const float*)(ws + WS_X), (float*)(ws + WS_U)}; pg8::gemm_phase<pg8::EpiOut, pg8::DenseOrder<T / 256, D / 256>>(lds, S, E, tid);
        }
        SEAM(pb + 4);
        if (IN(pb + 5)) REP(5) { SITE; phase_ln1_router_mfma(lds, (const float*)(ws + WS_U), ap->p.ln_g + (size_t)(L * 2) * D, ap->p.ln_b + (size_t)(L * 2) * D, (const bf16*)(ws + WS_RWT) + (size_t)L * 2 * NEXP * D, ap->p.router_b + L * NEXP,
                                         (float*)(ws + WS_X1), (bf16*)(ws + WS_X1B), (bf16*)(ws + WS_X1LO), (int*)(ws + WS_TOPE), (float*)(ws + WS_GATE), (int*)(ws + WS_LRANK), (int*)(ws + WS_CNT), bid, tid); }
        SEAM(pb + 5);
        if (IN(pb + 6)) REP(6) { SITE; phase_dispatch(lds, (const int*)(ws + WS_CNT), (const int*)(ws + WS_TOPE), (const int*)(ws + WS_LRANK), (int*)(ws + WS_SLOT), (int*)(ws + WS_TILES), (int*)(ws + WS_ROWIDX), bid, tid); }
        SEAM(pb + 6);
        if (IN(pb + 7)) REP(7) { SITE;
            LAS int* ltile = (LAS int*)(lds + MISC_OFF + 2048); const int* tiles = (const int*)(ws + WS_TILES);
            __syncthreads();
            for (int i = tid; i < 1 + MAXTILES; i += NTHR) ltile[i] = tiles[i];
            __syncthreads();
            pg8::GroupOrder<8, 0> S{(int)ltile[0], bid, (const char*)(ws + WS_X1B), (const char*)(ws + WS_WUP) + (size_t)L * 32 * 2048 * 1024 * 2, ltile + 1, (const int*)(ws + WS_ROWIDX), (unsigned*)(ws + WS_CTL), CW_MCNT + L * MAXTILES * 64, 0u};
            pg8::EpiUp E{(bf16*)(ws + WS_ACT), ap->p.b_up + (size_t)L * 32 * 2048}; pg8::gemm_phase<pg8::EpiUp, pg8::GroupOrder<8, 0>, true>(lds, S, E, tid);
        }
        SEAM(pb + 7);
        if (IN(pb + 8)) REP(8) { SITE;
            LAS int* ltile = (LAS int*)(lds + MISC_OFF + 2048); const int* tiles = (const int*)(ws + WS_TILES);
            __syncthreads();
            for (int i = tid; i < 1 + MAXTILES; i += NTHR) ltile[i] = tiles[i];
            __syncthreads();
            pg8::GroupOrder<4, 0> S{(int)ltile[0], bid, (const char*)(ws + WS_ACT), (const char*)(ws + WS_WDN) + (size_t)L * 32 * 1024 * 1024 * 2, ltile + 1, nullptr, (unsigned*)(ws + WS_CTL), CW_MCNT + L * MAXTILES * 64, 0u};
            pg8::EpiDown E{(bf16*)(ws + WS_OSLOT), ap->p.b_down + (size_t)L * 32 * 1024}; pg8::gemm_phase<pg8::EpiDown, pg8::GroupOrder<4, 0>>(lds, S, E, tid);
        }
        SEAM(pb + 8);
        if (IN(pb + 9)) REP(9) { SITE; phase_combine_ln2((const float*)(ws + WS_X1), (const bf16*)(ws + WS_OSLOT), (const int*)(ws + WS_SLOT), (const float*)(ws + WS_GATE), ap->p.ln_g + (size_t)(L * 2 + 1) * D, ap->p.ln_b + (size_t)(L * 2 + 1) * D,
                                          (L == DEPTH - 1) ? ap->p.out : (float*)(ws + WS_X), (L == DEPTH - 1) ? (bf16*)nullptr : (bf16*)(ws + WS_XB), bid, tid); }
        SEAM(pb + 9);
    }
#undef IN
#undef SEAM
#undef SITE
}

extern "C" void kernel_launch(void* const* d_in, const int* in_sizes, int n_in, void* d_out, int out_size, void* d_ws, size_t ws_size, hipStream_t stream) {
    static int ready = 0;
    if (ready == 0) {
        if (n_in != 15 || in_sizes[0] != T * D || out_size != T * D || ws_size < WS_END) {
            fprintf(stderr, "kernel_launch: unexpected problem (n_in %d, in0 %d, out %d, ws %zu); nothing launched\n", n_in, n_in > 0 ? in_sizes[0] : -1, out_size, ws_size); ready = -1; return; }
        if (hipFuncSetAttribute((const void*)fwd_kernel, hipFuncAttributeMaxDynamicSharedMemorySize, LDS_BYTES) != hipSuccess) { fprintf(stderr, "kernel_launch: hipFuncSetAttribute failed\n"); ready = -1; return; }
        int per_cu = 0;
        if (hipOccupancyMaxActiveBlocksPerMultiprocessor(&per_cu, (const void*)fwd_kernel, NTHR, LDS_BYTES) != hipSuccess || per_cu < 1) fprintf(stderr, "kernel_launch: occupancy query reports %d workgroups per CU\n", per_cu);
        (void)hipGetLastError();
        ready = 1;
    }
    if (ready < 0) return;
    (void)hipMemsetAsync((char*)d_ws + WS_CTL, 0, CTL_ZERO_BYTES, stream);
    Args a{};
    a.p.x = (const float*)d_in[0]; a.p.ab_w_in = (const float*)d_in[1]; a.p.ab_w_out = (const float*)d_in[2]; a.p.ret_decay = (const float*)d_in[3];
    a.p.c_w_in = (const float*)d_in[4]; a.p.c_w_out = (const float*)d_in[5]; a.p.c_rpb = (const float*)d_in[6]; a.p.ln_g = (const float*)d_in[7]; a.p.ln_b = (const float*)d_in[8];
    a.p.router_w = (const float*)d_in[9]; a.p.router_b = (const float*)d_in[10]; a.p.w_up = (const float*)d_in[11]; a.p.b_up = (const float*)d_in[12]; a.p.w_down = (const float*)d_in[13]; a.p.b_down = (const float*)d_in[14];
    a.p.out = (float*)d_out; a.p.ws = (unsigned char*)d_ws;
#if N_LAUNCH_MODE == 0
    a.ph_lo = 0; a.ph_hi = N_PHASES;
    hipLaunchKernelGGL(fwd_kernel, dim3(GRID), dim3(NTHR), LDS_BYTES, stream, a);
#else
    for (int ph = 0; ph < N_PHASES; ++ph) {
        if (ph >= 1) { const int L = (ph - 1) / NPH, p = (ph - 1) % NPH; if ((L & 1) && (p == 2 || p == 3)) continue; }
        a.ph_lo = ph; a.ph_hi = ph + 1;
        hipLaunchKernelGGL(fwd_kernel, dim3(GRID), dim3(NTHR), LDS_BYTES, stream, a);
    }
#endif
}
```

```cpp
#include <hip/hip_runtime.h>
#include <cstdio>
#include <cstdint>

#ifndef PROBE_MASK
#define PROBE_MASK 0
#endif
#define REP(id) for (int _r = 0; _r < 1 + ((PROBE_MASK >> (id)) & 1); ++_r)
#ifndef N_LAUNCH_MODE
#define N_LAUNCH_MODE 0
#endif

#define GAS __attribute__((address_space(1)))
#define LAS __attribute__((address_space(3)))
typedef unsigned short bf16;
typedef short bf16x8 __attribute__((ext_vector_type(8)));
typedef float f32x4 __attribute__((ext_vector_type(4)));
typedef float f32x2 __attribute__((ext_vector_type(2)));
typedef unsigned u32x4 __attribute__((ext_vector_type(4)));
typedef unsigned u32x2 __attribute__((ext_vector_type(2)));

constexpr int T = 16384, D = 1024, DEPTH = 4, HD = 64, NEXP = 32, TOPK = 4;
constexpr int EVEN_IN = 4096, ODD_IN = 3072;
constexpr int NPAD = T * TOPK + NEXP * 256;
constexpr int MAXTILES = NPAD / 256;
constexpr float LN_EPS = 1e-5f, GN_EPS = 1e-6f;
constexpr float ALPHA = 1.681792830507429f;
constexpr int NWAVES = 8, NTHR = 512, GRID = 256;

constexpr size_t MiB = 1u << 20;
constexpr size_t WS_CTL = 0, CTL_ZERO_BYTES = 1 * MiB;
constexpr size_t WS_COS = 1 * MiB, WS_SIN = 3 * MiB;
constexpr size_t WS_CNT = 5 * MiB;
constexpr size_t WS_TOPE = 6 * MiB, WS_GATE = 7 * MiB, WS_LRANK = 8 * MiB, WS_SLOT = 9 * MiB;
constexpr size_t WS_TILES = 10 * MiB;
constexpr size_t WS_ROWIDX = 10 * MiB + 65536;
constexpr size_t WS_RWT = 11 * MiB;
constexpr size_t WS_X1LO = 1744 * MiB;
constexpr size_t WS_WIN_E = 16 * MiB, WS_WOUT_E = 32 * MiB, WS_WIN_O = 36 * MiB, WS_WOUT_O = 48 * MiB;
constexpr size_t WS_WUP = 64 * MiB, WS_WDN = 576 * MiB;
constexpr size_t WS_X = 832 * MiB, WS_XB = 896 * MiB, WS_H = 928 * MiB, WS_Y = 1056 * MiB, WS_U = 1088 * MiB;
constexpr size_t WS_X1 = 1152 * MiB, WS_X1B = 1216 * MiB, WS_XPERM = 1248 * MiB, WS_ACT = 1392 * MiB, WS_OSLOT = 1536 * MiB;
constexpr size_t WS_RS = 1680 * MiB, WS_RR = 1712 * MiB, WS_END = 1776 * MiB;
static_assert((size_t)NPAD * 1024 * 2 <= 144 * MiB, "slot buffers");
constexpr int CW_TMO = 0;
constexpr int CW_MCNT = 16384;
constexpr int CW_BAR = 4096;

constexpr int RING_BYTES = 131072, MISC_OFF = 147456, LDS_BYTES = 163840;

__device__ __forceinline__ unsigned f2bf(float f) { unsigned u = __builtin_bit_cast(unsigned, f); return (u + 0x7fffu + ((u >> 16) & 1u)) >> 16; }
__device__ __forceinline__ unsigned pk2(float lo, float hi) { return f2bf(lo) | (f2bf(hi) << 16); }
__device__ __forceinline__ float bflo(unsigned w) { return __builtin_bit_cast(float, w << 16); }
__device__ __forceinline__ float bfhi(unsigned w) { return __builtin_bit_cast(float, w & 0xffff0000u); }
__device__ __forceinline__ unsigned cvt_pk_bf16(float lo, float hi) { unsigned r; asm volatile("v_cvt_pk_bf16_f32 %0, %1, %2" : "=v"(r) : "v"(lo), "v"(hi)); return r; }
__device__ __forceinline__ int lane_id_nohoist() { int l; asm volatile("v_mbcnt_lo_u32_b32 %0, -1, 0\n\tv_mbcnt_hi_u32_b32 %0, -1, %0" : "=v"(l)); return l; }
__device__ __forceinline__ int shx(int v, int m) { return __builtin_amdgcn_ds_bpermute((lane_id_nohoist() ^ m) << 2, v); }
__device__ __forceinline__ float shx(float v, int m) { return __builtin_bit_cast(float, __builtin_amdgcn_ds_bpermute((lane_id_nohoist() ^ m) << 2, __builtin_bit_cast(int, v))); }
__device__ __forceinline__ float wave_sum(float v) {
#pragma unroll
    for (int o = 1; o < 64; o <<= 1) v += shx(v, o);
    return v;
}
__device__ __forceinline__ void unpack8(const u32x4 w, float* f) {
    f[0] = bflo(w.x); f[1] = bfhi(w.x); f[2] = bflo(w.y); f[3] = bfhi(w.y); f[4] = bflo(w.z); f[5] = bfhi(w.z); f[6] = bflo(w.w); f[7] = bfhi(w.w);
}
__device__ __forceinline__ float log2_gamma(float logit) { return -log1pf(expf(-logit)) * 1.4426950408889634f; }
__device__ __forceinline__ float sigmoidf_(float z) { return 1.0f / (1.0f + __expf(-z)); }

#define XB_TMO      128
#define XB_XCNT(j)  (256  + 64 * (j))
#define XB_XSUB(j)  (1280 + 64 * (j))
#define XB_XGEN(j)  (2304 + 64 * (j))
#define XB_TOP      3328
#define XB_TOPGEN   3392
#define XCD_BAR_WORDS 3456
#define XB_SPIN_CAP (1u << 18)

__device__ __forceinline__ unsigned xb_ld(unsigned* p)              { return __hip_atomic_load(p, __ATOMIC_RELAXED, __HIP_MEMORY_SCOPE_AGENT); }
__device__ __forceinline__ unsigned xb_add(unsigned* p, unsigned v) { return __hip_atomic_fetch_add(p, v, __ATOMIC_RELAXED, __HIP_MEMORY_SCOPE_AGENT); }
__device__ __forceinline__ unsigned xb_xcc_id() { return (unsigned)__builtin_amdgcn_s_getreg((3 << 11) | 20) & 0xFu; }
#define XB_SPIN(cond, bar) do { unsigned _sp = 0; while (cond) { __builtin_amdgcn_s_sleep(1); \
    if ((++_sp & 255u) == 0u) { if (xb_ld(&(bar)[XB_TMO])) break; if (_sp > XB_SPIN_CAP) { atomicAdd(&(bar)[XB_TMO], 1u); break; } } } } while (0)

struct XcdBarrier { unsigned* bar; unsigned x; volatile LAS unsigned* st; };

__device__ __forceinline__ XcdBarrier xcd_barrier_post(unsigned* bar, volatile LAS unsigned* st) {
    XcdBarrier b; b.bar = bar; b.x = xb_xcc_id(); b.st = st;
    if (threadIdx.x == 0) (void)xb_add(&bar[XB_XCNT(b.x)], 1u);
    return b;
}
__device__ __forceinline__ void xcd_barrier_complete(unsigned* bar, unsigned x, unsigned& nloc, unsigned& nx) {
    const unsigned G = gridDim.x * gridDim.y * gridDim.z;
    unsigned sum, cnt, mine, sp = 0u;
    for (;;) {
        sum = 0u; cnt = 0u; mine = 0u;
#pragma unroll
        for (unsigned j = 0; j < 16; ++j) { const unsigned c = xb_ld(&bar[XB_XCNT(j)]); sum += c; cnt += (c > 0u) ? 1u : 0u; mine = (j == x) ? c : mine; }
        if (sum == G) break;
        __builtin_amdgcn_s_sleep(1);
        if ((++sp & 255u) == 0u) { if (xb_ld(&bar[XB_TMO])) break; if (sp > XB_SPIN_CAP) { atomicAdd(&bar[XB_TMO], 1u); break; } }
    }
    nloc = mine > 0u ? mine : 1u; nx = cnt > 0u ? cnt : 1u;
}
__device__ __forceinline__ void xcd_barrier(const XcdBarrier& b0, const bool leader) {
    XcdBarrier b = b0; asm volatile("" : "+s"(b.bar)); asm volatile("" : "+s"(b.x));
    asm volatile("s_waitcnt vmcnt(0)" ::: "memory");
    __syncthreads();
    if (leader) {
        unsigned* bar = b.bar;
        __builtin_amdgcn_s_waitcnt(0);
        unsigned nloc = b.st[0], nx = b.st[1];
        if (nloc == 0u) { xcd_barrier_complete(bar, b.x, nloc, nx); b.st[0] = nloc; b.st[1] = nx; }
        const unsigned old = xb_add(&bar[XB_XSUB(b.x)], 1u);
        const unsigned gen = old / nloc;
        if (old + 1u == (gen + 1u) * nloc) {
            __builtin_amdgcn_fence(__ATOMIC_RELEASE, "agent");
            asm volatile("s_waitcnt vmcnt(0)" ::: "memory");
            const unsigned og = xb_add(&bar[XB_TOP], 1u);
            const unsigned tg = og / nx;
            if (og + 1u == (tg + 1u) * nx) xb_add(&bar[XB_TOPGEN], 1u);
            else XB_SPIN(xb_ld(&bar[XB_TOPGEN]) == tg, bar);
            __builtin_amdgcn_fence(__ATOMIC_ACQUIRE, "agent");
            xb_add(&bar[XB_XGEN(b.x)], 1u);
            asm volatile("s_waitcnt vmcnt(0)" ::: "memory");
        } else {
            XB_SPIN(xb_ld(&bar[XB_XGEN(b.x)]) == gen, bar);
            __builtin_amdgcn_fence(__ATOMIC_ACQUIRE, "agent");
            asm volatile("s_waitcnt vmcnt(0)" ::: "memory");
        }
    }
    __syncthreads();
}

namespace pg8 {
constexpr int BM = 256, BK = 64, HALF = 128, HTB = HALF * BK * 2, STAGE_BYTES = 8 * HTB, NXCD = 8, WGM = 8, KD = 1024;
constexpr size_t TILE_BYTES = (size_t)BM * KD * 2;

__host__ __device__ __forceinline__ int lds_byte(int r, int c) { const int st = (r >> 4) * 2 + (c >> 5), rr = r & 15, cc = c & 31, ob = rr * 64 + cc * 2; return st * 1024 + (ob ^ (((ob >> 9) & 1) << 5)); }
__host__ __device__ __forceinline__ void stage_rc(int b, int& R, int& C) { const int st = b / 1024, sb = b % 1024, swz = sb ^ (((sb >> 9) & 1) << 5); R = (st >> 1) * 16 + swz / 64; C = (st & 1) * 32 + (swz % 64) / 2; }
__host__ __device__ __forceinline__ int perm32(int rho) { const int n = rho >> 4, i = rho & 15; return 8 * (i >> 2) + 4 * n + (i & 3); }

struct Unit { int pm, pn, e; };

template <int nN> __device__ __forceinline__ bool order_next(int i, int c, int nM, int& pm, int& pn) {
    constexpr int G = GRID;
    const int nwg = nM * nN; const long L = (long)i * G + c; if (L >= nwg) return false;
    int wgid = (int)L; { const int q = nwg / NXCD, r = nwg % NXCD, xcd = wgid % NXCD, off = wgid / NXCD; wgid = (xcd < r ? xcd * (q + 1) : r * (q + 1) + (xcd - r) * q) + off; }
    const int nig = WGM * nN, gid = wgid / nig, fm = gid * WGM, gsz = (nM - fm) < WGM ? (nM - fm) : WGM;
    pm = fm + ((wgid % nig) % gsz); pn = (wgid % nig) / gsz; return true;
}
template <int NM, int NN> struct DenseOrder {
    int c; const char* A; const char* B; const int* rowidx;
    __device__ __forceinline__ bool next(int i, Unit& u) const { u.e = 0; return order_next<NN>(i, c, NM, u.pm, u.pn); }
    __device__ __forceinline__ const char* a_base(const Unit& u) const { return A + (size_t)u.pm * TILE_BYTES; }
    __device__ __forceinline__ const char* b_base(const Unit& u) const { return B + (size_t)u.pn * TILE_BYTES; }
    __device__ __forceinline__ void a_ready(const Unit&, int, int) const {}
    __device__ __forceinline__ void done(int, int) const {}
};
template <int NN, int MODE> struct GroupOrder {
    static constexpr int mode = MODE; static constexpr size_t bstride = (size_t)NN * 256 * 1024 * 2;
    int nM, c; const char* A; const char* B; const LAS int* tile_e; const int* rowidx;
    unsigned* ctl; int moff; unsigned premask;
    __device__ __forceinline__ bool next(int i, Unit& u) const { if (!order_next<NN>(i, c, nM, u.pm, u.pn)) return false; u.e = tile_e[u.pm]; return true; }
    __device__ __forceinline__ const char* a_base(const Unit& u) const { return A + (size_t)u.pm * TILE_BYTES; }
    __device__ __forceinline__ const char* b_base(const Unit& u) const { return B + (size_t)u.e * bstride + (size_t)u.pn * TILE_BYTES; }
    __device__ __forceinline__ void a_ready(const Unit& u, int idx, int tid) const {
        if (mode != 2) return;
        if (tid < 64 && !((premask >> idx) & 1u)) {
            unsigned* dep = ctl + moff; unsigned* tmo = ctl; const unsigned need = 64u;
            const unsigned long long t0 = __builtin_amdgcn_s_memrealtime(); unsigned polls = 0;
            while ((unsigned)__builtin_amdgcn_readfirstlane(__hip_atomic_load(dep + 64 * u.pm, __ATOMIC_RELAXED, __HIP_MEMORY_SCOPE_AGENT)) < need) {
                if ((++polls & 255u) == 0u && __builtin_amdgcn_readfirstlane(__hip_atomic_load(tmo, __ATOMIC_RELAXED, __HIP_MEMORY_SCOPE_AGENT)) != 0u) break;
                if (__builtin_amdgcn_s_memrealtime() - t0 > 2000000ull) { if (tid == 0) __hip_atomic_store(tmo, 1u, __ATOMIC_RELAXED, __HIP_MEMORY_SCOPE_AGENT); break; }
                __builtin_amdgcn_s_sleep(2); }
            __builtin_amdgcn_fence(__ATOMIC_ACQUIRE, "agent");
            asm volatile("s_waitcnt vmcnt(0)" ::: "memory");
        }
        asm volatile("" ::: "memory"); __builtin_amdgcn_s_barrier(); asm volatile("" ::: "memory");
    }
    __device__ __forceinline__ void done(int pm, int lane) const { if (mode == 1 && lane == 0) __hip_atomic_fetch_add(ctl + moff + 64 * pm, 1u, __ATOMIC_RELAXED, __HIP_MEMORY_SCOPE_AGENT); }
};

__device__ __forceinline__ void store8(bf16* p, const f32x4 v0, const f32x4 v1) {
    u32x4 w; w.x = cvt_pk_bf16(v0[0], v0[1]); w.y = cvt_pk_bf16(v0[2], v0[3]); w.z = cvt_pk_bf16(v1[0], v1[1]); w.w = cvt_pk_bf16(v1[2], v1[3]); *(u32x4*)p = w;
}
struct EpiInEven {
    static constexpr bool PERM = true, AFTER_DRAIN = false;
    bf16* H; const float* cs; const float* sn;
    __device__ __forceinline__ void operator()(const f32x4 (&acc)[2][2][4][2], const Unit& u, int wr, int wc, int fr, int fq) const {
        const int pn = u.pn; const bool rope = (pn < 4) || (pn >= 10 && pn < 14);
        const float sc = ((pn >= 2 && pn < 4) || (pn >= 10 && pn < 12)) ? 0.125f : 1.0f;
        const int row0 = u.pm * BM + wr * 64 + fr;
        if (rope) {
#pragma unroll
            for (int ai = 0; ai < 2; ++ai)
#pragma unroll
                for (int m = 0; m < 4; ++m) {
                    const int row = row0 + ai * HALF + m * 16;
                    const float* cr = cs + (size_t)row * 32 + 8 * fq; const float* sr = sn + (size_t)row * 32 + 8 * fq;
                    const f32x4 c0 = *(const f32x4*)cr, c1 = *(const f32x4*)(cr + 4), s0 = *(const f32x4*)sr, s1 = *(const f32x4*)(sr + 4);
                    const f32x4 x1a = acc[ai][0][m][0], x1b = acc[ai][0][m][1], x2a = acc[ai][1][m][0], x2b = acc[ai][1][m][1];
                    const f32x4 o1a = (x1a * c0 - x2a * s0) * sc, o1b = (x1b * c1 - x2b * s1) * sc, o2a = (x2a * c0 + x1a * s0) * sc, o2b = (x2b * c1 + x1b * s1) * sc;
                    bf16* rowp = H + (size_t)row * EVEN_IN + pn * BM + wc * 64 + 8 * fq;
                    store8(rowp, o1a, o1b); store8(rowp + 32, o2a, o2b);
                }
        } else {
#pragma unroll
            for (int ai = 0; ai < 2; ++ai)
#pragma unroll
                for (int m = 0; m < 4; ++m) {
                    bf16* rowp = H + (size_t)(row0 + ai * HALF + m * 16) * EVEN_IN + pn * BM + wc * 32 + 8 * fq;
#pragma unroll
                    for (int bj = 0; bj < 2; ++bj) store8(rowp + bj * HALF, acc[ai][bj][m][0], acc[ai][bj][m][1]);
                }
        }
    }
};
struct EpiInOdd {
    static constexpr bool PERM = true, AFTER_DRAIN = false;
    bf16* H;
    __device__ __forceinline__ void operator()(const f32x4 (&acc)[2][2][4][2], const Unit& u, int wr, int wc, int fr, int fq) const {
        const float sc = (u.pn < 4) ? 0.125f : 1.0f;
        const int row0 = u.pm * BM + wr * 64 + fr;
#pragma unroll
        for (int ai = 0; ai < 2; ++ai)
#pragma unroll
            for (int m = 0; m < 4; ++m) {
                bf16* rowp = H + (size_t)(row0 + ai * HALF + m * 16) * ODD_IN + u.pn * BM + wc * 32 + 8 * fq;
#pragma unroll
                for (int bj = 0; bj < 2; ++bj) store8(rowp + bj * HALF, acc[ai][bj][m][0] * sc, acc[ai][bj][m][1] * sc);
            }
    }
};
struct EpiOut {
    static constexpr bool PERM = false, AFTER_DRAIN = false;
    const float* Xres; float* U;
    __device__ __forceinline__ void operator()(const f32x4 (&acc)[2][2][4][2], const Unit& u, int wr, int wc, int fr, int fq) const {
        const int row0 = u.pm * BM + wr * 64 + fr, col0 = u.pn * BM + wc * 32 + 4 * fq;
#pragma unroll
        for (int ai = 0; ai < 2; ++ai)
#pragma unroll
            for (int m = 0; m < 4; ++m) {
                const size_t off = (size_t)(row0 + ai * HALF + m * 16) * D + col0;
#pragma unroll
                for (int bj = 0; bj < 2; ++bj)
#pragma unroll
                    for (int n = 0; n < 2; ++n) { const f32x4 xr = *(const f32x4*)(Xres + off + bj * HALF + n * 16); *(f32x4*)(U + off + bj * HALF + n * 16) = xr * ALPHA + acc[ai][bj][m][n]; }
            }
    }
};
struct EpiUp {
    static constexpr bool PERM = true, AFTER_DRAIN = false;
    bf16* Act; const float* bup;
    __device__ __forceinline__ void operator()(const f32x4 (&acc)[2][2][4][2], const Unit& u, int wr, int wc, int fr, int fq) const {
        const int row0 = u.pm * BM + wr * 64 + fr, f0 = u.pn * HALF + wc * 32 + 8 * fq;
        const float* bp = bup + (size_t)u.e * 2048 + 2 * f0;
        f32x4 bb[4];
#pragma unroll
        for (int i = 0; i < 4; ++i) bb[i] = *(const f32x4*)(bp + 4 * i);
#pragma unroll
        for (int ai = 0; ai < 2; ++ai)
#pragma unroll
            for (int m = 0; m < 4; ++m) {
                f32x4 o[2];
#pragma unroll
                for (int n = 0; n < 2; ++n) {
                    const f32x4 g = acc[ai][0][m][n], l = acc[ai][1][m][n];
#pragma unroll
                    for (int j = 0; j < 4; ++j) {
                        const float bg = bb[2 * n + (j >> 1)][(j & 1) * 2], bl = bb[2 * n + (j >> 1)][(j & 1) * 2 + 1];
                        const float xg = fminf(g[j] + bg, 7.0f), xl = fminf(fmaxf(l[j] + bl, -7.0f), 7.0f);
                        o[n][j] = xg * sigmoidf_(1.702f * xg) * (xl + 1.0f);
                    }
                }
                u32x4 w; w.x = cvt_pk_bf16(o[0][0], o[0][1]); w.y = cvt_pk_bf16(o[0][2], o[0][3]); w.z = cvt_pk_bf16(o[1][0], o[1][1]); w.w = cvt_pk_bf16(o[1][2], o[1][3]);
                *(u32x4*)(Act + (size_t)(row0 + ai * HALF + m * 16) * 1024 + f0) = w;
            }
    }
};
struct EpiDown {
    static constexpr bool PERM = true, AFTER_DRAIN = false;
    bf16* O; const float* bdn;
    __device__ __forceinline__ void operator()(const f32x4 (&acc)[2][2][4][2], const Unit& u, int wr, int wc, int fr, int fq) const {
        const int row0 = u.pm * BM + wr * 64 + fr, col0 = u.pn * BM + wc * 32 + 8 * fq;
        const float* bp = bdn + (size_t)u.e * 1024 + col0;
        f32x4 bv[2][2];
#pragma unroll
        for (int bj = 0; bj < 2; ++bj)
#pragma unroll
            for (int n = 0; n < 2; ++n) bv[bj][n] = *(const f32x4*)(bp + bj * HALF + 4 * n);
#pragma unroll
        for (int ai = 0; ai < 2; ++ai)
#pragma unroll
            for (int m = 0; m < 4; ++m) {
                bf16* rowp = O + (size_t)(row0 + ai * HALF + m * 16) * 1024 + col0;
#pragma unroll
                for (int bj = 0; bj < 2; ++bj) store8(rowp + bj * HALF, acc[ai][bj][m][0] + bv[bj][0], acc[ai][bj][m][1] + bv[bj][1]);
            }
    }
};

template <class Epi, class Sched, bool GATHER = false, bool ALIGN_EPI = true, bool SP2 = true>
__device__ __forceinline__ void gemm_phase(LAS unsigned char* lds, const Sched& S, const Epi& E, const int tid) {
    const int wid = __builtin_amdgcn_readfirstlane(tid >> 6), lane = tid & 63, wr = wid >> 2, wc = wid & 3, fr = lane & 15, fq = lane >> 4;
    constexpr int K = KD, nt = K / BK;
    unsigned voffB[2]; int Ra[2], Ca[2];
#pragma unroll
    for (int i = 0; i < 2; ++i) { int R, C; stage_rc(tid * 16 + i * 8192, R, C); const int Rb = Epi::PERM ? ((R & ~31) + perm32(R & 31)) : R;
        Ra[i] = R; Ca[i] = C; voffB[i] = (unsigned)(Rb * K + C) * 2u; }
    unsigned vA[2][2], nvA[2][2];
#define PG8_VA(dst, unit) do { _Pragma("unroll") for (int _h = 0; _h < 2; ++_h) _Pragma("unroll") for (int _i = 0; _i < 2; ++_i) \
        dst[_h][_i] = GATHER ? ((unsigned)S.rowidx[(unit).pm * BM + _h * HALF + Ra[_i]] * (unsigned)(K * 2) + (unsigned)(Ca[_i] * 2)) : (unsigned)(((_h * HALF + Ra[_i]) * K + Ca[_i]) * 2); } while (0)
    const size_t kstep = (size_t)(BK * 2);
    const size_t hstep = (size_t)HALF * K * 2;
    const unsigned ldsw = (unsigned)wid * 1024u;
    const int aoff = lds_byte(wr * 64 + fr, fq * 8), boff = lds_byte(wc * 32 + fr, fq * 8);
#define PG8_SA(b, h) (((b) * 2 + (h)) * HTB)
#define PG8_SB(b, h) ((4 + (b) * 2 + (h)) * HTB)
#define PG8_STAGE(bufoff, gbase, voff) do { _Pragma("unroll") for (int _i = 0; _i < 2; ++_i) \
        __builtin_amdgcn_global_load_lds((const unsigned*)((const char*)(gbase) + (voff)[_i]), (LAS unsigned*)(lds + (bufoff) + ldsw + _i * 8192), 16, 0, 0); } while (0)
#define PG8_LDA(dst, b, h) do { _Pragma("unroll") for (int m = 0; m < 4; ++m) _Pragma("unroll") for (int k = 0; k < 2; ++k) dst[m][k] = *(const LAS bf16x8*)(lds + PG8_SA(b, h) + aoff + m * 2048 + k * 1024); } while (0)
#define PG8_LDB(dst, b, h) do { _Pragma("unroll") for (int n = 0; n < 2; ++n) _Pragma("unroll") for (int k = 0; k < 2; ++k) dst[n][k] = *(const LAS bf16x8*)(lds + PG8_SB(b, h) + boff + n * 2048 + k * 1024); } while (0)
#define PG8_MMA(ai, bj, At, Bt) do { __builtin_amdgcn_s_setprio(1); _Pragma("unroll") for (int m = 0; m < 4; ++m) _Pragma("unroll") for (int n = 0; n < 2; ++n) _Pragma("unroll") for (int k = 0; k < 2; ++k) \
        acc[ai][bj][m][n] = __builtin_amdgcn_mfma_f32_16x16x32_bf16(Bt[n][k], At[m][k], acc[ai][bj][m][n], 0, 0, 0); __builtin_amdgcn_s_setprio(0); } while (0)
#define PG8_WAIT_V(n) asm volatile("s_waitcnt vmcnt(" #n ")" ::: "memory")
#define PG8_WAIT_L(n) asm volatile("s_waitcnt lgkmcnt(" #n ")" ::: "memory")
#define PG8_BAR __builtin_amdgcn_s_barrier()
#define PG8_SCHED __builtin_amdgcn_sched_barrier(0)
    Unit cur, nxt; int ui = 0;
    if (!S.next(0, cur)) return;
    f32x4 acc[2][2][4][2];
#pragma unroll
    for (int a = 0; a < 2; ++a)
#pragma unroll
        for (int b = 0; b < 2; ++b)
#pragma unroll
            for (int m = 0; m < 4; ++m)
#pragma unroll
                for (int n = 0; n < 2; ++n) acc[a][b][m][n] = (f32x4){0.f, 0.f, 0.f, 0.f};
    bf16x8 At[4][2], B0[2][2], B1[2][2];
    const char* cA = GATHER ? S.A : S.a_base(cur); const char* cB = S.b_base(cur);
    PG8_VA(vA, cur);
    int pub_pm = -1;
    S.a_ready(cur, 0, tid);
    if constexpr (SP2) {
        PG8_STAGE(PG8_SB(0, 0), cB, voffB); PG8_STAGE(PG8_SB(0, 1), cB + hstep, voffB); PG8_STAGE(PG8_SA(0, 0), cA, vA[0]); PG8_STAGE(PG8_SA(0, 1), cA, vA[1]);
        if (wr == 1) PG8_BAR;
        PG8_WAIT_V(2); PG8_BAR;
        PG8_STAGE(PG8_SB(1, 0), cB + kstep, voffB); PG8_STAGE(PG8_SA(1, 0), cA + kstep, vA[0]); PG8_STAGE(PG8_SB(1, 1), cB + hstep + kstep, voffB);
        PG8_WAIT_V(6); PG8_BAR;
    } else {
        PG8_STAGE(PG8_SB(0, 0), cB, voffB); PG8_STAGE(PG8_SA(0, 0), cA, vA[0]); PG8_STAGE(PG8_SB(0, 1), cB + hstep, voffB); PG8_STAGE(PG8_SA(0, 1), cA, vA[1]);
        if (wr == 1) PG8_BAR;
        PG8_WAIT_V(4); PG8_BAR;
        PG8_STAGE(PG8_SB(1, 0), cB + kstep, voffB); PG8_STAGE(PG8_SA(1, 0), cA + kstep, vA[0]); PG8_STAGE(PG8_SB(1, 1), cB + hstep + kstep, voffB);
        PG8_WAIT_V(6); PG8_BAR;
    }
    for (;;) {
        const bool has_next = S.next(ui + 1, nxt);
        const char* nA = (has_next && !GATHER) ? S.a_base(nxt) : cA; const char* nB = has_next ? S.b_base(nxt) : cB;
        if (GATHER && has_next) PG8_VA(nvA, nxt); else { _Pragma("unroll") for (int _h = 0; _h < 2; ++_h) _Pragma("unroll") for (int _i = 0; _i < 2; ++_i) nvA[_h][_i] = vA[_h][_i]; }
        for (int t = 0; t < nt; t += 2) {
            const bool last = (t == nt - 2);
            const char* a1 = cA + (size_t)(t + 1) * kstep;
            const char* a2 = last ? nA : cA + (size_t)(t + 2) * kstep; const char* b2 = last ? nB : cB + (size_t)(t + 2) * kstep;
            const char* a3 = a2 + kstep; const char* b3 = b2 + kstep;
            if (last) { if (has_next) S.a_ready(nxt, ui + 1, tid);
                        if (pub_pm >= 0) { S.done(pub_pm, lane); pub_pm = -1; } }
            unsigned w0[2], w1[2];
            w0[0] = last ? nvA[0][0] : vA[0][0]; w0[1] = last ? nvA[0][1] : vA[0][1]; w1[0] = last ? nvA[1][0] : vA[1][0]; w1[1] = last ? nvA[1][1] : vA[1][1];
            if constexpr (SP2) {
            PG8_LDB(B0, 0, 0); PG8_LDB(B1, 0, 1); PG8_SCHED; PG8_LDA(At, 0, 0); PG8_STAGE(PG8_SA(1, 1), a1, vA[1]);
            PG8_WAIT_V(8); PG8_WAIT_L(0); PG8_BAR; PG8_MMA(0, 0, At, B0); PG8_MMA(0, 1, At, B1); PG8_BAR; PG8_SCHED;
            PG8_LDA(At, 0, 1); PG8_STAGE(PG8_SB(0, 0), b2, voffB); PG8_STAGE(PG8_SB(0, 1), b2 + hstep, voffB); PG8_STAGE(PG8_SA(0, 0), a2, w0);
            PG8_WAIT_V(8); PG8_WAIT_L(0); PG8_BAR; PG8_MMA(1, 0, At, B0); PG8_MMA(1, 1, At, B1); PG8_BAR; PG8_SCHED;
            PG8_LDB(B0, 1, 0); PG8_LDB(B1, 1, 1); PG8_SCHED; PG8_LDA(At, 1, 0); PG8_STAGE(PG8_SA(0, 1), a2, w1);
            PG8_WAIT_V(8); PG8_WAIT_L(0); PG8_BAR; PG8_MMA(0, 0, At, B0); PG8_MMA(0, 1, At, B1); PG8_BAR; PG8_SCHED;
            PG8_LDA(At, 1, 1); PG8_STAGE(PG8_SB(1, 0), b3, voffB); PG8_STAGE(PG8_SB(1, 1), b3 + hstep, voffB); PG8_STAGE(PG8_SA(1, 0), a3, w0);
            PG8_WAIT_V(8); PG8_WAIT_L(0); PG8_BAR; PG8_MMA(1, 0, At, B0); PG8_MMA(1, 1, At, B1); PG8_BAR; PG8_SCHED;
            } else {
            PG8_LDB(B0, 0, 0); PG8_SCHED; PG8_LDA(At, 0, 0); PG8_STAGE(PG8_SA(1, 1), a1, vA[1]);
            PG8_WAIT_L(8); PG8_BAR; PG8_WAIT_L(0); PG8_MMA(0, 0, At, B0); PG8_BAR; PG8_SCHED;
            PG8_LDB(B1, 0, 1); PG8_STAGE(PG8_SB(0, 0), b2, voffB);
            PG8_BAR; PG8_WAIT_L(0); PG8_MMA(0, 1, At, B1); PG8_BAR;
            PG8_LDA(At, 0, 1); PG8_STAGE(PG8_SA(0, 0), a2, w0);
            PG8_BAR; PG8_WAIT_L(0); PG8_MMA(1, 0, At, B0); PG8_BAR; PG8_SCHED;
            PG8_STAGE(PG8_SB(0, 1), b2 + hstep, voffB);
            PG8_WAIT_V(6); PG8_BAR; PG8_MMA(1, 1, At, B1); PG8_BAR;
            PG8_LDB(B0, 1, 0); PG8_SCHED; PG8_LDA(At, 1, 0); PG8_STAGE(PG8_SA(0, 1), a2, w1);
            PG8_WAIT_L(8); PG8_BAR; PG8_WAIT_L(0); PG8_MMA(0, 0, At, B0); PG8_BAR; PG8_SCHED;
            PG8_LDB(B1, 1, 1); PG8_STAGE(PG8_SB(1, 0), b3, voffB);
            PG8_BAR; PG8_WAIT_L(0); PG8_MMA(0, 1, At, B1); PG8_BAR;
            PG8_LDA(At, 1, 1); PG8_STAGE(PG8_SA(1, 0), a3, w0);
            PG8_BAR; PG8_WAIT_L(0); PG8_MMA(1, 0, At, B0); PG8_BAR; PG8_SCHED;
            PG8_STAGE(PG8_SB(1, 1), b3 + hstep, voffB);
            PG8_WAIT_V(6); PG8_BAR; PG8_MMA(1, 1, At, B1); PG8_BAR;
            }
        }
        if constexpr (ALIGN_EPI) { if (wr == 0) PG8_BAR; }
        E(acc, cur, wr, wc, fr, fq); pub_pm = cur.pm;
        if (!has_next) break;
#pragma unroll
        for (int a = 0; a < 2; ++a)
#pragma unroll
            for (int b = 0; b < 2; ++b)
#pragma unroll
                for (int m = 0; m < 4; ++m)
#pragma unroll
                    for (int n = 0; n < 2; ++n) acc[a][b][m][n] = (f32x4){0.f, 0.f, 0.f, 0.f};
        cur = nxt; cA = nA; cB = nB; ++ui;
#pragma unroll
        for (int _h = 0; _h < 2; ++_h)
#pragma unroll
            for (int _i = 0; _i < 2; ++_i) vA[_h][_i] = nvA[_h][_i];
        if constexpr (ALIGN_EPI) { if (wr == 1) PG8_BAR; }
    }
    PG8_WAIT_V(0);
    if (pub_pm >= 0) S.done(pub_pm, lane);
    if constexpr (!ALIGN_EPI) { if (wr == 0) PG8_BAR; }
    PG8_BAR;
#undef PG8_VA
#undef PG8_SA
#undef PG8_SB
#undef PG8_STAGE
#undef PG8_LDA
#undef PG8_LDB
#undef PG8_MMA
#undef PG8_WAIT_V
#undef PG8_WAIT_L
#undef PG8_BAR
#undef PG8_SCHED
}
}

__device__ __forceinline__ int rowmap(int mode, int c) {
    if (mode == 1) { const int pn = c >> 8; const bool rope = (pn < 4) || (pn >= 10 && pn < 14);
        return rope ? ((c & ~255) | (((c >> 5) & 1) << 7) | (((c >> 6) & 3) << 5) | (c & 31)) : c; }
    if (mode == 2) { const int f = c >> 1, bj = c & 1; return ((f >> 7) << 8) | (bj << 7) | (f & 127); }
    return c;
}
__device__ __forceinline__ void p0_transpose_item(const float* W, int N, bf16* WT, int mode, LAS float* scr, int item, int lane) {
    const int nblk = N / 64, kb = item / nblk, nb = item % nblk, k0 = 64 * kb, n0 = 64 * nb;
    f32x4 v[16];
#pragma unroll
    for (int i = 0; i < 16; ++i) v[i] = *(const f32x4*)(W + (size_t)(k0 + 4 * i + (lane >> 4)) * N + n0 + 4 * (lane & 15));
#pragma unroll
    for (int i = 0; i < 16; ++i) { const int kk = 4 * i + (lane >> 4); *(LAS f32x4*)(scr + ((kk >> 3) + 8 * (kk & 7)) * 68 + 4 * (lane & 15)) = v[i]; }
    asm volatile("s_waitcnt lgkmcnt(0)" ::: "memory");
    const int c = lane & 7;
#pragma unroll
    for (int jj = 0; jj < 8; ++jj) { const int n = (lane >> 3) + 8 * jj; const LAS float* s = scr + c * 68 + n;
        u32x4 o; o.x = pk2(s[0 * 544], s[1 * 544]); o.y = pk2(s[2 * 544], s[3 * 544]); o.z = pk2(s[4 * 544], s[5 * 544]); o.w = pk2(s[6 * 544], s[7 * 544]);
        *(u32x4*)(WT + (size_t)rowmap(mode, n0 + n) * 1024 + k0 + 8 * c) = o; }
    asm volatile("s_waitcnt lgkmcnt(0)" ::: "memory");
}
__device__ const double INV_FREQ[32] = {1, 0.74989420933245587, 0.56234132519034907, 0.42169650342858223, 0.31622776601683794, 0.23713737056616552, 0.17782794100389229, 0.1333521432163324,
    0.10000000000000001, 0.074989420933245579, 0.056234132519034911, 0.042169650342858224, 0.031622776601683791, 0.023713737056616554, 0.017782794100389229, 0.013335214321633241,
    0.01, 0.0074989420933245579, 0.005623413251903491, 0.0042169650342858229, 0.0031622776601683794, 0.0023713737056616554, 0.0017782794100389228, 0.0013335214321633241,
    0.001, 0.00074989420933245586, 0.0005623413251903491, 0.00042169650342858224, 0.00031622776601683794, 0.00023713737056616554, 0.00017782794100389227, 0.0001333521432163324};

struct Ptrs {
    const float *x, *ab_w_in, *ab_w_out, *ret_decay, *c_w_in, *c_w_out, *c_rpb, *ln_g, *ln_b, *router_w, *router_b, *w_up, *b_up, *w_down, *b_down;
    float* out; unsigned char* ws;
};

__device__ __forceinline__ void phase_prologue(const Ptrs& P, LAS unsigned char* lds, int bid, int tid) {
    const int wave = tid >> 6, lane = tid & 63;
    LAS float* scr = (LAS float*)(lds + wave * 17408);
    const int gw = bid * NWAVES + wave, NGW = GRID * NWAVES;
    constexpr int I0 = 2 * 1024, I1 = 2 * 256, I2 = 2 * 768, I3 = 2 * 256, I4 = 128 * 512, I5 = 128 * 256;
    constexpr int NITEMS = I0 + I1 + I2 + I3 + I4 + I5;
    unsigned char* ws = P.ws;
    for (int it = gw; it < NITEMS; it += NGW) {
        int r = it;
        if (r < I0) { const int mi = r / 1024, ii = r % 1024; p0_transpose_item(P.ab_w_in + (size_t)mi * 1024 * 4096, 4096, (bf16*)(ws + WS_WIN_E) + (size_t)mi * 4096 * 1024, 1, scr, ii, lane); continue; } r -= I0;
        if (r < I1) { const int mi = r / 256, ii = r % 256; p0_transpose_item(P.ab_w_out + (size_t)mi * 1024 * 1024, 1024, (bf16*)(ws + WS_WOUT_E) + (size_t)mi * 1024 * 1024, 0, scr, ii, lane); continue; } r -= I1;
        if (r < I2) { const int mi = r / 768, ii = r % 768; p0_transpose_item(P.c_w_in + (size_t)mi * 1024 * 3072, 3072, (bf16*)(ws + WS_WIN_O) + (size_t)mi * 3072 * 1024, 0, scr, ii, lane); continue; } r -= I2;
        if (r < I3) { const int mi = r / 256, ii = r % 256; p0_transpose_item(P.c_w_out + (size_t)mi * 1024 * 1024, 1024, (bf16*)(ws + WS_WOUT_O) + (size_t)mi * 1024 * 1024, 0, scr, ii, lane); continue; } r -= I3;
        if (r < I4) { const int mi = r / 512, ii = r % 512; p0_transpose_item(P.w_up + (size_t)mi * 1024 * 2048, 2048, (bf16*)(ws + WS_WUP) + (size_t)mi * 2048 * 1024, 2, scr, ii, lane); continue; } r -= I4;
        { const int mi = r / 256, ii = r % 256; p0_transpose_item(P.w_down + (size_t)mi * 1024 * 1024, 1024, (bf16*)(ws + WS_WDN) + (size_t)mi * 1024 * 1024, 0, scr, ii, lane); }
    }
    float* cs = (float*)(ws + WS_COS); float* sn = (float*)(ws + WS_SIN);
    for (int g = bid * NTHR + tid; g < T * 32; g += GRID * NTHR) {
        const int pos = g >> 5, i = g & 31;
        const double rev = (double)pos * INV_FREQ[i] * 0.15915494309189535;
        const double fr = rev - __builtin_rint(rev);
        const float a = (float)(fr * 6.283185307179586);
        cs[g] = cosf(a); sn[g] = sinf(a);
    }
    { bf16* rwt = (bf16*)(ws + WS_RWT);
      for (int g = bid * NTHR + tid; g < DEPTH * NEXP * D; g += GRID * NTHR) { const int l = g >> 15, e = (g >> 10) & 31, d = g & 1023;
          const float w = P.router_w[((size_t)l * D + d) * NEXP + e]; const unsigned hi = f2bf(w); const float wl = w - __builtin_bit_cast(float, hi << 16);
          rwt[((size_t)(l * 2) * NEXP + e) * D + d] = (bf16)hi; rwt[((size_t)(l * 2 + 1) * NEXP + e) * D + d] = (bf16)f2bf(wl); } }
    bf16* xb = (bf16*)(ws + WS_XB);
    for (size_t g = (size_t)bid * NTHR + tid; g < (size_t)T * D / 8; g += (size_t)GRID * NTHR) {
        const f32x4 a = *(const f32x4*)(P.x + g * 8), b = *(const f32x4*)(P.x + g * 8 + 4);
        u32x4 o; o.x = pk2(a[0], a[1]); o.y = pk2(a[2], a[3]); o.z = pk2(b[0], b[1]); o.w = pk2(b[2], b[3]);
        *(u32x4*)(xb + g * 8) = o;
    }
}

__device__ __forceinline__ void load_panel_f32(LAS float* dst, const bf16* src, int ldh, int tid) {
    const int row = tid >> 2, c0 = (tid & 3) * 16;
    const bf16* p = src + (size_t)row * ldh + c0;
    const u32x4 a = *(const u32x4*)p, b = *(const u32x4*)(p + 8);
    float f[16]; unpack8(a, f); unpack8(b, f + 8);
    LAS f32x4* d = (LAS f32x4*)(dst + row * 64 + c0);
    d[0] = (f32x4){f[0], f[1], f[2], f[3]}; d[1] = (f32x4){f[4], f[5], f[6], f[7]}; d[2] = (f32x4){f[8], f[9], f[10], f[11]}; d[3] = (f32x4){f[12], f[13], f[14], f[15]};
}
__device__ __forceinline__ void phase_ret_states(LAS unsigned char* lds, const bf16* H, const float* decay, float* S, int bid, int tid) {
    LAS float* kf = (LAS float*)lds; LAS float* vf = kf + 128 * 64; LAS float* zt = (LAS float*)(lds + MISC_OFF + 4096);
    for (int unit = bid; unit < 1024; unit += GRID) {
        const int h = unit >> 7, n = unit & 127;
        const float lgf = log2_gamma(decay[h]), lgb = log2_gamma(decay[8 + h]);
        __syncthreads();
        load_panel_f32(kf, H + (size_t)(n * 128) * EVEN_IN + 512 + h * 64, EVEN_IN, tid);
        load_panel_f32(vf, H + (size_t)(n * 128) * EVEN_IN + 1024 + h * 64, EVEN_IN, tid);
        if (tid < 128) { zt[tid] = exp2f(lgf * (float)(127 - tid)); zt[128 + tid] = exp2f(lgb * (float)tid); }
        __syncthreads();
        const int e = tid >> 3, d0 = (tid & 7) * 8;
        f32x4 af0 = {0, 0, 0, 0}, af1 = af0, ab0 = af0, ab1 = af0;
        for (int m = 0; m < 128; ++m) {
            const float ve = vf[m * 64 + e]; const float a = ve * zt[m], b = ve * zt[128 + m];
            const f32x4 k0 = *(const LAS f32x4*)(kf + m * 64 + d0), k1 = *(const LAS f32x4*)(kf + m * 64 + d0 + 4);
            af0 += k0 * a; af1 += k1 * a; ab0 += k0 * b; ab1 += k1 * b;
        }
        float* sf = S + ((size_t)(h) * 128 + n) * 4096 + e * 64 + d0;
        float* sb = S + ((size_t)(8 + h) * 128 + n) * 4096 + e * 64 + d0;
        *(f32x4*)sf = af0; *(f32x4*)(sf + 4) = af1; *(f32x4*)sb = ab0; *(f32x4*)(sb + 4) = ab1;
    }
}
__device__ __forceinline__ void phase_ret_scan(const float* S, bf16* R, const float* decay, int bid, int tid) {
    for (int g = bid * NTHR + tid; g < 65536; g += GRID * NTHR) {
        const int dir = g >> 15, h = (g >> 12) & 7, de = g & 4095;
        const float gc = exp2f(log2_gamma(decay[dir * 8 + h]) * 128.0f);
        const float* s = S + ((size_t)(dir * 8 + h) * 128) * 4096 + de; bf16* r = R + ((size_t)(dir * 8 + h) * 128) * 4096 + de;
        float a = 0.f;
        if (dir == 0) { for (int n = 0; n < 128; ++n) { r[(size_t)n * 4096] = (bf16)f2bf(a); a = gc * a + s[(size_t)n * 4096]; } }
        else { for (int n = 127; n >= 0; --n) { r[(size_t)n * 4096] = (bf16)f2bf(a); a = gc * a + s[(size_t)n * 4096]; } }
    }
}
__device__ __forceinline__ void phase_ret_out(LAS unsigned char* lds, const bf16* H, const float* R, const float* decay, bf16* Y, int bid, int tid) {
    LAS float* qf = (LAS float*)lds; LAS float* kf = qf + 8192; LAS float* vf = kf + 8192; LAS float* rf = vf + 8192; LAS float* rb = rf + 4096;
    for (int unit = bid; unit < 1024; unit += GRID) {
        const int h = unit >> 7, n = unit & 127;
        const float lgf = log2_gamma(decay[h]), lgb = log2_gamma(decay[8 + h]);
        __syncthreads();
        const bf16* hp = H + (size_t)(n * 128) * EVEN_IN + h * 64;
        load_panel_f32(qf, hp, EVEN_IN, tid); load_panel_f32(kf, hp + 512, EVEN_IN, tid); load_panel_f32(vf, hp + 1024, EVEN_IN, tid);
        { const float* r0 = R + ((size_t)(h) * 128 + n) * 4096 + tid * 8; const float* r1 = R + ((size_t)(8 + h) * 128 + n) * 4096 + tid * 8;
          *(LAS f32x4*)(rf + tid * 8) = *(const f32x4*)r0; *(LAS f32x4*)(rf + tid * 8 + 4) = *(const f32x4*)(r0 + 4);
          *(LAS f32x4*)(rb + tid * 8) = *(const f32x4*)r1; *(LAS f32x4*)(rb + tid * 8 + 4) = *(const f32x4*)(r1 + 4); }
        __syncthreads();
        const int c = tid >> 2, e0 = (tid & 3) * 16;
        f32x4 q[16];
#pragma unroll
        for (int i = 0; i < 16; ++i) q[i] = *(const LAS f32x4*)(qf + c * 64 + 4 * i);
        f32x4 of[4], ob[4];
#pragma unroll
        for (int i = 0; i < 4; ++i) { of[i] = (f32x4){0, 0, 0, 0}; ob[i] = of[i]; }
        for (int m = 0; m < 128; ++m) {
            f32x4 sv = {0, 0, 0, 0};
#pragma unroll
            for (int i = 0; i < 16; ++i) sv += q[i] * *(const LAS f32x4*)(kf + m * 64 + 4 * i);
            const float s = (sv[0] + sv[1]) + (sv[2] + sv[3]);
            const float df = (float)(c - m);
            const float pf = (m <= c) ? exp2f(lgf * df) : 0.0f;
            const float pb = (m > c) ? exp2f(-lgb * df) : 0.0f;
            const float wf = s * pf, wb = s * pb;
#pragma unroll
            for (int i = 0; i < 4; ++i) { const f32x4 v = *(const LAS f32x4*)(vf + m * 64 + e0 + 4 * i); of[i] += v * wf; ob[i] += v * wb; }
        }
        f32x4 cf[4], cb[4];
#pragma unroll
        for (int i = 0; i < 4; ++i) { cf[i] = (f32x4){0, 0, 0, 0}; cb[i] = cf[i]; }
#pragma unroll
        for (int d4 = 0; d4 < 16; ++d4)
#pragma unroll
            for (int dd = 0; dd < 4; ++dd) {
                const float qd = q[d4][dd]; const int d = 4 * d4 + dd;
#pragma unroll
                for (int i = 0; i < 4; ++i) { cf[i] += *(const LAS f32x4*)(rf + d * 64 + e0 + 4 * i) * qd; cb[i] += *(const LAS f32x4*)(rb + d * 64 + e0 + 4 * i) * qd; }
            }
        const float xif = exp2f(lgf * (float)(c + 1)), xib = exp2f(lgb * (float)(128 - c));
        float sf = 0.f, sb = 0.f;
#pragma unroll
        for (int i = 0; i < 4; ++i) { of[i] += cf[i] * xif; ob[i] += cb[i] * xib; sf += (of[i][0] + of[i][1]) + (of[i][2] + of[i][3]); sb += (ob[i][0] + ob[i][1]) + (ob[i][2] + ob[i][3]); }
        sf += shx(sf, 1); sf += shx(sf, 2); sb += shx(sb, 1); sb += shx(sb, 2);
        const float muf = sf * (1.0f / 64.0f), mub = sb * (1.0f / 64.0f);
        float vfq = 0.f, vbq = 0.f;
#pragma unroll
        for (int i = 0; i < 4; ++i) { of[i] = of[i] - muf; ob[i] = ob[i] - mub;
            vfq += (of[i][0] * of[i][0] + of[i][1] * of[i][1]) + (of[i][2] * of[i][2] + of[i][3] * of[i][3]);
            vbq += (ob[i][0] * ob[i][0] + ob[i][1] * ob[i][1]) + (ob[i][2] * ob[i][2] + ob[i][3] * ob[i][3]); }
        vfq += shx(vfq, 1); vfq += shx(vfq, 2); vbq += shx(vbq, 1); vbq += shx(vbq, 2);
        const float rsf = 1.0f / sqrtf(vfq * (1.0f / 64.0f) + GN_EPS), rsb = 1.0f / sqrtf(vbq * (1.0f / 64.0f) + GN_EPS);
        const int tok = n * 128 + c;
        const bf16* gp = H + (size_t)tok * EVEN_IN + 1536 + h * 64 + e0;
        float gf[16], gb[16];
        unpack8(*(const u32x4*)gp, gf); unpack8(*(const u32x4*)(gp + 8), gf + 8); unpack8(*(const u32x4*)(gp + 512), gb); unpack8(*(const u32x4*)(gp + 520), gb + 8);
        float y[16];
#pragma unroll
        for (int i = 0; i < 16; ++i) { const float a = gf[i] * sigmoidf_(gf[i]), b = gb[i] * sigmoidf_(gb[i]); y[i] = a * (of[i >> 2][i & 3] * rsf) + b * (ob[i >> 2][i & 3] * rsb); }
        bf16* yp = Y + (size_t)tok * D + h * 64 + e0;
        u32x4 w0, w1; w0.x = pk2(y[0], y[1]); w0.y = pk2(y[2], y[3]); w0.z = pk2(y[4], y[5]); w0.w = pk2(y[6], y[7]); w1.x = pk2(y[8], y[9]); w1.y = pk2(y[10], y[11]); w1.z = pk2(y[12], y[13]); w1.w = pk2(y[14], y[15]);
        *(u32x4*)yp = w0; *(u32x4*)(yp + 8) = w1;
    }
}

struct OnlineSm { float m, l; f32x4 o[16]; };
__device__ __forceinline__ void load_q64(const bf16* p, f32x4 (&q)[16]) {
#pragma unroll
    for (int i = 0; i < 8; ++i) { float f[8]; unpack8(*(const u32x4*)(p + 8 * i), f); q[2 * i] = (f32x4){f[0], f[1], f[2], f[3]}; q[2 * i + 1] = (f32x4){f[4], f[5], f[6], f[7]}; }
}
__device__ __forceinline__ float dot64(const f32x4 (&q)[16], const bf16* kp) {
    f32x4 sv = {0, 0, 0, 0};
#pragma unroll
    for (int i = 0; i < 8; ++i) { float f[8]; unpack8(*(const u32x4*)(kp + 8 * i), f); sv += q[2 * i] * (f32x4){f[0], f[1], f[2], f[3]}; sv += q[2 * i + 1] * (f32x4){f[4], f[5], f[6], f[7]}; }
    return (sv[0] + sv[1]) + (sv[2] + sv[3]);
}
__device__ __forceinline__ void sm_update(OnlineSm& st, float s, const bf16* vp) {
    const float mn = fmaxf(st.m, s), sc = __expf(st.m - mn), p = __expf(s - mn);
    st.l = st.l * sc + p; st.m = mn;
#pragma unroll
    for (int i = 0; i < 8; ++i) { float f[8]; unpack8(*(const u32x4*)(vp + 8 * i), f);
        st.o[2 * i] = st.o[2 * i] * sc + (f32x4){f[0], f[1], f[2], f[3]} * p; st.o[2 * i + 1] = st.o[2 * i + 1] * sc + (f32x4){f[4], f[5], f[6], f[7]} * p; }
}
__device__ __forceinline__ void sm_store(const OnlineSm& st, bf16* yp) {
    const float inv = 1.0f / st.l;
#pragma unroll
    for (int i = 0; i < 8; ++i) { const f32x4 a = st.o[2 * i] * inv, b = st.o[2 * i + 1] * inv; u32x4 w; w.x = pk2(a[0], a[1]); w.y = pk2(a[2], a[3]); w.z = pk2(b[0], b[1]); w.w = pk2(b[2], b[3]); *(u32x4*)(yp + 8 * i) = w; }
}
__device__ __forceinline__ void phase_dilated(const bf16* H, bf16* Y, int bid, int tid) {
    const int g = bid * NTHR + tid, h = g >> 14, i = g & 16383;
    f32x4 q[16]; load_q64(H + (size_t)i * EVEN_IN + 2560 + h * 64, q);
    OnlineSm st; st.m = -1e30f; st.l = 0.f;
#pragma unroll
    for (int k = 0; k < 16; ++k) st.o[k] = (f32x4){0, 0, 0, 0};
    for (int b = 0; b < 3; ++b) {
        const int dil = (b == 0) ? 1 : ((b == 1) ? 4 : 16);
        for (int jj = -64; jj <= 64; ++jj) {
            const int j = i + dil * jj;
            if (j < 0 || j >= T) continue;
            const bf16* kp = H + (size_t)j * EVEN_IN + 3072 + h * 64;
            const float s = dot64(q, kp);
            sm_update(st, s, kp + 512);
        }
    }
    sm_store(st, Y + (size_t)i * D + 512 + h * 64);
}
__device__ __forceinline__ void phase_natten(const bf16* H, const float* rpb, bf16* Y, int bid, int tid) {
    for (int rep = 0; rep < 2; ++rep) {
        const int g = rep * (GRID * NTHR) + bid * NTHR + tid, h = g >> 14, i = g & 16383, r = i >> 6, c = i & 63;
        const int r0 = min(max(r - 4, 0), 248), c0 = min(max(c - 8, 0), 48);
        f32x4 q[16]; load_q64(H + (size_t)i * ODD_IN + h * 64, q);
        OnlineSm st; st.m = -1e30f; st.l = 0.f;
#pragma unroll
        for (int k = 0; k < 16; ++k) st.o[k] = (f32x4){0, 0, 0, 0};
        for (int ii = 0; ii < 8; ++ii)
            for (int jj = 0; jj < 16; ++jj) {
                const int kr = r0 + ii, kc = c0 + jj, j = kr * 64 + kc;
                const float bias = rpb[(h * 15 + (kr - r + 7)) * 31 + (kc - c + 15)];
                const bf16* kp = H + (size_t)j * ODD_IN + 1024 + h * 64;
                const float s = dot64(q, kp) + bias;
                sm_update(st, s, kp + 1024);
            }
        sm_store(st, Y + (size_t)i * D + h * 64);
    }
}

typedef short s16x4 __attribute__((ext_vector_type(4)));
__device__ __forceinline__ void tr_read8(unsigned a0, unsigned a1, unsigned a2, unsigned a3, s16x4 (&r)[8]) {
    asm volatile("ds_read_b64_tr_b16 %0, %8\n\tds_read_b64_tr_b16 %1, %8 offset:2048\n\tds_read_b64_tr_b16 %2, %9\n\tds_read_b64_tr_b16 %3, %9 offset:2048\n\t"
                 "ds_read_b64_tr_b16 %4, %10\n\tds_read_b64_tr_b16 %5, %10 offset:2048\n\tds_read_b64_tr_b16 %6, %11\n\tds_read_b64_tr_b16 %7, %11 offset:2048\n\ts_waitcnt lgkmcnt(0)"
                 : "=&v"(r[0]), "=&v"(r[1]), "=&v"(r[2]), "=&v"(r[3]), "=&v"(r[4]), "=&v"(r[5]), "=&v"(r[6]), "=&v"(r[7]) : "v"(a0), "v"(a1), "v"(a2), "v"(a3) : "memory");
}
struct LaneOffs { unsigned k0, k1, v[4]; };
__device__ __forceinline__ LaneOffs lane_offs(int lane) {
    const int i = lane & 15, g = lane >> 4, q = i >> 2, p = i & 3, vrow = 4 * g + q; LaneOffs o;
    o.k0 = (unsigned)(i * 128 + (((g) ^ (i & 7)) << 4)); o.k1 = (unsigned)(i * 128 + (((4 + g) ^ (i & 7)) << 4));
#pragma unroll
    for (int dt = 0; dt < 4; ++dt) o.v[dt] = (unsigned)(vrow * 128 + (((2 * dt + (p >> 1)) ^ (vrow & 7)) << 4) + 8 * (p & 1));
    return o;
}
__device__ __forceinline__ unsigned lds_addr(const LAS unsigned char* p) { return (unsigned)(size_t)p; }
__device__ __forceinline__ void qk_tile(const LAS unsigned char* Kt, const LaneOffs& lo, const bf16x8 q0, const bf16x8 q1, f32x4 (&sa)[2]) {
    const bf16x8 k00 = *(const LAS bf16x8*)(Kt + lo.k0), k01 = *(const LAS bf16x8*)(Kt + lo.k1), k10 = *(const LAS bf16x8*)(Kt + 2048 + lo.k0), k11 = *(const LAS bf16x8*)(Kt + 2048 + lo.k1);
    sa[0] = (f32x4){0.f, 0.f, 0.f, 0.f}; sa[1] = sa[0];
    sa[0] = __builtin_amdgcn_mfma_f32_16x16x32_bf16(k00, q0, sa[0], 0, 0, 0); sa[0] = __builtin_amdgcn_mfma_f32_16x16x32_bf16(k01, q1, sa[0], 0, 0, 0);
    sa[1] = __builtin_amdgcn_mfma_f32_16x16x32_bf16(k10, q0, sa[1], 0, 0, 0); sa[1] = __builtin_amdgcn_mfma_f32_16x16x32_bf16(k11, q1, sa[1], 0, 0, 0);
}
__device__ __forceinline__ void pv_tile(const LAS unsigned char* Vt, const LaneOffs& lo, const f32x4 p0, const f32x4 p1, f32x4 (&o)[4]) {
    const unsigned vb = lds_addr(Vt); s16x4 r[8];
    tr_read8(vb + lo.v[0], vb + lo.v[1], vb + lo.v[2], vb + lo.v[3], r);
    u32x4 pw;
    asm volatile("v_cvt_pk_bf16_f32 %0, %4, %5\n\tv_cvt_pk_bf16_f32 %1, %6, %7\n\tv_cvt_pk_bf16_f32 %2, %8, %9\n\tv_cvt_pk_bf16_f32 %3, %10, %11\n\ts_nop 1"
                 : "=&v"(pw.x), "=&v"(pw.y), "=&v"(pw.z), "=&v"(pw.w) : "v"(p0[0]), "v"(p0[1]), "v"(p0[2]), "v"(p0[3]), "v"(p1[0]), "v"(p1[1]), "v"(p1[2]), "v"(p1[3]));
    const bf16x8 pb = __builtin_bit_cast(bf16x8, pw);
#pragma unroll
    for (int dt = 0; dt < 4; ++dt) { const bf16x8 va = __builtin_shufflevector(r[2 * dt], r[2 * dt + 1], 0, 1, 2, 3, 4, 5, 6, 7); o[dt] = __builtin_amdgcn_mfma_f32_16x16x32_bf16(va, pb, o[dt], 0, 0, 0); }
}
struct SmState { float m, l; f32x4 o[4]; };
__device__ __forceinline__ void sm_init(SmState& st) { st.m = -1e30f; st.l = 0.f;
#pragma unroll
    for (int dt = 0; dt < 4; ++dt) st.o[dt] = (f32x4){0.f, 0.f, 0.f, 0.f}; }
__device__ __forceinline__ void sm_step(SmState& st, f32x4 (&sa)[2], const LAS unsigned char* Vt, const LaneOffs& lo) {
    float tm = fmaxf(fmaxf(fmaxf(sa[0][0], sa[0][1]), fmaxf(sa[0][2], sa[0][3])), fmaxf(fmaxf(sa[1][0], sa[1][1]), fmaxf(sa[1][2], sa[1][3])));
    tm = fmaxf(tm, shx(tm, 16)); tm = fmaxf(tm, shx(tm, 32));
    const float mn = fmaxf(st.m, tm), sc = exp2f(st.m - mn);
    float ps = 0.f;
#pragma unroll
    for (int a = 0; a < 2; ++a)
#pragma unroll
        for (int r = 0; r < 4; ++r) { sa[a][r] = exp2f(sa[a][r] - mn); ps += sa[a][r]; }
    st.l = st.l * sc + ps; st.m = mn;
#pragma unroll
    for (int dt = 0; dt < 4; ++dt) st.o[dt] = st.o[dt] * sc;
    pv_tile(Vt, lo, sa[0], sa[1], st.o);
}

constexpr int DIL_UNITS = 8 * 3 * 128;
__device__ __forceinline__ void dil_decode(int u, int& h, int& b, int& r, int& blk) { h = u / 384; const int rem = u - h * 384; b = rem >> 7; const int x = rem & 127; r = x >> (7 - 2 * b); blk = x & ((128 >> (2 * b)) - 1); }
__device__ __forceinline__ void dil_issue(const bf16* H, int u, int tid, u32x4 (&kr)[4], u32x4 (&vr)[4]) {
    int h, b, r, blk; dil_decode(u, h, b, r, blk); const int Lc = T >> (2 * b), base = 128 * blk - 64;
#pragma unroll
    for (int k = 0; k < 4; ++k) { const int id = tid + 512 * k, row = id >> 3, c = id & 7, ki = base + row; const bool ok = (ki >= 0) && (ki < Lc);
        const bf16* src = H + (size_t)(r + (ki << (2 * b))) * EVEN_IN + 3072 + h * 64 + c * 8;
        kr[k] = ok ? *(const u32x4*)src : (u32x4){0u, 0u, 0u, 0u}; vr[k] = ok ? *(const u32x4*)(src + 512) : (u32x4){0u, 0u, 0u, 0u}; }
}
__device__ __forceinline__ void dil_commit(LAS unsigned char* buf, int tid, const u32x4 (&kr)[4], const u32x4 (&vr)[4]) {
#pragma unroll
    for (int k = 0; k < 4; ++k) { const int id = tid + 512 * k, row = id >> 3, c = id & 7; const unsigned off = (unsigned)(row * 128 + ((c ^ (row & 7)) << 4));
        *(LAS u32x4*)(buf + off) = kr[k]; *(LAS u32x4*)(buf + 32768 + off) = vr[k]; }
}
__device__ __forceinline__ void phase_dilated_mfma(LAS unsigned char* lds, const bf16* H, bf16* OG, float* LSE, int bid, int tid) {
    const int wave = tid >> 6, lane = tid & 63, i16 = lane & 15, g = lane >> 4;
    const LaneOffs lo = lane_offs(lane);
    u32x4 kr[4], vr[4];
    __syncthreads();
    dil_issue(H, bid, tid, kr, vr); dil_commit(lds, tid, kr, vr);
    __syncthreads();
    int it = 0;
    for (int u = bid; u < DIL_UNITS; u += GRID, ++it) {
        LAS unsigned char* buf = lds + (it & 1) * 65536;
        const bool has_next = (u + GRID) < DIL_UNITS;
        if (has_next) dil_issue(H, u + GRID, tid, kr, vr);
        int h, b, r, blk; dil_decode(u, h, b, r, blk); const int Lc = T >> (2 * b), base = 128 * blk - 64;
        const int ql = 16 * wave + i16, tokq = r + ((128 * blk + ql) << (2 * b));
        const bf16* qp = H + (size_t)tokq * EVEN_IN + 2560 + h * 64 + 8 * g;
        const bf16x8 q0 = *(const bf16x8*)qp, q1 = *(const bf16x8*)(qp + 32);
        SmState st; sm_init(st);
        const int t0 = wave >> 1;
#pragma unroll 1
        for (int t = t0; t < t0 + 5; ++t) {
            f32x4 sa[2]; qk_tile(buf + t * 4096, lo, q0, q1, sa);
#pragma unroll
            for (int a = 0; a < 2; ++a)
#pragma unroll
                for (int rg = 0; rg < 4; ++rg) { const int kl = 32 * t + 16 * a + 4 * g + rg, ki = base + kl; const bool ok = (kl >= ql) && (kl <= ql + 128) && (ki >= 0) && (ki < Lc);
                    sa[a][rg] = ok ? sa[a][rg] * 1.4426950408889634f : -INFINITY; }
            sm_step(st, sa, buf + 32768 + t * 4096, lo);
        }
        float l = st.l; l += shx(l, 16); l += shx(l, 32);
        const float inv = 1.0f / l;
        bf16* op = OG + ((size_t)b * T + tokq) * 512 + h * 64 + 4 * g;
#pragma unroll
        for (int dt = 0; dt < 4; ++dt) { const f32x4 o = st.o[dt] * inv; u32x2 w; w.x = cvt_pk_bf16(o[0], o[1]); w.y = cvt_pk_bf16(o[2], o[3]); *(u32x2*)(op + 16 * dt) = w; }
        if (g == 0) LSE[((size_t)b * T + tokq) * 8 + h] = (st.m + log2f(l)) * 0.6931471805599453f;
        if (has_next) dil_commit(lds + ((it + 1) & 1) * 65536, tid, kr, vr);
        __syncthreads();
    }
}
__device__ __forceinline__ void phase_dil_merge(const bf16* OG, const float* LSE, bf16* Y, int bid, int tid) {
    for (int item = bid * NTHR + tid; item < T * 64; item += GRID * NTHR) {
        const int tok = item >> 6, h = (item >> 3) & 7, c = item & 7;
        const float l0 = LSE[((size_t)0 * T + tok) * 8 + h], l1 = LSE[((size_t)1 * T + tok) * 8 + h], l2 = LSE[((size_t)2 * T + tok) * 8 + h];
        const float mx = fmaxf(l0, fmaxf(l1, l2)); float w0 = __expf(l0 - mx), w1 = __expf(l1 - mx), w2 = __expf(l2 - mx); const float inv = 1.0f / (w0 + w1 + w2); w0 *= inv; w1 *= inv; w2 *= inv;
        float a[8], b[8], d[8];
        unpack8(*(const u32x4*)(OG + ((size_t)0 * T + tok) * 512 + h * 64 + c * 8), a); unpack8(*(const u32x4*)(OG + ((size_t)1 * T + tok) * 512 + h * 64 + c * 8), b); unpack8(*(const u32x4*)(OG + ((size_t)2 * T + tok) * 512 + h * 64 + c * 8), d);
        float y[8];
#pragma unroll
        for (int j = 0; j < 8; ++j) y[j] = w0 * a[j] + w1 * b[j] + w2 * d[j];
        u32x4 o; o.x = pk2(y[0], y[1]); o.y = pk2(y[2], y[3]); o.z = pk2(y[4], y[5]); o.w = pk2(y[6], y[7]);
        *(u32x4*)(Y + (size_t)tok * D + 512 + h * 64 + c * 8) = o;
    }
}

__device__ __forceinline__ void phase_natten_mfma(LAS unsigned char* lds, const bf16* H, const float* rpb, bf16* Y, int bid, int tid) {
    const int wave = tid >> 6, lane = tid & 63, i16 = lane & 15, g = lane >> 4, cb = wave & 3, half = wave >> 2;
    const LaneOffs lo = lane_offs(lane);
    LAS float* btab = (LAS float*)(lds + MISC_OFF + 4096);
    LAS float* mbuf = (LAS float*)lds;
    const int wc0 = (cb == 0) ? 0 : (cb == 1) ? 8 : (cb == 2) ? 24 : 32;
    const int c = 16 * cb + i16, cs = min(max(c - 8, 0), 48);
#pragma unroll 1
    for (int k = 0; k < 16; ++k) {
        const int u = bid * 16 + k, h = u >> 8, r = u & 255, r0 = min(max(r - 4, 0), 248);
        __syncthreads();
#pragma unroll
        for (int kk = 0; kk < 8; ++kk) { const int id = tid + 512 * kk, row = id >> 3, ch = id & 7; const unsigned off = (unsigned)(row * 128 + ((ch ^ (row & 7)) << 4));
            const bf16* src = H + (size_t)(r0 * 64 + row) * ODD_IN + 1024 + h * 64 + ch * 8;
            *(LAS u32x4*)(lds + off) = *(const u32x4*)src; *(LAS u32x4*)(lds + 65536 + off) = *(const u32x4*)(src + 1024); }
        if (tid < 465) btab[tid] = rpb[h * 465 + tid];
        __syncthreads();
        const int tokq = r * 64 + c;
        const bf16* qp = H + (size_t)tokq * ODD_IN + h * 64 + 8 * g;
        const bf16x8 q0 = *(const bf16x8*)qp, q1 = *(const bf16x8*)(qp + 32);
        SmState st; sm_init(st);
#pragma unroll 1
        for (int tt = 0; tt < 4; ++tt) {
            const int krl = 4 * half + tt; const unsigned tb = (unsigned)((krl * 64 + wc0) * 128);
            f32x4 sa[2]; qk_tile(lds + tb, lo, q0, q1, sa);
            const int brow = (r0 + krl - r + 7) * 31 - c + 15;
#pragma unroll
            for (int a = 0; a < 2; ++a)
#pragma unroll
                for (int rg = 0; rg < 4; ++rg) { const int col = wc0 + 16 * a + 4 * g + rg; const bool ok = (col >= cs) && (col < cs + 16);
                    const float bias = btab[ok ? (brow + col) : 0];
                    sa[a][rg] = ok ? (sa[a][rg] + bias) * 1.4426950408889634f : -INFINITY; }
            sm_step(st, sa, lds + 65536 + tb, lo);
        }
        float l = st.l; l += shx(l, 16); l += shx(l, 32);
        __syncthreads();
        if (half == 1) { LAS float* mb = mbuf + ((wave - 4) * 64 + lane) * 20; mb[0] = st.m; mb[1] = l;
#pragma unroll
            for (int dt = 0; dt < 4; ++dt) *(LAS f32x4*)(mb + 4 + 4 * dt) = st.o[dt]; }
        __syncthreads();
        if (half == 0) { const LAS float* mb = mbuf + (wave * 64 + lane) * 20; const float m2 = mb[0], l2 = mb[1];
            const float M = fmaxf(st.m, m2), a1 = exp2f(st.m - M), a2 = exp2f(m2 - M); const float inv = 1.0f / (l * a1 + l2 * a2);
            bf16* op = Y + (size_t)tokq * D + h * 64 + 4 * g;
#pragma unroll
            for (int dt = 0; dt < 4; ++dt) { const f32x4 o2 = *(const LAS f32x4*)(mb + 4 + 4 * dt); const f32x4 o = (st.o[dt] * a1 + o2 * a2) * inv;
                u32x2 w; w.x = cvt_pk_bf16(o[0], o[1]); w.y = cvt_pk_bf16(o[2], o[3]); *(u32x2*)(op + 16 * dt) = w; } }
    }
}

__device__ __forceinline__ void ret_issue(const bf16* H, int u, int tid, u32x4 (&kr)[2], u32x4 (&vr)[2]) {
    const int h = u >> 7, n = u & 127;
#pragma unroll
    for (int k = 0; k < 2; ++k) { const int id = tid + 512 * k, row = id >> 3, c = id & 7; const bf16* src = H + (size_t)(n * 128 + row) * EVEN_IN + 512 + h * 64 + c * 8;
        kr[k] = *(const u32x4*)src; vr[k] = *(const u32x4*)(src + 512); }
}
__device__ __forceinline__ void ret_commit(LAS unsigned char* buf, int tid, const u32x4 (&kr)[2], const u32x4 (&vr)[2]) {
#pragma unroll
    for (int k = 0; k < 2; ++k) { const int id = tid + 512 * k, row = id >> 3, c = id & 7; const unsigned off = (unsigned)(row * 128 + ((c ^ (row & 7)) << 4));
        *(LAS u32x4*)(buf + off) = kr[k]; *(LAS u32x4*)(buf + 16384 + off) = vr[k]; }
}
__device__ __forceinline__ void phase_ret_out_mfma(LAS unsigned char* lds, const bf16* H, const bf16* RT, const float* decay, bf16* Y, int bid, int tid) {
    const int wave = tid >> 6, lane = tid & 63, i16 = lane & 15, g = lane >> 4;
    const LaneOffs lo = lane_offs(lane);
    u32x4 kr[2], vr[2];
    __syncthreads();
    ret_issue(H, bid, tid, kr, vr); ret_commit(lds, tid, kr, vr);
    __syncthreads();
    int it = 0;
    bf16x8 nq0, nq1;
    { const bf16* qp = H + (size_t)((bid & 127) * 128 + 16 * wave + i16) * EVEN_IN + (bid >> 7) * 64 + 8 * g; nq0 = *(const bf16x8*)qp; nq1 = *(const bf16x8*)(qp + 32); }
    for (int u = bid; u < 1024; u += GRID, ++it) {
        LAS unsigned char* buf = lds + (it & 1) * 32768;
        const bool has_next = (u + GRID) < 1024;
        if (has_next) ret_issue(H, u + GRID, tid, kr, vr);
        const int h = u >> 7, n = u & 127;
        const float lgf = log2_gamma(decay[h]), lgb = log2_gamma(decay[8 + h]);
        const int c = 16 * wave + i16, tok = n * 128 + c;
        const bf16x8 q0 = nq0, q1 = nq1;
        if (has_next) { const int u2 = u + GRID; const bf16* qp = H + (size_t)((u2 & 127) * 128 + c) * EVEN_IN + (u2 >> 7) * 64 + 8 * g; nq0 = *(const bf16x8*)qp; nq1 = *(const bf16x8*)(qp + 32); }
        f32x4 of[4], ob[4];
#pragma unroll
        for (int dt = 0; dt < 4; ++dt) { of[dt] = (f32x4){0.f, 0.f, 0.f, 0.f}; ob[dt] = of[dt]; }
#pragma unroll 1
        for (int t = 0; t < 4; ++t) {
            f32x4 sa[2]; qk_tile(buf + t * 4096, lo, q0, q1, sa);
            f32x4 pf[2], pb[2];
#pragma unroll
            for (int a = 0; a < 2; ++a)
#pragma unroll
                for (int rg = 0; rg < 4; ++rg) { const int m = 32 * t + 16 * a + 4 * g + rg; const float df = (float)(c - m);
                    pf[a][rg] = (m <= c) ? sa[a][rg] * exp2f(lgf * df) : 0.0f; pb[a][rg] = (m > c) ? sa[a][rg] * exp2f(-lgb * df) : 0.0f; }
            if (32 * t <= 16 * wave + 15) pv_tile(buf + 16384 + t * 4096, lo, pf[0], pf[1], of);
            if (32 * t + 31 > 16 * wave) pv_tile(buf + 16384 + t * 4096, lo, pb[0], pb[1], ob);
        }
        const bf16* rtf = RT + ((size_t)(h) * 128 + n) * 4096 + i16 * 64 + 8 * g; const bf16* rtb = RT + ((size_t)(8 + h) * 128 + n) * 4096 + i16 * 64 + 8 * g;
        const float xif = exp2f(lgf * (float)(c + 1)), xib = exp2f(lgb * (float)(128 - c));
#pragma unroll
        for (int et = 0; et < 4; ++et) {
            f32x4 cf = {0.f, 0.f, 0.f, 0.f}, cb = cf;
            cf = __builtin_amdgcn_mfma_f32_16x16x32_bf16(*(const bf16x8*)(rtf + et * 1024), q0, cf, 0, 0, 0); cf = __builtin_amdgcn_mfma_f32_16x16x32_bf16(*(const bf16x8*)(rtf + et * 1024 + 32), q1, cf, 0, 0, 0);
            cb = __builtin_amdgcn_mfma_f32_16x16x32_bf16(*(const bf16x8*)(rtb + et * 1024), q0, cb, 0, 0, 0); cb = __builtin_amdgcn_mfma_f32_16x16x32_bf16(*(const bf16x8*)(rtb + et * 1024 + 32), q1, cb, 0, 0, 0);
            of[et] += cf * xif; ob[et] += cb * xib;
        }
        float sf = 0.f, sb = 0.f;
#pragma unroll
        for (int dt = 0; dt < 4; ++dt) { sf += (of[dt][0] + of[dt][1]) + (of[dt][2] + of[dt][3]); sb += (ob[dt][0] + ob[dt][1]) + (ob[dt][2] + ob[dt][3]); }
        sf += shx(sf, 16); sf += shx(sf, 32); sb += shx(sb, 16); sb += shx(sb, 32);
        const float muf = sf * (1.0f / 64.0f), mub = sb * (1.0f / 64.0f);
        float vfq = 0.f, vbq = 0.f;
#pragma unroll
        for (int dt = 0; dt < 4; ++dt) { of[dt] = of[dt] - muf; ob[dt] = ob[dt] - mub;
            vfq += (of[dt][0] * of[dt][0] + of[dt][1] * of[dt][1]) + (of[dt][2] * of[dt][2] + of[dt][3] * of[dt][3]);
            vbq += (ob[dt][0] * ob[dt][0] + ob[dt][1] * ob[dt][1]) + (ob[dt][2] * ob[dt][2] + ob[dt][3] * ob[dt][3]); }
        vfq += shx(vfq, 16); vfq += shx(vfq, 32); vbq += shx(vbq, 16); vbq += shx(vbq, 32);
        const float rsf = 1.0f / sqrtf(vfq * (1.0f / 64.0f) + GN_EPS), rsb = 1.0f / sqrtf(vbq * (1.0f / 64.0f) + GN_EPS);
        const bf16* gp = H + (size_t)tok * EVEN_IN + 1536 + h * 64 + 4 * g;
        bf16* yp = Y + (size_t)tok * D + h * 64 + 4 * g;
#pragma unroll
        for (int dt = 0; dt < 4; ++dt) {
            const u32x2 wf = *(const u32x2*)(gp + 16 * dt), wb = *(const u32x2*)(gp + 512 + 16 * dt);
            const f32x4 gf = {bflo(wf.x), bfhi(wf.x), bflo(wf.y), bfhi(wf.y)}, gb = {bflo(wb.x), bfhi(wb.x), bflo(wb.y), bfhi(wb.y)};
            f32x4 y;
#pragma unroll
            for (int j = 0; j < 4; ++j) y[j] = gf[j] * sigmoidf_(gf[j]) * (of[dt][j] * rsf) + gb[j] * sigmoidf_(gb[j]) * (ob[dt][j] * rsb);
            u32x2 w; w.x = cvt_pk_bf16(y[0], y[1]); w.y = cvt_pk_bf16(y[2], y[3]); *(u32x2*)(yp + 16 * dt) = w;
        }
        if (has_next) ret_commit(lds + ((it + 1) & 1) * 32768, tid, kr, vr);
        __syncthreads();
    }
}

__device__ __forceinline__ void tr_read2(unsigned a, s16x4& r0, s16x4& r1) {
    asm volatile("ds_read_b64_tr_b16 %0, %2\n\tds_read_b64_tr_b16 %1, %2 offset:2048\n\ts_waitcnt lgkmcnt(0)" : "=&v"(r0), "=&v"(r1) : "v"(a) : "memory");
}
__device__ __forceinline__ u32x4 scale8(const u32x4 w, float z) {
    u32x4 o; o.x = pk2(bflo(w.x) * z, bfhi(w.x) * z); o.y = pk2(bflo(w.y) * z, bfhi(w.y) * z); o.z = pk2(bflo(w.z) * z, bfhi(w.z) * z); o.w = pk2(bflo(w.w) * z, bfhi(w.w) * z); return o;
}
__device__ __forceinline__ void rs_commit(LAS unsigned char* buf, int tid, const u32x4 (&kr)[2], const u32x4 (&vr)[2], float lgf, float lgb) {
#pragma unroll
    for (int k = 0; k < 2; ++k) { const int id = tid + 512 * k, row = id >> 3, c = id & 7; const unsigned off = (unsigned)(row * 128 + ((c ^ (row & 7)) << 4));
        *(LAS u32x4*)(buf + off) = scale8(kr[k], exp2f(lgf * (float)(127 - row))); *(LAS u32x4*)(buf + 16384 + off) = scale8(kr[k], exp2f(lgb * (float)row)); *(LAS u32x4*)(buf + 32768 + off) = vr[k]; }
}
__device__ __forceinline__ void phase_ret_states_mfma(LAS unsigned char* lds, const bf16* H, const float* decay, float* S, int bid, int tid) {
    const int wave = tid >> 6, lane = tid & 63, i16 = lane & 15, g = lane >> 4, dir = wave >> 2, et = wave & 3;
    const LaneOffs lo = lane_offs(lane);
    unsigned voff_et;
    { const int q = i16 >> 2, p = i16 & 3, vrow = 4 * g + q; voff_et = (unsigned)(vrow * 128 + (((2 * et + (p >> 1)) ^ (vrow & 7)) << 4) + 8 * (p & 1)); }
    u32x4 kr[2], vr[2];
    __syncthreads();
    ret_issue(H, bid, tid, kr, vr); rs_commit(lds, tid, kr, vr, log2_gamma(decay[bid >> 7]), log2_gamma(decay[8 + (bid >> 7)]));
    __syncthreads();
    int it = 0;
    for (int u = bid; u < 1024; u += GRID, ++it) {
        LAS unsigned char* buf = lds + (it & 1) * 49152;
        const bool has_next = (u + GRID) < 1024;
        if (has_next) ret_issue(H, u + GRID, tid, kr, vr);
        const int h = u >> 7, n = u & 127;
        f32x4 acc[4];
#pragma unroll
        for (int dt = 0; dt < 4; ++dt) acc[dt] = (f32x4){0.f, 0.f, 0.f, 0.f};
        const unsigned kb = lds_addr(buf + dir * 16384), vb = lds_addr(buf + 32768);
#pragma unroll
        for (int ks = 0; ks < 4; ++ks) {
            s16x4 a0, a1; tr_read2(vb + ks * 4096 + voff_et, a0, a1);
            const bf16x8 af = __builtin_shufflevector(a0, a1, 0, 1, 2, 3, 4, 5, 6, 7);
#pragma unroll
            for (int dt = 0; dt < 4; ++dt) { s16x4 b0, b1; tr_read2(kb + ks * 4096 + lo.v[dt], b0, b1);
                const bf16x8 bfr = __builtin_shufflevector(b0, b1, 0, 1, 2, 3, 4, 5, 6, 7); acc[dt] = __builtin_amdgcn_mfma_f32_16x16x32_bf16(af, bfr, acc[dt], 0, 0, 0); }
        }
        float* sp = S + ((size_t)(dir * 8 + h) * 128 + n) * 4096 + (16 * et + 4 * g) * 64 + i16;
#pragma unroll
        for (int dt = 0; dt < 4; ++dt)
#pragma unroll
            for (int rg = 0; rg < 4; ++rg) sp[rg * 64 + 16 * dt] = acc[dt][rg];
        if (has_next) { const int h2 = (u + GRID) >> 7; rs_commit(lds + ((it + 1) & 1) * 49152, tid, kr, vr, log2_gamma(decay[h2]), log2_gamma(decay[8 + h2])); }
        __syncthreads();
    }
}

template <int NT> __device__ __forceinline__ void sf_finish(f32x4 (&sc)[NT][2], const unsigned (&vt)[NT], const LaneOffs& lo, f32x4 (&o)[4], float& m_out, float& l_out) {
    float m = -1e30f;
#pragma unroll
    for (int t = 0; t < NT; ++t)
#pragma unroll
        for (int a = 0; a < 2; ++a) m = fmaxf(m, fmaxf(fmaxf(sc[t][a][0], sc[t][a][1]), fmaxf(sc[t][a][2], sc[t][a][3])));
    m = fmaxf(m, shx(m, 16)); m = fmaxf(m, shx(m, 32));
    float l = 0.f;
#pragma unroll
    for (int t = 0; t < NT; ++t)
#pragma unroll
        for (int a = 0; a < 2; ++a)
#pragma unroll
            for (int r = 0; r < 4; ++r) { sc[t][a][r] = __builtin_amdgcn_exp2f(sc[t][a][r] - m); l += sc[t][a][r]; }
#pragma unroll
    for (int dt = 0; dt < 4; ++dt) o[dt] = (f32x4){0.f, 0.f, 0.f, 0.f};
#pragma unroll
    for (int t = 0; t < NT; ++t) {
        s16x4 r[8]; tr_read8(vt[t] + lo.v[0], vt[t] + lo.v[1], vt[t] + lo.v[2], vt[t] + lo.v[3], r);
        u32x4 pw;
        asm volatile("v_cvt_pk_bf16_f32 %0, %4, %5\n\tv_cvt_pk_bf16_f32 %1, %6, %7\n\tv_cvt_pk_bf16_f32 %2, %8, %9\n\tv_cvt_pk_bf16_f32 %3, %10, %11\n\ts_nop 1"
                     : "=&v"(pw.x), "=&v"(pw.y), "=&v"(pw.z), "=&v"(pw.w) : "v"(sc[t][0][0]), "v"(sc[t][0][1]), "v"(sc[t][0][2]), "v"(sc[t][0][3]), "v"(sc[t][1][0]), "v"(sc[t][1][1]), "v"(sc[t][1][2]), "v"(sc[t][1][3]));
        const bf16x8 pb = __builtin_bit_cast(bf16x8, pw);
#pragma unroll
        for (int dt = 0; dt < 4; ++dt) { const bf16x8 va = __builtin_shufflevector(r[2 * dt], r[2 * dt + 1], 0, 1, 2, 3, 4, 5, 6, 7); o[dt] = __builtin_amdgcn_mfma_f32_16x16x32_bf16(va, pb, o[dt], 0, 0, 0); }
    }
    l += shx(l, 16); l += shx(l, 32);
    m_out = m; l_out = l;
}

__device__ __forceinline__ void phase_dilated_sf(LAS unsigned char* lds, const bf16* H, bf16* OG, float* LSE, int bid, int tid) {
    const int wave = tid >> 6, lane = tid & 63, i16 = lane & 15, g = lane >> 4;
    const LaneOffs lo = lane_offs(lane);
    u32x4 kr[4], vr[4];
    __syncthreads();
    dil_issue(H, bid, tid, kr, vr); dil_commit(lds, tid, kr, vr);
    __syncthreads();
    int it = 0;
    bf16x8 nq0, nq1;
    { int h, b, r, blk; dil_decode(bid, h, b, r, blk); const bf16* qp = H + (size_t)(r + ((128 * blk + 16 * wave + i16) << (2 * b))) * EVEN_IN + 2560 + h * 64 + 8 * g; nq0 = *(const bf16x8*)qp; nq1 = *(const bf16x8*)(qp + 32); }
    for (int u = bid; u < DIL_UNITS; u += GRID, ++it) {
        LAS unsigned char* buf = lds + (it & 1) * 65536;
        const bool has_next = (u + GRID) < DIL_UNITS;
        if (has_next) dil_issue(H, u + GRID, tid, kr, vr);
        int h, b, r, blk; dil_decode(u, h, b, r, blk); const int Lc = T >> (2 * b), base = 128 * blk - 64;
        const int ql = 16 * wave + i16, tokq = r + ((128 * blk + ql) << (2 * b));
        const bf16x8 q0 = nq0, q1 = nq1;
        if (has_next) { int h2, b2, r2, blk2; dil_decode(u + GRID, h2, b2, r2, blk2); const bf16* qp = H + (size_t)(r2 + ((128 * blk2 + ql) << (2 * b2))) * EVEN_IN + 2560 + h2 * 64 + 8 * g; nq0 = *(const bf16x8*)qp; nq1 = *(const bf16x8*)(qp + 32); }
        const int t0 = wave >> 1;
        f32x4 sc[5][2]; unsigned vt[5];
#pragma unroll
        for (int tt = 0; tt < 5; ++tt) { const int t = t0 + tt; qk_tile(buf + t * 4096, lo, q0, q1, sc[tt]); vt[tt] = lds_addr(buf + 32768 + t * 4096);
#pragma unroll
            for (int a = 0; a < 2; ++a)
#pragma unroll
                for (int rg = 0; rg < 4; ++rg) { const int kl = 32 * t + 16 * a + 4 * g + rg, ki = base + kl; const bool ok = (kl >= ql) && (kl <= ql + 128) && (ki >= 0) && (ki < Lc);
                    sc[tt][a][rg] = ok ? sc[tt][a][rg] * 1.4426950408889634f : -INFINITY; } }
        f32x4 o[4]; float m, l; sf_finish<5>(sc, vt, lo, o, m, l);
        const float inv = 1.0f / l;
        bf16* op = OG + ((size_t)b * T + tokq) * 512 + h * 64 + 4 * g;
#pragma unroll
        for (int dt = 0; dt < 4; ++dt) { const f32x4 ov = o[dt] * inv; u32x2 w; w.x = cvt_pk_bf16(ov[0], ov[1]); w.y = cvt_pk_bf16(ov[2], ov[3]); *(u32x2*)(op + 16 * dt) = w; }
        if (g == 0) LSE[((size_t)b * T + tokq) * 8 + h] = (m + log2f(l)) * 0.6931471805599453f;
        if (has_next) dil_commit(lds + ((it + 1) & 1) * 65536, tid, kr, vr);
        __syncthreads();
    }
}

__device__ __forceinline__ int na_r0(int r) { return min(max(r - 4, 0), 248); }
__device__ __forceinline__ void na_issue(const bf16* H, int h, int row_lo, int nrows, int tid, u32x4 (&pr)[4]) {
#pragma unroll
    for (int k = 0; k < 4; ++k) { const int id = tid + 512 * k, which = id >> 10, rs = (id >> 9) & 1, key = (id >> 3) & 63, ch = id & 7;
        if (rs < nrows) pr[k] = *(const u32x4*)(H + (size_t)((row_lo + rs) * 64 + key) * ODD_IN + 1024 + which * 1024 + h * 64 + ch * 8); }
}
__device__ __forceinline__ void na_commit(LAS unsigned char* lds, int row_lo, int nrows, int tid, const u32x4 (&pr)[4]) {
#pragma unroll
    for (int k = 0; k < 4; ++k) { const int id = tid + 512 * k, which = id >> 10, rs = (id >> 9) & 1, key = (id >> 3) & 63, ch = id & 7;
        if (rs < nrows) *(LAS u32x4*)(lds + which * 73728 + ((row_lo + rs) % 9) * 8192 + key * 128 + ((ch ^ (key & 7)) << 4)) = pr[k]; }
}
__device__ __forceinline__ void phase_natten_sf(LAS unsigned char* lds, const bf16* H, const float* rpb, bf16* Y, int bid, int tid) {
    const int wave = tid >> 6, lane = tid & 63, i16 = lane & 15, g = lane >> 4, cb = wave & 3, rq = wave >> 2;
    const LaneOffs lo = lane_offs(lane);
    LAS float* btab = (LAS float*)(lds + MISC_OFF + 4096);
    const int wc0 = (cb == 0) ? 0 : (cb == 1) ? 8 : (cb == 2) ? 24 : 32;
    const int c = 16 * cb + i16, cs = min(max(c - 8, 0), 48);
    const int h = bid >> 4, rbase = (bid & 15) * 16;
    __syncthreads();
    if (tid < 465) btab[tid] = rpb[h * 465 + tid];
    u32x4 pr[4];
    {
        const int wlo = na_r0(rbase), whi = na_r0(rbase + 1) + 7;
        u32x4 p5[5][4];
#pragma unroll
        for (int i = 0; i < 5; ++i) { const int rr = wlo + 2 * i; na_issue(H, h, rr, min(2, max(whi - rr + 1, 0)), tid, p5[i]); }
#pragma unroll
        for (int i = 0; i < 5; ++i) { const int rr = wlo + 2 * i; na_commit(lds, rr, min(2, max(whi - rr + 1, 0)), tid, p5[i]); }
    }
    bf16x8 nq0, nq1;
    { const bf16* qp = H + (size_t)((rbase + rq) * 64 + c) * ODD_IN + h * 64 + 8 * g; nq0 = *(const bf16x8*)qp; nq1 = *(const bf16x8*)(qp + 32); }
    __syncthreads();
#pragma unroll 1
    for (int k = 0; k < 8; ++k) {
        const int r = rbase + 2 * k, rme = r + rq, r0 = na_r0(rme);
        const int whi = na_r0(r + 1) + 7, nhi = (k < 7) ? (na_r0(r + 3) + 7) : whi, nnew = nhi - whi;
        if (nnew > 0) na_issue(H, h, whi + 1, nnew, tid, pr);
        const int tokq = rme * 64 + c;
        const bf16x8 q0 = nq0, q1 = nq1;
        if (k < 7) { const bf16* qp = H + (size_t)(tokq + 128) * ODD_IN + h * 64 + 8 * g; nq0 = *(const bf16x8*)qp; nq1 = *(const bf16x8*)(qp + 32); }
        f32x4 sc[8][2]; unsigned vt[8];
#pragma unroll
        for (int t = 0; t < 8; ++t) { const int kr = r0 + t; const unsigned tb = (unsigned)((kr % 9) * 8192 + wc0 * 128);
            qk_tile(lds + tb, lo, q0, q1, sc[t]); vt[t] = lds_addr(lds + 73728 + tb);
            const int brow = (kr - rme + 7) * 31 - c + 15;
#pragma unroll
            for (int a = 0; a < 2; ++a)
#pragma unroll
                for (int rg = 0; rg < 4; ++rg) { const int col = wc0 + 16 * a + 4 * g + rg; const bool ok = (col >= cs) && (col < cs + 16);
                    const float bias = btab[ok ? (brow + col) : 0];
                    sc[t][a][rg] = ok ? (sc[t][a][rg] + bias) * 1.4426950408889634f : -INFINITY; } }
        f32x4 o[4]; float m, l; sf_finish<8>(sc, vt, lo, o, m, l);
        const float inv = 1.0f / l;
        bf16* op = Y + (size_t)tokq * D + h * 64 + 4 * g;
#pragma unroll
        for (int dt = 0; dt < 4; ++dt) { const f32x4 ov = o[dt] * inv; u32x2 w; w.x = cvt_pk_bf16(ov[0], ov[1]); w.y = cvt_pk_bf16(ov[2], ov[3]); *(u32x2*)(op + 16 * dt) = w; }
        __syncthreads();
        if (nnew > 0) na_commit(lds, whi + 1, nnew, tid, pr);
        __syncthreads();
    }
}

__device__ __forceinline__ void phase_ln1_router(LAS unsigned char* lds, const float* U, const float* lng, const float* lnb, const float* rw, const float* rbias,
                                                 float* X1, bf16* X1b, int* tope, float* gate, int* lrank, int* cnt, int bid, int tid) {
    const int wave = tid >> 6, lane = tid & 63;
    LAS int* lcnt = (LAS int*)(lds + MISC_OFF + 1024);
    __syncthreads();
    for (int idx = tid; idx < 1024 * 8; idx += NTHR) { const int d = idx >> 3, c = idx & 7;
        *(LAS f32x4*)(lds + d * 128 + ((c ^ ((d >> 1) & 7)) << 4)) = *(const f32x4*)(rw + d * 32 + c * 4); }
    if (tid < 32) lcnt[tid] = 0;
    __syncthreads();
    float gg[16], bb[16];
#pragma unroll
    for (int i = 0; i < 16; ++i) { gg[i] = lng[64 * i + lane]; bb[i] = lnb[64 * i + lane]; }
    const float rbe = rbias[lane >> 1];
    for (int rr = 0; rr < 8; ++rr) {
        const int row = bid * 64 + wave * 8 + rr;
        float x[16]; float s = 0.f;
#pragma unroll
        for (int i = 0; i < 16; ++i) { x[i] = U[(size_t)row * D + 64 * i + lane]; s += x[i]; }
        const float mean = wave_sum(s) * (1.0f / D); float s2 = 0.f;
#pragma unroll
        for (int i = 0; i < 16; ++i) { x[i] -= mean; s2 += x[i] * x[i]; }
        const float rstd = 1.0f / sqrtf(wave_sum(s2) * (1.0f / D) + LN_EPS);
#pragma unroll
        for (int i = 0; i < 16; ++i) { x[i] = x[i] * rstd * gg[i] + bb[i]; X1[(size_t)row * D + 64 * i + lane] = x[i]; X1b[(size_t)row * D + 64 * i + lane] = (bf16)f2bf(x[i]); }
        float acc[32];
#pragma unroll
        for (int e = 0; e < 32; ++e) acc[e] = 0.f;
#pragma unroll
        for (int i = 0; i < 16; ++i) { const int d = 64 * i + lane;
#pragma unroll
            for (int c = 0; c < 8; ++c) { const f32x4 w = *(const LAS f32x4*)(lds + d * 128 + ((c ^ ((d >> 1) & 7)) << 4));
                acc[4 * c] += x[i] * w[0]; acc[4 * c + 1] += x[i] * w[1]; acc[4 * c + 2] += x[i] * w[2]; acc[4 * c + 3] += x[i] * w[3]; } }
#pragma unroll
        for (int t = 0; t < 16; ++t) { const bool up = (lane & 32) != 0; const float snd = up ? acc[t] : acc[t + 16]; const float rcv = shx(snd, 32); acc[t] = (up ? acc[t + 16] : acc[t]) + rcv; }
#pragma unroll
        for (int t = 0; t < 8; ++t) { const bool up = (lane & 16) != 0; const float snd = up ? acc[t] : acc[t + 8]; const float rcv = shx(snd, 16); acc[t] = (up ? acc[t + 8] : acc[t]) + rcv; }
#pragma unroll
        for (int t = 0; t < 4; ++t) { const bool up = (lane & 8) != 0; const float snd = up ? acc[t] : acc[t + 4]; const float rcv = shx(snd, 8); acc[t] = (up ? acc[t + 4] : acc[t]) + rcv; }
#pragma unroll
        for (int t = 0; t < 2; ++t) { const bool up = (lane & 4) != 0; const float snd = up ? acc[t] : acc[t + 2]; const float rcv = shx(snd, 4); acc[t] = (up ? acc[t + 2] : acc[t]) + rcv; }
        { const bool up = (lane & 2) != 0; const float snd = up ? acc[0] : acc[1]; const float rcv = shx(snd, 2); acc[0] = (up ? acc[1] : acc[0]) + rcv; }
        float lv = acc[0] + shx(acc[0], 1) + rbe;
        const int me = lane >> 1;
        float tv[4]; int ti[4];
#pragma unroll
        for (int k = 0; k < 4; ++k) {
            float bv = lv; int bi = me;
#pragma unroll
            for (int o = 32; o >= 1; o >>= 1) { const float ov = shx(bv, o); const int oi = shx(bi, o); if (ov > bv || (ov == bv && oi < bi)) { bv = ov; bi = oi; } }
            tv[k] = bv; ti[k] = bi; if (me == bi) lv = -INFINITY;
        }
        const float p1 = expf(tv[1] - tv[0]), p2 = expf(tv[2] - tv[0]), p3 = expf(tv[3] - tv[0]); const float inv = 1.0f / (1.0f + p1 + p2 + p3);
        if (lane < 4) {
            const int e = (lane == 0) ? ti[0] : (lane == 1) ? ti[1] : (lane == 2) ? ti[2] : ti[3];
            const float gk = ((lane == 0) ? 1.0f : (lane == 1) ? p1 : (lane == 2) ? p2 : p3) * inv;
            const int rk = __hip_atomic_fetch_add(lcnt + e, 1, __ATOMIC_RELAXED, __HIP_MEMORY_SCOPE_WORKGROUP);
            tope[row * 4 + lane] = e; gate[row * 4 + lane] = gk; lrank[row * 4 + lane] = rk;
        }
    }
    __syncthreads();
    if (tid < 32) cnt[bid * 32 + tid] = lcnt[tid];
}

__device__ __forceinline__ void phase_ln1_router_mfma(LAS unsigned char* lds, const float* U, const float* lng, const float* lnb, const bf16* rwt, const float* rbias,
                                                      float* X1, bf16* X1b, bf16* X1lo, int* tope, float* gate, int* lrank, int* cnt, int bid, int tid) {
    const int wave = tid >> 6, lane = tid & 63, i16 = lane & 15, g = lane >> 4;
    LAS int* lcnt = (LAS int*)(lds + MISC_OFF + 1024);
    LAS float* pbuf = (LAS float*)lds;
    __syncthreads();
    if (tid < 32) lcnt[tid] = 0;
    {   f32x4 gg[4], bb[4];
#pragma unroll
        for (int j = 0; j < 4; ++j) { gg[j] = *(const f32x4*)(lng + 256 * j + 4 * lane); bb[j] = *(const f32x4*)(lnb + 256 * j + 4 * lane); }
#pragma unroll 2
        for (int rr = 0; rr < 8; ++rr) {
            const size_t ro = (size_t)(bid * 64 + wave * 8 + rr) * D + 4 * lane;
            f32x4 v[4]; float s = 0.f;
#pragma unroll
            for (int j = 0; j < 4; ++j) { v[j] = *(const f32x4*)(U + ro + 256 * j); s += (v[j][0] + v[j][1]) + (v[j][2] + v[j][3]); }
            const float mean = wave_sum(s) * (1.0f / D); float s2 = 0.f;
#pragma unroll
            for (int j = 0; j < 4; ++j) { v[j] = v[j] - mean; s2 += (v[j][0] * v[j][0] + v[j][1] * v[j][1]) + (v[j][2] * v[j][2] + v[j][3] * v[j][3]); }
            const float rstd = 1.0f / sqrtf(wave_sum(s2) * (1.0f / D) + LN_EPS);
#pragma unroll
            for (int j = 0; j < 4; ++j) { const f32x4 o = v[j] * rstd * gg[j] + bb[j]; *(f32x4*)(X1 + ro + 256 * j) = o;
                const unsigned h0 = f2bf(o[0]), h1 = f2bf(o[1]), h2 = f2bf(o[2]), h3 = f2bf(o[3]);
                u32x2 wh; wh.x = h0 | (h1 << 16); wh.y = h2 | (h3 << 16); *(u32x2*)(X1b + ro + 256 * j) = wh;
                u32x2 wl; wl.x = pk2(o[0] - __builtin_bit_cast(float, h0 << 16), o[1] - __builtin_bit_cast(float, h1 << 16)); wl.y = pk2(o[2] - __builtin_bit_cast(float, h2 << 16), o[3] - __builtin_bit_cast(float, h3 << 16));
                *(u32x2*)(X1lo + ro + 256 * j) = wl; }
        }
    }
    asm volatile("s_waitcnt vmcnt(0)" ::: "memory");
    __syncthreads();
    const int rt = wave & 3, kh = wave >> 2;
    f32x4 acc[2]; acc[0] = (f32x4){0.f, 0.f, 0.f, 0.f}; acc[1] = acc[0];
    {   const size_t ao = (size_t)(bid * 64 + rt * 16 + i16) * D + kh * 512 + 8 * g;
        const bf16* bh = rwt + (size_t)i16 * D + kh * 512 + 8 * g; const bf16* bl = bh + (size_t)NEXP * D;
#pragma unroll 4
        for (int s = 0; s < 16; ++s) {
            const bf16x8 ah = *(const bf16x8*)(X1b + ao + 32 * s), al = *(const bf16x8*)(X1lo + ao + 32 * s);
#pragma unroll
            for (int et = 0; et < 2; ++et) { const bf16x8 wh = *(const bf16x8*)(bh + (size_t)et * 16 * D + 32 * s), wl = *(const bf16x8*)(bl + (size_t)et * 16 * D + 32 * s);
                acc[et] = __builtin_amdgcn_mfma_f32_16x16x32_bf16(ah, wh, acc[et], 0, 0, 0); acc[et] = __builtin_amdgcn_mfma_f32_16x16x32_bf16(ah, wl, acc[et], 0, 0, 0); acc[et] = __builtin_amdgcn_mfma_f32_16x16x32_bf16(al, wh, acc[et], 0, 0, 0); }
        }
    }
    if (kh == 1) { LAS f32x4* pb = (LAS f32x4*)(pbuf + ((wave - 4) * 64 + lane) * 8); pb[0] = acc[0]; pb[1] = acc[1]; }
    __syncthreads();
    if (kh == 0) {
        const LAS f32x4* pb = (const LAS f32x4*)(pbuf + (wave * 64 + lane) * 8);
        const float b0 = rbias[i16], b1 = rbias[16 + i16];
        const f32x4 l0 = acc[0] + pb[0] + b0, l1 = acc[1] + pb[1] + b1;
#pragma unroll
        for (int reg = 0; reg < 4; ++reg) {
            float v0 = l0[reg], v1 = l1[reg]; float tv[4]; int ti[4];
#pragma unroll
            for (int k = 0; k < 4; ++k) {
                float bv = (v0 >= v1) ? v0 : v1; int bi = (v0 >= v1) ? i16 : 16 + i16;
#pragma unroll
                for (int o = 1; o < 16; o <<= 1) { const float ov = shx(bv, o); const int oi = shx(bi, o); if (ov > bv || (ov == bv && oi < bi)) { bv = ov; bi = oi; } }
                tv[k] = bv; ti[k] = bi; if (bi == i16) v0 = -INFINITY; if (bi == 16 + i16) v1 = -INFINITY;
            }
            const float p1 = expf(tv[1] - tv[0]), p2 = expf(tv[2] - tv[0]), p3 = expf(tv[3] - tv[0]); const float inv = 1.0f / (1.0f + p1 + p2 + p3);
            if (i16 < 4) {
                const int row = bid * 64 + rt * 16 + 4 * g + reg;
                const int e = (i16 == 0) ? ti[0] : (i16 == 1) ? ti[1] : (i16 == 2) ? ti[2] : ti[3];
                const float gk = ((i16 == 0) ? 1.0f : (i16 == 1) ? p1 : (i16 == 2) ? p2 : p3) * inv;
                const int rk = __hip_atomic_fetch_add(lcnt + e, 1, __ATOMIC_RELAXED, __HIP_MEMORY_SCOPE_WORKGROUP);
                tope[row * 4 + i16] = e; gate[row * 4 + i16] = gk; lrank[row * 4 + i16] = rk;
            }
        }
    }
    __syncthreads();
    if (tid < 32) cnt[bid * 32 + tid] = lcnt[tid];
}

__device__ __forceinline__ void phase_dispatch(LAS unsigned char* lds, const int* cnt, const int* tope, const int* lrank, int* slot, int* tiles, int* rowidx, int bid, int tid) {
    LAS int* tot = (LAS int*)(lds + MISC_OFF + 1024); LAS int* pre = tot + 32; LAS int* pst = pre + 32;
    __syncthreads();
    if (tid < 32) { int t = 0, p = 0; for (int b2 = 0; b2 < GRID; ++b2) { const int v = cnt[b2 * 32 + tid]; t += v; p += (b2 < bid) ? v : 0; } tot[tid] = t; pre[tid] = p; }
    __syncthreads();
    if (tid == 0) { int ps = 0;
#pragma unroll 1
        for (int e = 0; e < NEXP; ++e) { pst[e] = ps; ps += ((tot[e] + 255) >> 8) << 8; }
        pst[NEXP] = ps; }
    __syncthreads();
    if (bid == 0 && tid < 1 + MAXTILES) {
        if (tid == 0) tiles[0] = pst[NEXP] >> 8;
        else { const int i = tid - 1; int ee = 0;
#pragma unroll 1
            for (int e = 0; e < NEXP; ++e) ee = ((pst[e] >> 8) <= i) ? e : ee;
            tiles[tid] = ee; }
    }
    if (bid < NEXP) { const int e = bid, lo = pst[e] + tot[e], hi = pst[e + 1]; for (int i = lo + tid; i < hi; i += NTHR) rowidx[i] = 0; }
    if (tid < 256) { const int row = bid * 64 + (tid >> 2), k = tid & 3; const int e = tope[row * 4 + k]; const int dest = pst[e] + pre[e] + lrank[row * 4 + k]; slot[row * 4 + k] = dest; rowidx[dest] = row; }
}

__device__ __forceinline__ void phase_combine_ln2(const float* X1, const bf16* Oslot, const int* slot, const float* gate, const float* lng, const float* lnb, float* Xout, bf16* Xb, int bid, int tid) {
    const int wave = tid >> 6, lane = tid & 63;
    f32x4 gg[4], bb[4];
#pragma unroll
    for (int j = 0; j < 4; ++j) { gg[j] = *(const f32x4*)(lng + 256 * j + 4 * lane); bb[j] = *(const f32x4*)(lnb + 256 * j + 4 * lane); }
    for (int rr = 0; rr < 8; ++rr) {
        const int row = bid * 64 + wave * 8 + rr;
        f32x4 v[4];
#pragma unroll
        for (int j = 0; j < 4; ++j) v[j] = *(const f32x4*)(X1 + (size_t)row * D + 256 * j + 4 * lane) * ALPHA;
#pragma unroll
        for (int k = 0; k < 4; ++k) { const int s = slot[row * 4 + k]; const float g = gate[row * 4 + k];
#pragma unroll
            for (int j = 0; j < 4; ++j) { const u32x2 w = *(const u32x2*)(Oslot + (size_t)s * D + 256 * j + 4 * lane); v[j] += (f32x4){bflo(w.x), bfhi(w.x), bflo(w.y), bfhi(w.y)} * g; } }
        float s = 0.f;
#pragma unroll
        for (int j = 0; j < 4; ++j) s += (v[j][0] + v[j][1]) + (v[j][2] + v[j][3]);
        const float mean = wave_sum(s) * (1.0f / D); float s2 = 0.f;
#pragma unroll
        for (int j = 0; j < 4; ++j) { v[j] = v[j] - mean; s2 += (v[j][0] * v[j][0] + v[j][1] * v[j][1]) + (v[j][2] * v[j][2] + v[j][3] * v[j][3]); }
        const float rstd = 1.0f / sqrtf(wave_sum(s2) * (1.0f / D) + LN_EPS);
#pragma unroll
        for (int j = 0; j < 4; ++j) { const f32x4 o = v[j] * rstd * gg[j] + bb[j]; *(f32x4*)(Xout + (size_t)row * D + 256 * j + 4 * lane) = o;
            if (Xb) { u32x2 w; w.x = pk2(o[0], o[1]); w.y = pk2(o[2], o[3]); *(u32x2*)(Xb + (size_t)row * D + 256 * j + 4 * lane) = w; } }
    }
}

constexpr int NPH = 10, N_PHASES = 1 + DEPTH * NPH;
struct Args { Ptrs p; int ph_lo, ph_hi; };
static_assert(sizeof(Args) == 17 * 8 + 8, "Args has no padding");
typedef __attribute__((address_space(4))) const Args CArgs;

__global__ void __launch_bounds__(NTHR, 2) fwd_kernel(Args args) {
    extern __shared__ __attribute__((aligned(16))) unsigned char lds_raw[];
    LAS unsigned char* lds0 = (LAS unsigned char*)lds_raw;
    const int tid0 = threadIdx.x, bid0 = blockIdx.x; const int wave0 = __builtin_amdgcn_readfirstlane(tid0 >> 6);
    const int lo = args.ph_lo, hi = args.ph_hi;
    volatile LAS unsigned* MISC = (volatile LAS unsigned*)(lds0 + MISC_OFF);
    if (tid0 < 64) MISC[tid0] = 0u;
    __syncthreads();
    XcdBarrier bar = xcd_barrier_post((unsigned*)(((CArgs*)__builtin_amdgcn_kernarg_segment_ptr())->p.ws + WS_CTL) + CW_BAR, MISC + 8);
#define IN(k) (lo <= (k) && (k) < hi)
#define SEAM(k) do { if (IN(k) && IN((k) + 1)) xcd_barrier(bar, wave0 == 0 && lane_id_nohoist() == 0); } while (0)
#define SITE int tid = wave0 * 64 + lane_id_nohoist(), bid = bid0, L = L0; CArgs* ap = (CArgs*)__builtin_amdgcn_kernarg_segment_ptr(); asm volatile("" : "+v"(tid)); asm volatile("" : "+s"(bid)); asm volatile("" : "+s"(L)); asm volatile("" : "+s"(ap)); LAS unsigned char* lds = lds0; asm volatile("" : "+s"(lds)); \
    unsigned char* ws = ap->p.ws; const int jl = L >> 1; const bool odd = (L & 1) != 0; (void)jl; (void)odd; (void)tid; (void)bid; (void)ws;

    { const int L0 = 0; if (IN(0)) REP(10) { SITE; Ptrs P{}; P.x = ap->p.x; P.ab_w_in = ap->p.ab_w_in; P.ab_w_out = ap->p.ab_w_out; P.c_w_in = ap->p.c_w_in; P.c_w_out = ap->p.c_w_out; P.w_up = ap->p.w_up; P.w_down = ap->p.w_down; P.router_w = ap->p.router_w; P.ws = ws; phase_prologue(P, lds, bid, tid); } }
    SEAM(0);

    for (int L0 = 0; L0 < DEPTH; ++L0) {
        const int pb = 1 + L0 * NPH; const bool odd0 = (L0 & 1) != 0;
        if (IN(pb + 0)) REP(0) {
            if (!odd0) { SITE; pg8::DenseOrder<T / 256, EVEN_IN / 256> S{bid, (const char*)(ws + WS_XB), (const char*)(ws + WS_WIN_E) + (size_t)jl * EVEN_IN * 1024 * 2, nullptr};
                pg8::EpiInEven E{(bf16*)(ws + WS_H), (const float*)(ws + WS_COS), (const float*)(ws + WS_SIN)}; pg8::gemm_phase<pg8::EpiInEven, pg8::DenseOrder<T / 256, EVEN_IN / 256>>(lds, S, E, tid); }
            else { SITE; pg8::DenseOrder<T / 256, ODD_IN / 256> S{bid, (const char*)(ws + WS_XB), (const char*)(ws + WS_WIN_O) + (size_t)jl * ODD_IN * 1024 * 2, nullptr};
                pg8::EpiInOdd E{(bf16*)(ws + WS_H)}; pg8::gemm_phase<pg8::EpiInOdd, pg8::DenseOrder<T / 256, ODD_IN / 256>>(lds, S, E, tid); }
        }
        SEAM(pb + 0);
        if (IN(pb + 1)) REP(1) {
            if (!odd0) { REP(11) { SITE; phase_ret_states_mfma(lds, (const bf16*)(ws + WS_H), ap->p.ret_decay + jl * 16, (float*)(ws + WS_RS), bid, tid); }
                         REP(12) { SITE; phase_dilated_sf(lds, (const bf16*)(ws + WS_H), (bf16*)(ws + WS_ACT), (float*)(ws + WS_OSLOT), bid, tid); } }
            else REP(13) { SITE; phase_natten_sf(lds, (const bf16*)(ws + WS_H), ap->p.c_rpb + (size_t)jl * 16 * 15 * 31, (bf16*)(ws + WS_Y), bid, tid); }
        }
        SEAM(pb + 1);
        if (!odd0) {
            if (IN(pb + 2)) REP(2) { { SITE; phase_ret_scan((const float*)(ws + WS_RS), (bf16*)(ws + WS_RR), ap->p.ret_decay + jl * 16, bid, tid); }
                              { SITE; phase_dil_merge((const bf16*)(ws + WS_ACT), (const float*)(ws + WS_OSLOT), (bf16*)(ws + WS_Y), bid, tid); } }
            SEAM(pb + 2);
            if (IN(pb + 3)) REP(3) { SITE; phase_ret_out_mfma(lds, (const bf16*)(ws + WS_H), (const bf16*)(ws + WS_RR), ap->p.ret_decay + jl * 16, (bf16*)(ws + WS_Y), bid, tid); }
            SEAM(pb + 3);
        }
        if (IN(pb + 4)) REP(4) { SITE;
            pg8::DenseOrder<T / 256, D / 256> S{bid, (const char*)(ws + WS_Y), (const char*)(ws + (odd ? WS_WOUT_O : WS_WOUT_E)) + (size_t)jl * 1024 * 1024 * 2, nullptr};
            pg8::EpiOut E{(L == 0) ? ap->p.x : (const float*)(ws + WS_X), (float*)(ws + WS_U)}; pg8::gemm_phase<pg8::EpiOut, pg8::DenseOrder<T / 256, D / 256>>(lds, S, E, tid);
        }
        SEAM(pb + 4);
        if (IN(pb + 5)) REP(5) { SITE; phase_ln1_router_mfma(lds, (const float*)(ws + WS_U), ap->p.ln_g + (size_t)(L * 2) * D, ap->p.ln_b + (size_t)(L * 2) * D, (const bf16*)(ws + WS_RWT) + (size_t)L * 2 * NEXP * D, ap->p.router_b + L * NEXP,
                                         (float*)(ws + WS_X1), (bf16*)(ws + WS_X1B), (bf16*)(ws + WS_X1LO), (int*)(ws + WS_TOPE), (float*)(ws + WS_GATE), (int*)(ws + WS_LRANK), (int*)(ws + WS_CNT), bid, tid); }
        SEAM(pb + 5);
        if (IN(pb + 6)) REP(6) { SITE; phase_dispatch(lds, (const int*)(ws + WS_CNT), (const int*)(ws + WS_TOPE), (const int*)(ws + WS_LRANK), (int*)(ws + WS_SLOT), (int*)(ws + WS_TILES), (int*)(ws + WS_ROWIDX), bid, tid); }
        SEAM(pb + 6);
        if (IN(pb + 7)) REP(7) { SITE;
            LAS int* ltile = (LAS int*)(lds + MISC_OFF + 2048); const int* tiles = (const int*)(ws + WS_TILES);
            __syncthreads();
            for (int i = tid; i < 1 + MAXTILES; i += NTHR) ltile[i] = tiles[i];
            __syncthreads();
            pg8::GroupOrder<8, 0> S{(int)ltile[0], bid, (const char*)(ws + WS_X1B), (const char*)(ws + WS_WUP) + (size_t)L * 32 * 2048 * 1024 * 2, ltile + 1, (const int*)(ws + WS_ROWIDX), (unsigned*)(ws + WS_CTL), CW_MCNT + L * MAXTILES * 64, 0u};
            pg8::EpiUp E{(bf16*)(ws + WS_ACT), ap->p.b_up + (size_t)L * 32 * 2048}; pg8::gemm_phase<pg8::EpiUp, pg8::GroupOrder<8, 0>, true>(lds, S, E, tid);
        }
        SEAM(pb + 7);
        if (IN(pb + 8)) REP(8) { SITE;
            LAS int* ltile = (LAS int*)(lds + MISC_OFF + 2048); const int* tiles = (const int*)(ws + WS_TILES);
            __syncthreads();
            for (int i = tid; i < 1 + MAXTILES; i += NTHR) ltile[i] = tiles[i];
            __syncthreads();
            pg8::GroupOrder<4, 0> S{(int)ltile[0], bid, (const char*)(ws + WS_ACT), (const char*)(ws + WS_WDN) + (size_t)L * 32 * 1024 * 1024 * 2, ltile + 1, nullptr, (unsigned*)(ws + WS_CTL), CW_MCNT + L * MAXTILES * 64, 0u};
            pg8::EpiDown E{(bf16*)(ws + WS_OSLOT), ap->p.b_down + (size_t)L * 32 * 1024}; pg8::gemm_phase<pg8::EpiDown, pg8::GroupOrder<4, 0>>(lds, S, E, tid);
        }
        SEAM(pb + 8);
        if (IN(pb + 9)) REP(9) { SITE; phase_combine_ln2((const float*)(ws + WS_X1), (const bf16*)(ws + WS_OSLOT), (const int*)(ws + WS_SLOT), (const float*)(ws + WS_GATE), ap->p.ln_g + (size_t)(L * 2 + 1) * D, ap->p.ln_b + (size_t)(L * 2 + 1) * D,
                                          (L == DEPTH - 1) ? ap->p.out : (float*)(ws + WS_X), (L == DEPTH - 1) ? (bf16*)nullptr : (bf16*)(ws + WS_XB), bid, tid); }
        SEAM(pb + 9);
    }
#undef IN
#undef SEAM
#undef SITE
}

extern "C" void kernel_launch(void* const* d_in, const int* in_sizes, int n_in, void* d_out, int out_size, void* d_ws, size_t ws_size, hipStream_t stream) {
    static int ready = 0;
    if (ready == 0) {
        if (n_in != 15 || in_sizes[0] != T * D || out_size != T * D || ws_size < WS_END) {
            fprintf(stderr, "kernel_launch: unexpected problem (n_in %d, in0 %d, out %d, ws %zu); nothing launched\n", n_in, n_in > 0 ? in_sizes[0] : -1, out_size, ws_size); ready = -1; return; }
        if (hipFuncSetAttribute((const void*)fwd_kernel, hipFuncAttributeMaxDynamicSharedMemorySize, LDS_BYTES) != hipSuccess) { fprintf(stderr, "kernel_launch: hipFuncSetAttribute failed\n"); ready = -1; return; }
        int per_cu = 0;
        if (hipOccupancyMaxActiveBlocksPerMultiprocessor(&per_cu, (const void*)fwd_kernel, NTHR, LDS_BYTES) != hipSuccess || per_cu < 1) fprintf(stderr, "kernel_launch: occupancy query reports %d workgroups per CU\n", per_cu);
        (void)hipGetLastError();
        ready = 1;
    }
    if (ready < 0) return;
    (void)hipMemsetAsync((char*)d_ws + WS_CTL, 0, CTL_ZERO_BYTES, stream);
    Args a{};
    a.p.x = (const float*)d_in[0]; a.p.ab_w_in = (const float*)d_in[1]; a.p.ab_w_out = (const float*)d_in[2]; a.p.ret_decay = (const float*)d_in[3];
    a.p.c_w_in = (const float*)d_in[4]; a.p.c_w_out = (const float*)d_in[5]; a.p.c_rpb = (const float*)d_in[6]; a.p.ln_g = (const float*)d_in[7]; a.p.ln_b = (const float*)d_in[8];
    a.p.router_w = (const float*)d_in[9]; a.p.router_b = (const float*)d_in[10]; a.p.w_up = (const float*)d_in[11]; a.p.b_up = (const float*)d_in[12]; a.p.w_down = (const float*)d_in[13]; a.p.b_down = (const float*)d_in[14];
    a.p.out = (float*)d_out; a.p.ws = (unsigned char*)d_ws;
#if N_LAUNCH_MODE == 0
    a.ph_lo = 0; a.ph_hi = N_PHASES;
    hipLaunchKernelGGL(fwd_kernel, dim3(GRID), dim3(NTHR), LDS_BYTES, stream, a);
#else
    for (int ph = 0; ph < N_PHASES; ++ph) {
        if (ph >= 1) { const int L = (ph - 1) / NPH, p = (ph - 1) % NPH; if ((L & 1) && (p == 2 || p == 3)) continue; }
        a.ph_lo = ph; a.ph_hi = ph + 1;
        hipLaunchKernelGGL(fwd_kernel, dim3(GRID), dim3(NTHR), LDS_BYTES, stream, a);
    }
#endif
}
```

```cpp
#include <hip/hip_runtime.h>
#include <cstdio>
#include <cstdint>

#ifndef PROBE_MASK
#define PROBE_MASK 0
#endif
#define REP(id) for (int _r = 0; _r < 1 + ((PROBE_MASK >> (id)) & 1); ++_r)
#ifndef NA_PROBE
#define NA_PROBE 0
#endif
#ifndef N_LAUNCH_MODE
#define N_LAUNCH_MODE 0
#endif

#define GAS __attribute__((address_space(1)))
#define LAS __attribute__((address_space(3)))
typedef unsigned short bf16;
typedef short bf16x8 __attribute__((ext_vector_type(8)));
typedef float f32x4 __attribute__((ext_vector_type(4)));
typedef float f32x2 __attribute__((ext_vector_type(2)));
typedef unsigned u32x4 __attribute__((ext_vector_type(4)));
typedef unsigned u32x2 __attribute__((ext_vector_type(2)));

constexpr int T = 16384, D = 1024, DEPTH = 4, HD = 64, NEXP = 32, TOPK = 4;
constexpr int EVEN_IN = 4096, ODD_IN = 3072;
constexpr int NPAD = T * TOPK + NEXP * 256;
constexpr int MAXTILES = NPAD / 256;
constexpr float LN_EPS = 1e-5f, GN_EPS = 1e-6f;
constexpr float ALPHA = 1.681792830507429f;
constexpr int NWAVES = 8, NTHR = 512, GRID = 256;

constexpr size_t MiB = 1u << 20;
constexpr size_t WS_CTL = 0, CTL_ZERO_BYTES = 1 * MiB;
constexpr size_t WS_COS = 1 * MiB, WS_SIN = 3 * MiB;
constexpr size_t WS_CNT = 5 * MiB;
constexpr size_t WS_TOPE = 6 * MiB, WS_GATE = 7 * MiB, WS_LRANK = 8 * MiB, WS_SLOT = 9 * MiB;
constexpr size_t WS_TILES = 10 * MiB;
constexpr size_t WS_ROWIDX = 10 * MiB + 65536;
constexpr size_t WS_RWT = 11 * MiB;
constexpr size_t WS_X1LO = 1744 * MiB;
constexpr size_t WS_WIN_E = 16 * MiB, WS_WOUT_E = 32 * MiB, WS_WIN_O = 36 * MiB, WS_WOUT_O = 48 * MiB;
constexpr size_t WS_WUP = 64 * MiB, WS_WDN = 576 * MiB;
constexpr size_t WS_X = 832 * MiB, WS_XB = 896 * MiB, WS_H = 928 * MiB, WS_Y = 1056 * MiB, WS_U = 1088 * MiB;
constexpr size_t WS_X1 = 1152 * MiB, WS_X1B = 1216 * MiB, WS_XPERM = 1248 * MiB, WS_ACT = 1392 * MiB, WS_OSLOT = 1536 * MiB;
constexpr size_t WS_RS = 1680 * MiB, WS_RR = 1712 * MiB, WS_END = 1776 * MiB;
static_assert((size_t)NPAD * 1024 * 2 <= 144 * MiB, "slot buffers");
constexpr int CW_TMO = 0;
constexpr int CW_MCNT = 16384;
constexpr int CW_BAR = 4096;

constexpr int RING_BYTES = 131072, MISC_OFF = 147456, LDS_BYTES = 163840;

__device__ __forceinline__ unsigned f2bf(float f) { unsigned u = __builtin_bit_cast(unsigned, f); return (u + 0x7fffu + ((u >> 16) & 1u)) >> 16; }
__device__ __forceinline__ unsigned pk2(float lo, float hi) { return f2bf(lo) | (f2bf(hi) << 16); }
__device__ __forceinline__ float bflo(unsigned w) { return __builtin_bit_cast(float, w << 16); }
__device__ __forceinline__ float bfhi(unsigned w) { return __builtin_bit_cast(float, w & 0xffff0000u); }
__device__ __forceinline__ unsigned cvt_pk_bf16(float lo, float hi) { unsigned r; asm volatile("v_cvt_pk_bf16_f32 %0, %1, %2" : "=v"(r) : "v"(lo), "v"(hi)); return r; }
__device__ __forceinline__ int lane_id_nohoist() { int l; asm volatile("v_mbcnt_lo_u32_b32 %0, -1, 0\n\tv_mbcnt_hi_u32_b32 %0, -1, %0" : "=v"(l)); return l; }
__device__ __forceinline__ int shx(int v, int m) { return __builtin_amdgcn_ds_bpermute((lane_id_nohoist() ^ m) << 2, v); }
__device__ __forceinline__ float shx(float v, int m) { return __builtin_bit_cast(float, __builtin_amdgcn_ds_bpermute((lane_id_nohoist() ^ m) << 2, __builtin_bit_cast(int, v))); }
__device__ __forceinline__ float wave_sum(float v) {
#pragma unroll
    for (int o = 1; o < 64; o <<= 1) v += shx(v, o);
    return v;
}
__device__ __forceinline__ void unpack8(const u32x4 w, float* f) {
    f[0] = bflo(w.x); f[1] = bfhi(w.x); f[2] = bflo(w.y); f[3] = bfhi(w.y); f[4] = bflo(w.z); f[5] = bfhi(w.z); f[6] = bflo(w.w); f[7] = bfhi(w.w);
}
__device__ __forceinline__ float log2_gamma(float logit) { return -log1pf(expf(-logit)) * 1.4426950408889634f; }
__device__ __forceinline__ float sigmoidf_(float z) { return 1.0f / (1.0f + __expf(-z)); }

#define XB_TMO      128
#define XB_XCNT(j)  (256  + 64 * (j))
#define XB_XSUB(j)  (1280 + 64 * (j))
#define XB_XGEN(j)  (2304 + 64 * (j))
#define XB_TOP      3328
#define XB_TOPGEN   3392
#define XCD_BAR_WORDS 3456
#define XB_SPIN_CAP (1u << 18)

__device__ __forceinline__ unsigned xb_ld(unsigned* p)              { return __hip_atomic_load(p, __ATOMIC_RELAXED, __HIP_MEMORY_SCOPE_AGENT); }
__device__ __forceinline__ unsigned xb_add(unsigned* p, unsigned v) { return __hip_atomic_fetch_add(p, v, __ATOMIC_RELAXED, __HIP_MEMORY_SCOPE_AGENT); }
__device__ __forceinline__ unsigned xb_xcc_id() { return (unsigned)__builtin_amdgcn_s_getreg((3 << 11) | 20) & 0xFu; }
#define XB_SPIN(cond, bar) do { unsigned _sp = 0; while (cond) { __builtin_amdgcn_s_sleep(1); \
    if ((++_sp & 255u) == 0u) { if (xb_ld(&(bar)[XB_TMO])) break; if (_sp > XB_SPIN_CAP) { atomicAdd(&(bar)[XB_TMO], 1u); break; } } } } while (0)

struct XcdBarrier { unsigned* bar; unsigned x; volatile LAS unsigned* st; };

__device__ __forceinline__ XcdBarrier xcd_barrier_post(unsigned* bar, volatile LAS unsigned* st) {
    XcdBarrier b; b.bar = bar; b.x = xb_xcc_id(); b.st = st;
    if (threadIdx.x == 0) (void)xb_add(&bar[XB_XCNT(b.x)], 1u);
    return b;
}
__device__ __forceinline__ void xcd_barrier_complete(unsigned* bar, unsigned x, unsigned& nloc, unsigned& nx) {
    const unsigned G = gridDim.x * gridDim.y * gridDim.z;
    unsigned sum, cnt, mine, sp = 0u;
    for (;;) {
        sum = 0u; cnt = 0u; mine = 0u;
#pragma unroll
        for (unsigned j = 0; j < 16; ++j) { const unsigned c = xb_ld(&bar[XB_XCNT(j)]); sum += c; cnt += (c > 0u) ? 1u : 0u; mine = (j == x) ? c : mine; }
        if (sum == G) break;
        __builtin_amdgcn_s_sleep(1);
        if ((++sp & 255u) == 0u) { if (xb_ld(&bar[XB_TMO])) break; if (sp > XB_SPIN_CAP) { atomicAdd(&bar[XB_TMO], 1u); break; } }
    }
    nloc = mine > 0u ? mine : 1u; nx = cnt > 0u ? cnt : 1u;
}
__device__ __forceinline__ void xcd_barrier(const XcdBarrier& b0, const bool leader) {
    XcdBarrier b = b0; asm volatile("" : "+s"(b.bar)); asm volatile("" : "+s"(b.x));
    asm volatile("s_waitcnt vmcnt(0)" ::: "memory");
    __syncthreads();
    if (leader) {
        unsigned* bar = b.bar;
        __builtin_amdgcn_s_waitcnt(0);
        unsigned nloc = b.st[0], nx = b.st[1];
        if (nloc == 0u) { xcd_barrier_complete(bar, b.x, nloc, nx); b.st[0] = nloc; b.st[1] = nx; }
        const unsigned old = xb_add(&bar[XB_XSUB(b.x)], 1u);
        const unsigned gen = old / nloc;
        if (old + 1u == (gen + 1u) * nloc) {
            __builtin_amdgcn_fence(__ATOMIC_RELEASE, "agent");
            asm volatile("s_waitcnt vmcnt(0)" ::: "memory");
            const unsigned og = xb_add(&bar[XB_TOP], 1u);
            const unsigned tg = og / nx;
            if (og + 1u == (tg + 1u) * nx) xb_add(&bar[XB_TOPGEN], 1u);
            else XB_SPIN(xb_ld(&bar[XB_TOPGEN]) == tg, bar);
            __builtin_amdgcn_fence(__ATOMIC_ACQUIRE, "agent");
            xb_add(&bar[XB_XGEN(b.x)], 1u);
            asm volatile("s_waitcnt vmcnt(0)" ::: "memory");
        } else {
            XB_SPIN(xb_ld(&bar[XB_XGEN(b.x)]) == gen, bar);
            __builtin_amdgcn_fence(__ATOMIC_ACQUIRE, "agent");
            asm volatile("s_waitcnt vmcnt(0)" ::: "memory");
        }
    }
    __syncthreads();
}

namespace pg8 {
constexpr int BM = 256, BK = 64, HALF = 128, HTB = HALF * BK * 2, STAGE_BYTES = 8 * HTB, NXCD = 8, WGM = 8, KD = 1024;
constexpr size_t TILE_BYTES = (size_t)BM * KD * 2;

__host__ __device__ __forceinline__ int lds_byte(int r, int c) { const int st = (r >> 4) * 2 + (c >> 5), rr = r & 15, cc = c & 31, ob = rr * 64 + cc * 2; return st * 1024 + (ob ^ (((ob >> 9) & 1) << 5)); }
__host__ __device__ __forceinline__ void stage_rc(int b, int& R, int& C) { const int st = b / 1024, sb = b % 1024, swz = sb ^ (((sb >> 9) & 1) << 5); R = (st >> 1) * 16 + swz / 64; C = (st & 1) * 32 + (swz % 64) / 2; }
__host__ __device__ __forceinline__ int perm32(int rho) { const int n = rho >> 4, i = rho & 15; return 8 * (i >> 2) + 4 * n + (i & 3); }

struct Unit { int pm, pn, e; };

template <int nN> __device__ __forceinline__ bool order_next(int i, int c, int nM, int& pm, int& pn) {
    constexpr int G = GRID;
    const int nwg = nM * nN; const long L = (long)i * G + c; if (L >= nwg) return false;
    int wgid = (int)L; { const int q = nwg / NXCD, r = nwg % NXCD, xcd = wgid % NXCD, off = wgid / NXCD; wgid = (xcd < r ? xcd * (q + 1) : r * (q + 1) + (xcd - r) * q) + off; }
    const int nig = WGM * nN, gid = wgid / nig, fm = gid * WGM, gsz = (nM - fm) < WGM ? (nM - fm) : WGM;
    pm = fm + ((wgid % nig) % gsz); pn = (wgid % nig) / gsz; return true;
}
template <int NM, int NN> struct DenseOrder {
    int c; const char* A; const char* B; const int* rowidx;
    __device__ __forceinline__ bool next(int i, Unit& u) const { u.e = 0; return order_next<NN>(i, c, NM, u.pm, u.pn); }
    __device__ __forceinline__ const char* a_base(const Unit& u) const { return A + (size_t)u.pm * TILE_BYTES; }
    __device__ __forceinline__ const char* b_base(const Unit& u) const { return B + (size_t)u.pn * TILE_BYTES; }
    __device__ __forceinline__ void a_ready(const Unit&, int, int) const {}
    __device__ __forceinline__ void done(int, int) const {}
};
template <int NN, int MODE> struct GroupOrder {
    static constexpr int mode = MODE; static constexpr size_t bstride = (size_t)NN * 256 * 1024 * 2;
    int nM, c; const char* A; const char* B; const LAS int* tile_e; const int* rowidx;
    unsigned* ctl; int moff; unsigned premask;
    __device__ __forceinline__ bool next(int i, Unit& u) const { if (!order_next<NN>(i, c, nM, u.pm, u.pn)) return false; u.e = tile_e[u.pm]; return true; }
    __device__ __forceinline__ const char* a_base(const Unit& u) const { return A + (size_t)u.pm * TILE_BYTES; }
    __device__ __forceinline__ const char* b_base(const Unit& u) const { return B + (size_t)u.e * bstride + (size_t)u.pn * TILE_BYTES; }
    __device__ __forceinline__ void a_ready(const Unit& u, int idx, int tid) const {
        if (mode != 2) return;
        if (tid < 64 && !((premask >> idx) & 1u)) {
            unsigned* dep = ctl + moff; unsigned* tmo = ctl; const unsigned need = 64u;
            const unsigned long long t0 = __builtin_amdgcn_s_memrealtime(); unsigned polls = 0;
            while ((unsigned)__builtin_amdgcn_readfirstlane(__hip_atomic_load(dep + 64 * u.pm, __ATOMIC_RELAXED, __HIP_MEMORY_SCOPE_AGENT)) < need) {
                if ((++polls & 255u) == 0u && __builtin_amdgcn_readfirstlane(__hip_atomic_load(tmo, __ATOMIC_RELAXED, __HIP_MEMORY_SCOPE_AGENT)) != 0u) break;
                if (__builtin_amdgcn_s_memrealtime() - t0 > 2000000ull) { if (tid == 0) __hip_atomic_store(tmo, 1u, __ATOMIC_RELAXED, __HIP_MEMORY_SCOPE_AGENT); break; }
                __builtin_amdgcn_s_sleep(2); }
            __builtin_amdgcn_fence(__ATOMIC_ACQUIRE, "agent");
            asm volatile("s_waitcnt vmcnt(0)" ::: "memory");
        }
        asm volatile("" ::: "memory"); __builtin_amdgcn_s_barrier(); asm volatile("" ::: "memory");
    }
    __device__ __forceinline__ void done(int pm, int lane) const { if (mode == 1 && lane == 0) __hip_atomic_fetch_add(ctl + moff + 64 * pm, 1u, __ATOMIC_RELAXED, __HIP_MEMORY_SCOPE_AGENT); }
};

__device__ __forceinline__ void store8(bf16* p, const f32x4 v0, const f32x4 v1) {
    u32x4 w; w.x = cvt_pk_bf16(v0[0], v0[1]); w.y = cvt_pk_bf16(v0[2], v0[3]); w.z = cvt_pk_bf16(v1[0], v1[1]); w.w = cvt_pk_bf16(v1[2], v1[3]); *(u32x4*)p = w;
}
struct EpiInEven {
    static constexpr bool PERM = true, AFTER_DRAIN = false;
    bf16* H; const float* cs; const float* sn;
    __device__ __forceinline__ void operator()(const f32x4 (&acc)[2][2][4][2], const Unit& u, int wr, int wc, int fr, int fq) const {
        const int pn = u.pn; const bool rope = (pn < 4) || (pn >= 10 && pn < 14);
        const float sc = ((pn >= 2 && pn < 4) || (pn >= 10 && pn < 12)) ? 0.125f : 1.0f;
        const int row0 = u.pm * BM + wr * 64 + fr;
        if (rope) {
#pragma unroll
            for (int ai = 0; ai < 2; ++ai)
#pragma unroll
                for (int m = 0; m < 4; ++m) {
                    const int row = row0 + ai * HALF + m * 16;
                    const float* cr = cs + (size_t)row * 32 + 8 * fq; const float* sr = sn + (size_t)row * 32 + 8 * fq;
                    const f32x4 c0 = *(const f32x4*)cr, c1 = *(const f32x4*)(cr + 4), s0 = *(const f32x4*)sr, s1 = *(const f32x4*)(sr + 4);
                    const f32x4 x1a = acc[ai][0][m][0], x1b = acc[ai][0][m][1], x2a = acc[ai][1][m][0], x2b = acc[ai][1][m][1];
                    const f32x4 o1a = (x1a * c0 - x2a * s0) * sc, o1b = (x1b * c1 - x2b * s1) * sc, o2a = (x2a * c0 + x1a * s0) * sc, o2b = (x2b * c1 + x1b * s1) * sc;
                    bf16* rowp = H + (size_t)row * EVEN_IN + pn * BM + wc * 64 + 8 * fq;
                    store8(rowp, o1a, o1b); store8(rowp + 32, o2a, o2b);
                }
        } else {
#pragma unroll
            for (int ai = 0; ai < 2; ++ai)
#pragma unroll
                for (int m = 0; m < 4; ++m) {
                    bf16* rowp = H + (size_t)(row0 + ai * HALF + m * 16) * EVEN_IN + pn * BM + wc * 32 + 8 * fq;
#pragma unroll
                    for (int bj = 0; bj < 2; ++bj) store8(rowp + bj * HALF, acc[ai][bj][m][0], acc[ai][bj][m][1]);
                }
        }
    }
};
struct EpiInOdd {
    static constexpr bool PERM = true, AFTER_DRAIN = false;
    bf16* H;
    __device__ __forceinline__ void operator()(const f32x4 (&acc)[2][2][4][2], const Unit& u, int wr, int wc, int fr, int fq) const {
        const float sc = (u.pn < 4) ? 0.125f : 1.0f;
        const int row0 = u.pm * BM + wr * 64 + fr;
#pragma unroll
        for (int ai = 0; ai < 2; ++ai)
#pragma unroll
            for (int m = 0; m < 4; ++m) {
                bf16* rowp = H + (size_t)(row0 + ai * HALF + m * 16) * ODD_IN + u.pn * BM + wc * 32 + 8 * fq;
#pragma unroll
                for (int bj = 0; bj < 2; ++bj) store8(rowp + bj * HALF, acc[ai][bj][m][0] * sc, acc[ai][bj][m][1] * sc);
            }
    }
};
struct EpiOut {
    static constexpr bool PERM = false, AFTER_DRAIN = false;
    const float* Xres; float* U;
    __device__ __forceinline__ void operator()(const f32x4 (&acc)[2][2][4][2], const Unit& u, int wr, int wc, int fr, int fq) const {
        const int row0 = u.pm * BM + wr * 64 + fr, col0 = u.pn * BM + wc * 32 + 4 * fq;
#pragma unroll
        for (int ai = 0; ai < 2; ++ai)
#pragma unroll
            for (int m = 0; m < 4; ++m) {
                const size_t off = (size_t)(row0 + ai * HALF + m * 16) * D + col0;
#pragma unroll
                for (int bj = 0; bj < 2; ++bj)
#pragma unroll
                    for (int n = 0; n < 2; ++n) { const f32x4 xr = *(const f32x4*)(Xres + off + bj * HALF + n * 16); *(f32x4*)(U + off + bj * HALF + n * 16) = xr * ALPHA + acc[ai][bj][m][n]; }
            }
    }
};
struct EpiUp {
    static constexpr bool PERM = true, AFTER_DRAIN = false;
    bf16* Act; const float* bup;
    __device__ __forceinline__ void operator()(const f32x4 (&acc)[2][2][4][2], const Unit& u, int wr, int wc, int fr, int fq) const {
        const int row0 = u.pm * BM + wr * 64 + fr, f0 = u.pn * HALF + wc * 32 + 8 * fq;
        const float* bp = bup + (size_t)u.e * 2048 + 2 * f0;
        f32x4 bb[4];
#pragma unroll
        for (int i = 0; i < 4; ++i) bb[i] = *(const f32x4*)(bp + 4 * i);
#pragma unroll
        for (int ai = 0; ai < 2; ++ai)
#pragma unroll
            for (int m = 0; m < 4; ++m) {
                f32x4 o[2];
#pragma unroll
                for (int n = 0; n < 2; ++n) {
                    const f32x4 g = acc[ai][0][m][n], l = acc[ai][1][m][n];
#pragma unroll
                    for (int j = 0; j < 4; ++j) {
                        const float bg = bb[2 * n + (j >> 1)][(j & 1) * 2], bl = bb[2 * n + (j >> 1)][(j & 1) * 2 + 1];
                        const float xg = fminf(g[j] + bg, 7.0f), xl = fminf(fmaxf(l[j] + bl, -7.0f), 7.0f);
                        o[n][j] = xg * sigmoidf_(1.702f * xg) * (xl + 1.0f);
                    }
                }
                u32x4 w; w.x = cvt_pk_bf16(o[0][0], o[0][1]); w.y = cvt_pk_bf16(o[0][2], o[0][3]); w.z = cvt_pk_bf16(o[1][0], o[1][1]); w.w = cvt_pk_bf16(o[1][2], o[1][3]);
                *(u32x4*)(Act + (size_t)(row0 + ai * HALF + m * 16) * 1024 + f0) = w;
            }
    }
};
struct EpiDown {
    static constexpr bool PERM = true, AFTER_DRAIN = false;
    bf16* O; const float* bdn;
    __device__ __forceinline__ void operator()(const f32x4 (&acc)[2][2][4][2], const Unit& u, int wr, int wc, int fr, int fq) const {
        const int row0 = u.pm * BM + wr * 64 + fr, col0 = u.pn * BM + wc * 32 + 8 * fq;
        const float* bp = bdn + (size_t)u.e * 1024 + col0;
        f32x4 bv[2][2];
#pragma unroll
        for (int bj = 0; bj < 2; ++bj)
#pragma unroll
            for (int n = 0; n < 2; ++n) bv[bj][n] = *(const f32x4*)(bp + bj * HALF + 4 * n);
#pragma unroll
        for (int ai = 0; ai < 2; ++ai)
#pragma unroll
            for (int m = 0; m < 4; ++m) {
                bf16* rowp = O + (size_t)(row0 + ai * HALF + m * 16) * 1024 + col0;
#pragma unroll
                for (int bj = 0; bj < 2; ++bj) store8(rowp + bj * HALF, acc[ai][bj][m][0] + bv[bj][0], acc[ai][bj][m][1] + bv[bj][1]);
            }
    }
};

template <class Epi, class Sched, bool GATHER = false, bool ALIGN_EPI = true, bool SP2 = true>
__device__ __forceinline__ void gemm_phase(LAS unsigned char* lds, const Sched& S, const Epi& E, const int tid) {
    const int wid = __builtin_amdgcn_readfirstlane(tid >> 6), lane = tid & 63, wr = wid >> 2, wc = wid & 3, fr = lane & 15, fq = lane >> 4;
    constexpr int K = KD, nt = K / BK;
    unsigned voffB[2]; int Ra[2], Ca[2];
#pragma unroll
    for (int i = 0; i < 2; ++i) { int R, C; stage_rc(tid * 16 + i * 8192, R, C); const int Rb = Epi::PERM ? ((R & ~31) + perm32(R & 31)) : R;
        Ra[i] = R; Ca[i] = C; voffB[i] = (unsigned)(Rb * K + C) * 2u; }
    unsigned vA[2][2], nvA[2][2];
#define PG8_VA(dst, unit) do { _Pragma("unroll") for (int _h = 0; _h < 2; ++_h) _Pragma("unroll") for (int _i = 0; _i < 2; ++_i) \
        dst[_h][_i] = GATHER ? ((unsigned)S.rowidx[(unit).pm * BM + _h * HALF + Ra[_i]] * (unsigned)(K * 2) + (unsigned)(Ca[_i] * 2)) : (unsigned)(((_h * HALF + Ra[_i]) * K + Ca[_i]) * 2); } while (0)
    const size_t kstep = (size_t)(BK * 2);
    const size_t hstep = (size_t)HALF * K * 2;
    const unsigned ldsw = (unsigned)wid * 1024u;
    const int aoff = lds_byte(wr * 64 + fr, fq * 8), boff = lds_byte(wc * 32 + fr, fq * 8);
#define PG8_SA(b, h) (((b) * 2 + (h)) * HTB)
#define PG8_SB(b, h) ((4 + (b) * 2 + (h)) * HTB)
#define PG8_STAGE(bufoff, gbase, voff) do { _Pragma("unroll") for (int _i = 0; _i < 2; ++_i) \
        __builtin_amdgcn_global_load_lds((const unsigned*)((const char*)(gbase) + (voff)[_i]), (LAS unsigned*)(lds + (bufoff) + ldsw + _i * 8192), 16, 0, 0); } while (0)
#define PG8_LDA(dst, b, h) do { _Pragma("unroll") for (int m = 0; m < 4; ++m) _Pragma("unroll") for (int k = 0; k < 2; ++k) dst[m][k] = *(const LAS bf16x8*)(lds + PG8_SA(b, h) + aoff + m * 2048 + k * 1024); } while (0)
#define PG8_LDB(dst, b, h) do { _Pragma("unroll") for (int n = 0; n < 2; ++n) _Pragma("unroll") for (int k = 0; k < 2; ++k) dst[n][k] = *(const LAS bf16x8*)(lds + PG8_SB(b, h) + boff + n * 2048 + k * 1024); } while (0)
#define PG8_MMA(ai, bj, At, Bt) do { __builtin_amdgcn_s_setprio(1); _Pragma("unroll") for (int m = 0; m < 4; ++m) _Pragma("unroll") for (int n = 0; n < 2; ++n) _Pragma("unroll") for (int k = 0; k < 2; ++k) \
        acc[ai][bj][m][n] = __builtin_amdgcn_mfma_f32_16x16x32_bf16(Bt[n][k], At[m][k], acc[ai][bj][m][n], 0, 0, 0); __builtin_amdgcn_s_setprio(0); } while (0)
#define PG8_WAIT_V(n) asm volatile("s_waitcnt vmcnt(" #n ")" ::: "memory")
#define PG8_WAIT_L(n) asm volatile("s_waitcnt lgkmcnt(" #n ")" ::: "memory")
#define PG8_BAR __builtin_amdgcn_s_barrier()
#define PG8_SCHED __builtin_amdgcn_sched_barrier(0)
    Unit cur, nxt; int ui = 0;
    if (!S.next(0, cur)) return;
    f32x4 acc[2][2][4][2];
#pragma unroll
    for (int a = 0; a < 2; ++a)
#pragma unroll
        for (int b = 0; b < 2; ++b)
#pragma unroll
            for (int m = 0; m < 4; ++m)
#pragma unroll
                for (int n = 0; n < 2; ++n) acc[a][b][m][n] = (f32x4){0.f, 0.f, 0.f, 0.f};
    bf16x8 At[4][2], B0[2][2], B1[2][2];
    const char* cA = GATHER ? S.A : S.a_base(cur); const char* cB = S.b_base(cur);
    PG8_VA(vA, cur);
    int pub_pm = -1;
    S.a_ready(cur, 0, tid);
    if constexpr (SP2) {
        PG8_STAGE(PG8_SB(0, 0), cB, voffB); PG8_STAGE(PG8_SB(0, 1), cB + hstep, voffB); PG8_STAGE(PG8_SA(0, 0), cA, vA[0]); PG8_STAGE(PG8_SA(0, 1), cA, vA[1]);
        if (wr == 1) PG8_BAR;
        PG8_WAIT_V(2); PG8_BAR;
        PG8_STAGE(PG8_SB(1, 0), cB + kstep, voffB); PG8_STAGE(PG8_SA(1, 0), cA + kstep, vA[0]); PG8_STAGE(PG8_SB(1, 1), cB + hstep + kstep, voffB);
        PG8_WAIT_V(6); PG8_BAR;
    } else {
        PG8_STAGE(PG8_SB(0, 0), cB, voffB); PG8_STAGE(PG8_SA(0, 0), cA, vA[0]); PG8_STAGE(PG8_SB(0, 1), cB + hstep, voffB); PG8_STAGE(PG8_SA(0, 1), cA, vA[1]);
        if (wr == 1) PG8_BAR;
        PG8_WAIT_V(4); PG8_BAR;
        PG8_STAGE(PG8_SB(1, 0), cB + kstep, voffB); PG8_STAGE(PG8_SA(1, 0), cA + kstep, vA[0]); PG8_STAGE(PG8_SB(1, 1), cB + hstep + kstep, voffB);
        PG8_WAIT_V(6); PG8_BAR;
    }
    for (;;) {
        const bool has_next = S.next(ui + 1, nxt);
        const char* nA = (has_next && !GATHER) ? S.a_base(nxt) : cA; const char* nB = has_next ? S.b_base(nxt) : cB;
        if (GATHER && has_next) PG8_VA(nvA, nxt); else { _Pragma("unroll") for (int _h = 0; _h < 2; ++_h) _Pragma("unroll") for (int _i = 0; _i < 2; ++_i) nvA[_h][_i] = vA[_h][_i]; }
        for (int t = 0; t < nt; t += 2) {
            const bool last = (t == nt - 2);
            const char* a1 = cA + (size_t)(t + 1) * kstep;
            const char* a2 = last ? nA : cA + (size_t)(t + 2) * kstep; const char* b2 = last ? nB : cB + (size_t)(t + 2) * kstep;
            const char* a3 = a2 + kstep; const char* b3 = b2 + kstep;
            if (last) { if (has_next) S.a_ready(nxt, ui + 1, tid);
                        if (pub_pm >= 0) { S.done(pub_pm, lane); pub_pm = -1; } }
            unsigned w0[2], w1[2];
            w0[0] = last ? nvA[0][0] : vA[0][0]; w0[1] = last ? nvA[0][1] : vA[0][1]; w1[0] = last ? nvA[1][0] : vA[1][0]; w1[1] = last ? nvA[1][1] : vA[1][1];
            if constexpr (SP2) {
            PG8_LDB(B0, 0, 0); PG8_LDB(B1, 0, 1); PG8_SCHED; PG8_LDA(At, 0, 0); PG8_STAGE(PG8_SA(1, 1), a1, vA[1]);
            PG8_WAIT_V(8); PG8_WAIT_L(0); PG8_BAR; PG8_MMA(0, 0, At, B0); PG8_MMA(0, 1, At, B1); PG8_BAR; PG8_SCHED;
            PG8_LDA(At, 0, 1); PG8_STAGE(PG8_SB(0, 0), b2, voffB); PG8_STAGE(PG8_SB(0, 1), b2 + hstep, voffB); PG8_STAGE(PG8_SA(0, 0), a2, w0);
            PG8_WAIT_V(8); PG8_WAIT_L(0); PG8_BAR; PG8_MMA(1, 0, At, B0); PG8_MMA(1, 1, At, B1); PG8_BAR; PG8_SCHED;
            PG8_LDB(B0, 1, 0); PG8_LDB(B1, 1, 1); PG8_SCHED; PG8_LDA(At, 1, 0); PG8_STAGE(PG8_SA(0, 1), a2, w1);
            PG8_WAIT_V(8); PG8_WAIT_L(0); PG8_BAR; PG8_MMA(0, 0, At, B0); PG8_MMA(0, 1, At, B1); PG8_BAR; PG8_SCHED;
            PG8_LDA(At, 1, 1); PG8_STAGE(PG8_SB(1, 0), b3, voffB); PG8_STAGE(PG8_SB(1, 1), b3 + hstep, voffB); PG8_STAGE(PG8_SA(1, 0), a3, w0);
            PG8_WAIT_V(8); PG8_WAIT_L(0); PG8_BAR; PG8_MMA(1, 0, At, B0); PG8_MMA(1, 1, At, B1); PG8_BAR; PG8_SCHED;
            } else {
            PG8_LDB(B0, 0, 0); PG8_SCHED; PG8_LDA(At, 0, 0); PG8_STAGE(PG8_SA(1, 1), a1, vA[1]);
            PG8_WAIT_L(8); PG8_BAR; PG8_WAIT_L(0); PG8_MMA(0, 0, At, B0); PG8_BAR; PG8_SCHED;
            PG8_LDB(B1, 0, 1); PG8_STAGE(PG8_SB(0, 0), b2, voffB);
            PG8_BAR; PG8_WAIT_L(0); PG8_MMA(0, 1, At, B1); PG8_BAR;
            PG8_LDA(At, 0, 1); PG8_STAGE(PG8_SA(0, 0), a2, w0);
            PG8_BAR; PG8_WAIT_L(0); PG8_MMA(1, 0, At, B0); PG8_BAR; PG8_SCHED;
            PG8_STAGE(PG8_SB(0, 1), b2 + hstep, voffB);
            PG8_WAIT_V(6); PG8_BAR; PG8_MMA(1, 1, At, B1); PG8_BAR;
            PG8_LDB(B0, 1, 0); PG8_SCHED; PG8_LDA(At, 1, 0); PG8_STAGE(PG8_SA(0, 1), a2, w1);
            PG8_WAIT_L(8); PG8_BAR; PG8_WAIT_L(0); PG8_MMA(0, 0, At, B0); PG8_BAR; PG8_SCHED;
            PG8_LDB(B1, 1, 1); PG8_STAGE(PG8_SB(1, 0), b3, voffB);
            PG8_BAR; PG8_WAIT_L(0); PG8_MMA(0, 1, At, B1); PG8_BAR;
            PG8_LDA(At, 1, 1); PG8_STAGE(PG8_SA(1, 0), a3, w0);
            PG8_BAR; PG8_WAIT_L(0); PG8_MMA(1, 0, At, B0); PG8_BAR; PG8_SCHED;
            PG8_STAGE(PG8_SB(1, 1), b3 + hstep, voffB);
            PG8_WAIT_V(6); PG8_BAR; PG8_MMA(1, 1, At, B1); PG8_BAR;
            }
        }
        if constexpr (ALIGN_EPI) { if (wr == 0) PG8_BAR; }
        E(acc, cur, wr, wc, fr, fq); pub_pm = cur.pm;
        if (!has_next) break;
#pragma unroll
        for (int a = 0; a < 2; ++a)
#pragma unroll
            for (int b = 0; b < 2; ++b)
#pragma unroll
                for (int m = 0; m < 4; ++m)
#pragma unroll
                    for (int n = 0; n < 2; ++n) acc[a][b][m][n] = (f32x4){0.f, 0.f, 0.f, 0.f};
        cur = nxt; cA = nA; cB = nB; ++ui;
#pragma unroll
        for (int _h = 0; _h < 2; ++_h)
#pragma unroll
            for (int _i = 0; _i < 2; ++_i) vA[_h][_i] = nvA[_h][_i];
        if constexpr (ALIGN_EPI) { if (wr == 1) PG8_BAR; }
    }
    PG8_WAIT_V(0);
    if (pub_pm >= 0) S.done(pub_pm, lane);
    if constexpr (!ALIGN_EPI) { if (wr == 0) PG8_BAR; }
    PG8_BAR;
#undef PG8_VA
#undef PG8_SA
#undef PG8_SB
#undef PG8_STAGE
#undef PG8_LDA
#undef PG8_LDB
#undef PG8_MMA
#undef PG8_WAIT_V
#undef PG8_WAIT_L
#undef PG8_BAR
#undef PG8_SCHED
}
}

__device__ __forceinline__ int rowmap(int mode, int c) {
    if (mode == 1) { const int pn = c >> 8; const bool rope = (pn < 4) || (pn >= 10 && pn < 14);
        return rope ? ((c & ~255) | (((c >> 5) & 1) << 7) | (((c >> 6) & 3) << 5) | (c & 31)) : c; }
    if (mode == 2) { const int f = c >> 1, bj = c & 1; return ((f >> 7) << 8) | (bj << 7) | (f & 127); }
    return c;
}
__device__ __forceinline__ void p0_transpose_item(const float* W, int N, bf16* WT, int mode, LAS float* scr, int item, int lane) {
    const int nblk = N / 64, kb = item / nblk, nb = item % nblk, k0 = 64 * kb, n0 = 64 * nb;
    f32x4 v[16];
#pragma unroll
    for (int i = 0; i < 16; ++i) v[i] = *(const f32x4*)(W + (size_t)(k0 + 4 * i + (lane >> 4)) * N + n0 + 4 * (lane & 15));
#pragma unroll
    for (int i = 0; i < 16; ++i) { const int kk = 4 * i + (lane >> 4); *(LAS f32x4*)(scr + ((kk >> 3) + 8 * (kk & 7)) * 68 + 4 * (lane & 15)) = v[i]; }
    asm volatile("s_waitcnt lgkmcnt(0)" ::: "memory");
    const int c = lane & 7;
#pragma unroll
    for (int jj = 0; jj < 8; ++jj) { const int n = (lane >> 3) + 8 * jj; const LAS float* s = scr + c * 68 + n;
        u32x4 o; o.x = pk2(s[0 * 544], s[1 * 544]); o.y = pk2(s[2 * 544], s[3 * 544]); o.z = pk2(s[4 * 544], s[5 * 544]); o.w = pk2(s[6 * 544], s[7 * 544]);
        *(u32x4*)(WT + (size_t)rowmap(mode, n0 + n) * 1024 + k0 + 8 * c) = o; }
    asm volatile("s_waitcnt lgkmcnt(0)" ::: "memory");
}
__device__ const double INV_FREQ[32] = {1, 0.74989420933245587, 0.56234132519034907, 0.42169650342858223, 0.31622776601683794, 0.23713737056616552, 0.17782794100389229, 0.1333521432163324,
    0.10000000000000001, 0.074989420933245579, 0.056234132519034911, 0.042169650342858224, 0.031622776601683791, 0.023713737056616554, 0.017782794100389229, 0.013335214321633241,
    0.01, 0.0074989420933245579, 0.005623413251903491, 0.0042169650342858229, 0.0031622776601683794, 0.0023713737056616554, 0.0017782794100389228, 0.0013335214321633241,
    0.001, 0.00074989420933245586, 0.0005623413251903491, 0.00042169650342858224, 0.00031622776601683794, 0.00023713737056616554, 0.00017782794100389227, 0.0001333521432163324};

struct Ptrs {
    const float *x, *ab_w_in, *ab_w_out, *ret_decay, *c_w_in, *c_w_out, *c_rpb, *ln_g, *ln_b, *router_w, *router_b, *w_up, *b_up, *w_down, *b_down;
    float* out; unsigned char* ws;
};

__device__ __forceinline__ void phase_prologue(const Ptrs& P, LAS unsigned char* lds, int bid, int tid) {
    const int wave = tid >> 6, lane = tid & 63;
    LAS float* scr = (LAS float*)(lds + wave * 17408);
    const int gw = bid * NWAVES + wave, NGW = GRID * NWAVES;
    constexpr int I0 = 2 * 1024, I1 = 2 * 256, I2 = 2 * 768, I3 = 2 * 256, I4 = 128 * 512, I5 = 128 * 256;
    constexpr int NITEMS = I0 + I1 + I2 + I3 + I4 + I5;
    unsigned char* ws = P.ws;
    for (int it = gw; it < NITEMS; it += NGW) {
        int r = it;
        if (r < I0) { const int mi = r / 1024, ii = r % 1024; p0_transpose_item(P.ab_w_in + (size_t)mi * 1024 * 4096, 4096, (bf16*)(ws + WS_WIN_E) + (size_t)mi * 4096 * 1024, 1, scr, ii, lane); continue; } r -= I0;
        if (r < I1) { const int mi = r / 256, ii = r % 256; p0_transpose_item(P.ab_w_out + (size_t)mi * 1024 * 1024, 1024, (bf16*)(ws + WS_WOUT_E) + (size_t)mi * 1024 * 1024, 0, scr, ii, lane); continue; } r -= I1;
        if (r < I2) { const int mi = r / 768, ii = r % 768; p0_transpose_item(P.c_w_in + (size_t)mi * 1024 * 3072, 3072, (bf16*)(ws + WS_WIN_O) + (size_t)mi * 3072 * 1024, 0, scr, ii, lane); continue; } r -= I2;
        if (r < I3) { const int mi = r / 256, ii = r % 256; p0_transpose_item(P.c_w_out + (size_t)mi * 1024 * 1024, 1024, (bf16*)(ws + WS_WOUT_O) + (size_t)mi * 1024 * 1024, 0, scr, ii, lane); continue; } r -= I3;
        if (r < I4) { const int mi = r / 512, ii = r % 512; p0_transpose_item(P.w_up + (size_t)mi * 1024 * 2048, 2048, (bf16*)(ws + WS_WUP) + (size_t)mi * 2048 * 1024, 2, scr, ii, lane); continue; } r -= I4;
        { const int mi = r / 256, ii = r % 256; p0_transpose_item(P.w_down + (size_t)mi * 1024 * 1024, 1024, (bf16*)(ws + WS_WDN) + (size_t)mi * 1024 * 1024, 0, scr, ii, lane); }
    }
    float* cs = (float*)(ws + WS_COS); float* sn = (float*)(ws + WS_SIN);
    for (int g = bid * NTHR + tid; g < T * 32; g += GRID * NTHR) {
        const int pos = g >> 5, i = g & 31;
        const double rev = (double)pos * INV_FREQ[i] * 0.15915494309189535;
        const double fr = rev - __builtin_rint(rev);
        const float a = (float)(fr * 6.283185307179586);
        cs[g] = cosf(a); sn[g] = sinf(a);
    }
    { bf16* rwt = (bf16*)(ws + WS_RWT);
      for (int g = bid * NTHR + tid; g < DEPTH * NEXP * D; g += GRID * NTHR) { const int l = g >> 15, e = (g >> 10) & 31, d = g & 1023;
          const float w = P.router_w[((size_t)l * D + d) * NEXP + e]; const unsigned hi = f2bf(w); const float wl = w - __builtin_bit_cast(float, hi << 16);
          rwt[((size_t)(l * 2) * NEXP + e) * D + d] = (bf16)hi; rwt[((size_t)(l * 2 + 1) * NEXP + e) * D + d] = (bf16)f2bf(wl); } }
    bf16* xb = (bf16*)(ws + WS_XB);
    for (size_t g = (size_t)bid * NTHR + tid; g < (size_t)T * D / 8; g += (size_t)GRID * NTHR) {
        const f32x4 a = *(const f32x4*)(P.x + g * 8), b = *(const f32x4*)(P.x + g * 8 + 4);
        u32x4 o; o.x = pk2(a[0], a[1]); o.y = pk2(a[2], a[3]); o.z = pk2(b[0], b[1]); o.w = pk2(b[2], b[3]);
        *(u32x4*)(xb + g * 8) = o;
    }
}

__device__ __forceinline__ void load_panel_f32(LAS float* dst, const bf16* src, int ldh, int tid) {
    const int row = tid >> 2, c0 = (tid & 3) * 16;
    const bf16* p = src + (size_t)row * ldh + c0;
    const u32x4 a = *(const u32x4*)p, b = *(const u32x4*)(p + 8);
    float f[16]; unpack8(a, f); unpack8(b, f + 8);
    LAS f32x4* d = (LAS f32x4*)(dst + row * 64 + c0);
    d[0] = (f32x4){f[0], f[1], f[2], f[3]}; d[1] = (f32x4){f[4], f[5], f[6], f[7]}; d[2] = (f32x4){f[8], f[9], f[10], f[11]}; d[3] = (f32x4){f[12], f[13], f[14], f[15]};
}
__device__ __forceinline__ void phase_ret_states(LAS unsigned char* lds, const bf16* H, const float* decay, float* S, int bid, int tid) {
    LAS float* kf = (LAS float*)lds; LAS float* vf = kf + 128 * 64; LAS float* zt = (LAS float*)(lds + MISC_OFF + 4096);
    for (int unit = bid; unit < 1024; unit += GRID) {
        const int h = unit >> 7, n = unit & 127;
        const float lgf = log2_gamma(decay[h]), lgb = log2_gamma(decay[8 + h]);
        __syncthreads();
        load_panel_f32(kf, H + (size_t)(n * 128) * EVEN_IN + 512 + h * 64, EVEN_IN, tid);
        load_panel_f32(vf, H + (size_t)(n * 128) * EVEN_IN + 1024 + h * 64, EVEN_IN, tid);
        if (tid < 128) { zt[tid] = exp2f(lgf * (float)(127 - tid)); zt[128 + tid] = exp2f(lgb * (float)tid); }
        __syncthreads();
        const int e = tid >> 3, d0 = (tid & 7) * 8;
        f32x4 af0 = {0, 0, 0, 0}, af1 = af0, ab0 = af0, ab1 = af0;
        for (int m = 0; m < 128; ++m) {
            const float ve = vf[m * 64 + e]; const float a = ve * zt[m], b = ve * zt[128 + m];
            const f32x4 k0 = *(const LAS f32x4*)(kf + m * 64 + d0), k1 = *(const LAS f32x4*)(kf + m * 64 + d0 + 4);
            af0 += k0 * a; af1 += k1 * a; ab0 += k0 * b; ab1 += k1 * b;
        }
        float* sf = S + ((size_t)(h) * 128 + n) * 4096 + e * 64 + d0;
        float* sb = S + ((size_t)(8 + h) * 128 + n) * 4096 + e * 64 + d0;
        *(f32x4*)sf = af0; *(f32x4*)(sf + 4) = af1; *(f32x4*)sb = ab0; *(f32x4*)(sb + 4) = ab1;
    }
}
__device__ __forceinline__ void phase_ret_scan(const float* S, bf16* R, const float* decay, int bid, int tid) {
    for (int g = bid * NTHR + tid; g < 65536; g += GRID * NTHR) {
        const int dir = g >> 15, h = (g >> 12) & 7, de = g & 4095;
        const float gc = exp2f(log2_gamma(decay[dir * 8 + h]) * 128.0f);
        const float* s = S + ((size_t)(dir * 8 + h) * 128) * 4096 + de; bf16* r = R + ((size_t)(dir * 8 + h) * 128) * 4096 + de;
        float a = 0.f;
        if (dir == 0) { for (int n = 0; n < 128; ++n) { r[(size_t)n * 4096] = (bf16)f2bf(a); a = gc * a + s[(size_t)n * 4096]; } }
        else { for (int n = 127; n >= 0; --n) { r[(size_t)n * 4096] = (bf16)f2bf(a); a = gc * a + s[(size_t)n * 4096]; } }
    }
}
__device__ __forceinline__ void phase_ret_out(LAS unsigned char* lds, const bf16* H, const float* R, const float* decay, bf16* Y, int bid, int tid) {
    LAS float* qf = (LAS float*)lds; LAS float* kf = qf + 8192; LAS float* vf = kf + 8192; LAS float* rf = vf + 8192; LAS float* rb = rf + 4096;
    for (int unit = bid; unit < 1024; unit += GRID) {
        const int h = unit >> 7, n = unit & 127;
        const float lgf = log2_gamma(decay[h]), lgb = log2_gamma(decay[8 + h]);
        __syncthreads();
        const bf16* hp = H + (size_t)(n * 128) * EVEN_IN + h * 64;
        load_panel_f32(qf, hp, EVEN_IN, tid); load_panel_f32(kf, hp + 512, EVEN_IN, tid); load_panel_f32(vf, hp + 1024, EVEN_IN, tid);
        { const float* r0 = R + ((size_t)(h) * 128 + n) * 4096 + tid * 8; const float* r1 = R + ((size_t)(8 + h) * 128 + n) * 4096 + tid * 8;
          *(LAS f32x4*)(rf + tid * 8) = *(const f32x4*)r0; *(LAS f32x4*)(rf + tid * 8 + 4) = *(const f32x4*)(r0 + 4);
          *(LAS f32x4*)(rb + tid * 8) = *(const f32x4*)r1; *(LAS f32x4*)(rb + tid * 8 + 4) = *(const f32x4*)(r1 + 4); }
        __syncthreads();
        const int c = tid >> 2, e0 = (tid & 3) * 16;
        f32x4 q[16];
#pragma unroll
        for (int i = 0; i < 16; ++i) q[i] = *(const LAS f32x4*)(qf + c * 64 + 4 * i);
        f32x4 of[4], ob[4];
#pragma unroll
        for (int i = 0; i < 4; ++i) { of[i] = (f32x4){0, 0, 0, 0}; ob[i] = of[i]; }
        for (int m = 0; m < 128; ++m) {
            f32x4 sv = {0, 0, 0, 0};
#pragma unroll
            for (int i = 0; i < 16; ++i) sv += q[i] * *(const LAS f32x4*)(kf + m * 64 + 4 * i);
            const float s = (sv[0] + sv[1]) + (sv[2] + sv[3]);
            const float df = (float)(c - m);
            const float pf = (m <= c) ? exp2f(lgf * df) : 0.0f;
            const float pb = (m > c) ? exp2f(-lgb * df) : 0.0f;
            const float wf = s * pf, wb = s * pb;
#pragma unroll
            for (int i = 0; i < 4; ++i) { const f32x4 v = *(const LAS f32x4*)(vf + m * 64 + e0 + 4 * i); of[i] += v * wf; ob[i] += v * wb; }
        }
        f32x4 cf[4], cb[4];
#pragma unroll
        for (int i = 0; i < 4; ++i) { cf[i] = (f32x4){0, 0, 0, 0}; cb[i] = cf[i]; }
#pragma unroll
        for (int d4 = 0; d4 < 16; ++d4)
#pragma unroll
            for (int dd = 0; dd < 4; ++dd) {
                const float qd = q[d4][dd]; const int d = 4 * d4 + dd;
#pragma unroll
                for (int i = 0; i < 4; ++i) { cf[i] += *(const LAS f32x4*)(rf + d * 64 + e0 + 4 * i) * qd; cb[i] += *(const LAS f32x4*)(rb + d * 64 + e0 + 4 * i) * qd; }
            }
        const float xif = exp2f(lgf * (float)(c + 1)), xib = exp2f(lgb * (float)(128 - c));
        float sf = 0.f, sb = 0.f;
#pragma unroll
        for (int i = 0; i < 4; ++i) { of[i] += cf[i] * xif; ob[i] += cb[i] * xib; sf += (of[i][0] + of[i][1]) + (of[i][2] + of[i][3]); sb += (ob[i][0] + ob[i][1]) + (ob[i][2] + ob[i][3]); }
        sf += shx(sf, 1); sf += shx(sf, 2); sb += shx(sb, 1); sb += shx(sb, 2);
        const float muf = sf * (1.0f / 64.0f), mub = sb * (1.0f / 64.0f);
        float vfq = 0.f, vbq = 0.f;
#pragma unroll
        for (int i = 0; i < 4; ++i) { of[i] = of[i] - muf; ob[i] = ob[i] - mub;
            vfq += (of[i][0] * of[i][0] + of[i][1] * of[i][1]) + (of[i][2] * of[i][2] + of[i][3] * of[i][3]);
            vbq += (ob[i][0] * ob[i][0] + ob[i][1] * ob[i][1]) + (ob[i][2] * ob[i][2] + ob[i][3] * ob[i][3]); }
        vfq += shx(vfq, 1); vfq += shx(vfq, 2); vbq += shx(vbq, 1); vbq += shx(vbq, 2);
        const float rsf = 1.0f / sqrtf(vfq * (1.0f / 64.0f) + GN_EPS), rsb = 1.0f / sqrtf(vbq * (1.0f / 64.0f) + GN_EPS);
        const int tok = n * 128 + c;
        const bf16* gp = H + (size_t)tok * EVEN_IN + 1536 + h * 64 + e0;
        float gf[16], gb[16];
        unpack8(*(const u32x4*)gp, gf); unpack8(*(const u32x4*)(gp + 8), gf + 8); unpack8(*(const u32x4*)(gp + 512), gb); unpack8(*(const u32x4*)(gp + 520), gb + 8);
        float y[16];
#pragma unroll
        for (int i = 0; i < 16; ++i) { const float a = gf[i] * sigmoidf_(gf[i]), b = gb[i] * sigmoidf_(gb[i]); y[i] = a * (of[i >> 2][i & 3] * rsf) + b * (ob[i >> 2][i & 3] * rsb); }
        bf16* yp = Y + (size_t)tok * D + h * 64 + e0;
        u32x4 w0, w1; w0.x = pk2(y[0], y[1]); w0.y = pk2(y[2], y[3]); w0.z = pk2(y[4], y[5]); w0.w = pk2(y[6], y[7]); w1.x = pk2(y[8], y[9]); w1.y = pk2(y[10], y[11]); w1.z = pk2(y[12], y[13]); w1.w = pk2(y[14], y[15]);
        *(u32x4*)yp = w0; *(u32x4*)(yp + 8) = w1;
    }
}

struct OnlineSm { float m, l; f32x4 o[16]; };
__device__ __forceinline__ void load_q64(const bf16* p, f32x4 (&q)[16]) {
#pragma unroll
    for (int i = 0; i < 8; ++i) { float f[8]; unpack8(*(const u32x4*)(p + 8 * i), f); q[2 * i] = (f32x4){f[0], f[1], f[2], f[3]}; q[2 * i + 1] = (f32x4){f[4], f[5], f[6], f[7]}; }
}
__device__ __forceinline__ float dot64(const f32x4 (&q)[16], const bf16* kp) {
    f32x4 sv = {0, 0, 0, 0};
#pragma unroll
    for (int i = 0; i < 8; ++i) { float f[8]; unpack8(*(const u32x4*)(kp + 8 * i), f); sv += q[2 * i] * (f32x4){f[0], f[1], f[2], f[3]}; sv += q[2 * i + 1] * (f32x4){f[4], f[5], f[6], f[7]}; }
    return (sv[0] + sv[1]) + (sv[2] + sv[3]);
}
__device__ __forceinline__ void sm_update(OnlineSm& st, float s, const bf16* vp) {
    const float mn = fmaxf(st.m, s), sc = __expf(st.m - mn), p = __expf(s - mn);
    st.l = st.l * sc + p; st.m = mn;
#pragma unroll
    for (int i = 0; i < 8; ++i) { float f[8]; unpack8(*(const u32x4*)(vp + 8 * i), f);
        st.o[2 * i] = st.o[2 * i] * sc + (f32x4){f[0], f[1], f[2], f[3]} * p; st.o[2 * i + 1] = st.o[2 * i + 1] * sc + (f32x4){f[4], f[5], f[6], f[7]} * p; }
}
__device__ __forceinline__ void sm_store(const OnlineSm& st, bf16* yp) {
    const float inv = 1.0f / st.l;
#pragma unroll
    for (int i = 0; i < 8; ++i) { const f32x4 a = st.o[2 * i] * inv, b = st.o[2 * i + 1] * inv; u32x4 w; w.x = pk2(a[0], a[1]); w.y = pk2(a[2], a[3]); w.z = pk2(b[0], b[1]); w.w = pk2(b[2], b[3]); *(u32x4*)(yp + 8 * i) = w; }
}
__device__ __forceinline__ void phase_dilated(const bf16* H, bf16* Y, int bid, int tid) {
    const int g = bid * NTHR + tid, h = g >> 14, i = g & 16383;
    f32x4 q[16]; load_q64(H + (size_t)i * EVEN_IN + 2560 + h * 64, q);
    OnlineSm st; st.m = -1e30f; st.l = 0.f;
#pragma unroll
    for (int k = 0; k < 16; ++k) st.o[k] = (f32x4){0, 0, 0, 0};
    for (int b = 0; b < 3; ++b) {
        const int dil = (b == 0) ? 1 : ((b == 1) ? 4 : 16);
        for (int jj = -64; jj <= 64; ++jj) {
            const int j = i + dil * jj;
            if (j < 0 || j >= T) continue;
            const bf16* kp = H + (size_t)j * EVEN_IN + 3072 + h * 64;
            const float s = dot64(q, kp);
            sm_update(st, s, kp + 512);
        }
    }
    sm_store(st, Y + (size_t)i * D + 512 + h * 64);
}
__device__ __forceinline__ void phase_natten(const bf16* H, const float* rpb, bf16* Y, int bid, int tid) {
    for (int rep = 0; rep < 2; ++rep) {
        const int g = rep * (GRID * NTHR) + bid * NTHR + tid, h = g >> 14, i = g & 16383, r = i >> 6, c = i & 63;
        const int r0 = min(max(r - 4, 0), 248), c0 = min(max(c - 8, 0), 48);
        f32x4 q[16]; load_q64(H + (size_t)i * ODD_IN + h * 64, q);
        OnlineSm st; st.m = -1e30f; st.l = 0.f;
#pragma unroll
        for (int k = 0; k < 16; ++k) st.o[k] = (f32x4){0, 0, 0, 0};
        for (int ii = 0; ii < 8; ++ii)
            for (int jj = 0; jj < 16; ++jj) {
                const int kr = r0 + ii, kc = c0 + jj, j = kr * 64 + kc;
                const float bias = rpb[(h * 15 + (kr - r + 7)) * 31 + (kc - c + 15)];
                const bf16* kp = H + (size_t)j * ODD_IN + 1024 + h * 64;
                const float s = dot64(q, kp) + bias;
                sm_update(st, s, kp + 1024);
            }
        sm_store(st, Y + (size_t)i * D + h * 64);
    }
}

__device__ __forceinline__ void lds_barrier() { asm volatile("s_waitcnt lgkmcnt(0)" ::: "memory"); __builtin_amdgcn_s_barrier(); asm volatile("" ::: "memory"); }

typedef short s16x4 __attribute__((ext_vector_type(4)));
__device__ __forceinline__ void tr_read8(unsigned a0, unsigned a1, unsigned a2, unsigned a3, s16x4 (&r)[8]) {
    asm volatile("ds_read_b64_tr_b16 %0, %8\n\tds_read_b64_tr_b16 %1, %8 offset:2048\n\tds_read_b64_tr_b16 %2, %9\n\tds_read_b64_tr_b16 %3, %9 offset:2048\n\t"
                 "ds_read_b64_tr_b16 %4, %10\n\tds_read_b64_tr_b16 %5, %10 offset:2048\n\tds_read_b64_tr_b16 %6, %11\n\tds_read_b64_tr_b16 %7, %11 offset:2048\n\ts_waitcnt lgkmcnt(0)"
                 : "=&v"(r[0]), "=&v"(r[1]), "=&v"(r[2]), "=&v"(r[3]), "=&v"(r[4]), "=&v"(r[5]), "=&v"(r[6]), "=&v"(r[7]) : "v"(a0), "v"(a1), "v"(a2), "v"(a3) : "memory");
}
struct LaneOffs { unsigned k0, k1, v[4]; };
__device__ __forceinline__ LaneOffs lane_offs(int lane) {
    const int i = lane & 15, g = lane >> 4, q = i >> 2, p = i & 3, vrow = 4 * g + q; LaneOffs o;
    o.k0 = (unsigned)(i * 128 + (((g) ^ (i & 7)) << 4)); o.k1 = (unsigned)(i * 128 + (((4 + g) ^ (i & 7)) << 4));
#pragma unroll
    for (int dt = 0; dt < 4; ++dt) o.v[dt] = (unsigned)(vrow * 128 + (((2 * dt + (p >> 1)) ^ (vrow & 7)) << 4) + 8 * (p & 1));
    return o;
}
__device__ __forceinline__ unsigned lds_addr(const LAS unsigned char* p) { return (unsigned)(size_t)p; }
__device__ __forceinline__ void tr_read16(unsigned b0, unsigned b1, const unsigned (&v)[4], s16x4 (&r)[16]) {
    const unsigned a0 = b0 + v[0], a1 = b0 + v[1], a2 = b0 + v[2], a3 = b0 + v[3], c0 = b1 + v[0], c1 = b1 + v[1], c2 = b1 + v[2], c3 = b1 + v[3];
    asm volatile("ds_read_b64_tr_b16 %0, %16\n\tds_read_b64_tr_b16 %1, %16 offset:2048\n\tds_read_b64_tr_b16 %2, %17\n\tds_read_b64_tr_b16 %3, %17 offset:2048\n\t"
                 "ds_read_b64_tr_b16 %4, %18\n\tds_read_b64_tr_b16 %5, %18 offset:2048\n\tds_read_b64_tr_b16 %6, %19\n\tds_read_b64_tr_b16 %7, %19 offset:2048\n\t"
                 "ds_read_b64_tr_b16 %8, %20\n\tds_read_b64_tr_b16 %9, %20 offset:2048\n\tds_read_b64_tr_b16 %10, %21\n\tds_read_b64_tr_b16 %11, %21 offset:2048\n\t"
                 "ds_read_b64_tr_b16 %12, %22\n\tds_read_b64_tr_b16 %13, %22 offset:2048\n\tds_read_b64_tr_b16 %14, %23\n\tds_read_b64_tr_b16 %15, %23 offset:2048\n\ts_waitcnt lgkmcnt(0)"
                 : "=&v"(r[0]), "=&v"(r[1]), "=&v"(r[2]), "=&v"(r[3]), "=&v"(r[4]), "=&v"(r[5]), "=&v"(r[6]), "=&v"(r[7]), "=&v"(r[8]), "=&v"(r[9]), "=&v"(r[10]), "=&v"(r[11]), "=&v"(r[12]), "=&v"(r[13]), "=&v"(r[14]), "=&v"(r[15])
                 : "v"(a0), "v"(a1), "v"(a2), "v"(a3), "v"(c0), "v"(c1), "v"(c2), "v"(c3) : "memory");
}
__device__ __forceinline__ void k_read8(unsigned b0, unsigned b1, unsigned k0, unsigned k1, bf16x8 (&r)[8]) {
    const unsigned a0 = b0 + k0, a1 = b0 + k1, c0 = b1 + k0, c1 = b1 + k1;
    asm volatile("ds_read_b128 %0, %8\n\tds_read_b128 %1, %9\n\tds_read_b128 %2, %8 offset:2048\n\tds_read_b128 %3, %9 offset:2048\n\t"
                 "ds_read_b128 %4, %10\n\tds_read_b128 %5, %11\n\tds_read_b128 %6, %10 offset:2048\n\tds_read_b128 %7, %11 offset:2048\n\ts_waitcnt lgkmcnt(0)"
                 : "=&v"(r[0]), "=&v"(r[1]), "=&v"(r[2]), "=&v"(r[3]), "=&v"(r[4]), "=&v"(r[5]), "=&v"(r[6]), "=&v"(r[7]) : "v"(a0), "v"(a1), "v"(c0), "v"(c1) : "memory");
}
__device__ __forceinline__ void qk_pair(unsigned kb0, unsigned kb1, const LaneOffs& lo, const bf16x8 q0, const bf16x8 q1, f32x4 (&s0)[2], f32x4 (&s1)[2]) {
    bf16x8 kf[8]; k_read8(kb0, kb1, lo.k0, lo.k1, kf);
    const f32x4 z = {0.f, 0.f, 0.f, 0.f};
    s0[0] = __builtin_amdgcn_mfma_f32_16x16x32_bf16(kf[0], q0, z, 0, 0, 0); s0[1] = __builtin_amdgcn_mfma_f32_16x16x32_bf16(kf[2], q0, z, 0, 0, 0);
    s1[0] = __builtin_amdgcn_mfma_f32_16x16x32_bf16(kf[4], q0, z, 0, 0, 0); s1[1] = __builtin_amdgcn_mfma_f32_16x16x32_bf16(kf[6], q0, z, 0, 0, 0);
    s0[0] = __builtin_amdgcn_mfma_f32_16x16x32_bf16(kf[1], q1, s0[0], 0, 0, 0); s0[1] = __builtin_amdgcn_mfma_f32_16x16x32_bf16(kf[3], q1, s0[1], 0, 0, 0);
    s1[0] = __builtin_amdgcn_mfma_f32_16x16x32_bf16(kf[5], q1, s1[0], 0, 0, 0); s1[1] = __builtin_amdgcn_mfma_f32_16x16x32_bf16(kf[7], q1, s1[1], 0, 0, 0);
}
__device__ __forceinline__ void qk_tile(const LAS unsigned char* Kt, const LaneOffs& lo, const bf16x8 q0, const bf16x8 q1, f32x4 (&sa)[2]) {
    const bf16x8 k00 = *(const LAS bf16x8*)(Kt + lo.k0), k01 = *(const LAS bf16x8*)(Kt + lo.k1), k10 = *(const LAS bf16x8*)(Kt + 2048 + lo.k0), k11 = *(const LAS bf16x8*)(Kt + 2048 + lo.k1);
    sa[0] = (f32x4){0.f, 0.f, 0.f, 0.f}; sa[1] = sa[0];
    sa[0] = __builtin_amdgcn_mfma_f32_16x16x32_bf16(k00, q0, sa[0], 0, 0, 0); sa[0] = __builtin_amdgcn_mfma_f32_16x16x32_bf16(k01, q1, sa[0], 0, 0, 0);
    sa[1] = __builtin_amdgcn_mfma_f32_16x16x32_bf16(k10, q0, sa[1], 0, 0, 0); sa[1] = __builtin_amdgcn_mfma_f32_16x16x32_bf16(k11, q1, sa[1], 0, 0, 0);
}
__device__ __forceinline__ void pv_tile(const LAS unsigned char* Vt, const LaneOffs& lo, const f32x4 p0, const f32x4 p1, f32x4 (&o)[4]) {
    const unsigned vb = lds_addr(Vt); s16x4 r[8];
    tr_read8(vb + lo.v[0], vb + lo.v[1], vb + lo.v[2], vb + lo.v[3], r);
    u32x4 pw;
    asm volatile("v_cvt_pk_bf16_f32 %0, %4, %5\n\tv_cvt_pk_bf16_f32 %1, %6, %7\n\tv_cvt_pk_bf16_f32 %2, %8, %9\n\tv_cvt_pk_bf16_f32 %3, %10, %11\n\ts_nop 1"
                 : "=&v"(pw.x), "=&v"(pw.y), "=&v"(pw.z), "=&v"(pw.w) : "v"(p0[0]), "v"(p0[1]), "v"(p0[2]), "v"(p0[3]), "v"(p1[0]), "v"(p1[1]), "v"(p1[2]), "v"(p1[3]));
    const bf16x8 pb = __builtin_bit_cast(bf16x8, pw);
#pragma unroll
    for (int dt = 0; dt < 4; ++dt) { const bf16x8 va = __builtin_shufflevector(r[2 * dt], r[2 * dt + 1], 0, 1, 2, 3, 4, 5, 6, 7); o[dt] = __builtin_amdgcn_mfma_f32_16x16x32_bf16(va, pb, o[dt], 0, 0, 0); }
}
struct SmState { float m, l; f32x4 o[4]; };
__device__ __forceinline__ void sm_init(SmState& st) { st.m = -1e30f; st.l = 0.f;
#pragma unroll
    for (int dt = 0; dt < 4; ++dt) st.o[dt] = (f32x4){0.f, 0.f, 0.f, 0.f}; }
__device__ __forceinline__ void sm_step(SmState& st, f32x4 (&sa)[2], const LAS unsigned char* Vt, const LaneOffs& lo) {
    float tm = fmaxf(fmaxf(fmaxf(sa[0][0], sa[0][1]), fmaxf(sa[0][2], sa[0][3])), fmaxf(fmaxf(sa[1][0], sa[1][1]), fmaxf(sa[1][2], sa[1][3])));
    tm = fmaxf(tm, shx(tm, 16)); tm = fmaxf(tm, shx(tm, 32));
    const float mn = fmaxf(st.m, tm), sc = exp2f(st.m - mn);
    float ps = 0.f;
#pragma unroll
    for (int a = 0; a < 2; ++a)
#pragma unroll
        for (int r = 0; r < 4; ++r) { sa[a][r] = exp2f(sa[a][r] - mn); ps += sa[a][r]; }
    st.l = st.l * sc + ps; st.m = mn;
#pragma unroll
    for (int dt = 0; dt < 4; ++dt) st.o[dt] = st.o[dt] * sc;
    pv_tile(Vt, lo, sa[0], sa[1], st.o);
}

constexpr int DIL_UNITS = 8 * 3 * 128;
__device__ __forceinline__ void dil_decode(int u, int& h, int& b, int& r, int& blk) { h = u / 384; const int rem = u - h * 384; b = rem >> 7; const int x = rem & 127; r = x >> (7 - 2 * b); blk = x & ((128 >> (2 * b)) - 1); }
__device__ __forceinline__ void dil_issue(const bf16* H, int u, int tid, u32x4 (&kr)[4], u32x4 (&vr)[4]) {
    int h, b, r, blk; dil_decode(u, h, b, r, blk); const int Lc = T >> (2 * b), base = 128 * blk - 64;
#pragma unroll
    for (int k = 0; k < 4; ++k) { const int id = tid + 512 * k, row = id >> 3, c = id & 7, ki = base + row; const bool ok = (ki >= 0) && (ki < Lc);
        const bf16* src = H + (size_t)(r + (ki << (2 * b))) * EVEN_IN + 3072 + h * 64 + c * 8;
        kr[k] = ok ? *(const u32x4*)src : (u32x4){0u, 0u, 0u, 0u}; vr[k] = ok ? *(const u32x4*)(src + 512) : (u32x4){0u, 0u, 0u, 0u}; }
}
__device__ __forceinline__ void dil_commit(LAS unsigned char* buf, int tid, const u32x4 (&kr)[4], const u32x4 (&vr)[4]) {
#pragma unroll
    for (int k = 0; k < 4; ++k) { const int id = tid + 512 * k, row = id >> 3, c = id & 7; const unsigned off = (unsigned)(row * 128 + ((c ^ (row & 7)) << 4));
        *(LAS u32x4*)(buf + off) = kr[k]; *(LAS u32x4*)(buf + 32768 + off) = vr[k]; }
}
__device__ __forceinline__ void phase_dilated_mfma(LAS unsigned char* lds, const bf16* H, bf16* OG, float* LSE, int bid, int tid) {
    const int wave = tid >> 6, lane = tid & 63, i16 = lane & 15, g = lane >> 4;
    const LaneOffs lo = lane_offs(lane);
    u32x4 kr[4], vr[4];
    __syncthreads();
    dil_issue(H, bid, tid, kr, vr); dil_commit(lds, tid, kr, vr);
    __syncthreads();
    int it = 0;
    for (int u = bid; u < DIL_UNITS; u += GRID, ++it) {
        LAS unsigned char* buf = lds + (it & 1) * 65536;
        const bool has_next = (u + GRID) < DIL_UNITS;
        if (has_next) dil_issue(H, u + GRID, tid, kr, vr);
        int h, b, r, blk; dil_decode(u, h, b, r, blk); const int Lc = T >> (2 * b), base = 128 * blk - 64;
        const int ql = 16 * wave + i16, tokq = r + ((128 * blk + ql) << (2 * b));
        const bf16* qp = H + (size_t)tokq * EVEN_IN + 2560 + h * 64 + 8 * g;
        const bf16x8 q0 = *(const bf16x8*)qp, q1 = *(const bf16x8*)(qp + 32);
        SmState st; sm_init(st);
        const int t0 = wave >> 1;
#pragma unroll 1
        for (int t = t0; t < t0 + 5; ++t) {
            f32x4 sa[2]; qk_tile(buf + t * 4096, lo, q0, q1, sa);
#pragma unroll
            for (int a = 0; a < 2; ++a)
#pragma unroll
                for (int rg = 0; rg < 4; ++rg) { const int kl = 32 * t + 16 * a + 4 * g + rg, ki = base + kl; const bool ok = (kl >= ql) && (kl <= ql + 128) && (ki >= 0) && (ki < Lc);
                    sa[a][rg] = ok ? sa[a][rg] * 1.4426950408889634f : -INFINITY; }
            sm_step(st, sa, buf + 32768 + t * 4096, lo);
        }
        float l = st.l; l += shx(l, 16); l += shx(l, 32);
        const float inv = 1.0f / l;
        bf16* op = OG + ((size_t)b * T + tokq) * 512 + h * 64 + 4 * g;
#pragma unroll
        for (int dt = 0; dt < 4; ++dt) { const f32x4 o = st.o[dt] * inv; u32x2 w; w.x = cvt_pk_bf16(o[0], o[1]); w.y = cvt_pk_bf16(o[2], o[3]); *(u32x2*)(op + 16 * dt) = w; }
        if (g == 0) LSE[((size_t)b * T + tokq) * 8 + h] = (st.m + log2f(l)) * 0.6931471805599453f;
        if (has_next) dil_commit(lds + ((it + 1) & 1) * 65536, tid, kr, vr);
        __syncthreads();
    }
}
__device__ __forceinline__ void phase_dil_merge(const bf16* OG, const float* LSE, bf16* Y, int bid, int tid) {
    for (int item = bid * NTHR + tid; item < T * 64; item += GRID * NTHR) {
        const int tok = item >> 6, h = (item >> 3) & 7, c = item & 7;
        const float l0 = LSE[((size_t)0 * T + tok) * 8 + h], l1 = LSE[((size_t)1 * T + tok) * 8 + h], l2 = LSE[((size_t)2 * T + tok) * 8 + h];
        const float mx = fmaxf(l0, fmaxf(l1, l2)); float w0 = __expf(l0 - mx), w1 = __expf(l1 - mx), w2 = __expf(l2 - mx); const float inv = 1.0f / (w0 + w1 + w2); w0 *= inv; w1 *= inv; w2 *= inv;
        float a[8], b[8], d[8];
        unpack8(*(const u32x4*)(OG + ((size_t)0 * T + tok) * 512 + h * 64 + c * 8), a); unpack8(*(const u32x4*)(OG + ((size_t)1 * T + tok) * 512 + h * 64 + c * 8), b); unpack8(*(const u32x4*)(OG + ((size_t)2 * T + tok) * 512 + h * 64 + c * 8), d);
        float y[8];
#pragma unroll
        for (int j = 0; j < 8; ++j) y[j] = w0 * a[j] + w1 * b[j] + w2 * d[j];
        u32x4 o; o.x = pk2(y[0], y[1]); o.y = pk2(y[2], y[3]); o.z = pk2(y[4], y[5]); o.w = pk2(y[6], y[7]);
        *(u32x4*)(Y + (size_t)tok * D + 512 + h * 64 + c * 8) = o;
    }
}

__device__ __forceinline__ void phase_natten_mfma(LAS unsigned char* lds, const bf16* H, const float* rpb, bf16* Y, int bid, int tid) {
    const int wave = tid >> 6, lane = tid & 63, i16 = lane & 15, g = lane >> 4, cb = wave & 3, half = wave >> 2;
    const LaneOffs lo = lane_offs(lane);
    LAS float* btab = (LAS float*)(lds + MISC_OFF + 4096);
    LAS float* mbuf = (LAS float*)lds;
    const int wc0 = (cb == 0) ? 0 : (cb == 1) ? 8 : (cb == 2) ? 24 : 32;
    const int c = 16 * cb + i16, cs = min(max(c - 8, 0), 48);
#pragma unroll 1
    for (int k = 0; k < 16; ++k) {
        const int u = bid * 16 + k, h = u >> 8, r = u & 255, r0 = min(max(r - 4, 0), 248);
        __syncthreads();
#pragma unroll
        for (int kk = 0; kk < 8; ++kk) { const int id = tid + 512 * kk, row = id >> 3, ch = id & 7; const unsigned off = (unsigned)(row * 128 + ((ch ^ (row & 7)) << 4));
            const bf16* src = H + (size_t)(r0 * 64 + row) * ODD_IN + 1024 + h * 64 + ch * 8;
            *(LAS u32x4*)(lds + off) = *(const u32x4*)src; *(LAS u32x4*)(lds + 65536 + off) = *(const u32x4*)(src + 1024); }
        if (tid < 465) btab[tid] = rpb[h * 465 + tid];
        __syncthreads();
        const int tokq = r * 64 + c;
        const bf16* qp = H + (size_t)tokq * ODD_IN + h * 64 + 8 * g;
        const bf16x8 q0 = *(const bf16x8*)qp, q1 = *(const bf16x8*)(qp + 32);
        SmState st; sm_init(st);
#pragma unroll 1
        for (int tt = 0; tt < 4; ++tt) {
            const int krl = 4 * half + tt; const unsigned tb = (unsigned)((krl * 64 + wc0) * 128);
            f32x4 sa[2]; qk_tile(lds + tb, lo, q0, q1, sa);
            const int brow = (r0 + krl - r + 7) * 31 - c + 15;
#pragma unroll
            for (int a = 0; a < 2; ++a)
#pragma unroll
                for (int rg = 0; rg < 4; ++rg) { const int col = wc0 + 16 * a + 4 * g + rg; const bool ok = (col >= cs) && (col < cs + 16);
                    const float bias = btab[ok ? (brow + col) : 0];
                    sa[a][rg] = ok ? (sa[a][rg] + bias) * 1.4426950408889634f : -INFINITY; }
            sm_step(st, sa, lds + 65536 + tb, lo);
        }
        float l = st.l; l += shx(l, 16); l += shx(l, 32);
        __syncthreads();
        if (half == 1) { LAS float* mb = mbuf + ((wave - 4) * 64 + lane) * 20; mb[0] = st.m; mb[1] = l;
#pragma unroll
            for (int dt = 0; dt < 4; ++dt) *(LAS f32x4*)(mb + 4 + 4 * dt) = st.o[dt]; }
        __syncthreads();
        if (half == 0) { const LAS float* mb = mbuf + (wave * 64 + lane) * 20; const float m2 = mb[0], l2 = mb[1];
            const float M = fmaxf(st.m, m2), a1 = exp2f(st.m - M), a2 = exp2f(m2 - M); const float inv = 1.0f / (l * a1 + l2 * a2);
            bf16* op = Y + (size_t)tokq * D + h * 64 + 4 * g;
#pragma unroll
            for (int dt = 0; dt < 4; ++dt) { const f32x4 o2 = *(const LAS f32x4*)(mb + 4 + 4 * dt); const f32x4 o = (st.o[dt] * a1 + o2 * a2) * inv;
                u32x2 w; w.x = cvt_pk_bf16(o[0], o[1]); w.y = cvt_pk_bf16(o[2], o[3]); *(u32x2*)(op + 16 * dt) = w; } }
    }
}

__device__ __forceinline__ bf16x8 pack_p(const f32x4 p0, const f32x4 p1);
__device__ __forceinline__ void ret_issue(const bf16* H, int u, int tid, u32x4 (&kr)[2], u32x4 (&vr)[2]) {
    const int h = u >> 7, n = u & 127;
#pragma unroll
    for (int k = 0; k < 2; ++k) { const int id = tid + 512 * k, row = id >> 3, c = id & 7; const bf16* src = H + (size_t)(n * 128 + row) * EVEN_IN + 512 + h * 64 + c * 8;
        kr[k] = *(const u32x4*)src; vr[k] = *(const u32x4*)(src + 512); }
}
__device__ __forceinline__ void ret_commit(LAS unsigned char* buf, int tid, const u32x4 (&kr)[2], const u32x4 (&vr)[2]) {
#pragma unroll
    for (int k = 0; k < 2; ++k) { const int id = tid + 512 * k, row = id >> 3, c = id & 7; const unsigned off = (unsigned)(row * 128 + ((c ^ (row & 7)) << 4));
        *(LAS u32x4*)(buf + off) = kr[k]; *(LAS u32x4*)(buf + 16384 + off) = vr[k]; }
}
__device__ __forceinline__ void phase_ret_out_mfma(LAS unsigned char* lds, const bf16* H, const bf16* RT, const float* decay, bf16* Y, int bid, int tid) {
    const int wave = tid >> 6, lane = tid & 63, i16 = lane & 15, g = lane >> 4;
    const LaneOffs lo = lane_offs(lane);
    u32x4 kr[2], vr[2];
    __syncthreads();
    ret_issue(H, bid, tid, kr, vr); ret_commit(lds, tid, kr, vr);
    lds_barrier();
    int it = 0;
    bf16x8 nq0, nq1;
    { const bf16* qp = H + (size_t)((bid & 127) * 128 + 16 * wave + i16) * EVEN_IN + (bid >> 7) * 64 + 8 * g; nq0 = *(const bf16x8*)qp; nq1 = *(const bf16x8*)(qp + 32); }
    for (int u = bid; u < 1024; u += GRID, ++it) {
        LAS unsigned char* buf = lds + (it & 1) * 32768;
        const bool has_next = (u + GRID) < 1024;
        if (has_next) ret_issue(H, u + GRID, tid, kr, vr);
        const int h = u >> 7, n = u & 127;
        const float lgf = log2_gamma(decay[h]), lgb = log2_gamma(decay[8 + h]);
        const int c = 16 * wave + i16, tok = n * 128 + c;
        const bf16x8 q0 = nq0, q1 = nq1;
        if (has_next) { const int u2 = u + GRID; const bf16* qp = H + (size_t)((u2 & 127) * 128 + c) * EVEN_IN + (u2 >> 7) * 64 + 8 * g; nq0 = *(const bf16x8*)qp; nq1 = *(const bf16x8*)(qp + 32); }
        f32x4 of[4], ob[4];
#pragma unroll
        for (int dt = 0; dt < 4; ++dt) { of[dt] = (f32x4){0.f, 0.f, 0.f, 0.f}; ob[dt] = of[dt]; }
        {
            f32x4 sa[4][2];
            const unsigned kb = lds_addr(buf), vb = lds_addr(buf + 16384);
            qk_pair(kb, kb + 4096, lo, q0, q1, sa[0], sa[1]); qk_pair(kb + 8192, kb + 12288, lo, q0, q1, sa[2], sa[3]);
            const int tw = wave >> 1;
#pragma unroll
            for (int tp = 0; tp < 2; ++tp) {
                s16x4 vr[16]; tr_read16(vb + tp * 8192, vb + tp * 8192 + 4096, lo.v, vr);
#pragma unroll
                for (int th = 0; th < 2; ++th) { const int t = 2 * tp + th;
                    f32x4 pf[2], pb[2];
#pragma unroll
                    for (int a2 = 0; a2 < 2; ++a2)
#pragma unroll
                        for (int rg = 0; rg < 4; ++rg) { const int m = 32 * t + 16 * a2 + 4 * g + rg; const float df = (float)(c - m);
                            const float ef = sa[t][a2][rg] * __builtin_amdgcn_exp2f(lgf * fmaxf(df, 0.0f)), eb = sa[t][a2][rg] * __builtin_amdgcn_exp2f(lgb * fmaxf(-df, 0.0f));
                            pf[a2][rg] = (m <= c) ? ef : 0.0f; pb[a2][rg] = (m > c) ? eb : 0.0f; }
                    if (t <= tw) { const bf16x8 pw = pack_p(pf[0], pf[1]);
#pragma unroll
                        for (int dt = 0; dt < 4; ++dt) { const bf16x8 va = __builtin_shufflevector(vr[8 * th + 2 * dt], vr[8 * th + 2 * dt + 1], 0, 1, 2, 3, 4, 5, 6, 7); of[dt] = __builtin_amdgcn_mfma_f32_16x16x32_bf16(va, pw, of[dt], 0, 0, 0); } }
                    if (t >= tw) { const bf16x8 pw = pack_p(pb[0], pb[1]);
#pragma unroll
                        for (int dt = 0; dt < 4; ++dt) { const bf16x8 va = __builtin_shufflevector(vr[8 * th + 2 * dt], vr[8 * th + 2 * dt + 1], 0, 1, 2, 3, 4, 5, 6, 7); ob[dt] = __builtin_amdgcn_mfma_f32_16x16x32_bf16(va, pw, ob[dt], 0, 0, 0); } }
                }
            }
        }
        const bf16* rtf = RT + ((size_t)(h) * 128 + n) * 4096 + i16 * 64 + 8 * g; const bf16* rtb = RT + ((size_t)(8 + h) * 128 + n) * 4096 + i16 * 64 + 8 * g;
        const float xif = exp2f(lgf * (float)(c + 1)), xib = exp2f(lgb * (float)(128 - c));
#pragma unroll
        for (int et = 0; et < 4; ++et) {
            f32x4 cf = {0.f, 0.f, 0.f, 0.f}, cb = cf;
            cf = __builtin_amdgcn_mfma_f32_16x16x32_bf16(*(const bf16x8*)(rtf + et * 1024), q0, cf, 0, 0, 0); cf = __builtin_amdgcn_mfma_f32_16x16x32_bf16(*(const bf16x8*)(rtf + et * 1024 + 32), q1, cf, 0, 0, 0);
            cb = __builtin_amdgcn_mfma_f32_16x16x32_bf16(*(const bf16x8*)(rtb + et * 1024), q0, cb, 0, 0, 0); cb = __builtin_amdgcn_mfma_f32_16x16x32_bf16(*(const bf16x8*)(rtb + et * 1024 + 32), q1, cb, 0, 0, 0);
            of[et] += cf * xif; ob[et] += cb * xib;
        }
        float sf = 0.f, sb = 0.f;
#pragma unroll
        for (int dt = 0; dt < 4; ++dt) { sf += (of[dt][0] + of[dt][1]) + (of[dt][2] + of[dt][3]); sb += (ob[dt][0] + ob[dt][1]) + (ob[dt][2] + ob[dt][3]); }
        sf += shx(sf, 16); sf += shx(sf, 32); sb += shx(sb, 16); sb += shx(sb, 32);
        const float muf = sf * (1.0f / 64.0f), mub = sb * (1.0f / 64.0f);
        float vfq = 0.f, vbq = 0.f;
#pragma unroll
        for (int dt = 0; dt < 4; ++dt) { of[dt] = of[dt] - muf; ob[dt] = ob[dt] - mub;
            vfq += (of[dt][0] * of[dt][0] + of[dt][1] * of[dt][1]) + (of[dt][2] * of[dt][2] + of[dt][3] * of[dt][3]);
            vbq += (ob[dt][0] * ob[dt][0] + ob[dt][1] * ob[dt][1]) + (ob[dt][2] * ob[dt][2] + ob[dt][3] * ob[dt][3]); }
        vfq += shx(vfq, 16); vfq += shx(vfq, 32); vbq += shx(vbq, 16); vbq += shx(vbq, 32);
        const float rsf = 1.0f / sqrtf(vfq * (1.0f / 64.0f) + GN_EPS), rsb = 1.0f / sqrtf(vbq * (1.0f / 64.0f) + GN_EPS);
        const bf16* gp = H + (size_t)tok * EVEN_IN + 1536 + h * 64 + 4 * g;
        bf16* yp = Y + (size_t)tok * D + h * 64 + 4 * g;
#pragma unroll
        for (int dt = 0; dt < 4; ++dt) {
            const u32x2 wf = *(const u32x2*)(gp + 16 * dt), wb = *(const u32x2*)(gp + 512 + 16 * dt);
            const f32x4 gf = {bflo(wf.x), bfhi(wf.x), bflo(wf.y), bfhi(wf.y)}, gb = {bflo(wb.x), bfhi(wb.x), bflo(wb.y), bfhi(wb.y)};
            f32x4 y;
#pragma unroll
            for (int j = 0; j < 4; ++j) y[j] = gf[j] * sigmoidf_(gf[j]) * (of[dt][j] * rsf) + gb[j] * sigmoidf_(gb[j]) * (ob[dt][j] * rsb);
            u32x2 w; w.x = cvt_pk_bf16(y[0], y[1]); w.y = cvt_pk_bf16(y[2], y[3]); *(u32x2*)(yp + 16 * dt) = w;
        }
        if (has_next) ret_commit(lds + ((it + 1) & 1) * 32768, tid, kr, vr);
        lds_barrier();
    }
}

__device__ __forceinline__ void tr_read2(unsigned a, s16x4& r0, s16x4& r1) {
    asm volatile("ds_read_b64_tr_b16 %0, %2\n\tds_read_b64_tr_b16 %1, %2 offset:2048\n\ts_waitcnt lgkmcnt(0)" : "=&v"(r0), "=&v"(r1) : "v"(a) : "memory");
}
__device__ __forceinline__ u32x4 scale8(const u32x4 w, float z) {
    u32x4 o; o.x = pk2(bflo(w.x) * z, bfhi(w.x) * z); o.y = pk2(bflo(w.y) * z, bfhi(w.y) * z); o.z = pk2(bflo(w.z) * z, bfhi(w.z) * z); o.w = pk2(bflo(w.w) * z, bfhi(w.w) * z); return o;
}
__device__ __forceinline__ void rs_commit(LAS unsigned char* buf, int tid, const u32x4 (&kr)[2], const u32x4 (&vr)[2], float lgf, float lgb) {
#pragma unroll
    for (int k = 0; k < 2; ++k) { const int id = tid + 512 * k, row = id >> 3, c = id & 7; const unsigned off = (unsigned)(row * 128 + ((c ^ (row & 7)) << 4));
        *(LAS u32x4*)(buf + off) = scale8(kr[k], exp2f(lgf * (float)(127 - row))); *(LAS u32x4*)(buf + 16384 + off) = scale8(kr[k], exp2f(lgb * (float)row)); *(LAS u32x4*)(buf + 32768 + off) = vr[k]; }
}
__device__ __forceinline__ void phase_ret_states_mfma(LAS unsigned char* lds, const bf16* H, const float* decay, float* S, int bid, int tid) {
    const int wave = tid >> 6, lane = tid & 63, i16 = lane & 15, g = lane >> 4, dir = wave >> 2, et = wave & 3;
    const LaneOffs lo = lane_offs(lane);
    unsigned voff_et;
    { const int q = i16 >> 2, p = i16 & 3, vrow = 4 * g + q; voff_et = (unsigned)(vrow * 128 + (((2 * et + (p >> 1)) ^ (vrow & 7)) << 4) + 8 * (p & 1)); }
    u32x4 kr[2], vr[2];
    __syncthreads();
    ret_issue(H, bid, tid, kr, vr); rs_commit(lds, tid, kr, vr, log2_gamma(decay[bid >> 7]), log2_gamma(decay[8 + (bid >> 7)]));
    lds_barrier();
    int it = 0;
    for (int u = bid; u < 1024; u += GRID, ++it) {
        LAS unsigned char* buf = lds + (it & 1) * 49152;
        const bool has_next = (u + GRID) < 1024;
        if (has_next) ret_issue(H, u + GRID, tid, kr, vr);
        const int h = u >> 7, n = u & 127;
        f32x4 acc[4];
#pragma unroll
        for (int dt = 0; dt < 4; ++dt) acc[dt] = (f32x4){0.f, 0.f, 0.f, 0.f};
        const unsigned kb = lds_addr(buf + dir * 16384), vb = lds_addr(buf + 32768);
#pragma unroll
        for (int ks = 0; ks < 4; ++ks) {
            s16x4 a0, a1; tr_read2(vb + ks * 4096 + voff_et, a0, a1);
            const bf16x8 af = __builtin_shufflevector(a0, a1, 0, 1, 2, 3, 4, 5, 6, 7);
#pragma unroll
            for (int dt = 0; dt < 4; ++dt) { s16x4 b0, b1; tr_read2(kb + ks * 4096 + lo.v[dt], b0, b1);
                const bf16x8 bfr = __builtin_shufflevector(b0, b1, 0, 1, 2, 3, 4, 5, 6, 7); acc[dt] = __builtin_amdgcn_mfma_f32_16x16x32_bf16(af, bfr, acc[dt], 0, 0, 0); }
        }
        float* sp = S + ((size_t)(dir * 8 + h) * 128 + n) * 4096 + (16 * et + 4 * g) * 64 + i16;
#pragma unroll
        for (int dt = 0; dt < 4; ++dt)
#pragma unroll
            for (int rg = 0; rg < 4; ++rg) sp[rg * 64 + 16 * dt] = acc[dt][rg];
        if (has_next) { const int h2 = (u + GRID) >> 7; rs_commit(lds + ((it + 1) & 1) * 49152, tid, kr, vr, log2_gamma(decay[h2]), log2_gamma(decay[8 + h2])); }
        lds_barrier();
    }
}

__device__ __forceinline__ bf16x8 pack_p(const f32x4 p0, const f32x4 p1) {
    u32x4 pw;
    asm volatile("v_cvt_pk_bf16_f32 %0, %4, %5\n\tv_cvt_pk_bf16_f32 %1, %6, %7\n\tv_cvt_pk_bf16_f32 %2, %8, %9\n\tv_cvt_pk_bf16_f32 %3, %10, %11\n\ts_nop 1"
                 : "=&v"(pw.x), "=&v"(pw.y), "=&v"(pw.z), "=&v"(pw.w) : "v"(p0[0]), "v"(p0[1]), "v"(p0[2]), "v"(p0[3]), "v"(p1[0]), "v"(p1[1]), "v"(p1[2]), "v"(p1[3]));
    return __builtin_bit_cast(bf16x8, pw);
}
template <int NT> __device__ __forceinline__ void sf_finish(f32x4 (&sc)[NT][2], const unsigned (&vt)[NT], const LaneOffs& lo, f32x4 (&o)[4], float& m_out, float& l_out) {
    float m = -1e30f;
#pragma unroll
    for (int t = 0; t < NT; ++t)
#pragma unroll
        for (int a = 0; a < 2; ++a) m = fmaxf(m, fmaxf(fmaxf(sc[t][a][0], sc[t][a][1]), fmaxf(sc[t][a][2], sc[t][a][3])));
    m = fmaxf(m, shx(m, 16)); m = fmaxf(m, shx(m, 32));
    float l = 0.f;
#pragma unroll
    for (int t = 0; t < NT; ++t)
#pragma unroll
        for (int a = 0; a < 2; ++a)
#pragma unroll
            for (int r = 0; r < 4; ++r) { sc[t][a][r] = __builtin_amdgcn_exp2f(sc[t][a][r] - m); l += sc[t][a][r]; }
#pragma unroll
    for (int dt = 0; dt < 4; ++dt) o[dt] = (f32x4){0.f, 0.f, 0.f, 0.f};
#pragma unroll
    for (int t = 0; t + 1 < NT; t += 2) {
        s16x4 r[16]; tr_read16(vt[t], vt[t + 1], lo.v, r);
        const bf16x8 pa = pack_p(sc[t][0], sc[t][1]), pb = pack_p(sc[t + 1][0], sc[t + 1][1]);
#pragma unroll
        for (int dt = 0; dt < 4; ++dt) { const bf16x8 va = __builtin_shufflevector(r[2 * dt], r[2 * dt + 1], 0, 1, 2, 3, 4, 5, 6, 7); o[dt] = __builtin_amdgcn_mfma_f32_16x16x32_bf16(va, pa, o[dt], 0, 0, 0); }
#pragma unroll
        for (int dt = 0; dt < 4; ++dt) { const bf16x8 vb = __builtin_shufflevector(r[8 + 2 * dt], r[9 + 2 * dt], 0, 1, 2, 3, 4, 5, 6, 7); o[dt] = __builtin_amdgcn_mfma_f32_16x16x32_bf16(vb, pb, o[dt], 0, 0, 0); }
    }
    if (NT & 1) { constexpr int t = NT - 1;
        s16x4 r[8]; tr_read8(vt[t] + lo.v[0], vt[t] + lo.v[1], vt[t] + lo.v[2], vt[t] + lo.v[3], r);
        const bf16x8 pa = pack_p(sc[t][0], sc[t][1]);
#pragma unroll
        for (int dt = 0; dt < 4; ++dt) { const bf16x8 va = __builtin_shufflevector(r[2 * dt], r[2 * dt + 1], 0, 1, 2, 3, 4, 5, 6, 7); o[dt] = __builtin_amdgcn_mfma_f32_16x16x32_bf16(va, pa, o[dt], 0, 0, 0); }
    }
    l += shx(l, 16); l += shx(l, 32);
    m_out = m; l_out = l;
}

__device__ __forceinline__ void phase_dilated_sf(LAS unsigned char* lds, const bf16* H, bf16* OG, float* LSE, int bid, int tid) {
    const int wave = tid >> 6, lane = tid & 63, i16 = lane & 15, g = lane >> 4;
    const LaneOffs lo = lane_offs(lane);
    u32x4 kr[4], vr[4];
    __syncthreads();
    dil_issue(H, bid, tid, kr, vr); dil_commit(lds, tid, kr, vr);
    lds_barrier();
    int it = 0;
    bf16x8 nq0, nq1;
    { int h, b, r, blk; dil_decode(bid, h, b, r, blk); const bf16* qp = H + (size_t)(r + ((128 * blk + 16 * wave + i16) << (2 * b))) * EVEN_IN + 2560 + h * 64 + 8 * g; nq0 = *(const bf16x8*)qp; nq1 = *(const bf16x8*)(qp + 32); }
    for (int u = bid; u < DIL_UNITS; u += GRID, ++it) {
        LAS unsigned char* buf = lds + (it & 1) * 65536;
        const bool has_next = (u + GRID) < DIL_UNITS;
        if (has_next) dil_issue(H, u + GRID, tid, kr, vr);
        int h, b, r, blk; dil_decode(u, h, b, r, blk); const int Lc = T >> (2 * b), base = 128 * blk - 64;
        const int ql = 16 * wave + i16, tokq = r + ((128 * blk + ql) << (2 * b));
        const bf16x8 q0 = nq0, q1 = nq1;
        if (has_next) { int h2, b2, r2, blk2; dil_decode(u + GRID, h2, b2, r2, blk2); const bf16* qp = H + (size_t)(r2 + ((128 * blk2 + ql) << (2 * b2))) * EVEN_IN + 2560 + h2 * 64 + 8 * g; nq0 = *(const bf16x8*)qp; nq1 = *(const bf16x8*)(qp + 32); }
        const int t0 = wave >> 1;
        f32x4 sc[5][2]; unsigned vt[5];
        { const unsigned kb = lds_addr(buf + t0 * 4096);
          qk_pair(kb, kb + 4096, lo, q0, q1, sc[0], sc[1]); qk_pair(kb + 8192, kb + 12288, lo, q0, q1, sc[2], sc[3]); qk_tile(buf + (t0 + 4) * 4096, lo, q0, q1, sc[4]); }
        const int dq0 = 32 * t0 + 4 * g - ql;
        const bool edge = (base < 0) || (base + 256 > Lc);
#pragma unroll
        for (int tt = 0; tt < 5; ++tt) { vt[tt] = lds_addr(buf + 32768 + (t0 + tt) * 4096);
#pragma unroll
            for (int a = 0; a < 2; ++a)
#pragma unroll
                for (int rg = 0; rg < 4; ++rg) { const int dk = dq0 + 32 * tt + 16 * a + rg; bool ok = (unsigned)dk <= 128u;
                    if (edge) ok = ok & ((unsigned)(base + dk + ql) < (unsigned)Lc);
                    const float sv = sc[tt][a][rg] * 1.4426950408889634f; sc[tt][a][rg] = ok ? sv : -INFINITY; } }
        f32x4 o[4]; float m, l; sf_finish<5>(sc, vt, lo, o, m, l);
        const float inv = 1.0f / l;
        bf16* op = OG + ((size_t)b * T + tokq) * 512 + h * 64 + 4 * g;
#pragma unroll
        for (int dt = 0; dt < 4; ++dt) { const f32x4 ov = o[dt] * inv; u32x2 w; w.x = cvt_pk_bf16(ov[0], ov[1]); w.y = cvt_pk_bf16(ov[2], ov[3]); *(u32x2*)(op + 16 * dt) = w; }
        if (g == 0) LSE[((size_t)b * T + tokq) * 8 + h] = (m + log2f(l)) * 0.6931471805599453f;
        if (has_next) dil_commit(lds + ((it + 1) & 1) * 65536, tid, kr, vr);
        lds_barrier();
    }
}

__device__ __forceinline__ int na_r0(int r) { return min(max(r - 4, 0), 248); }
__device__ __forceinline__ void na_issue(const bf16* H, int h, int row_lo, int nrows, int tid, u32x4 (&pr)[4]) {
#pragma unroll
    for (int k = 0; k < 4; ++k) { const int id = tid + 512 * k, which = id >> 10, rs = (id >> 9) & 1, key = (id >> 3) & 63, ch = id & 7;
        if (rs < nrows) pr[k] = *(const u32x4*)(H + (size_t)((row_lo + rs) * 64 + key) * ODD_IN + 1024 + which * 1024 + h * 64 + ch * 8); }
}
__device__ __forceinline__ void na_commit(LAS unsigned char* lds, int row_lo, int nrows, int tid, const u32x4 (&pr)[4]) {
#pragma unroll
    for (int k = 0; k < 4; ++k) { const int id = tid + 512 * k, which = id >> 10, rs = (id >> 9) & 1, key = (id >> 3) & 63, ch = id & 7;
        if (rs < nrows) *(LAS u32x4*)(lds + which * 73728 + ((row_lo + rs) % 9) * 8192 + key * 128 + ((ch ^ (key & 7)) << 4)) = pr[k]; }
}
template <int PM  > __device__ __forceinline__ void phase_natten_sf(LAS unsigned char* lds, const bf16* H, const float* rpb, bf16* Y, int bid, int tid) {
    const int wave = tid >> 6, lane = tid & 63, i16 = lane & 15, g = lane >> 4, cb = wave & 3, rq = wave >> 2;
    const LaneOffs lo = lane_offs(lane);
    LAS float* btab = (LAS float*)(lds + MISC_OFF + 4096);
    const int wc0 = (cb == 0) ? 0 : (cb == 1) ? 8 : (cb == 2) ? 24 : 32;
    const int c = 16 * cb + i16, cs = min(max(c - 8, 0), 48);
    int cx[2][4]; unsigned okbits = 0u;
#pragma unroll
    for (int a = 0; a < 2; ++a)
#pragma unroll
        for (int rg = 0; rg < 4; ++rg) { const int col = wc0 + 16 * a + 4 * g + rg; cx[a][rg] = min(max(col - c + 15, 0), 30); okbits |= ((unsigned)(col - cs) < 16u) ? (1u << (4 * a + rg)) : 0u; }
    const int h = bid >> 4, rbase = (bid & 15) * 16;
    __syncthreads();
    if (tid < 465) btab[tid] = rpb[h * 465 + tid];
    u32x4 pr[4];
    {
        const int wlo = na_r0(rbase), whi = na_r0(rbase + 1) + 7;
        u32x4 p5[5][4];
#pragma unroll
        for (int i = 0; i < 5; ++i) { const int rr = wlo + 2 * i; na_issue(H, h, rr, min(2, max(whi - rr + 1, 0)), tid, p5[i]); }
#pragma unroll
        for (int i = 0; i < 5; ++i) { const int rr = wlo + 2 * i; na_commit(lds, rr, min(2, max(whi - rr + 1, 0)), tid, p5[i]); }
    }
    bf16x8 nq0, nq1;
    { const bf16* qp = H + (size_t)((rbase + rq) * 64 + c) * ODD_IN + h * 64 + 8 * g; nq0 = *(const bf16x8*)qp; nq1 = *(const bf16x8*)(qp + 32); }
    lds_barrier();
#pragma unroll 1
    for (int k = 0; k < 8; ++k) {
        const int r = rbase + 2 * k, rme = r + rq, r0 = na_r0(rme);
        const int whi = na_r0(r + 1) + 7, nhi = (k < 7) ? (na_r0(r + 3) + 7) : whi, nnew = nhi - whi;
        if (PM != 2 && nnew > 0) na_issue(H, h, whi + 1, nnew, tid, pr);
        const int tokq = rme * 64 + c;
        if (PM != 1) {
        const bf16x8 q0 = nq0, q1 = nq1;
        if (k < 7) { const bf16* qp = H + (size_t)(tokq + 128) * ODD_IN + h * 64 + 8 * g; nq0 = *(const bf16x8*)qp; nq1 = *(const bf16x8*)(qp + 32); }
        f32x4 sc[8][2]; unsigned vt[8]; float bia[8][2][4];
#pragma unroll
        for (int t = 0; t < 8; ++t) { const LAS float* bp = btab + (r0 + t - rme + 7) * 31;
#pragma unroll
            for (int a = 0; a < 2; ++a)
#pragma unroll
                for (int rg = 0; rg < 4; ++rg) bia[t][a][rg] = bp[cx[a][rg]]; }
#pragma unroll
        for (int t = 0; t < 8; t += 2) { const unsigned tb0 = (unsigned)(((r0 + t) % 9) * 8192 + wc0 * 128), tb1 = (unsigned)(((r0 + t + 1) % 9) * 8192 + wc0 * 128);
            qk_pair(lds_addr(lds + tb0), lds_addr(lds + tb1), lo, q0, q1, sc[t], sc[t + 1]); vt[t] = lds_addr(lds + 73728 + tb0); vt[t + 1] = lds_addr(lds + 73728 + tb1); }
#pragma unroll
        for (int t = 0; t < 8; ++t)
#pragma unroll
            for (int a = 0; a < 2; ++a)
#pragma unroll
                for (int rg = 0; rg < 4; ++rg) { const float sv = (sc[t][a][rg] + bia[t][a][rg]) * 1.4426950408889634f; sc[t][a][rg] = ((okbits >> (4 * a + rg)) & 1u) ? sv : -INFINITY; }
        f32x4 o[4]; float m, l; sf_finish<8>(sc, vt, lo, o, m, l);
        const float inv = 1.0f / l;
        bf16* op = Y + (size_t)tokq * D + h * 64 + 4 * g;
#pragma unroll
        for (int dt = 0; dt < 4; ++dt) { const f32x4 ov = o[dt] * inv; u32x2 w; w.x = cvt_pk_bf16(ov[0], ov[1]); w.y = cvt_pk_bf16(ov[2], ov[3]); *(u32x2*)(op + 16 * dt) = w; }
        }
        lds_barrier();
        if (PM != 2 && nnew > 0) na_commit(lds, whi + 1, nnew, tid, pr);
        lds_barrier();
    }
}

__device__ __forceinline__ void phase_ln1_router(LAS unsigned char* lds, const float* U, const float* lng, const float* lnb, const float* rw, const float* rbias,
                                                 float* X1, bf16* X1b, int* tope, float* gate, int* lrank, int* cnt, int bid, int tid) {
    const int wave = tid >> 6, lane = tid & 63;
    LAS int* lcnt = (LAS int*)(lds + MISC_OFF + 1024);
    __syncthreads();
    for (int idx = tid; idx < 1024 * 8; idx += NTHR) { const int d = idx >> 3, c = idx & 7;
        *(LAS f32x4*)(lds + d * 128 + ((c ^ ((d >> 1) & 7)) << 4)) = *(const f32x4*)(rw + d * 32 + c * 4); }
    if (tid < 32) lcnt[tid] = 0;
    __syncthreads();
    float gg[16], bb[16];
#pragma unroll
    for (int i = 0; i < 16; ++i) { gg[i] = lng[64 * i + lane]; bb[i] = lnb[64 * i + lane]; }
    const float rbe = rbias[lane >> 1];
    for (int rr = 0; rr < 8; ++rr) {
        const int row = bid * 64 + wave * 8 + rr;
        float x[16]; float s = 0.f;
#pragma unroll
        for (int i = 0; i < 16; ++i) { x[i] = U[(size_t)row * D + 64 * i + lane]; s += x[i]; }
        const float mean = wave_sum(s) * (1.0f / D); float s2 = 0.f;
#pragma unroll
        for (int i = 0; i < 16; ++i) { x[i] -= mean; s2 += x[i] * x[i]; }
        const float rstd = 1.0f / sqrtf(wave_sum(s2) * (1.0f / D) + LN_EPS);
#pragma unroll
        for (int i = 0; i < 16; ++i) { x[i] = x[i] * rstd * gg[i] + bb[i]; X1[(size_t)row * D + 64 * i + lane] = x[i]; X1b[(size_t)row * D + 64 * i + lane] = (bf16)f2bf(x[i]); }
        float acc[32];
#pragma unroll
        for (int e = 0; e < 32; ++e) acc[e] = 0.f;
#pragma unroll
        for (int i = 0; i < 16; ++i) { const int d = 64 * i + lane;
#pragma unroll
            for (int c = 0; c < 8; ++c) { const f32x4 w = *(const LAS f32x4*)(lds + d * 128 + ((c ^ ((d >> 1) & 7)) << 4));
                acc[4 * c] += x[i] * w[0]; acc[4 * c + 1] += x[i] * w[1]; acc[4 * c + 2] += x[i] * w[2]; acc[4 * c + 3] += x[i] * w[3]; } }
#pragma unroll
        for (int t = 0; t < 16; ++t) { const bool up = (lane & 32) != 0; const float snd = up ? acc[t] : acc[t + 16]; const float rcv = shx(snd, 32); acc[t] = (up ? acc[t + 16] : acc[t]) + rcv; }
#pragma unroll
        for (int t = 0; t < 8; ++t) { const bool up = (lane & 16) != 0; const float snd = up ? acc[t] : acc[t + 8]; const float rcv = shx(snd, 16); acc[t] = (up ? acc[t + 8] : acc[t]) + rcv; }
#pragma unroll
        for (int t = 0; t < 4; ++t) { const bool up = (lane & 8) != 0; const float snd = up ? acc[t] : acc[t + 4]; const float rcv = shx(snd, 8); acc[t] = (up ? acc[t + 4] : acc[t]) + rcv; }
#pragma unroll
        for (int t = 0; t < 2; ++t) { const bool up = (lane & 4) != 0; const float snd = up ? acc[t] : acc[t + 2]; const float rcv = shx(snd, 4); acc[t] = (up ? acc[t + 2] : acc[t]) + rcv; }
        { const bool up = (lane & 2) != 0; const float snd = up ? acc[0] : acc[1]; const float rcv = shx(snd, 2); acc[0] = (up ? acc[1] : acc[0]) + rcv; }
        float lv = acc[0] + shx(acc[0], 1) + rbe;
        const int me = lane >> 1;
        float tv[4]; int ti[4];
#pragma unroll
        for (int k = 0; k < 4; ++k) {
            float bv = lv; int bi = me;
#pragma unroll
            for (int o = 32; o >= 1; o >>= 1) { const float ov = shx(bv, o); const int oi = shx(bi, o); if (ov > bv || (ov == bv && oi < bi)) { bv = ov; bi = oi; } }
            tv[k] = bv; ti[k] = bi; if (me == bi) lv = -INFINITY;
        }
        const float p1 = expf(tv[1] - tv[0]), p2 = expf(tv[2] - tv[0]), p3 = expf(tv[3] - tv[0]); const float inv = 1.0f / (1.0f + p1 + p2 + p3);
        if (lane < 4) {
            const int e = (lane == 0) ? ti[0] : (lane == 1) ? ti[1] : (lane == 2) ? ti[2] : ti[3];
            const float gk = ((lane == 0) ? 1.0f : (lane == 1) ? p1 : (lane == 2) ? p2 : p3) * inv;
            const int rk = __hip_atomic_fetch_add(lcnt + e, 1, __ATOMIC_RELAXED, __HIP_MEMORY_SCOPE_WORKGROUP);
            tope[row * 4 + lane] = e; gate[row * 4 + lane] = gk; lrank[row * 4 + lane] = rk;
        }
    }
    __syncthreads();
    if (tid < 32) cnt[bid * 32 + tid] = lcnt[tid];
}

__device__ __forceinline__ void phase_ln1_router_mfma(LAS unsigned char* lds, const float* U, const float* lng, const float* lnb, const bf16* rwt, const float* rbias,
                                                      float* X1, bf16* X1b, bf16* X1lo, int* tope, float* gate, int* lrank, int* cnt, int bid, int tid) {
    const int wave = tid >> 6, lane = tid & 63, i16 = lane & 15, g = lane >> 4;
    LAS int* lcnt = (LAS int*)(lds + MISC_OFF + 1024);
    LAS float* pbuf = (LAS float*)lds;
    __syncthreads();
    if (tid < 32) lcnt[tid] = 0;
    {   f32x4 gg[4], bb[4];
#pragma unroll
        for (int j = 0; j < 4; ++j) { gg[j] = *(const f32x4*)(lng + 256 * j + 4 * lane); bb[j] = *(const f32x4*)(lnb + 256 * j + 4 * lane); }
#pragma unroll 2
        for (int rr = 0; rr < 8; ++rr) {
            const size_t ro = (size_t)(bid * 64 + wave * 8 + rr) * D + 4 * lane;
            f32x4 v[4]; float s = 0.f;
#pragma unroll
            for (int j = 0; j < 4; ++j) { v[j] = *(const f32x4*)(U + ro + 256 * j); s += (v[j][0] + v[j][1]) + (v[j][2] + v[j][3]); }
            const float mean = wave_sum(s) * (1.0f / D); float s2 = 0.f;
#pragma unroll
            for (int j = 0; j < 4; ++j) { v[j] = v[j] - mean; s2 += (v[j][0] * v[j][0] + v[j][1] * v[j][1]) + (v[j][2] * v[j][2] + v[j][3] * v[j][3]); }
            const float rstd = 1.0f / sqrtf(wave_sum(s2) * (1.0f / D) + LN_EPS);
#pragma unroll
            for (int j = 0; j < 4; ++j) { const f32x4 o = v[j] * rstd * gg[j] + bb[j]; *(f32x4*)(X1 + ro + 256 * j) = o;
                const unsigned h0 = f2bf(o[0]), h1 = f2bf(o[1]), h2 = f2bf(o[2]), h3 = f2bf(o[3]);
                u32x2 wh; wh.x = h0 | (h1 << 16); wh.y = h2 | (h3 << 16); *(u32x2*)(X1b + ro + 256 * j) = wh;
                u32x2 wl; wl.x = pk2(o[0] - __builtin_bit_cast(float, h0 << 16), o[1] - __builtin_bit_cast(float, h1 << 16)); wl.y = pk2(o[2] - __builtin_bit_cast(float, h2 << 16), o[3] - __builtin_bit_cast(float, h3 << 16));
                *(u32x2*)(X1lo + ro + 256 * j) = wl; }
        }
    }
    asm volatile("s_waitcnt vmcnt(0)" ::: "memory");
    __syncthreads();
    const int rt = wave & 3, kh = wave >> 2;
    f32x4 acc[2]; acc[0] = (f32x4){0.f, 0.f, 0.f, 0.f}; acc[1] = acc[0];
    {   const size_t ao = (size_t)(bid * 64 + rt * 16 + i16) * D + kh * 512 + 8 * g;
        const bf16* bh = rwt + (size_t)i16 * D + kh * 512 + 8 * g; const bf16* bl = bh + (size_t)NEXP * D;
#pragma unroll 4
        for (int s = 0; s < 16; ++s) {
            const bf16x8 ah = *(const bf16x8*)(X1b + ao + 32 * s), al = *(const bf16x8*)(X1lo + ao + 32 * s);
#pragma unroll
            for (int et = 0; et < 2; ++et) { const bf16x8 wh = *(const bf16x8*)(bh + (size_t)et * 16 * D + 32 * s), wl = *(const bf16x8*)(bl + (size_t)et * 16 * D + 32 * s);
                acc[et] = __builtin_amdgcn_mfma_f32_16x16x32_bf16(ah, wh, acc[et], 0, 0, 0); acc[et] = __builtin_amdgcn_mfma_f32_16x16x32_bf16(ah, wl, acc[et], 0, 0, 0); acc[et] = __builtin_amdgcn_mfma_f32_16x16x32_bf16(al, wh, acc[et], 0, 0, 0); }
        }
    }
    if (kh == 1) { LAS f32x4* pb = (LAS f32x4*)(pbuf + ((wave - 4) * 64 + lane) * 8); pb[0] = acc[0]; pb[1] = acc[1]; }
    __syncthreads();
    if (kh == 0) {
        const LAS f32x4* pb = (const LAS f32x4*)(pbuf + (wave * 64 + lane) * 8);
        const float b0 = rbias[i16], b1 = rbias[16 + i16];
        const f32x4 l0 = acc[0] + pb[0] + b0, l1 = acc[1] + pb[1] + b1;
#pragma unroll
        for (int reg = 0; reg < 4; ++reg) {
            float v0 = l0[reg], v1 = l1[reg]; float tv[4]; int ti[4];
#pragma unroll
            for (int k = 0; k < 4; ++k) {
                float bv = (v0 >= v1) ? v0 : v1; int bi = (v0 >= v1) ? i16 : 16 + i16;
#pragma unroll
                for (int o = 1; o < 16; o <<= 1) { const float ov = shx(bv, o); const int oi = shx(bi, o); if (ov > bv || (ov == bv && oi < bi)) { bv = ov; bi = oi; } }
                tv[k] = bv; ti[k] = bi; if (bi == i16) v0 = -INFINITY; if (bi == 16 + i16) v1 = -INFINITY;
            }
            const float p1 = expf(tv[1] - tv[0]), p2 = expf(tv[2] - tv[0]), p3 = expf(tv[3] - tv[0]); const float inv = 1.0f / (1.0f + p1 + p2 + p3);
            if (i16 < 4) {
                const int row = bid * 64 + rt * 16 + 4 * g + reg;
                const int e = (i16 == 0) ? ti[0] : (i16 == 1) ? ti[1] : (i16 == 2) ? ti[2] : ti[3];
                const float gk = ((i16 == 0) ? 1.0f : (i16 == 1) ? p1 : (i16 == 2) ? p2 : p3) * inv;
                const int rk = __hip_atomic_fetch_add(lcnt + e, 1, __ATOMIC_RELAXED, __HIP_MEMORY_SCOPE_WORKGROUP);
                tope[row * 4 + i16] = e; gate[row * 4 + i16] = gk; lrank[row * 4 + i16] = rk;
            }
        }
    }
    __syncthreads();
    if (tid < 32) cnt[bid * 32 + tid] = lcnt[tid];
}

__device__ __forceinline__ void phase_dispatch(LAS unsigned char* lds, const int* cnt, const int* tope, const int* lrank, int* slot, int* tiles, int* rowidx, int bid, int tid) {
    LAS int* tot = (LAS int*)(lds + MISC_OFF + 1024); LAS int* pre = tot + 32; LAS int* pst = pre + 32;
    __syncthreads();
    if (tid < 32) { int t = 0, p = 0; for (int b2 = 0; b2 < GRID; ++b2) { const int v = cnt[b2 * 32 + tid]; t += v; p += (b2 < bid) ? v : 0; } tot[tid] = t; pre[tid] = p; }
    __syncthreads();
    if (tid == 0) { int ps = 0;
#pragma unroll 1
        for (int e = 0; e < NEXP; ++e) { pst[e] = ps; ps += ((tot[e] + 255) >> 8) << 8; }
        pst[NEXP] = ps; }
    __syncthreads();
    if (bid == 0 && tid < 1 + MAXTILES) {
        if (tid == 0) tiles[0] = pst[NEXP] >> 8;
        else { const int i = tid - 1; int ee = 0;
#pragma unroll 1
            for (int e = 0; e < NEXP; ++e) ee = ((pst[e] >> 8) <= i) ? e : ee;
            tiles[tid] = ee; }
    }
    if (bid < NEXP) { const int e = bid, lo = pst[e] + tot[e], hi = pst[e + 1]; for (int i = lo + tid; i < hi; i += NTHR) rowidx[i] = 0; }
    if (tid < 256) { const int row = bid * 64 + (tid >> 2), k = tid & 3; const int e = tope[row * 4 + k]; const int dest = pst[e] + pre[e] + lrank[row * 4 + k]; slot[row * 4 + k] = dest; rowidx[dest] = row; }
}

__device__ __forceinline__ void phase_combine_ln2(const float* X1, const bf16* Oslot, const int* slot, const float* gate, const float* lng, const float* lnb, float* Xout, bf16* Xb, int bid, int tid) {
    const int wave = tid >> 6, lane = tid & 63;
    f32x4 gg[4], bb[4];
#pragma unroll
    for (int j = 0; j < 4; ++j) { gg[j] = *(const f32x4*)(lng + 256 * j + 4 * lane); bb[j] = *(const f32x4*)(lnb + 256 * j + 4 * lane); }
    for (int rr = 0; rr < 8; ++rr) {
        const int row = bid * 64 + wave * 8 + rr;
        f32x4 v[4];
#pragma unroll
        for (int j = 0; j < 4; ++j) v[j] = *(const f32x4*)(X1 + (size_t)row * D + 256 * j + 4 * lane) * ALPHA;
#pragma unroll
        for (int k = 0; k < 4; ++k) { const int s = slot[row * 4 + k]; const float g = gate[row * 4 + k];
#pragma unroll
            for (int j = 0; j < 4; ++j) { const u32x2 w = *(const u32x2*)(Oslot + (size_t)s * D + 256 * j + 4 * lane); v[j] += (f32x4){bflo(w.x), bfhi(w.x), bflo(w.y), bfhi(w.y)} * g; } }
        float s = 0.f;
#pragma unroll
        for (int j = 0; j < 4; ++j) s += (v[j][0] + v[j][1]) + (v[j][2] + v[j][3]);
        const float mean = wave_sum(s) * (1.0f / D); float s2 = 0.f;
#pragma unroll
        for (int j = 0; j < 4; ++j) { v[j] = v[j] - mean; s2 += (v[j][0] * v[j][0] + v[j][1] * v[j][1]) + (v[j][2] * v[j][2] + v[j][3] * v[j][3]); }
        const float rstd = 1.0f / sqrtf(wave_sum(s2) * (1.0f / D) + LN_EPS);
#pragma unroll
        for (int j = 0; j < 4; ++j) { const f32x4 o = v[j] * rstd * gg[j] + bb[j]; *(f32x4*)(Xout + (size_t)row * D + 256 * j + 4 * lane) = o;
            if (Xb) { u32x2 w; w.x = pk2(o[0], o[1]); w.y = pk2(o[2], o[3]); *(u32x2*)(Xb + (size_t)row * D + 256 * j + 4 * lane) = w; } }
    }
}

constexpr int NPH = 10, N_PHASES = 1 + DEPTH * NPH;
struct Args { Ptrs p; int ph_lo, ph_hi; };
static_assert(sizeof(Args) == 17 * 8 + 8, "Args has no padding");
typedef __attribute__((address_space(4))) const Args CArgs;

__global__ void __launch_bounds__(NTHR, 2) fwd_kernel(Args args) {
    extern __shared__ __attribute__((aligned(16))) unsigned char lds_raw[];
    LAS unsigned char* lds0 = (LAS unsigned char*)lds_raw;
    const int tid0 = threadIdx.x, bid0 = blockIdx.x; const int wave0 = __builtin_amdgcn_readfirstlane(tid0 >> 6);
    const int lo = args.ph_lo, hi = args.ph_hi;
    volatile LAS unsigned* MISC = (volatile LAS unsigned*)(lds0 + MISC_OFF);
    if (tid0 < 64) MISC[tid0] = 0u;
    __syncthreads();
    XcdBarrier bar = xcd_barrier_post((unsigned*)(((CArgs*)__builtin_amdgcn_kernarg_segment_ptr())->p.ws + WS_CTL) + CW_BAR, MISC + 8);
#define IN(k) (lo <= (k) && (k) < hi)
#define SEAM(k) do { if (IN(k) && IN((k) + 1)) xcd_barrier(bar, wave0 == 0 && lane_id_nohoist() == 0); } while (0)
#define SITE int tid = wave0 * 64 + lane_id_nohoist(), bid = bid0, L = L0; CArgs* ap = (CArgs*)__builtin_amdgcn_kernarg_segment_ptr(); asm volatile("" : "+v"(tid)); asm volatile("" : "+s"(bid)); asm volatile("" : "+s"(L)); asm volatile("" : "+s"(ap)); LAS unsigned char* lds = lds0; asm volatile("" : "+s"(lds)); \
    unsigned char* ws = ap->p.ws; const int jl = L >> 1; const bool odd = (L & 1) != 0; (void)jl; (void)odd; (void)tid; (void)bid; (void)ws;

    { const int L0 = 0; if (IN(0)) REP(10) { SITE; Ptrs P{}; P.x = ap->p.x; P.ab_w_in = ap->p.ab_w_in; P.ab_w_out = ap->p.ab_w_out; P.c_w_in = ap->p.c_w_in; P.c_w_out = ap->p.c_w_out; P.w_up = ap->p.w_up; P.w_down = ap->p.w_down; P.router_w = ap->p.router_w; P.ws = ws; phase_prologue(P, lds, bid, tid); } }
    SEAM(0);

    for (int L0 = 0; L0 < DEPTH; ++L0) {
        const int pb = 1 + L0 * NPH; const bool odd0 = (L0 & 1) != 0;
        if (IN(pb + 0)) REP(0) {
            if (!odd0) { SITE; pg8::DenseOrder<T / 256, EVEN_IN / 256> S{bid, (const char*)(ws + WS_XB), (const char*)(ws + WS_WIN_E) + (size_t)jl * EVEN_IN * 1024 * 2, nullptr};
                pg8::EpiInEven E{(bf16*)(ws + WS_H), (const float*)(ws + WS_COS), (const float*)(ws + WS_SIN)}; pg8::gemm_phase<pg8::EpiInEven, pg8::DenseOrder<T / 256, EVEN_IN / 256>>(lds, S, E, tid); }
            else { SITE; pg8::DenseOrder<T / 256, ODD_IN / 256> S{bid, (const char*)(ws + WS_XB), (const char*)(ws + WS_WIN_O) + (size_t)jl * ODD_IN * 1024 * 2, nullptr};
                pg8::EpiInOdd E{(bf16*)(ws + WS_H)}; pg8::gemm_phase<pg8::EpiInOdd, pg8::DenseOrder<T / 256, ODD_IN / 256>>(lds, S, E, tid); }
        }
        SEAM(pb + 0);
        if (IN(pb + 1)) REP(1) {
            if (!odd0) { REP(11) { SITE; phase_ret_states_mfma(lds, (const bf16*)(ws + WS_H), ap->p.ret_decay + jl * 16, (float*)(ws + WS_RS), bid, tid); }
                         REP(12) { SITE; phase_dilated_sf(lds, (const bf16*)(ws + WS_H), (bf16*)(ws + WS_ACT), (float*)(ws + WS_OSLOT), bid, tid); } }
            else { { SITE; phase_natten_sf<0>(lds, (const bf16*)(ws + WS_H), ap->p.c_rpb + (size_t)jl * 16 * 15 * 31, (bf16*)(ws + WS_Y), bid, tid); }
#if NA_PROBE
                   { SITE; phase_natten_sf<NA_PROBE>(lds, (const bf16*)(ws + WS_H), ap->p.c_rpb + (size_t)jl * 16 * 15 * 31, (bf16*)(ws + WS_XPERM), bid, tid); }
#endif
            }
        }
        SEAM(pb + 1);
        if (!odd0) {
            if (IN(pb + 2)) REP(2) { { SITE; phase_ret_scan((const float*)(ws + WS_RS), (bf16*)(ws + WS_RR), ap->p.ret_decay + jl * 16, bid, tid); }
                              { SITE; phase_dil_merge((const bf16*)(ws + WS_ACT), (const float*)(ws + WS_OSLOT), (bf16*)(ws + WS_Y), bid, tid); } }
            SEAM(pb + 2);
            if (IN(pb + 3)) REP(3) { SITE; phase_ret_out_mfma(lds, (const bf16*)(ws + WS_H), (const bf16*)(ws + WS_RR), ap->p.ret_decay + jl * 16, (bf16*)(ws + WS_Y), bid, tid); }
            SEAM(pb + 3);
        }
        if (IN(pb + 4)) REP(4) { SITE;
            pg8::DenseOrder<T / 256, D / 256> S{bid, (const char*)(ws + WS_Y), (const char*)(ws + (odd ? WS_WOUT_O : WS_WOUT_E)) + (size_t)jl * 1024 * 1024 * 2, nullptr};
            pg8::EpiOut E{(L == 0) ? ap->p.x : (const float*)(ws + WS_X), (float*)(ws + WS_U)}; pg8::gemm_phase<pg8::EpiOut, pg8::DenseOrder<T / 256, D / 256>>(lds, S, E, tid);
        }
        SEAM(pb + 4);
        if (IN(pb + 5)) REP(5) { SITE; phase_ln1_router_mfma(lds, (const float*)(ws + WS_U), ap->p.ln_g + (size_t)(L * 2) * D, ap->p.ln_b + (size_t)(L * 2) * D, (const bf16*)(ws + WS_RWT) + (size_t)L * 2 * NEXP * D, ap->p.router_b + L * NEXP,
                                         (float*)(ws + WS_X1), (bf16*)(ws + WS_X1B), (bf16*)(ws + WS_X1LO), (int*)(ws + WS_TOPE), (float*)(ws + WS_GATE), (int*)(ws + WS_LRANK), (int*)(ws + WS_CNT), bid, tid); }
        SEAM(pb + 5);
        if (IN(pb + 6)) REP(6) { SITE; phase_dispatch(lds, (const int*)(ws + WS_CNT), (const int*)(ws + WS_TOPE), (const int*)(ws + WS_LRANK), (int*)(ws + WS_SLOT), (int*)(ws + WS_TILES), (int*)(ws + WS_ROWIDX), bid, tid); }
        SEAM(pb + 6);
        if (IN(pb + 7)) REP(7) { SITE;
            LAS int* ltile = (LAS int*)(lds + MISC_OFF + 2048); const int* tiles = (const int*)(ws + WS_TILES);
            __syncthreads();
            for (int i = tid; i < 1 + MAXTILES; i += NTHR) ltile[i] = tiles[i];
            __syncthreads();
            pg8::GroupOrder<8, 0> S{(int)ltile[0], bid, (const char*)(ws + WS_X1B), (const char*)(ws + WS_WUP) + (size_t)L * 32 * 2048 * 1024 * 2, ltile + 1, (const int*)(ws + WS_ROWIDX), (unsigned*)(ws + WS_CTL), CW_MCNT + L * MAXTILES * 64, 0u};
            pg8::EpiUp E{(bf16*)(ws + WS_ACT), ap->p.b_up + (size_t)L * 32 * 2048}; pg8::gemm_phase<pg8::EpiUp, pg8::GroupOrder<8, 0>, true>(lds, S, E, tid);
        }
        SEAM(pb + 7);
        if (IN(pb + 8)) REP(8) { SITE;
            LAS int* ltile = (LAS int*)(lds + MISC_OFF + 2048); const int* tiles = (const int*)(ws + WS_TILES);
            __syncthreads();
            for (int i = tid; i < 1 + MAXTILES; i += NTHR) ltile[i] = tiles[i];
            __syncthreads();
            pg8::GroupOrder<4, 0> S{(int)ltile[0], bid, (const char*)(ws + WS_ACT), (const char*)(ws + WS_WDN) + (size_t)L * 32 * 1024 * 1024 * 2, ltile + 1, nullptr, (unsigned*)(ws + WS_CTL), CW_MCNT + L * MAXTILES * 64, 0u};
            pg8::EpiDown E{(bf16*)(ws + WS_OSLOT), ap->p.b_down + (size_t)L * 32 * 1024}; pg8::gemm_phase<pg8::EpiDown, pg8::GroupOrder<4, 0>>(lds, S, E, tid);
        }
        SEAM(pb + 8);
        if (IN(pb + 9)) REP(9) { SITE; phase_combine_ln2((const float*)(ws + WS_X1), (const bf16*)(ws + WS_OSLOT), (const int*)(ws + WS_SLOT), (const float*)(ws + WS_GATE), ap->p.ln_g + (size_t)(L * 2 + 1) * D, ap->p.ln_b + (size_t)(L * 2 + 1) * D,
                                          (L == DEPTH - 1) ? ap->p.out : (float*)(ws + WS_X), (L == DEPTH - 1) ? (bf16*)nullptr : (bf16*)(ws + WS_XB), bid, tid); }
        SEAM(pb + 9);
    }
#undef IN
#undef SEAM
#undef SITE
}

extern "C" void kernel_launch(void* const* d_in, const int* in_sizes, int n_in, void* d_out, int out_size, void* d_ws, size_t ws_size, hipStream_t stream) {
    static int ready = 0;
    if (ready == 0) {
        if (n_in != 15 || in_sizes[0] != T * D || out_size != T * D || ws_size < WS_END) {
            fprintf(stderr, "kernel_launch: unexpected problem (n_in %d, in0 %d, out %d, ws %zu); nothing launched\n", n_in, n_in > 0 ? in_sizes[0] : -1, out_size, ws_size); ready = -1; return; }
        if (hipFuncSetAttribute((const void*)fwd_kernel, hipFuncAttributeMaxDynamicSharedMemorySize, LDS_BYTES) != hipSuccess) { fprintf(stderr, "kernel_launch: hipFuncSetAttribute failed\n"); ready = -1; return; }
        int per_cu = 0;
        if (hipOccupancyMaxActiveBlocksPerMultiprocessor(&per_cu, (const void*)fwd_kernel, NTHR, LDS_BYTES) != hipSuccess || per_cu < 1) fprintf(stderr, "kernel_launch: occupancy query reports %d workgroups per CU\n", per_cu);
        (void)hipGetLastError();
        ready = 1;
    }
    if (ready < 0) return;
    (void)hipMemsetAsync((char*)d_ws + WS_CTL, 0, CTL_ZERO_BYTES, stream);
    Args a{};
    a.p.x = (const float*)d_in[0]; a.p.ab_w_in = (const float*)d_in[1]; a.p.ab_w_out = (const float*)d_in[2]; a.p.ret_decay = (const float*)d_in[3];
    a.p.c_w_in = (const float*)d_in[4]; a.p.c_w_out = (const float*)d_in[5]; a.p.c_rpb = (const float*)d_in[6]; a.p.ln_g = (const float*)d_in[7]; a.p.ln_b = (const float*)d_in[8];
    a.p.router_w = (const float*)d_in[9]; a.p.router_b = (const float*)d_in[10]; a.p.w_up = (const float*)d_in[11]; a.p.b_up = (const float*)d_in[12]; a.p.w_down = (const float*)d_in[13]; a.p.b_down = (const float*)d_in[14];
    a.p.out = (float*)d_out; a.p.ws = (unsigned char*)d_ws;
#if N_LAUNCH_MODE == 0
    a.ph_lo = 0; a.ph_hi = N_PHASES;
    hipLaunchKernelGGL(fwd_kernel, dim3(GRID), dim3(NTHR), LDS_BYTES, stream, a);
#else
    for (int ph = 0; ph < N_PHASES; ++ph) {
        if (ph >= 1) { const int L = (ph - 1) / NPH, p = (ph - 1) % NPH; if ((L & 1) && (p == 2 || p == 3)) continue; }
        a.ph_lo = ph; a.ph_hi = ph + 1;
        hipLaunchKernelGGL(fwd_kernel, dim3(GRID), dim3(NTHR), LDS_BYTES, stream, a);
    }
#endif
}
```
